# Optimizing an MI355X kernel written in HIP

```python
import jax, jax.numpy as jnp
from jax import lax
import numpy as np

D_MODEL = 1024
BATCH = 4
SEQ = 4096
DEPTH = 2

GRID_W = 64
CTX_LEN = 256
D_MIX = D_MODEL
N_GROUPS = 4
D_GROUP = D_MIX // N_GROUPS
CONV_WIDTH = 31
FNET_HEADS = 4
FNET_HEAD_DIM = D_GROUP // FNET_HEADS
NA_HEADS = 4
NA_HEAD_DIM = D_GROUP // NA_HEADS
NA_WIN_ROWS = 8
NA_WIN_COLS = 16
NA_QBLOCK_COLS = 16
NA_KBLOCK_COLS = NA_QBLOCK_COLS + NA_WIN_COLS
SSM_GROUP_CH = 16
SSM_GROUPS = D_GROUP // SSM_GROUP_CH
SSM_STATE = 64
D_FF = 4 * D_MODEL
EPS = 1e-6
COLS_CONV = 2 * D_GROUP
COLS_FNET = D_GROUP
COLS_NA = 3 * D_GROUP
COLS_SSM = D_GROUP
IN_COLS = COLS_CONV + COLS_FNET + COLS_NA + COLS_SSM

kernel_name = "hybrid_parallel_group_dit_block"


def rmsnorm(x, g):
    xf = x.astype(jnp.float32)
    y = xf * lax.rsqrt(jnp.mean(xf * xf, axis=-1, keepdims=True) + EPS)
    return (y * g.astype(jnp.float32)).astype(x.dtype)


def layernorm(x, g, b):
    xf = x.astype(jnp.float32)
    mu = jnp.mean(xf, axis=-1, keepdims=True)
    var = jnp.mean(jnp.square(xf - mu), axis=-1, keepdims=True)
    y = (xf - mu) * lax.rsqrt(var + EPS)
    return (y * g.astype(jnp.float32) + b.astype(jnp.float32)).astype(x.dtype)


def modulate(h, shift, scale):
    return h * (1 + scale) + shift


def group_rmsnorm(y, g):
    shp = y.shape
    yf = y.astype(jnp.float32).reshape(shp[:-1] + (N_GROUPS, D_GROUP))
    yf = yf * lax.rsqrt(jnp.mean(yf * yf, axis=-1, keepdims=True) + EPS)
    return (yf.reshape(shp) * g.astype(jnp.float32)).astype(y.dtype)


def split_cols(p):
    o1 = COLS_CONV
    o2 = o1 + COLS_FNET
    o3 = o2 + COLS_NA
    return p[..., :o1], p[..., o1:o2], p[..., o2:o3], p[..., o3:]


def conformer_conv(u, w_dw, b_dw, ln_g, ln_b, w_pw, b_pw):
    a, g = jnp.split(u, 2, axis=-1)
    v = a * jax.nn.sigmoid(g)
    v = lax.conv_general_dilated(
        v, w_dw[:, None, :], window_strides=(1,),
        padding=[(CONV_WIDTH // 2, CONV_WIDTH // 2)],
        dimension_numbers=("NWC", "WIO", "NWC"),
        feature_group_count=D_GROUP) + b_dw
    v = jax.nn.silu(layernorm(v, ln_g, ln_b))
    return v @ w_pw + b_pw


def fourier_mix(u, w_f, b_f):
    bsz, L, _ = u.shape
    uh = u.astype(jnp.float32).reshape(bsz, L, FNET_HEADS, FNET_HEAD_DIM)
    f = jnp.fft.fftn(uh, axes=(1, 3), norm="ortho").real
    return f.reshape(bsz, L, D_GROUP).astype(u.dtype) @ w_f + b_f


def neighbourhood_attention(q, k, v, kc, vc, rpb):
    bsz, L = q.shape[0], q.shape[1]
    rows = L // GRID_W
    wr = min(NA_WIN_ROWS, rows)
    ncb = GRID_W // NA_QBLOCK_COLS
    scale = NA_HEAD_DIM ** -0.5
    grid = lambda t: t.reshape(bsz, rows, GRID_W, NA_HEADS, NA_HEAD_DIM)
    qg, kg, vg = grid(q), grid(k), grid(v)
    r = jnp.arange(rows)
    row_start = jnp.clip(r - wr // 2, 0, rows - wr)
    row_idx = row_start[:, None] + jnp.arange(wr)
    j = jnp.arange(ncb)
    kcol_start = jnp.clip(j * NA_QBLOCK_COLS - NA_WIN_COLS // 2, 0, GRID_W - NA_KBLOCK_COLS)
    col_idx = kcol_start[:, None] + jnp.arange(NA_KBLOCK_COLS)
    row_sel = row_idx[:, None, :, None]
    col_sel = col_idx[None, :, None, :]
    kb = kg[:, row_sel, col_sel]
    vb = vg[:, row_sel, col_sel]
    qb = qg.reshape(bsz, rows, ncb, NA_QBLOCK_COLS, NA_HEADS, NA_HEAD_DIM)
    qcol = j[:, None] * NA_QBLOCK_COLS + jnp.arange(NA_QBLOCK_COLS)
    cstart = jnp.clip(qcol - NA_WIN_COLS // 2, 0, GRID_W - NA_WIN_COLS)
    kcol = col_idx[:, None, :]
    in_win = (kcol >= cstart[:, :, None]) & (kcol < cstart[:, :, None] + NA_WIN_COLS)
    dr = row_idx - r[:, None] + (NA_WIN_ROWS - 1)
    dc = jnp.clip(kcol - qcol[:, :, None] + (NA_WIN_COLS - 1), 0, 2 * NA_WIN_COLS - 2)
    bias = rpb[:, dr[:, None, None, :, None], dc[None, :, :, None, :]]
    s_loc = jnp.einsum("brjqhd,brjikhd->bhrjqik", qb, kb,
                       preferred_element_type=jnp.float32) * scale
    s_loc = s_loc + bias[None].astype(jnp.float32)
    s_loc = jnp.where(in_win[:, :, None, :], s_loc, jnp.float32(-1e30))
    s_ctx = jnp.einsum("brjqhd,bchd->bhrjqc", qb, kc,
                       preferred_element_type=jnp.float32) * scale
    n_loc = wr * NA_KBLOCK_COLS
    s = jnp.concatenate([s_loc.reshape(s_loc.shape[:5] + (n_loc,)), s_ctx], axis=-1)
    p = jax.nn.softmax(s, axis=-1).astype(v.dtype)
    p_loc = p[..., :n_loc].reshape(s_loc.shape)
    p_ctx = p[..., n_loc:]
    out = (jnp.einsum("bhrjqik,brjikhd->brjqhd", p_loc, vb)
           + jnp.einsum("bhrjqc,bchd->brjqhd", p_ctx, vc))
    return out.reshape(bsz, L, D_GROUP)


def context_attention(q, k, v):
    s = jnp.einsum("bqhd,bkhd->bhqk", q, k, preferred_element_type=jnp.float32) * NA_HEAD_DIM ** -0.5
    p = jax.nn.softmax(s, axis=-1).astype(v.dtype)
    out = jnp.einsum("bhqk,bkhd->bqhd", p, v)
    return out.reshape(q.shape[0], q.shape[1], D_GROUP)


def _scan_op(e1, e2):
    a1, b1 = e1
    a2, b2 = e2
    return a1 * a2, a2 * b1 + b2


def diag_scan(a_bar, bu, reverse):
    a = jnp.broadcast_to(a_bar, bu.shape)
    _, h = lax.associative_scan(_scan_op, (a, bu), axis=1, reverse=reverse)
    return h


def s5_bidirectional(u_x, u_c, a_re, a_im, log_dt, b_re, b_im, c_re, c_im, d_skip,
                     w_glu, b_glu, with_ctx_out):
    f32 = jnp.float32
    bsz, L, _ = u_x.shape
    n_ctx = u_c.shape[1]
    ux = u_x.astype(f32).reshape(bsz, L, SSM_GROUPS, SSM_GROUP_CH)
    uc = u_c.astype(f32).reshape(bsz, n_ctx, SSM_GROUPS, SSM_GROUP_CH)
    d = d_skip.astype(f32).reshape(SSM_GROUPS, SSM_GROUP_CH)
    uxc = ux.astype(jnp.complex64)
    ucc = uc.astype(jnp.complex64)
    y_x = d * ux
    y_c = d * uc
    for dirn, reverse in ((0, False), (1, True)):
        lam = lax.complex(a_re[dirn].astype(f32), a_im[dirn].astype(f32))
        dt = jnp.exp(log_dt[dirn].astype(f32))[:, None]
        a_bar = jnp.exp(lam * dt)
        b_bar = ((a_bar - 1) / lam)[..., None] * lax.complex(
            b_re[dirn].astype(f32), b_im[dirn].astype(f32))
        c_mat = lax.complex(c_re[dirn].astype(f32), c_im[dirn].astype(f32))
        h_c = diag_scan(a_bar, jnp.einsum("blgm,gpm->blgp", ucc, b_bar), reverse)
        h0 = h_c[:, 0] if reverse else h_c[:, -1]
        bu_x = jnp.einsum("blgm,gpm->blgp", uxc, b_bar)
        edge = -1 if reverse else 0
        bu_x = bu_x.at[:, edge].add(a_bar * h0)
        h_x = diag_scan(a_bar, bu_x, reverse)
        y_x = y_x + jnp.einsum("blgp,gmp->blgm", h_x, c_mat).real
        if with_ctx_out:
            y_c = y_c + jnp.einsum("blgp,gmp->blgm", h_c, c_mat).real

    def glu(y):
        z = y.reshape(y.shape[0], y.shape[1], D_GROUP).astype(u_x.dtype) @ w_glu + b_glu
        a, g = jnp.split(z, 2, axis=-1)
        return a * jax.nn.sigmoid(g)

    return glu(y_x), (glu(y_c) if with_ctx_out else None)


def squared_relu_mlp(h, w1, b1, w2, b2):
    return jnp.square(jax.nn.relu(h @ w1 + b1)) @ w2 + b2


def setup_inputs(seed: int = 0) -> dict:
    key = jax.random.key(seed)
    ks = iter(jax.random.split(key, 48))
    nrm = lambda shape, s: s * jax.random.normal(next(ks), shape, jnp.float32)
    Ld = DEPTH
    G, P, M = SSM_GROUPS, SSM_STATE, SSM_GROUP_CH
    n = jnp.arange(P, dtype=jnp.float32)
    return {
        "x": nrm((BATCH, SEQ, D_MODEL), 1.0),
        "c": nrm((BATCH, D_MODEL), 1.0),
        "ctx": nrm((BATCH, CTX_LEN, D_MODEL), 1.0),
        "c_ctx": nrm((D_MODEL,), 1.0),
        "w_mod": nrm((Ld, D_MODEL, 6 * D_MODEL), D_MODEL ** -0.5),
        "b_mod": nrm((Ld, 6 * D_MODEL), 0.02),
        "g_norm_mix": 1.0 + nrm((Ld, D_MODEL), 0.02),
        "w_in": nrm((Ld, D_MODEL, IN_COLS), D_MODEL ** -0.5),
        "conv_w_dw": nrm((Ld, CONV_WIDTH, D_GROUP), CONV_WIDTH ** -0.5),
        "conv_b_dw": nrm((Ld, D_GROUP), 0.02),
        "conv_ln_g": 1.0 + nrm((Ld, D_GROUP), 0.02),
        "conv_ln_b": nrm((Ld, D_GROUP), 0.02),
        "conv_w_pw": nrm((Ld, D_GROUP, D_GROUP), D_GROUP ** -0.5),
        "conv_b_pw": nrm((Ld, D_GROUP), 0.02),
        "fnet_w": nrm((Ld, D_GROUP, D_GROUP), D_GROUP ** -0.5),
        "fnet_b": nrm((Ld, D_GROUP), 0.02),
        "na_rpb": nrm((Ld, NA_HEADS, 2 * NA_WIN_ROWS - 1, 2 * NA_WIN_COLS - 1), 0.1),
        "ssm_a_re": -0.5 + nrm((Ld, 2, G, P), 0.01),
        "ssm_a_im": jnp.pi * n + nrm((Ld, 2, G, P), 0.01),
        "ssm_log_dt": jax.random.uniform(next(ks), (Ld, 2, G), jnp.float32,
                                         minval=float(np.log(1e-3)), maxval=float(np.log(1e-1))),
        "ssm_b_re": nrm((Ld, 2, G, P, M), (2 * M) ** -0.5),
        "ssm_b_im": nrm((Ld, 2, G, P, M), (2 * M) ** -0.5),
        "ssm_c_re": nrm((Ld, 2, G, M, P), P ** -0.5),
        "ssm_c_im": nrm((Ld, 2, G, M, P), P ** -0.5),
        "ssm_d": nrm((Ld, D_GROUP), 0.5),
        "ssm_w_glu": nrm((Ld, D_GROUP, 2 * D_GROUP), D_GROUP ** -0.5),
        "ssm_b_glu": nrm((Ld, 2 * D_GROUP), 0.02),
        "g_group": 1.0 + nrm((Ld, D_MIX), 0.02),
        "w_out": nrm((Ld, D_MIX, D_MODEL), D_MIX ** -0.5),
        "b_out": nrm((Ld, D_MODEL), 0.02),
        "g_norm_mlp": 1.0 + nrm((Ld, D_MODEL), 0.02),
        "w_ff1": nrm((Ld, D_MODEL, D_FF), D_MODEL ** -0.5),
        "b_ff1": nrm((Ld, D_FF), 0.02),
        "w_ff2": nrm((Ld, D_FF, D_MODEL), D_FF ** -0.5),
        "b_ff2": nrm((Ld, D_MODEL), 0.02),
        "g_final": 1.0 + nrm((D_MODEL,), 0.02),
    }


def reference(x, c, ctx, c_ctx, w_mod, b_mod, g_norm_mix, w_in,
              conv_w_dw, conv_b_dw, conv_ln_g, conv_ln_b, conv_w_pw, conv_b_pw,
              fnet_w, fnet_b, na_rpb,
              ssm_a_re, ssm_a_im, ssm_log_dt, ssm_b_re, ssm_b_im, ssm_c_re, ssm_c_im,
              ssm_d, ssm_w_glu, ssm_b_glu,
              g_group, w_out, b_out, g_norm_mlp, w_ff1, b_ff1, w_ff2, b_ff2, g_final):
    bsz, L, _ = x.shape
    n_ctx = ctx.shape[1]
    for l in range(DEPTH):
        ctx_out = l < DEPTH - 1
        mod_x = jax.nn.silu(c) @ w_mod[l] + b_mod[l]
        mod_c = jax.nn.silu(c_ctx) @ w_mod[l] + b_mod[l]
        sh1, sc1, gt1, sh2, sc2, gt2 = jnp.split(mod_x[:, None, :], 6, axis=-1)
        ch1, cc1, cg1, ch2, cc2, cg2 = jnp.split(mod_c, 6)

        px = modulate(rmsnorm(x, g_norm_mix[l]), sh1, sc1) @ w_in[l]
        pc = modulate(rmsnorm(ctx, g_norm_mix[l]), ch1, cc1) @ w_in[l]
        conv_x, fnet_x, qkv_x, ssm_x = split_cols(px)
        conv_c, fnet_c, qkv_c, ssm_c = split_cols(pc)
        qkv_x = qkv_x.reshape(bsz, L, 3, NA_HEADS, NA_HEAD_DIM)
        qkv_c = qkv_c.reshape(bsz, n_ctx, 3, NA_HEADS, NA_HEAD_DIM)

        y_conv_x = conformer_conv(conv_x, conv_w_dw[l], conv_b_dw[l], conv_ln_g[l],
                                  conv_ln_b[l], conv_w_pw[l], conv_b_pw[l])
        y_fnet_x = fourier_mix(fnet_x, fnet_w[l], fnet_b[l])
        y_na_x = neighbourhood_attention(qkv_x[:, :, 0], qkv_x[:, :, 1], qkv_x[:, :, 2],
                                         qkv_c[:, :, 1], qkv_c[:, :, 2], na_rpb[l])
        y_ssm_x, y_ssm_c = s5_bidirectional(
            ssm_x, ssm_c, ssm_a_re[l], ssm_a_im[l], ssm_log_dt[l], ssm_b_re[l], ssm_b_im[l],
            ssm_c_re[l], ssm_c_im[l], ssm_d[l], ssm_w_glu[l], ssm_b_glu[l], ctx_out)
        mix_x = jnp.concatenate([y_conv_x, y_fnet_x, y_na_x, y_ssm_x], axis=-1)
        out_x = group_rmsnorm(mix_x, g_group[l]) @ w_out[l] + b_out[l]
        x_mid = x + gt1 * out_x

        if ctx_out:
            y_conv_c = conformer_conv(conv_c, conv_w_dw[l], conv_b_dw[l], conv_ln_g[l],
                                      conv_ln_b[l], conv_w_pw[l], conv_b_pw[l])
            y_fnet_c = fourier_mix(fnet_c, fnet_w[l], fnet_b[l])
            y_na_c = context_attention(qkv_c[:, :, 0], qkv_c[:, :, 1], qkv_c[:, :, 2])
            mix_c = jnp.concatenate([y_conv_c, y_fnet_c, y_na_c, y_ssm_c], axis=-1)
            out_c = group_rmsnorm(mix_c, g_group[l]) @ w_out[l] + b_out[l]
            ctx_mid = ctx + cg1 * out_c

        hx = modulate(rmsnorm(x_mid, g_norm_mlp[l]), sh2, sc2)
        x = x_mid + gt2 * squared_relu_mlp(hx, w_ff1[l], b_ff1[l], w_ff2[l], b_ff2[l])
        if ctx_out:
            hc = modulate(rmsnorm(ctx_mid, g_norm_mlp[l]), ch2, cc2)
            ctx = ctx_mid + cg2 * squared_relu_mlp(hc, w_ff1[l], b_ff1[l], w_ff2[l], b_ff2[l])
    return rmsnorm(x, g_final)
```

```cpp
#include <hip/hip_runtime.h>
#include <hip/hip_cooperative_groups.h>
#include <cstdio>
#include <cstdint>
namespace cg = cooperative_groups;
#ifndef MODE_COOP
#define MODE_COOP 0
#endif
namespace pg8 {
#define PG8_LAS __attribute__((address_space(3)))
typedef unsigned short bf16_t;
typedef short bf16x8 __attribute__((ext_vector_type(8)));
typedef float f32x4 __attribute__((ext_vector_type(4)));
typedef unsigned u32x4 __attribute__((ext_vector_type(4)));
constexpr int BM = 256, BK = 64, HALF = 128, HTB = HALF * BK * 2  , STAGE_BYTES = 8 * HTB, NXCD = 8, WGM = 8;

__host__ __device__ __forceinline__ int lds_byte(int r, int c) { const int st = (r >> 4) * 2 + (c >> 5), rr = r & 15, cc = c & 31, ob = rr * 64 + cc * 2; return st * 1024 + (ob ^ (((ob >> 9) & 1) << 5)); }
__host__ __device__ __forceinline__ void stage_rc(int b, int& R, int& C) { const int st = b / 1024, sb = b % 1024, swz = sb ^ (((sb >> 9) & 1) << 5); R = (st >> 1) * 16 + swz / 64; C = (st & 1) * 32 + (swz % 64) / 2; }
__host__ __device__ __forceinline__ int perm32(int rho) { const int n = rho >> 4, i = rho & 15; return 8 * (i >> 2) + 4 * n + (i & 3); }

struct Unit { int pm, pn; };
struct Gemm { const bf16_t* A; const bf16_t* Bt; int M, N, K; };

struct StaticOrder {
    int nM, nN, nwg, G, c;
    __host__ __device__ void init(int M, int N, int G_, int c_) { nM = M / BM; nN = N / BM; nwg = nM * nN; G = G_; c = c_; }
    __host__ __device__ bool next(int i, Unit& u) const {
        const long L = (long)i * G + c; if (L >= nwg) return false;
        int wgid = (int)L; { const int q = nwg / NXCD, r = nwg % NXCD, xcd = wgid % NXCD, off = wgid / NXCD; wgid = (xcd < r ? xcd * (q + 1) : r * (q + 1) + (xcd - r) * q) + off; }
        const int nig = WGM * nN, gid = wgid / nig, fm = gid * WGM, gsz = (nM - fm) < WGM ? (nM - fm) : WGM;
        u.pm = fm + ((wgid % nig) % gsz); u.pn = (wgid % nig) / gsz; return true;
    }
    __device__ __forceinline__ void a_ready(const Unit&) const {}
    __device__ __forceinline__ void done(const Unit&) const {}
};

}
namespace pg8 {
template <class Epi, class Sched, bool ALIGN_EPI = false, bool SP2 = false>
__device__ __forceinline__ void gemm_phase(PG8_LAS unsigned char* lds, const Gemm g, const Sched& S, const Epi& E) {
    const int tid = threadIdx.x, wid = __builtin_amdgcn_readfirstlane(tid >> 6), lane = tid & 63, wr = wid >> 2, wc = wid & 3, fr = lane & 15, fq = lane >> 4;
    const int K = g.K, nt = K / BK;
    unsigned voffA[2], voffB[2];
#pragma unroll
    for (int i = 0; i < 2; ++i) { int R, C; stage_rc(tid * 16 + i * 8192, R, C); const int Rb = Epi::PERM ? ((R & ~31) + perm32(R & 31)) : R;
        voffA[i] = (unsigned)(R * K + C) * 2u; voffB[i] = (unsigned)(Rb * K + C) * 2u; }
    const size_t kstep = (size_t)(BK * 2);
    const size_t hstep = (size_t)HALF * K * 2;
    const size_t tstep = 2 * hstep;
    const unsigned ldsw = (unsigned)wid * 1024u;
    const int aoff = lds_byte(wr * 64 + fr, fq * 8), boff = lds_byte(wc * 32 + fr, fq * 8);
#define PG8_SA(b, h) (((b) * 2 + (h)) * HTB)
#define PG8_SB(b, h) ((4 + (b) * 2 + (h)) * HTB)
#define PG8_STAGE(bufoff, gbase, voff) do { _Pragma("unroll") for (int _i = 0; _i < 2; ++_i) \
        __builtin_amdgcn_global_load_lds((const unsigned*)((const char*)(gbase) + (voff)[_i]), (PG8_LAS unsigned*)(lds + (bufoff) + ldsw + _i * 8192), 16, 0, 0); } while (0)
#define PG8_LDA(dst, b, h) do { _Pragma("unroll") for (int m = 0; m < 4; ++m) _Pragma("unroll") for (int k = 0; k < 2; ++k) dst[m][k] = *(const PG8_LAS bf16x8*)(lds + PG8_SA(b, h) + aoff + m * 2048 + k * 1024); } while (0)
#define PG8_LDB(dst, b, h) do { _Pragma("unroll") for (int n = 0; n < 2; ++n) _Pragma("unroll") for (int k = 0; k < 2; ++k) dst[n][k] = *(const PG8_LAS bf16x8*)(lds + PG8_SB(b, h) + boff + n * 2048 + k * 1024); } while (0)
#define PG8_MMA(ai, bj, At, Bt) do { __builtin_amdgcn_s_setprio(1); _Pragma("unroll") for (int m = 0; m < 4; ++m) _Pragma("unroll") for (int n = 0; n < 2; ++n) _Pragma("unroll") for (int k = 0; k < 2; ++k) \
        acc[ai][bj][m][n] = __builtin_amdgcn_mfma_f32_16x16x32_bf16(Bt[n][k], At[m][k], acc[ai][bj][m][n], 0, 0, 0); __builtin_amdgcn_s_setprio(0); } while (0)
#define PG8_WAIT_V(n) asm volatile("s_waitcnt vmcnt(" #n ")" ::: "memory")
#define PG8_WAIT_L(n) asm volatile("s_waitcnt lgkmcnt(" #n ")" ::: "memory")
#define PG8_BAR __builtin_amdgcn_s_barrier()
#define PG8_SCHED __builtin_amdgcn_sched_barrier(0)
    Unit cur, nxt; int ui = 0;
    if (!S.next(0, cur)) return;
    f32x4 acc[2][2][4][2];
#pragma unroll
    for (int a = 0; a < 2; ++a)
#pragma unroll
        for (int b = 0; b < 2; ++b)
#pragma unroll
            for (int m = 0; m < 4; ++m)
#pragma unroll
                for (int n = 0; n < 2; ++n) acc[a][b][m][n] = (f32x4){0.f, 0.f, 0.f, 0.f};
    bf16x8 At[4][2], B0[2][2], B1[2][2];
    const char* cA = (const char*)g.A + (size_t)cur.pm * tstep; const char* cB = (const char*)g.Bt + (size_t)cur.pn * tstep;
    S.a_ready(cur);
    if constexpr (SP2) {
        PG8_STAGE(PG8_SB(0, 0), cB, voffB); PG8_STAGE(PG8_SB(0, 1), cB + hstep, voffB); PG8_STAGE(PG8_SA(0, 0), cA, voffA); PG8_STAGE(PG8_SA(0, 1), cA + hstep, voffA);
        if (wr == 1) PG8_BAR;
        PG8_WAIT_V(2); PG8_BAR;
        PG8_STAGE(PG8_SB(1, 0), cB + kstep, voffB); PG8_STAGE(PG8_SA(1, 0), cA + kstep, voffA); PG8_STAGE(PG8_SB(1, 1), cB + hstep + kstep, voffB);
        PG8_WAIT_V(6); PG8_BAR;
    } else {
        PG8_STAGE(PG8_SB(0, 0), cB, voffB); PG8_STAGE(PG8_SA(0, 0), cA, voffA); PG8_STAGE(PG8_SB(0, 1), cB + hstep, voffB); PG8_STAGE(PG8_SA(0, 1), cA + hstep, voffA);
        if (wr == 1) PG8_BAR;
        PG8_WAIT_V(4); PG8_BAR;
        PG8_STAGE(PG8_SB(1, 0), cB + kstep, voffB); PG8_STAGE(PG8_SA(1, 0), cA + kstep, voffA); PG8_STAGE(PG8_SB(1, 1), cB + hstep + kstep, voffB);
        PG8_WAIT_V(6); PG8_BAR;
    }
    for (;;) {
        const bool has_next = S.next(ui + 1, nxt);
        const char* nA = has_next ? (const char*)g.A + (size_t)nxt.pm * tstep : cA; const char* nB = has_next ? (const char*)g.Bt + (size_t)nxt.pn * tstep : cB;
        for (int t = 0; t < nt; t += 2) {
            const bool last = (t == nt - 2);
            const char* a1 = cA + (size_t)(t + 1) * kstep;
            const char* a2 = last ? nA : cA + (size_t)(t + 2) * kstep; const char* b2 = last ? nB : cB + (size_t)(t + 2) * kstep;
            const char* a3 = a2 + kstep; const char* b3 = b2 + kstep;
            if (last && has_next) S.a_ready(nxt);
            if constexpr (SP2) {
            PG8_LDB(B0, 0, 0); PG8_LDB(B1, 0, 1); PG8_SCHED; PG8_LDA(At, 0, 0); PG8_STAGE(PG8_SA(1, 1), a1 + hstep, voffA);
            PG8_WAIT_V(8); PG8_WAIT_L(0); PG8_BAR; PG8_MMA(0, 0, At, B0); PG8_MMA(0, 1, At, B1); PG8_BAR; PG8_SCHED;
            PG8_LDA(At, 0, 1); PG8_STAGE(PG8_SB(0, 0), b2, voffB); PG8_STAGE(PG8_SB(0, 1), b2 + hstep, voffB); PG8_STAGE(PG8_SA(0, 0), a2, voffA);
            PG8_WAIT_V(8); PG8_WAIT_L(0); PG8_BAR; PG8_MMA(1, 0, At, B0); PG8_MMA(1, 1, At, B1); PG8_BAR; PG8_SCHED;
            PG8_LDB(B0, 1, 0); PG8_LDB(B1, 1, 1); PG8_SCHED; PG8_LDA(At, 1, 0); PG8_STAGE(PG8_SA(0, 1), a2 + hstep, voffA);
            PG8_WAIT_V(8); PG8_WAIT_L(0); PG8_BAR; PG8_MMA(0, 0, At, B0); PG8_MMA(0, 1, At, B1); PG8_BAR; PG8_SCHED;
            PG8_LDA(At, 1, 1); PG8_STAGE(PG8_SB(1, 0), b3, voffB); PG8_STAGE(PG8_SB(1, 1), b3 + hstep, voffB); PG8_STAGE(PG8_SA(1, 0), a3, voffA);
            PG8_WAIT_V(8); PG8_WAIT_L(0); PG8_BAR; PG8_MMA(1, 0, At, B0); PG8_MMA(1, 1, At, B1); PG8_BAR; PG8_SCHED;
            } else {
            PG8_LDB(B0, 0, 0); PG8_SCHED; PG8_LDA(At, 0, 0); PG8_STAGE(PG8_SA(1, 1), a1 + hstep, voffA);
            PG8_WAIT_L(8); PG8_BAR; PG8_WAIT_L(0); PG8_MMA(0, 0, At, B0); PG8_BAR; PG8_SCHED;
            PG8_LDB(B1, 0, 1); PG8_STAGE(PG8_SB(0, 0), b2, voffB);
            PG8_BAR; PG8_WAIT_L(0); PG8_MMA(0, 1, At, B1); PG8_BAR;
            PG8_LDA(At, 0, 1); PG8_STAGE(PG8_SA(0, 0), a2, voffA);
            PG8_BAR; PG8_WAIT_L(0); PG8_MMA(1, 0, At, B0); PG8_BAR; PG8_SCHED;
            PG8_STAGE(PG8_SB(0, 1), b2 + hstep, voffB);
            PG8_WAIT_V(6); PG8_BAR; PG8_MMA(1, 1, At, B1); PG8_BAR;
            PG8_LDB(B0, 1, 0); PG8_SCHED; PG8_LDA(At, 1, 0); PG8_STAGE(PG8_SA(0, 1), a2 + hstep, voffA);
            PG8_WAIT_L(8); PG8_BAR; PG8_WAIT_L(0); PG8_MMA(0, 0, At, B0); PG8_BAR; PG8_SCHED;
            PG8_LDB(B1, 1, 1); PG8_STAGE(PG8_SB(1, 0), b3, voffB);
            PG8_BAR; PG8_WAIT_L(0); PG8_MMA(0, 1, At, B1); PG8_BAR;
            PG8_LDA(At, 1, 1); PG8_STAGE(PG8_SA(1, 0), a3, voffA);
            PG8_BAR; PG8_WAIT_L(0); PG8_MMA(1, 0, At, B0); PG8_BAR; PG8_SCHED;
            PG8_STAGE(PG8_SB(1, 1), b3 + hstep, voffB);
            PG8_WAIT_V(6); PG8_BAR; PG8_MMA(1, 1, At, B1); PG8_BAR;
            }
        }
        if constexpr (ALIGN_EPI) { if (wr == 0) PG8_BAR; }
        if constexpr (!Epi::AFTER_DRAIN) { E(acc, cur, wr, wc, fr, fq); S.done(cur); }
        if (!has_next) break;
#pragma unroll
        for (int a = 0; a < 2; ++a)
#pragma unroll
            for (int b = 0; b < 2; ++b)
#pragma unroll
                for (int m = 0; m < 4; ++m)
#pragma unroll
                    for (int n = 0; n < 2; ++n) acc[a][b][m][n] = (f32x4){0.f, 0.f, 0.f, 0.f};
        cur = nxt; cA = nA; cB = nB; ++ui;
        if constexpr (ALIGN_EPI) { if (wr == 1) PG8_BAR; }
    }
    PG8_WAIT_V(0);
    if constexpr (!ALIGN_EPI) { if (wr == 0) PG8_BAR; }
    PG8_BAR;
    if constexpr (Epi::AFTER_DRAIN) { E.fused(acc, cur, wr, wc, fr, fq, lds, wid, lane); S.done(cur); }
#undef PG8_SA
#undef PG8_SB
#undef PG8_STAGE
#undef PG8_LDA
#undef PG8_LDB
#undef PG8_MMA
#undef PG8_WAIT_V
#undef PG8_WAIT_L
#undef PG8_BAR
#undef PG8_SCHED
}
}

using pg8::bf16_t; using pg8::bf16x8; using pg8::f32x4;
#define LAS __attribute__((address_space(3)))
typedef short bf16x4 __attribute__((ext_vector_type(4)));
typedef unsigned u32x4 __attribute__((ext_vector_type(4)));
typedef unsigned u32x2 __attribute__((ext_vector_type(2)));

constexpr int NTHREADS = 512;
constexpr int T_ALL = 17408, NCTX = 1024, NLAT = 16384, DM = 1024, INC = 1792, FFD = 4096;
constexpr int LDS_BYTES = 147456;
constexpr float EPS = 1e-6f;

constexpr size_t MiB = 1u << 20;
constexpr size_t WS_MOD = 0;
constexpr size_t WS_CTAB = 256 * 1024;
constexpr size_t WS_STAB = 256 * 1024 + 8192;
constexpr size_t WS_PACK = 1 * MiB;
constexpr size_t WS_SLOC = 3 * MiB;
constexpr size_t WS_CARRY = 7 * MiB + 256 * 1024;
constexpr size_t WS_W = 12 * MiB;
constexpr size_t W_IN = 0, W_PW = W_IN + (size_t)INC * DM * 2, W_F = W_PW + 256 * 256 * 2, W_GLU = W_F + 256 * 256 * 2,
                 W_OUT = W_GLU + 512 * 256 * 2, W_1 = W_OUT + (size_t)DM * DM * 2, W_2 = W_1 + (size_t)FFD * DM * 2, W_LAYER = W_2 + (size_t)FFD * DM * 2;
static_assert(W_LAYER == 22 * MiB, "weights per layer");
constexpr size_t WS_XC = 56 * MiB;
constexpr size_t WS_XN = 60 * MiB;
constexpr size_t WS_BIG = 94 * MiB;
constexpr size_t WS_H = WS_BIG;
constexpr size_t WS_PX = WS_BIG;
constexpr size_t WS_VT = 154 * MiB;
constexpr size_t WS_VTC = 162 * MiB;
constexpr size_t WS_CV = 163 * MiB;
constexpr size_t WS_YB = 172 * MiB;
constexpr size_t WS_FN = 188 * MiB;
constexpr size_t WS_YS = 197 * MiB;
constexpr size_t WS_ZS = 206 * MiB;
constexpr size_t WS_MIX = 223 * MiB;
constexpr size_t WS_END = 256 * MiB;
static_assert(WS_H + (size_t)T_ALL * FFD * 2 <= WS_END && WS_MIX + (size_t)T_ALL * 768 * 2 <= WS_END && WS_PX + (size_t)T_ALL * INC * 2 <= WS_VT, "ws map");

__device__ __forceinline__ unsigned f2bf(float f) { unsigned u = __builtin_bit_cast(unsigned, f); return (u + 0x7fffu + ((u >> 16) & 1u)) >> 16; }
__device__ __forceinline__ unsigned pk2(float lo, float hi) { return f2bf(lo) | (f2bf(hi) << 16); }
__device__ __forceinline__ float bf2f(unsigned h) { return __builtin_bit_cast(float, (h & 0xffffu) << 16); }
__device__ __forceinline__ float bflo(unsigned w) { return __builtin_bit_cast(float, w << 16); }
__device__ __forceinline__ float bfhi(unsigned w) { return __builtin_bit_cast(float, w & 0xffff0000u); }
__device__ __forceinline__ bf16x8 pack8(f32x4 a, f32x4 b) {
    u32x4 w; w.x = pk2(a[0], a[1]); w.y = pk2(a[2], a[3]); w.z = pk2(b[0], b[1]); w.w = pk2(b[2], b[3]);
    return __builtin_bit_cast(bf16x8, w);
}
__device__ __forceinline__ bf16x8 neg8(bf16x8 v) { u32x4 w = __builtin_bit_cast(u32x4, v); w.x ^= 0x80008000u; w.y ^= 0x80008000u; w.z ^= 0x80008000u; w.w ^= 0x80008000u; return __builtin_bit_cast(bf16x8, w); }
__device__ __forceinline__ bf16x8 zero8() { u32x4 w = {0u, 0u, 0u, 0u}; return __builtin_bit_cast(bf16x8, w); }
__device__ __forceinline__ bf16x8 cat4(u32x2 a, u32x2 b) { u32x4 w; w.x = a.x; w.y = a.y; w.z = b.x; w.w = b.y; return __builtin_bit_cast(bf16x8, w); }
__device__ __forceinline__ f32x4 mfma16(bf16x8 a, bf16x8 b, f32x4 c) { return __builtin_amdgcn_mfma_f32_16x16x32_bf16(a, b, c, 0, 0, 0); }
__device__ __forceinline__ float wave_sum(float v) {
    v += __shfl_xor(v, 1); v += __shfl_xor(v, 2); v += __shfl_xor(v, 4); v += __shfl_xor(v, 8); v += __shfl_xor(v, 16); v += __shfl_xor(v, 32); return v;
}
__device__ __forceinline__ float sigmoidf_(float x) { return 1.0f / (1.0f + __expf(-x)); }
struct cplx { float re, im; };
__device__ __forceinline__ cplx cmul(cplx a, cplx b) { return cplx{a.re * b.re - a.im * b.im, a.re * b.im + a.im * b.re}; }
__device__ __forceinline__ cplx cmad(cplx acc, cplx a, cplx b) { return cplx{acc.re + a.re * b.re - a.im * b.im, acc.im + a.re * b.im + a.im * b.re}; }

struct Args { const float* in[36]; float* out; unsigned char* ws; int ph_lo, ph_hi; };
struct Frame {
    const Args& A;
    float* out; unsigned char* ws;
    int tid, lane, wave;
};
#define FP(off, type) ((type*)(F.ws + (off)))

constexpr int PK_N = 23;
constexpr int PK_IDX[PK_N] = {6,8,9,10,11,13,15,16,17,18,19,20,21,22,23,24,26,27,29,30,32,34,35};
constexpr int PK_CNT[PK_N] = {2048,15872,512,512,512,512,512,3720,4096,4096,64,65536,65536,65536,65536,512,1024,2048,2048,2048,8192,2048,1024};
constexpr int pk_off(int k) { int o = 0; for (int i = 0; i < PK_N; ++i) { if (PK_IDX[i] == k) return o; o += PK_CNT[i]; } return -1; }
#define PK(k) (FP(WS_PACK, float) + pk_off(k))
static_assert(pk_off(35) + 1024 <= (int)(2 * MiB / 4), "pack size");

struct EpiInProj {
    static constexpr bool PERM = false, AFTER_DRAIN = false;
    bf16_t* PX;
    __device__ __forceinline__ void operator()(const f32x4 (&acc)[2][2][4][2], const pg8::Unit& u, int wr, int wc, int fr, int fq) const {
        bf16_t* base = PX + (size_t)(u.pm * 256 + wr * 64 + fr) * INC + u.pn * 256 + wc * 32 + fq * 4;
#pragma unroll
        for (int ai = 0; ai < 2; ++ai)
#pragma unroll
            for (int m = 0; m < 4; ++m)
#pragma unroll
                for (int bj = 0; bj < 2; ++bj)
#pragma unroll
                    for (int n = 0; n < 2; ++n) {
                        const f32x4 v = acc[ai][bj][m][n];
                        u32x2 w; w.x = pk2(v[0], v[1]); w.y = pk2(v[2], v[3]);
                        *(u32x2*)(base + (size_t)(ai * 128 + m * 16) * INC + bj * 128 + n * 16) = w;
                    }
    }
};
struct EpiVT {
    static constexpr bool PERM = false, AFTER_DRAIN = false;
    bf16_t* VT; bf16_t* VTc;
    __device__ __forceinline__ void operator()(const f32x4 (&acc)[2][2][4][2], const pg8::Unit& u, int wr, int wc, int fr, int fq) const {
        bf16_t* base; int stride;
        if (u.pn < 4) { base = VTc + (size_t)u.pn * 256 * 256; stride = 256; }
        else { const int tt = u.pn - 4; base = VT + (size_t)(tt >> 4) * 256 * 4096 + (tt & 15) * 256; stride = 4096; }
        base += (size_t)(wr * 64 + fr) * stride + wc * 32 + fq * 4;
#pragma unroll
        for (int ai = 0; ai < 2; ++ai)
#pragma unroll
            for (int m = 0; m < 4; ++m)
#pragma unroll
                for (int bj = 0; bj < 2; ++bj)
#pragma unroll
                    for (int n = 0; n < 2; ++n) {
                        const f32x4 v = acc[ai][bj][m][n];
                        u32x2 w; w.x = pk2(v[0], v[1]); w.y = pk2(v[2], v[3]);
                        *(u32x2*)(base + (size_t)(ai * 128 + m * 16) * stride + bj * 128 + n * 16) = w;
                    }
    }
};
template <int ACT>
struct EpiBias {
    static constexpr bool PERM = false, AFTER_DRAIN = false;
    bf16_t* O; int ldc; int row0; int col0; const float* bias;
    __device__ __forceinline__ void operator()(const f32x4 (&acc)[2][2][4][2], const pg8::Unit& u, int wr, int wc, int fr, int fq) const {
        const int c0 = u.pn * 256 + wc * 32 + fq * 4;
        bf16_t* base = O + (size_t)(row0 + u.pm * 256 + wr * 64 + fr) * ldc + col0 + c0;
#pragma unroll
        for (int bj = 0; bj < 2; ++bj)
#pragma unroll
            for (int n = 0; n < 2; ++n) {
                const f32x4 bv = *(const f32x4*)(bias + c0 + bj * 128 + n * 16);
#pragma unroll
                for (int ai = 0; ai < 2; ++ai)
#pragma unroll
                    for (int m = 0; m < 4; ++m) {
                        f32x4 v = acc[ai][bj][m][n] + bv;
                        if (ACT == 1) {
#pragma unroll
                            for (int j = 0; j < 4; ++j) { const float r = fmaxf(v[j], 0.f); v[j] = r * r; }
                        }
                        u32x2 w; w.x = pk2(v[0], v[1]); w.y = pk2(v[2], v[3]);
                        *(u32x2*)(base + (size_t)(ai * 128 + m * 16) * ldc + bj * 128 + n * 16) = w;
                    }
            }
    }
};
struct EpiResid {
    static constexpr bool PERM = false, AFTER_DRAIN = false;
    const float* srcC; const float* srcL; float* dstC; float* dstL; const float* bias; const float* modl; int gate_off; int tile0;
    __device__ __forceinline__ void operator()(const f32x4 (&acc)[2][2][4][2], const pg8::Unit& u, int wr, int wc, int fr, int fq) const {
        const int gp = u.pm + tile0; const bool isc = gp < 4; const int lrow0 = isc ? gp * 256 : (gp - 4) * 256; const int br = isc ? 4 : ((gp - 4) >> 4);
        const float* s = (isc ? srcC : srcL) + (size_t)lrow0 * DM; float* d = (isc ? dstC : dstL) + (size_t)lrow0 * DM;
        const float* gate = modl + br * 6144 + gate_off;
#pragma unroll
        for (int bj = 0; bj < 2; ++bj)
#pragma unroll
            for (int n = 0; n < 2; ++n) {
                const int c = u.pn * 256 + bj * 128 + wc * 32 + n * 16 + fq * 4;
                const f32x4 bv = *(const f32x4*)(bias + c); const f32x4 gv = *(const f32x4*)(gate + c);
#pragma unroll
                for (int ai = 0; ai < 2; ++ai)
#pragma unroll
                    for (int m = 0; m < 4; ++m) {
                        const int r = ai * 128 + wr * 64 + m * 16 + fr;
                        const f32x4 xv = *(const f32x4*)(s + (size_t)r * DM + c);
                        *(f32x4*)(d + (size_t)r * DM + c) = xv + gv * (acc[ai][bj][m][n] + bv);
                    }
            }
    }
};

__device__ __forceinline__ void transpose_tile(const float* W, int K, int N, bf16_t* Wt, int tile, float* scr) {
    const int ntn = N >> 6; const int tk = tile / ntn, tn = tile - tk * ntn; const int k0 = tk * 64, n0 = tn * 64;
    const int tid = threadIdx.x;
    { const int n = tid & 63, kk = tid >> 6;
#pragma unroll
      for (int i = 0; i < 8; ++i) { const int k = kk + 8 * i; scr[k * 65 + n] = W[(size_t)(k0 + k) * N + n0 + n]; } }
    __syncthreads();
    { const int kp = tid & 31, nn = tid >> 5;
#pragma unroll
      for (int i = 0; i < 4; ++i) { const int n = nn + 16 * i; const unsigned v = pk2(scr[(2 * kp) * 65 + n], scr[(2 * kp + 1) * 65 + n]); *(unsigned*)(Wt + (size_t)(n0 + n) * K + k0 + 2 * kp) = v; } }
    __syncthreads();
}
__device__ __forceinline__ void mod_unit(const Frame& F, int unit, float* scr) {
    const int l = unit / 96, cc = unit - l * 96; const int tid = threadIdx.x;
    float* sl = scr; float* red = scr + 5 * 1024;
    for (int i = tid; i < 5 * 1024; i += NTHREADS) { const int r = i >> 10, k = i & 1023; const float c = r < 4 ? F.A.in[1][r * 1024 + k] : F.A.in[3][k]; sl[i] = c * sigmoidf_(c); }
    __syncthreads();
    const int col = tid & 63, kg = tid >> 6;
    const float* w = F.A.in[4] + (size_t)l * DM * 6144 + cc * 64 + col;
    float a0 = 0.f, a1 = 0.f, a2 = 0.f, a3 = 0.f, a4 = 0.f;
    for (int k = kg * 128; k < kg * 128 + 128; ++k) { const float wv = w[(size_t)k * 6144]; a0 += sl[k] * wv; a1 += sl[1024 + k] * wv; a2 += sl[2048 + k] * wv; a3 += sl[3072 + k] * wv; a4 += sl[4096 + k] * wv; }
    red[(kg * 5 + 0) * 64 + col] = a0; red[(kg * 5 + 1) * 64 + col] = a1; red[(kg * 5 + 2) * 64 + col] = a2; red[(kg * 5 + 3) * 64 + col] = a3; red[(kg * 5 + 4) * 64 + col] = a4;
    __syncthreads();
    if (tid < 320) { const int r = tid >> 6, c2 = tid & 63; float s = 0.f;
#pragma unroll
        for (int g = 0; g < 8; ++g) s += red[(g * 5 + r) * 64 + c2];
        FP(WS_MOD, float)[(l * 5 + r) * 6144 + cc * 64 + c2] = s + F.A.in[5][l * 6144 + cc * 64 + c2]; }
    __syncthreads();
}
__device__ __forceinline__ void p0_prologue(const Frame& F, float* scr) {
    const int NT_L = 448 + 16 + 16 + 32 + 256 + 1024 + 1024;
    const int njobs = 193 + 2 * NT_L + PK_N;
    for (int job = blockIdx.x; job < njobs; job += gridDim.x) {
        if (job >= 193 + 2 * NT_L) {
            const int e = job - (193 + 2 * NT_L); const float* src = nullptr; int cnt = 0, off = 0;
#define PKC(i) if (e == i) { src = F.A.in[PK_IDX[i]]; cnt = PK_CNT[i]; off = pk_off(PK_IDX[i]); }
            PKC(0) PKC(1) PKC(2) PKC(3) PKC(4) PKC(5) PKC(6) PKC(7) PKC(8) PKC(9) PKC(10) PKC(11) PKC(12) PKC(13) PKC(14) PKC(15) PKC(16) PKC(17) PKC(18) PKC(19) PKC(20) PKC(21) PKC(22)
#undef PKC
            float* dst = FP(WS_PACK, float) + off;
            for (int i = threadIdx.x; i < cnt; i += NTHREADS) dst[i] = src[i];
        }
        else if (job < 192) { mod_unit(F, job, scr); }
        else if (job == 192) {
            for (int i = threadIdx.x; i < 4096; i += NTHREADS) { const int m = i >> 6, j = i & 63; const float x = (float)((m * j) & 63) * (1.0f / 32.0f);
                FP(WS_CTAB, bf16_t)[i] = (bf16_t)f2bf(cospif(x)); FP(WS_STAB, bf16_t)[i] = (bf16_t)f2bf(sinpif(x)); }
        } else {
            int t = job - 193; const int l = t / NT_L; t -= l * NT_L;
            unsigned char* wl = F.ws + WS_W + (size_t)l * W_LAYER;
            if (t < 448) transpose_tile(F.A.in[7] + (size_t)l * DM * INC, DM, INC, (bf16_t*)(wl + W_IN), t, scr);
            else if ((t -= 448) < 16) transpose_tile(F.A.in[12] + (size_t)l * 65536, 256, 256, (bf16_t*)(wl + W_PW), t, scr);
            else if ((t -= 16) < 16) transpose_tile(F.A.in[14] + (size_t)l * 65536, 256, 256, (bf16_t*)(wl + W_F), t, scr);
            else if ((t -= 16) < 32) transpose_tile(F.A.in[25] + (size_t)l * 131072, 256, 512, (bf16_t*)(wl + W_GLU), t, scr);
            else if ((t -= 32) < 256) transpose_tile(F.A.in[28] + (size_t)l * DM * DM, DM, DM, (bf16_t*)(wl + W_OUT), t, scr);
            else if ((t -= 256) < 1024) transpose_tile(F.A.in[31] + (size_t)l * DM * FFD, DM, FFD, (bf16_t*)(wl + W_1), t, scr);
            else { t -= 1024; transpose_tile(F.A.in[33] + (size_t)l * DM * FFD, FFD, DM, (bf16_t*)(wl + W_2), t, scr); }
        }
    }
}

__device__ __forceinline__ void prep_norm_mod(const Frame& F, const float* srcC, const float* srcL, const float* g, const float* modl, int sh_off, int sc_off, bf16_t* XN, int row_lo) {
    const int gw = blockIdx.x * 8 + F.wave, nw = gridDim.x * 8, lane = F.lane;
    for (int row = row_lo + gw; row < T_ALL; row += nw) {
        const bool isc = row < NCTX; const float* x = isc ? srcC + (size_t)row * DM : srcL + (size_t)(row - NCTX) * DM; const int br = isc ? 4 : ((row - NCTX) >> 12);
        const float* sh = modl + br * 6144 + sh_off; const float* sc = modl + br * 6144 + sc_off;
        f32x4 v[4]; float ss = 0.f;
#pragma unroll
        for (int i = 0; i < 4; ++i) { v[i] = *(const f32x4*)(x + i * 256 + lane * 4); ss += v[i][0] * v[i][0] + v[i][1] * v[i][1] + v[i][2] * v[i][2] + v[i][3] * v[i][3]; }
        ss = wave_sum(ss); const float r = rsqrtf(ss * (1.0f / 1024.0f) + EPS);
#pragma unroll
        for (int i = 0; i < 4; ++i) { const int c = i * 256 + lane * 4; const f32x4 gv = *(const f32x4*)(g + c), shv = *(const f32x4*)(sh + c), scv = *(const f32x4*)(sc + c);
            f32x4 y = v[i] * r * gv; y = y * (scv + 1.0f) + shv; u32x2 w; w.x = pk2(y[0], y[1]); w.y = pk2(y[2], y[3]); *(u32x2*)(XN + (size_t)row * DM + c) = w; }
    }
}
__device__ __forceinline__ f32x4 ld_bf4(const bf16_t* p) { const u32x2 w = *(const u32x2*)p; return f32x4{bflo(w.x), bfhi(w.x), bflo(w.y), bfhi(w.y)}; }
__device__ __forceinline__ void prep_group(const Frame& F, int l, int row_lo) {
    const int gw = blockIdx.x * 8 + F.wave, nw = gridDim.x * 8, lane = F.lane;
    const bf16_t* MIX = FP(WS_MIX, bf16_t); const bf16_t* ZS = FP(WS_ZS, bf16_t); bf16_t* O = FP(WS_XN, bf16_t); const float* gg = PK(27) + l * DM;
    for (int row = row_lo + gw; row < T_ALL; row += nw) {
#pragma unroll
        for (int grp = 0; grp < 4; ++grp) {
            f32x4 v;
            if (grp < 3) v = ld_bf4(MIX + (size_t)row * 768 + grp * 256 + lane * 4);
            else { const f32x4 a = ld_bf4(ZS + (size_t)row * 512 + lane * 4), gt = ld_bf4(ZS + (size_t)row * 512 + 256 + lane * 4);
#pragma unroll
                for (int j = 0; j < 4; ++j) v[j] = a[j] * sigmoidf_(gt[j]); }
            float ss = v[0] * v[0] + v[1] * v[1] + v[2] * v[2] + v[3] * v[3]; ss = wave_sum(ss);
            const float r = rsqrtf(ss * (1.0f / 256.0f) + EPS); const f32x4 gv = *(const f32x4*)(gg + grp * 256 + lane * 4); const f32x4 y = v * r * gv;
            u32x2 w; w.x = pk2(y[0], y[1]); w.y = pk2(y[2], y[3]); *(u32x2*)(O + (size_t)row * DM + grp * 256 + lane * 4) = w;
        }
    }
}
__device__ __forceinline__ void final_norm(const Frame& F) {
    const int gw = blockIdx.x * 8 + F.wave, nw = gridDim.x * 8, lane = F.lane; const float* g = PK(35);
    for (int row = gw; row < NLAT; row += nw) {
        float* x = F.out + (size_t)row * DM; f32x4 v[4]; float ss = 0.f;
#pragma unroll
        for (int i = 0; i < 4; ++i) { v[i] = *(const f32x4*)(x + i * 256 + lane * 4); ss += v[i][0] * v[i][0] + v[i][1] * v[i][1] + v[i][2] * v[i][2] + v[i][3] * v[i][3]; }
        ss = wave_sum(ss); const float r = rsqrtf(ss * (1.0f / 1024.0f) + EPS);
#pragma unroll
        for (int i = 0; i < 4; ++i) { const int c = i * 256 + lane * 4; *(f32x4*)(x + c) = v[i] * r * *(const f32x4*)(g + c); }
    }
}

__device__ __forceinline__ void conv_unit(const Frame& F, int l, int unit, float* scr) {
    const bf16_t* PX = FP(WS_PX, bf16_t); bf16_t* CV = FP(WS_CV, bf16_t);
    int prow0, Lseq, t0;
    if (unit < 512) { const int b = unit >> 7; t0 = (unit & 127) * 32; prow0 = NCTX + b * 4096; Lseq = 4096; }
    else { const int uu = unit - 512; const int b = uu >> 3; t0 = (uu & 7) * 32; prow0 = b * 256; Lseq = 256; }
    float* vt = scr; float* ot = scr + 62 * 256; const int tid = threadIdx.x;
    for (int idx = tid; idx < 62 * 256; idx += NTHREADS) { const int rr = idx >> 8, c = idx & 255; const int t = t0 - 15 + rr; float v = 0.f;
        if (t >= 0 && t < Lseq) { const bf16_t* p = PX + (size_t)(prow0 + t) * INC; const float a = bf2f(p[c]), gt = bf2f(p[256 + c]); v = a * sigmoidf_(gt); }
        vt[idx] = v; }
    __syncthreads();
    { const int c = tid & 255, half = tid >> 8; float w[31];
#pragma unroll
      for (int j = 0; j < 31; ++j) w[j] = PK(8)[(l * 31 + j) * 256 + c];
      const float bd = PK(9)[l * 256 + c];
      for (int tt = 0; tt < 16; ++tt) { const int t = half * 16 + tt; float s = bd;
#pragma unroll
          for (int j = 0; j < 31; ++j) s += w[j] * vt[(t + j) * 256 + c];
          ot[t * 256 + c] = s; } }
    __syncthreads();
    { const int lane = F.lane; const f32x4 lg = *(const f32x4*)(PK(10) + l * 256 + lane * 4), lb = *(const f32x4*)(PK(11) + l * 256 + lane * 4);
      for (int i = 0; i < 4; ++i) { const int t = F.wave * 4 + i; const f32x4 x = *(const f32x4*)(ot + t * 256 + lane * 4);
          const float mu = wave_sum(x[0] + x[1] + x[2] + x[3]) * (1.0f / 256.0f); const f32x4 d = x - mu;
          const float var = wave_sum(d[0] * d[0] + d[1] * d[1] + d[2] * d[2] + d[3] * d[3]) * (1.0f / 256.0f); const float r = rsqrtf(var + EPS);
          f32x4 y = d * r * lg + lb;
#pragma unroll
          for (int j = 0; j < 4; ++j) y[j] = y[j] * sigmoidf_(y[j]);
          u32x2 w; w.x = pk2(y[0], y[1]); w.y = pk2(y[2], y[3]); *(u32x2*)(CV + (size_t)(prow0 + t0 + t) * 256 + lane * 4) = w; } }
    __syncthreads();
}

__device__ __forceinline__ void fnetctx_unit(const Frame& F, int unit, float* scr) {
    const bf16_t* PX = FP(WS_PX, bf16_t); bf16_t* FN = FP(WS_FN, bf16_t);
    const int mh = unit & 1, h = (unit >> 1) & 3, b = unit >> 3; const int tid = threadIdx.x;
    float* zc = scr; float* zs = scr + 8192; float* c64 = scr + 16384; float* s64 = c64 + 64; float* c256 = s64 + 64; float* s256 = c256 + 256;
    if (tid < 64) { const float x = (float)tid * (1.0f / 32.0f); c64[tid] = cospif(x); s64[tid] = sinpif(x); }
    if (tid < 256) { const float x = (float)tid * (1.0f / 128.0f); c256[tid] = cospif(x); s256[tid] = sinpif(x); }
    __syncthreads();
    for (int idx = tid; idx < 8192; idx += NTHREADS) { const int n = idx >> 5, mm = idx & 31, m = mh * 32 + mm; const bf16_t* up = PX + (size_t)(b * 256 + n) * INC + 512 + h * 64;
        float ac = 0.f, as = 0.f;
        for (int j = 0; j < 64; ++j) { const float uv = bf2f(up[j]); const int a = (j * m) & 63; ac += uv * c64[a]; as += uv * s64[a]; }
        zc[idx] = ac; zs[idx] = as; }
    __syncthreads();
    for (int idx = tid; idx < 8192; idx += NTHREADS) { const int k = idx >> 5, mm = idx & 31; float acc = 0.f;
        for (int n = 0; n < 256; ++n) { const int a = (k * n) & 255; acc += c256[a] * zc[n * 32 + mm] - s256[a] * zs[n * 32 + mm]; }
        FN[(size_t)(b * 256 + k) * 256 + h * 64 + mh * 32 + mm] = (bf16_t)f2bf(acc * (1.0f / 128.0f)); }
    __syncthreads();
}
__device__ __forceinline__ void fnetA_unit(const Frame& F, int unit, unsigned char* lds) {
    const bf16_t* PX = FP(WS_PX, bf16_t); const bf16_t* Ct = FP(WS_CTAB, bf16_t); const bf16_t* St = FP(WS_STAB, bf16_t); bf16_t* YB = FP(WS_YB, bf16_t);
    const int oct = unit & 7, h = (unit >> 3) & 3, b = unit >> 5; const int lane = F.lane, fr = lane & 15, fq = lane >> 4; const int n2 = oct * 8 + F.wave;
    bf16x8 ua[4][2];
#pragma unroll
    for (int mi = 0; mi < 4; ++mi)
#pragma unroll
        for (int kk = 0; kk < 2; ++kk) ua[mi][kk] = *(const bf16x8*)(PX + (size_t)(NCTX + b * 4096 + 64 * (16 * mi + fr) + n2) * INC + 512 + h * 64 + kk * 32 + fq * 8);
    bf16x8 zre[2][4], zs[2][4];
#pragma unroll
    for (int ni = 0; ni < 4; ++ni) {
        bf16x8 bc[2], bs[2];
#pragma unroll
        for (int kk = 0; kk < 2; ++kk) { bc[kk] = *(const bf16x8*)(Ct + (16 * ni + fr) * 64 + kk * 32 + fq * 8); bs[kk] = *(const bf16x8*)(St + (16 * ni + fr) * 64 + kk * 32 + fq * 8); }
#pragma unroll
        for (int pr = 0; pr < 2; ++pr) {
            f32x4 c0 = {0.f, 0.f, 0.f, 0.f}, c1 = c0, s0 = c0, s1 = c0;
#pragma unroll
            for (int kk = 0; kk < 2; ++kk) { c0 = mfma16(ua[2 * pr][kk], bc[kk], c0); c1 = mfma16(ua[2 * pr + 1][kk], bc[kk], c1); s0 = mfma16(ua[2 * pr][kk], bs[kk], s0); s1 = mfma16(ua[2 * pr + 1][kk], bs[kk], s1); }
            zre[pr][ni] = pack8(c0, c1); zs[pr][ni] = pack8(s0, s1);
        }
    }
    bf16_t* T = (bf16_t*)lds;
    for (int mi2 = 0; mi2 < 4; ++mi2) {
        bf16x8 cf[2], sf[2], sfn[2];
#pragma unroll
        for (int pr = 0; pr < 2; ++pr) {
            const bf16_t* cp = Ct + (16 * mi2 + fr) * 64 + 32 * pr + 4 * fq; const bf16_t* sp = St + (16 * mi2 + fr) * 64 + 32 * pr + 4 * fq;
            cf[pr] = cat4(*(const u32x2*)cp, *(const u32x2*)(cp + 16)); sf[pr] = cat4(*(const u32x2*)sp, *(const u32x2*)(sp + 16)); sfn[pr] = neg8(sf[pr]);
        }
        float cs[4], sn[4];
#pragma unroll
        for (int j = 0; j < 4; ++j) { const int k1 = 16 * mi2 + 4 * fq + j; const float x = (float)(n2 * k1) * (1.0f / 2048.0f); cs[j] = cospif(x); sn[j] = sinpif(x); }
#pragma unroll
        for (int ni = 0; ni < 4; ++ni) {
            f32x4 yre = {0.f, 0.f, 0.f, 0.f}, yin = yre;
#pragma unroll
            for (int pr = 0; pr < 2; ++pr) { yre = mfma16(cf[pr], zre[pr][ni], yre); yre = mfma16(sfn[pr], zs[pr][ni], yre); yin = mfma16(cf[pr], zs[pr][ni], yin); yin = mfma16(sf[pr], zre[pr][ni], yin); }
#pragma unroll
            for (int j = 0; j < 4; ++j) { const int k1 = 16 * mi2 + 4 * fq + j; const int m = 16 * ni + fr;
                const float y1 = yre[j] * cs[j] - yin[j] * sn[j], y2 = yin[j] * cs[j] + yre[j] * sn[j];
                T[((0 * 64 + k1) * 64 + m) * 8 + F.wave] = (bf16_t)f2bf(y1); T[((1 * 64 + k1) * 64 + m) * 8 + F.wave] = (bf16_t)f2bf(y2); }
        }
    }
    __syncthreads();
    for (int it = 0; it < 16; ++it) { const int cidx = it * NTHREADS + threadIdx.x; const int m = cidx & 63, k1 = (cidx >> 6) & 63, plane = cidx >> 12;
        const u32x4 v = *(const u32x4*)(lds + (size_t)cidx * 16);
        *(u32x4*)(YB + ((((size_t)(b * 4 + h) * 64 + k1) * 2 + plane) * 64 + m) * 64 + oct * 8) = v; }
    __syncthreads();
}
__device__ __forceinline__ void fnetB_item(const Frame& F, int item) {
    const bf16_t* Ct = FP(WS_CTAB, bf16_t); const bf16_t* St = FP(WS_STAB, bf16_t); const bf16_t* YB = FP(WS_YB, bf16_t); bf16_t* FN = FP(WS_FN, bf16_t);
    const int k1 = item & 63, h = (item >> 6) & 3, b = item >> 8; const int lane = F.lane, fr = lane & 15, fq = lane >> 4;
    const bf16_t* base = YB + (((size_t)(b * 4 + h) * 64 + k1) * 2) * 4096;
    f32x4 acc[4][4];
#pragma unroll
    for (int mi = 0; mi < 4; ++mi)
#pragma unroll
        for (int ni = 0; ni < 4; ++ni) acc[mi][ni] = f32x4{0.f, 0.f, 0.f, 0.f};
#pragma unroll
    for (int kk = 0; kk < 2; ++kk) {
        bf16x8 bc[4], bsn[4];
#pragma unroll
        for (int ni = 0; ni < 4; ++ni) { bc[ni] = *(const bf16x8*)(Ct + (16 * ni + fr) * 64 + kk * 32 + fq * 8); bsn[ni] = neg8(*(const bf16x8*)(St + (16 * ni + fr) * 64 + kk * 32 + fq * 8)); }
#pragma unroll
        for (int mi = 0; mi < 4; ++mi) {
            const bf16x8 are = *(const bf16x8*)(base + (16 * mi + fr) * 64 + kk * 32 + fq * 8), aim = *(const bf16x8*)(base + 4096 + (16 * mi + fr) * 64 + kk * 32 + fq * 8);
#pragma unroll
            for (int ni = 0; ni < 4; ++ni) { acc[mi][ni] = mfma16(are, bc[ni], acc[mi][ni]); acc[mi][ni] = mfma16(aim, bsn[ni], acc[mi][ni]); }
        }
    }
#pragma unroll
    for (int mi = 0; mi < 4; ++mi)
#pragma unroll
        for (int ni = 0; ni < 4; ++ni) { const int k = k1 + 64 * (16 * ni + fr); const f32x4 v = acc[mi][ni] * (1.0f / 512.0f);
            u32x2 w; w.x = pk2(v[0], v[1]); w.y = pk2(v[2], v[3]); *(u32x2*)(FN + (size_t)(NCTX + b * 4096 + k) * 256 + h * 64 + 16 * mi + 4 * fq) = w; }
}

template <bool LOCAL>
__device__ __forceinline__ void attn_item(const Frame& F, int l, int item) {
    const bf16_t* PX = FP(WS_PX, bf16_t); const bf16_t* VT = FP(WS_VT, bf16_t); const bf16_t* VTc = FP(WS_VTC, bf16_t); bf16_t* MIX = FP(WS_MIX, bf16_t);
    const float* rpb = PK(16) + l * (4 * 15 * 31);
    const int lane = F.lane, fr = lane & 15, fq = lane >> 4;
    int b, h, r = 0, jb = 0, qrow0;
    if (LOCAL) { h = item & 3; jb = (item >> 2) & 3; r = (item >> 4) & 63; b = item >> 10; qrow0 = NCTX + b * 4096 + r * 64 + jb * 16; }
    else { h = item & 3; const int qb = (item >> 2) & 15; b = item >> 6; qrow0 = b * 256 + qb * 16; }
    constexpr int NT = LOCAL ? 32 : 16;
    const int rs = LOCAL ? min(max(r - 4, 0), 56) : 0; const int kcs = LOCAL ? min(max(16 * jb - 8, 0), 32) : 0;
    bf16x8 qf[2];
#pragma unroll
    for (int kk = 0; kk < 2; ++kk) qf[kk] = *(const bf16x8*)(PX + (size_t)(qrow0 + fr) * INC + 768 + h * 64 + kk * 32 + fq * 8);
    f32x4 s[NT];
#pragma unroll
    for (int t = 0; t < NT; ++t) {
        int krow;
        if (LOCAL && t < 16) krow = NCTX + b * 4096 + (rs + (t >> 1)) * 64 + kcs + (t & 1) * 16 + fr;
        else krow = b * 256 + (t - (LOCAL ? 16 : 0)) * 16 + fr;
        const bf16_t* kp = PX + (size_t)krow * INC + 1024 + h * 64 + fq * 8;
        const bf16x8 k0 = *(const bf16x8*)kp, k1 = *(const bf16x8*)(kp + 32);
        f32x4 a = {0.f, 0.f, 0.f, 0.f}; a = mfma16(k0, qf[0], a); a = mfma16(k1, qf[1], a); s[t] = a;
    }
    float mx = -3.0e38f;
    const int qcol = 16 * jb + fr; const int cstart = min(max(qcol - 8, 0), 48);
#pragma unroll
    for (int t = 0; t < NT; ++t)
#pragma unroll
        for (int j = 0; j < 4; ++j) {
            float v = s[t][j] * 0.125f;
            if (LOCAL && t < 16) { const int kcol = kcs + (t & 1) * 16 + 4 * fq + j; const bool valid = (kcol >= cstart) && (kcol < cstart + 16);
                const int dr = rs + (t >> 1) - r + 7; const int dc = min(max(kcol - qcol + 15, 0), 30);
                v = valid ? v + rpb[(h * 15 + dr) * 31 + dc] : -1.0e30f; }
            s[t][j] = v; mx = fmaxf(mx, v);
        }
    mx = fmaxf(mx, __shfl_xor(mx, 16)); mx = fmaxf(mx, __shfl_xor(mx, 32));
    float sum = 0.f;
#pragma unroll
    for (int t = 0; t < NT; ++t)
#pragma unroll
        for (int j = 0; j < 4; ++j) { const float p = __expf(s[t][j] - mx); s[t][j] = p; sum += p; }
    sum += __shfl_xor(sum, 16); sum += __shfl_xor(sum, 32);
    f32x4 o[4];
#pragma unroll
    for (int di = 0; di < 4; ++di) o[di] = f32x4{0.f, 0.f, 0.f, 0.f};
#pragma unroll
    for (int u = 0; u < NT / 2; ++u) {
        const bf16x8 pb = pack8(s[2 * u], s[2 * u + 1]);
        const bf16_t* vbase; size_t stride;
        if (LOCAL && u < 8) { vbase = VT + (size_t)(b * 256 + h * 64) * 4096 + (rs + u) * 64 + kcs + 4 * fq; stride = 4096; }
        else { const int uu = u - (LOCAL ? 8 : 0); vbase = VTc + (size_t)(b * 256 + h * 64) * 256 + uu * 32 + 4 * fq; stride = 256; }
#pragma unroll
        for (int di = 0; di < 4; ++di) { const bf16_t* vp = vbase + (size_t)(16 * di + fr) * stride; const bf16x8 va = cat4(*(const u32x2*)vp, *(const u32x2*)(vp + 16)); o[di] = mfma16(va, pb, o[di]); }
    }
    const float inv = 1.0f / sum;
#pragma unroll
    for (int di = 0; di < 4; ++di) { const f32x4 v = o[di] * inv; u32x2 w; w.x = pk2(v[0], v[1]); w.y = pk2(v[2], v[3]);
        *(u32x2*)(MIX + (size_t)(qrow0 + fr) * 768 + 512 + h * 64 + 16 * di + 4 * fq) = w; }
}

__device__ __forceinline__ cplx pow_sel(int k, cplx a, cplx a2, cplx a4, cplx a8, cplx a16) {
    cplx r = cplx{1.f, 0.f};
    if (k & 1) r = cmul(r, a); if (k & 2) r = cmul(r, a2); if (k & 4) r = cmul(r, a4); if (k & 8) r = cmul(r, a8); if (k & 16) r = cmul(r, a16);
    return r;
}
template <int PASS, int DIR>
__device__ __forceinline__ void ssm_dir(const Frame& F, int l, int b, int g, int tb, const bf16x8 (&ub)[4], f32x4 (&accy)[4]) {
    const int lane = F.lane, fr = lane & 15, fq = lane >> 4;
    const int c = DIR == 0 ? tb : (tb < 4 ? 3 - tb : 71 - tb);
    const int pg = (l * 2 + DIR) * 16 + g;
    const float dt = expf(PK(19)[pg]);
    cplx* Sloc = FP(WS_SLOC, cplx); const cplx* Carry = FP(WS_CARRY, cplx);
    const size_t sbase = ((size_t)((b * 2 + DIR) * 16 + g) * 68 + c) * 64;
    for (int q = 0; q < 4; ++q) {
        bf16x8 are = zero8(), aim = zero8();
        if (fq < 2) { const float* pr = PK(20) + ((size_t)pg * 64 + 16 * q + fr) * 16 + fq * 8; const float* pi = PK(21) + ((size_t)pg * 64 + 16 * q + fr) * 16 + fq * 8;
            are = pack8(*(const f32x4*)pr, *(const f32x4*)(pr + 4)); aim = pack8(*(const f32x4*)pi, *(const f32x4*)(pi + 4)); }
        f32x4 bre[4], bim[4];
#pragma unroll
        for (int ni = 0; ni < 4; ++ni) { bre[ni] = mfma16(are, ub[ni], f32x4{0.f, 0.f, 0.f, 0.f}); bim[ni] = mfma16(aim, ub[ni], f32x4{0.f, 0.f, 0.f, 0.f}); }
#pragma unroll
        for (int j = 0; j < 4; ++j) {
            const int p = 16 * q + 4 * fq + j;
            const float lre = PK(17)[pg * 64 + p], lim = PK(18)[pg * 64 + p];
            const float e = expf(lre * dt), ang = lim * dt; const cplx a = cplx{e * cosf(ang), e * sinf(ang)};
            const float xr = a.re - 1.0f, xi = a.im, den = 1.0f / (lre * lre + lim * lim); const cplx f = cplx{(xr * lre + xi * lim) * den, (xi * lre - xr * lim) * den};
            const cplx a2 = cmul(a, a), a4 = cmul(a2, a2), a8 = cmul(a4, a4), a16 = cmul(a8, a8);
            if (PASS == 1) {
                cplx Tt;
                if (DIR == 0) { Tt = cplx{bre[0][j], bim[0][j]}; Tt = cmad(cplx{bre[1][j], bim[1][j]}, Tt, a16); Tt = cmad(cplx{bre[2][j], bim[2][j]}, Tt, a16); Tt = cmad(cplx{bre[3][j], bim[3][j]}, Tt, a16); }
                else { Tt = cplx{bre[3][j], bim[3][j]}; Tt = cmad(cplx{bre[2][j], bim[2][j]}, Tt, a16); Tt = cmad(cplx{bre[1][j], bim[1][j]}, Tt, a16); Tt = cmad(cplx{bre[0][j], bim[0][j]}, Tt, a16); }
                const cplx w = pow_sel(DIR == 0 ? 15 - fr : fr, a, a2, a4, a8, a16);
                Tt = cmul(Tt, w);
                Tt.re += __shfl_xor(Tt.re, 1); Tt.im += __shfl_xor(Tt.im, 1); Tt.re += __shfl_xor(Tt.re, 2); Tt.im += __shfl_xor(Tt.im, 2);
                Tt.re += __shfl_xor(Tt.re, 4); Tt.im += __shfl_xor(Tt.im, 4); Tt.re += __shfl_xor(Tt.re, 8); Tt.im += __shfl_xor(Tt.im, 8);
                Tt = cmul(Tt, f);
                if (fr == 0) Sloc[sbase + p] = Tt;
            } else {
                const cplx w = pow_sel(DIR == 0 ? fr + 1 : 16 - fr, a, a2, a4, a8, a16);
                cplx x[4];
#pragma unroll
                for (int ni = 0; ni < 4; ++ni) {
                    cplx v = cmul(f, cplx{bre[ni][j], bim[ni][j]});
#define KS_STEP(d, ad) { cplx y; if (DIR == 0) { y.re = __shfl_up(v.re, d, 16); y.im = __shfl_up(v.im, d, 16); if (fr >= d) v = cmad(v, ad, y); } \
                                   else { y.re = __shfl_down(v.re, d, 16); y.im = __shfl_down(v.im, d, 16); if (fr + d <= 15) v = cmad(v, ad, y); } }
                    KS_STEP(1, a) KS_STEP(2, a2) KS_STEP(4, a4) KS_STEP(8, a8)
#undef KS_STEP
                    x[ni] = v;
                }
                cplx E = Carry[sbase + p];
#pragma unroll
                for (int bi = 0; bi < 4; ++bi) {
                    const int ni = DIR == 0 ? bi : 3 - bi;
                    const cplx hh = cmad(x[ni], w, E);
                    cplx tot; tot.re = __shfl(x[ni].re, DIR == 0 ? 15 : 0, 16); tot.im = __shfl(x[ni].im, DIR == 0 ? 15 : 0, 16);
                    E = cmad(tot, a16, E);
                    bre[ni][j] = hh.re; bim[ni][j] = hh.im;
                }
            }
        }
        if (PASS == 3) {
            const float* cr = PK(22) + ((size_t)pg * 16 + fr) * 64 + 16 * q + 4 * fq; const float* ci = PK(23) + ((size_t)pg * 16 + fr) * 64 + 16 * q + 4 * fq;
            const f32x4 cre = *(const f32x4*)cr; const f32x4 cim = *(const f32x4*)ci;
            const bf16x8 ca = pack8(cre, f32x4{-cim[0], -cim[1], -cim[2], -cim[3]});
#pragma unroll
            for (int ni = 0; ni < 4; ++ni) accy[ni] = mfma16(ca, pack8(bre[ni], bim[ni]), accy[ni]);
        }
    }
}
template <int PASS>
__device__ __forceinline__ void ssm_item(const Frame& F, int l, int item) {
    const bf16_t* PX = FP(WS_PX, bf16_t);
    const int lane = F.lane, fr = lane & 15, fq = lane >> 4;
    const int tb = item % 68; const int g = (item / 68) & 15; const int b = item / (68 * 16);
    const int prow0 = tb < 4 ? b * 256 + tb * 64 : NCTX + b * 4096 + (tb - 4) * 64;
    bf16x8 ub[4];
#pragma unroll
    for (int ni = 0; ni < 4; ++ni) { ub[ni] = zero8(); if (fq < 2) ub[ni] = *(const bf16x8*)(PX + (size_t)(prow0 + 16 * ni + fr) * INC + 1536 + g * 16 + fq * 8); }
    f32x4 accy[4];
#pragma unroll
    for (int ni = 0; ni < 4; ++ni) accy[ni] = f32x4{0.f, 0.f, 0.f, 0.f};
    ssm_dir<PASS, 0>(F, l, b, g, tb, ub, accy);
    ssm_dir<PASS, 1>(F, l, b, g, tb, ub, accy);
    if (PASS == 3) {
        bf16_t* YS = FP(WS_YS, bf16_t); const f32x4 dv = *(const f32x4*)(PK(24) + l * 256 + g * 16 + 4 * fq);
#pragma unroll
        for (int ni = 0; ni < 4; ++ni) { const int row = prow0 + 16 * ni + fr; const f32x4 uv = ld_bf4(PX + (size_t)row * INC + 1536 + g * 16 + 4 * fq);
            const f32x4 y = accy[ni] + dv * uv; u32x2 w; w.x = pk2(y[0], y[1]); w.y = pk2(y[2], y[3]); *(u32x2*)(YS + (size_t)row * 256 + g * 16 + 4 * fq) = w; }
    }
}
__device__ __forceinline__ void ssm_pass2(const Frame& F, int l) {
    const int idx = blockIdx.x * NTHREADS + threadIdx.x; if (idx >= 8192) return;
    const int p = idx & 63, g = (idx >> 6) & 15, dir = (idx >> 10) & 1, b = idx >> 11;
    const int pg = (l * 2 + dir) * 16 + g; const float dt = expf(PK(19)[pg]);
    const float lre = PK(17)[pg * 64 + p], lim = PK(18)[pg * 64 + p]; const float e = expf(lre * dt), ang = lim * dt;
    cplx a = cplx{e * cosf(ang), e * sinf(ang)};
#pragma unroll
    for (int i = 0; i < 6; ++i) a = cmul(a, a);
    const cplx* Sloc = FP(WS_SLOC, cplx); cplx* Carry = FP(WS_CARRY, cplx);
    const size_t base = ((size_t)((b * 2 + dir) * 16 + g) * 68) * 64 + p;
    cplx E = cplx{0.f, 0.f};
    for (int c = 0; c < 68; ++c) { Carry[base + (size_t)c * 64] = E; E = cmad(Sloc[base + (size_t)c * 64], a, E); }
}


template <int KIND>
__global__ void __launch_bounds__(NTHREADS, 2) fwd(Args args) {
#define KD(k) (KIND < 0 || KIND == (k))
    extern __shared__ __attribute__((aligned(16))) unsigned char lds[];
    cg::grid_group grid = cg::this_grid();
    const int tid_ = threadIdx.x;
    const Frame F{args, args.out, args.ws, tid_, tid_ & 63, __builtin_amdgcn_readfirstlane(tid_ >> 6)};
    float* scr = (float*)lds;
    const int G = gridDim.x, bx = blockIdx.x;
    const int gw = bx * 8 + F.wave, nw = G * 8;
    const int lo = args.ph_lo, hi = args.ph_hi;
#define PH(k) (lo <= (k) && (k) < hi)
#define SYNC(k) do { if ((k) + 1 < hi) grid.sync(); } while (0)
    if (KD(0) && PH(0)) { p0_prologue(F, scr); SYNC(0); }
#pragma nounroll
    for (int l = 0; l < 2; ++l) {
        const int base = 1 + 11 * l;
        const float* modl = FP(WS_MOD, float) + l * 5 * 6144;
        unsigned char* wl = F.ws + WS_W + (size_t)l * W_LAYER;
        const float* srcC = l == 0 ? F.A.in[2] : FP(WS_XC, float); const float* srcL = l == 0 ? F.A.in[0] : F.out;
        const int row_lo = l == 0 ? 0 : NCTX;
        const int M_post = T_ALL - row_lo;
        if (KD(0) && PH(base + 0)) { prep_norm_mod(F, srcC, srcL, PK(6) + l * DM, modl, 0, 1024, FP(WS_XN, bf16_t), 0); SYNC(base + 0); }
        if (PH(base + 1)) {
            if (KD(1)) {
                pg8::Gemm g{FP(WS_XN, bf16_t), (const bf16_t*)(wl + W_IN), T_ALL, INC, DM}; pg8::StaticOrder S; S.init(T_ALL, INC, G, bx);
                EpiInProj E{FP(WS_PX, bf16_t)};
                pg8::gemm_phase<EpiInProj, pg8::StaticOrder, true, true>((PG8_LAS unsigned char*)lds, g, S, E);
            }
            if (KD(6)) {
                pg8::Gemm g{(const bf16_t*)(wl + W_IN) + (size_t)1280 * DM, FP(WS_XN, bf16_t), 256, T_ALL, DM}; pg8::StaticOrder S; S.init(256, T_ALL, G, bx);
                EpiVT E{FP(WS_VT, bf16_t), FP(WS_VTC, bf16_t)};
                pg8::gemm_phase<EpiVT, pg8::StaticOrder, true, true>((PG8_LAS unsigned char*)lds, g, S, E);
            }
            SYNC(base + 1);
        }
        if (PH(base + 2)) {
            const int n_fc = l == 0 ? 32 : 0, n_cv = l == 0 ? 544 : 512; const int nbu = n_fc + 128 + n_cv;
            if (KD(2) || KD(11) || KD(12)) for (int u = bx; u < nbu; u += G) {
                if (u < n_fc) { if (KD(2)) fnetctx_unit(F, u, scr); }
                else if (u < n_fc + 128) { if (KD(11)) fnetA_unit(F, u - n_fc, lds); }
                else { if (KD(12)) conv_unit(F, l, u - n_fc - 128, scr); }
            }
            const int n_ac = l == 0 ? 256 : 0;
            if (KD(7)) for (int it = gw; it < n_ac + 4096; it += nw) {
                if (it < n_ac) attn_item<false>(F, l, it);
                else attn_item<true>(F, l, it - n_ac);
            }
            if (KD(8)) for (int it = gw; it < 4352; it += nw) ssm_item<1>(F, l, it);
            SYNC(base + 2);
        }
#pragma unroll
        for (int sp = 3; sp <= 5; ++sp) {
            if (!PH(base + sp)) continue;
            if ((KD(3) && sp == 3) || (KD(13) && sp == 4) || (KD(14) && sp == 5)) {
            const bf16_t* A; const bf16_t* Bt; int N; bf16_t* O; int ldc, col0; const float* bias;
            if (sp == 3) { A = FP(WS_CV, bf16_t); Bt = (const bf16_t*)(wl + W_PW); N = 256; O = FP(WS_MIX, bf16_t); ldc = 768; col0 = 0; bias = PK(13) + l * 256; }
            else if (sp == 4) { A = FP(WS_FN, bf16_t); Bt = (const bf16_t*)(wl + W_F); N = 256; O = FP(WS_MIX, bf16_t); ldc = 768; col0 = 256; bias = PK(15) + l * 256; }
            else { A = FP(WS_YS, bf16_t); Bt = (const bf16_t*)(wl + W_GLU); N = 512; O = FP(WS_ZS, bf16_t); ldc = 512; col0 = 0; bias = PK(26) + l * 512; }
            pg8::Gemm g{A + (size_t)row_lo * 256, Bt, M_post, N, 256}; pg8::StaticOrder S; S.init(M_post, N, G, bx);
            EpiBias<0> E{O, ldc, row_lo, col0, bias};
            pg8::gemm_phase<EpiBias<0>, pg8::StaticOrder, true, true>((PG8_LAS unsigned char*)lds, g, S, E);
            }
            if (KD(9) && sp == 3) { ssm_pass2(F, l); for (int it = gw; it < 1024; it += nw) fnetB_item(F, it); }
            if (KD(10) && sp == 4) { for (int it = gw; it < 4352; it += nw) { const int tb = it % 68; if (l == 0 || tb >= 4) ssm_item<3>(F, l, it); } }
            SYNC(base + sp);
        }
        if (KD(0) && PH(base + 6)) { prep_group(F, l, row_lo); SYNC(base + 6); }
#pragma nounroll
        for (int hh = 0; hh < 2; ++hh) {
            const int sp = hh == 0 ? 7 : 10;
            if (KD(4) && PH(base + sp)) {
                const bf16_t* A; const bf16_t* Bt; int K; const float* bias; int gate_off; const float* sC; const float* sL;
                if (hh == 0) { A = FP(WS_XN, bf16_t); Bt = (const bf16_t*)(wl + W_OUT); K = DM; bias = PK(29) + l * DM; gate_off = 2048; sC = srcC; sL = srcL; }
                else { A = FP(WS_H, bf16_t); Bt = (const bf16_t*)(wl + W_2); K = FFD; bias = PK(34) + l * DM; gate_off = 5 * 1024; sC = FP(WS_XC, float); sL = F.out; }
                pg8::Gemm g{A + (size_t)row_lo * K, Bt, M_post, DM, K}; pg8::StaticOrder S; S.init(M_post, DM, G, bx);
                EpiResid E{sC, sL, FP(WS_XC, float), F.out, bias, modl, gate_off, row_lo / 256};
                pg8::gemm_phase<EpiResid, pg8::StaticOrder, true, true>((PG8_LAS unsigned char*)lds, g, S, E);
                SYNC(base + sp);
            }
            if (hh == 0) {
                if (KD(0) && PH(base + 8)) { prep_norm_mod(F, FP(WS_XC, float), F.out, PK(30) + l * DM, modl, 3072, 4096, FP(WS_XN, bf16_t), row_lo); SYNC(base + 8); }
                if (KD(5) && PH(base + 9)) {
                    pg8::Gemm g{FP(WS_XN, bf16_t) + (size_t)row_lo * DM, (const bf16_t*)(wl + W_1), M_post, FFD, DM}; pg8::StaticOrder S; S.init(M_post, FFD, G, bx);
                    EpiBias<1> E{FP(WS_H, bf16_t), FFD, row_lo, 0, PK(32) + l * FFD};
                    pg8::gemm_phase<EpiBias<1>, pg8::StaticOrder, true, true>((PG8_LAS unsigned char*)lds, g, S, E);
                    SYNC(base + 9);
                }
            }
        }
    }
    if (KD(0) && PH(23)) final_norm(F);
#undef KD
#undef PH
#undef SYNC
}

template <int KIND> static void launch_kind(int grid, Args a, hipStream_t stream) {
    static bool attr_set = false;
    if (!attr_set) { (void)hipFuncSetAttribute((const void*)fwd<KIND>, hipFuncAttributeMaxDynamicSharedMemorySize, LDS_BYTES); attr_set = true; }
    hipLaunchKernelGGL(fwd<KIND>, dim3(grid), dim3(NTHREADS), LDS_BYTES, stream, a);
}
extern "C" void kernel_launch(void* const* d_in, const int* in_sizes, int n_in, void* d_out, int out_size, void* d_ws, size_t ws_size, hipStream_t stream) {
    static int grid = 0;
    if (grid == 0) {
        if (n_in != 36 || ws_size < WS_END) { fprintf(stderr, "kernel_launch: unexpected n_in %d / ws %zu\n", n_in, ws_size); grid = -1; return; }
        int dev = 0, cus = 0;
        (void)hipGetDevice(&dev); (void)hipDeviceGetAttribute(&cus, hipDeviceAttributeMultiprocessorCount, dev);
        (void)hipGetLastError();
        grid = cus > 0 ? cus : 256;
    }
    if (grid < 0) return;
    Args a{};
    for (int i = 0; i < 36; ++i) a.in[i] = (const float*)d_in[i];
    a.out = (float*)d_out; a.ws = (unsigned char*)d_ws;
#if MODE_COOP
    a.ph_lo = 0; a.ph_hi = 24;
    static bool attr_set = false;
    if (!attr_set) { (void)hipFuncSetAttribute((const void*)fwd<-1>, hipFuncAttributeMaxDynamicSharedMemorySize, LDS_BYTES); attr_set = true; }
    void* kargs[] = {&a};
    hipError_t e = hipLaunchCooperativeKernel((const void*)fwd<-1>, dim3(grid), dim3(NTHREADS), kargs, LDS_BYTES, stream);
    if (e != hipSuccess) fprintf(stderr, "cooperative launch failed: %s (grid %d)\n", hipGetErrorString(e), grid);
#else
    for (int ph = 0; ph < 24; ++ph) {
        a.ph_lo = ph; a.ph_hi = ph + 1;
        const int sp = (ph == 0 || ph == 23) ? 0 : (ph - 1) % 11;
        if (ph == 0 || ph == 23 || sp == 0 || sp == 6 || sp == 8) launch_kind<0>(grid, a, stream);
        else if (sp == 1) { launch_kind<1>(grid, a, stream); launch_kind<6>(grid, a, stream); }
        else if (sp == 2) { launch_kind<2>(grid, a, stream); launch_kind<11>(grid, a, stream); launch_kind<12>(grid, a, stream); launch_kind<7>(grid, a, stream); launch_kind<8>(grid, a, stream); }
        else if (sp == 3) { launch_kind<3>(grid, a, stream); launch_kind<9>(grid, a, stream); }
        else if (sp == 4) { launch_kind<13>(grid, a, stream); launch_kind<10>(grid, a, stream); }
        else if (sp == 5) launch_kind<14>(grid, a, stream);
        else if (sp == 7 || sp == 10) launch_kind<4>(grid, a, stream);
        else launch_kind<5>(grid, a, stream);
    }
#endif
}
```

```cpp
#include <hip/hip_runtime.h>
#include <hip/hip_cooperative_groups.h>
#include <cstdio>
#include <cstdint>
namespace cg = cooperative_groups;
#ifndef MODE_COOP
#define MODE_COOP 1
#endif
namespace pg8 {
#define PG8_LAS __attribute__((address_space(3)))
typedef unsigned short bf16_t;
typedef short bf16x8 __attribute__((ext_vector_type(8)));
typedef float f32x4 __attribute__((ext_vector_type(4)));
typedef unsigned u32x4 __attribute__((ext_vector_type(4)));
constexpr int BM = 256, BK = 64, HALF = 128, HTB = HALF * BK * 2  , STAGE_BYTES = 8 * HTB, NXCD = 8, WGM = 8;

__host__ __device__ __forceinline__ int lds_byte(int r, int c) { const int st = (r >> 4) * 2 + (c >> 5), rr = r & 15, cc = c & 31, ob = rr * 64 + cc * 2; return st * 1024 + (ob ^ (((ob >> 9) & 1) << 5)); }
__host__ __device__ __forceinline__ void stage_rc(int b, int& R, int& C) { const int st = b / 1024, sb = b % 1024, swz = sb ^ (((sb >> 9) & 1) << 5); R = (st >> 1) * 16 + swz / 64; C = (st & 1) * 32 + (swz % 64) / 2; }
__host__ __device__ __forceinline__ int perm32(int rho) { const int n = rho >> 4, i = rho & 15; return 8 * (i >> 2) + 4 * n + (i & 3); }

struct Unit { int pm, pn; };
struct Gemm { const bf16_t* A; const bf16_t* Bt; int M, N, K; };

struct StaticOrder {
    int nM, nN, nwg, G, c;
    __host__ __device__ void init(int M, int N, int G_, int c_) { nM = M / BM; nN = N / BM; nwg = nM * nN; G = G_; c = c_; }
    __host__ __device__ bool next(int i, Unit& u) const {
        const long L = (long)i * G + c; if (L >= nwg) return false;
        int wgid = (int)L; { const int q = nwg / NXCD, r = nwg % NXCD, xcd = wgid % NXCD, off = wgid / NXCD; wgid = (xcd < r ? xcd * (q + 1) : r * (q + 1) + (xcd - r) * q) + off; }
        const int nig = WGM * nN, gid = wgid / nig, fm = gid * WGM, gsz = (nM - fm) < WGM ? (nM - fm) : WGM;
        u.pm = fm + ((wgid % nig) % gsz); u.pn = (wgid % nig) / gsz; return true;
    }
    __device__ __forceinline__ void a_ready(const Unit&) const {}
    __device__ __forceinline__ void done(const Unit&) const {}
};

}
namespace pg8 {
template <class Epi, class Sched, bool ALIGN_EPI = false, bool SP2 = false>
__device__ __forceinline__ void gemm_phase(PG8_LAS unsigned char* lds, const Gemm g, const Sched& S, const Epi& E) {
    const int tid = threadIdx.x, wid = __builtin_amdgcn_readfirstlane(tid >> 6), lane = tid & 63, wr = wid >> 2, wc = wid & 3, fr = lane & 15, fq = lane >> 4;
    const int K = g.K, nt = K / BK;
    unsigned voffA[2], voffB[2];
#pragma unroll
    for (int i = 0; i < 2; ++i) { int R, C; stage_rc(tid * 16 + i * 8192, R, C); const int Rb = Epi::PERM ? ((R & ~31) + perm32(R & 31)) : R;
        voffA[i] = (unsigned)(R * K + C) * 2u; voffB[i] = (unsigned)(Rb * K + C) * 2u; }
    const size_t kstep = (size_t)(BK * 2);
    const size_t hstep = (size_t)HALF * K * 2;
    const size_t tstep = 2 * hstep;
    const unsigned ldsw = (unsigned)wid * 1024u;
    const int aoff = lds_byte(wr * 64 + fr, fq * 8), boff = lds_byte(wc * 32 + fr, fq * 8);
#define PG8_SA(b, h) (((b) * 2 + (h)) * HTB)
#define PG8_SB(b, h) ((4 + (b) * 2 + (h)) * HTB)
#define PG8_STAGE(bufoff, gbase, voff) do { _Pragma("unroll") for (int _i = 0; _i < 2; ++_i) \
        __builtin_amdgcn_global_load_lds((const unsigned*)((const char*)(gbase) + (voff)[_i]), (PG8_LAS unsigned*)(lds + (bufoff) + ldsw + _i * 8192), 16, 0, 0); } while (0)
#define PG8_LDA(dst, b, h) do { _Pragma("unroll") for (int m = 0; m < 4; ++m) _Pragma("unroll") for (int k = 0; k < 2; ++k) dst[m][k] = *(const PG8_LAS bf16x8*)(lds + PG8_SA(b, h) + aoff + m * 2048 + k * 1024); } while (0)
#define PG8_LDB(dst, b, h) do { _Pragma("unroll") for (int n = 0; n < 2; ++n) _Pragma("unroll") for (int k = 0; k < 2; ++k) dst[n][k] = *(const PG8_LAS bf16x8*)(lds + PG8_SB(b, h) + boff + n * 2048 + k * 1024); } while (0)
#define PG8_MMA(ai, bj, At, Bt) do { __builtin_amdgcn_s_setprio(1); _Pragma("unroll") for (int m = 0; m < 4; ++m) _Pragma("unroll") for (int n = 0; n < 2; ++n) _Pragma("unroll") for (int k = 0; k < 2; ++k) \
        acc[ai][bj][m][n] = __builtin_amdgcn_mfma_f32_16x16x32_bf16(Bt[n][k], At[m][k], acc[ai][bj][m][n], 0, 0, 0); __builtin_amdgcn_s_setprio(0); } while (0)
#define PG8_WAIT_V(n) asm volatile("s_waitcnt vmcnt(" #n ")" ::: "memory")
#define PG8_WAIT_L(n) asm volatile("s_waitcnt lgkmcnt(" #n ")" ::: "memory")
#define PG8_BAR __builtin_amdgcn_s_barrier()
#define PG8_SCHED __builtin_amdgcn_sched_barrier(0)
    Unit cur, nxt; int ui = 0;
    if (!S.next(0, cur)) return;
    f32x4 acc[2][2][4][2];
#pragma unroll
    for (int a = 0; a < 2; ++a)
#pragma unroll
        for (int b = 0; b < 2; ++b)
#pragma unroll
            for (int m = 0; m < 4; ++m)
#pragma unroll
                for (int n = 0; n < 2; ++n) acc[a][b][m][n] = (f32x4){0.f, 0.f, 0.f, 0.f};
    bf16x8 At[4][2], B0[2][2], B1[2][2];
    const char* cA = (const char*)g.A + (size_t)cur.pm * tstep; const char* cB = (const char*)g.Bt + (size_t)cur.pn * tstep;
    S.a_ready(cur);
    if constexpr (SP2) {
        PG8_STAGE(PG8_SB(0, 0), cB, voffB); PG8_STAGE(PG8_SB(0, 1), cB + hstep, voffB); PG8_STAGE(PG8_SA(0, 0), cA, voffA); PG8_STAGE(PG8_SA(0, 1), cA + hstep, voffA);
        if (wr == 1) PG8_BAR;
        PG8_WAIT_V(2); PG8_BAR;
        PG8_STAGE(PG8_SB(1, 0), cB + kstep, voffB); PG8_STAGE(PG8_SA(1, 0), cA + kstep, voffA); PG8_STAGE(PG8_SB(1, 1), cB + hstep + kstep, voffB);
        PG8_WAIT_V(6); PG8_BAR;
    } else {
        PG8_STAGE(PG8_SB(0, 0), cB, voffB); PG8_STAGE(PG8_SA(0, 0), cA, voffA); PG8_STAGE(PG8_SB(0, 1), cB + hstep, voffB); PG8_STAGE(PG8_SA(0, 1), cA + hstep, voffA);
        if (wr == 1) PG8_BAR;
        PG8_WAIT_V(4); PG8_BAR;
        PG8_STAGE(PG8_SB(1, 0), cB + kstep, voffB); PG8_STAGE(PG8_SA(1, 0), cA + kstep, voffA); PG8_STAGE(PG8_SB(1, 1), cB + hstep + kstep, voffB);
        PG8_WAIT_V(6); PG8_BAR;
    }
    for (;;) {
        const bool has_next = S.next(ui + 1, nxt);
        const char* nA = has_next ? (const char*)g.A + (size_t)nxt.pm * tstep : cA; const char* nB = has_next ? (const char*)g.Bt + (size_t)nxt.pn * tstep : cB;
        for (int t = 0; t < nt; t += 2) {
            const bool last = (t == nt - 2);
            const char* a1 = cA + (size_t)(t + 1) * kstep;
            const char* a2 = last ? nA : cA + (size_t)(t + 2) * kstep; const char* b2 = last ? nB : cB + (size_t)(t + 2) * kstep;
            const char* a3 = a2 + kstep; const char* b3 = b2 + kstep;
            if (last && has_next) S.a_ready(nxt);
            if constexpr (SP2) {
            PG8_LDB(B0, 0, 0); PG8_LDB(B1, 0, 1); PG8_SCHED; PG8_LDA(At, 0, 0); PG8_STAGE(PG8_SA(1, 1), a1 + hstep, voffA);
            PG8_WAIT_V(8); PG8_WAIT_L(0); PG8_BAR; PG8_MMA(0, 0, At, B0); PG8_MMA(0, 1, At, B1); PG8_BAR; PG8_SCHED;
            PG8_LDA(At, 0, 1); PG8_STAGE(PG8_SB(0, 0), b2, voffB); PG8_STAGE(PG8_SB(0, 1), b2 + hstep, voffB); PG8_STAGE(PG8_SA(0, 0), a2, voffA);
            PG8_WAIT_V(8); PG8_WAIT_L(0); PG8_BAR; PG8_MMA(1, 0, At, B0); PG8_MMA(1, 1, At, B1); PG8_BAR; PG8_SCHED;
            PG8_LDB(B0, 1, 0); PG8_LDB(B1, 1, 1); PG8_SCHED; PG8_LDA(At, 1, 0); PG8_STAGE(PG8_SA(0, 1), a2 + hstep, voffA);
            PG8_WAIT_V(8); PG8_WAIT_L(0); PG8_BAR; PG8_MMA(0, 0, At, B0); PG8_MMA(0, 1, At, B1); PG8_BAR; PG8_SCHED;
            PG8_LDA(At, 1, 1); PG8_STAGE(PG8_SB(1, 0), b3, voffB); PG8_STAGE(PG8_SB(1, 1), b3 + hstep, voffB); PG8_STAGE(PG8_SA(1, 0), a3, voffA);
            PG8_WAIT_V(8); PG8_WAIT_L(0); PG8_BAR; PG8_MMA(1, 0, At, B0); PG8_MMA(1, 1, At, B1); PG8_BAR; PG8_SCHED;
            } else {
            PG8_LDB(B0, 0, 0); PG8_SCHED; PG8_LDA(At, 0, 0); PG8_STAGE(PG8_SA(1, 1), a1 + hstep, voffA);
            PG8_WAIT_L(8); PG8_BAR; PG8_WAIT_L(0); PG8_MMA(0, 0, At, B0); PG8_BAR; PG8_SCHED;
            PG8_LDB(B1, 0, 1); PG8_STAGE(PG8_SB(0, 0), b2, voffB);
            PG8_BAR; PG8_WAIT_L(0); PG8_MMA(0, 1, At, B1); PG8_BAR;
            PG8_LDA(At, 0, 1); PG8_STAGE(PG8_SA(0, 0), a2, voffA);
            PG8_BAR; PG8_WAIT_L(0); PG8_MMA(1, 0, At, B0); PG8_BAR; PG8_SCHED;
            PG8_STAGE(PG8_SB(0, 1), b2 + hstep, voffB);
            PG8_WAIT_V(6); PG8_BAR; PG8_MMA(1, 1, At, B1); PG8_BAR;
            PG8_LDB(B0, 1, 0); PG8_SCHED; PG8_LDA(At, 1, 0); PG8_STAGE(PG8_SA(0, 1), a2 + hstep, voffA);
            PG8_WAIT_L(8); PG8_BAR; PG8_WAIT_L(0); PG8_MMA(0, 0, At, B0); PG8_BAR; PG8_SCHED;
            PG8_LDB(B1, 1, 1); PG8_STAGE(PG8_SB(1, 0), b3, voffB);
            PG8_BAR; PG8_WAIT_L(0); PG8_MMA(0, 1, At, B1); PG8_BAR;
            PG8_LDA(At, 1, 1); PG8_STAGE(PG8_SA(1, 0), a3, voffA);
            PG8_BAR; PG8_WAIT_L(0); PG8_MMA(1, 0, At, B0); PG8_BAR; PG8_SCHED;
            PG8_STAGE(PG8_SB(1, 1), b3 + hstep, voffB);
            PG8_WAIT_V(6); PG8_BAR; PG8_MMA(1, 1, At, B1); PG8_BAR;
            }
        }
        if constexpr (ALIGN_EPI) { if (wr == 0) PG8_BAR; }
        if constexpr (!Epi::AFTER_DRAIN) { E(acc, cur, wr, wc, fr, fq); S.done(cur); }
        if (!has_next) break;
#pragma unroll
        for (int a = 0; a < 2; ++a)
#pragma unroll
            for (int b = 0; b < 2; ++b)
#pragma unroll
                for (int m = 0; m < 4; ++m)
#pragma unroll
                    for (int n = 0; n < 2; ++n) acc[a][b][m][n] = (f32x4){0.f, 0.f, 0.f, 0.f};
        cur = nxt; cA = nA; cB = nB; ++ui;
        if constexpr (ALIGN_EPI) { if (wr == 1) PG8_BAR; }
    }
    PG8_WAIT_V(0);
    if constexpr (!ALIGN_EPI) { if (wr == 0) PG8_BAR; }
    PG8_BAR;
    if constexpr (Epi::AFTER_DRAIN) { E.fused(acc, cur, wr, wc, fr, fq, lds, wid, lane); S.done(cur); }
#undef PG8_SA
#undef PG8_SB
#undef PG8_STAGE
#undef PG8_LDA
#undef PG8_LDB
#undef PG8_MMA
#undef PG8_WAIT_V
#undef PG8_WAIT_L
#undef PG8_BAR
#undef PG8_SCHED
}
}

using pg8::bf16_t; using pg8::bf16x8; using pg8::f32x4;
#define LAS __attribute__((address_space(3)))
typedef short bf16x4 __attribute__((ext_vector_type(4)));
typedef unsigned u32x4 __attribute__((ext_vector_type(4)));
typedef unsigned u32x2 __attribute__((ext_vector_type(2)));

constexpr int NTHREADS = 512;
constexpr int T_ALL = 17408, NCTX = 1024, NLAT = 16384, DM = 1024, INC = 1792, FFD = 4096;
constexpr int LDS_BYTES = 147456;
constexpr float EPS = 1e-6f;

constexpr size_t MiB = 1u << 20;
constexpr size_t WS_MOD = 0;
constexpr size_t WS_CTAB = 256 * 1024;
constexpr size_t WS_STAB = 256 * 1024 + 8192;
constexpr size_t WS_PACK = 1 * MiB;
constexpr size_t WS_SLOC = 3 * MiB;
constexpr size_t WS_CARRY = 7 * MiB + 256 * 1024;
constexpr size_t WS_W = 12 * MiB;
constexpr size_t W_IN = 0, W_PW = W_IN + (size_t)INC * DM * 2, W_F = W_PW + 256 * 256 * 2, W_GLU = W_F + 256 * 256 * 2,
                 W_OUT = W_GLU + 512 * 256 * 2, W_1 = W_OUT + (size_t)DM * DM * 2, W_2 = W_1 + (size_t)FFD * DM * 2, W_LAYER = W_2 + (size_t)FFD * DM * 2;
static_assert(W_LAYER == 22 * MiB, "weights per layer");
constexpr size_t WS_XC = 56 * MiB;
constexpr size_t WS_XN = 60 * MiB;
constexpr size_t WS_BIG = 94 * MiB;
constexpr size_t WS_H = WS_BIG;
constexpr size_t WS_PX = WS_BIG;
constexpr size_t WS_VT = 154 * MiB;
constexpr size_t WS_VTC = 162 * MiB;
constexpr size_t WS_CV = 163 * MiB;
constexpr size_t WS_YB = 172 * MiB;
constexpr size_t WS_FN = 188 * MiB;
constexpr size_t WS_YS = 197 * MiB;
constexpr size_t WS_ZS = 206 * MiB;
constexpr size_t WS_MIX = 223 * MiB;
constexpr size_t WS_END = 256 * MiB;
static_assert(WS_H + (size_t)T_ALL * FFD * 2 <= WS_END && WS_MIX + (size_t)T_ALL * 768 * 2 <= WS_END && WS_PX + (size_t)T_ALL * INC * 2 <= WS_VT, "ws map");

__device__ __forceinline__ unsigned f2bf(float f) { unsigned u = __builtin_bit_cast(unsigned, f); return (u + 0x7fffu + ((u >> 16) & 1u)) >> 16; }
__device__ __forceinline__ unsigned pk2(float lo, float hi) { return f2bf(lo) | (f2bf(hi) << 16); }
__device__ __forceinline__ float bf2f(unsigned h) { return __builtin_bit_cast(float, (h & 0xffffu) << 16); }
__device__ __forceinline__ float bflo(unsigned w) { return __builtin_bit_cast(float, w << 16); }
__device__ __forceinline__ float bfhi(unsigned w) { return __builtin_bit_cast(float, w & 0xffff0000u); }
__device__ __forceinline__ bf16x8 pack8(f32x4 a, f32x4 b) {
    u32x4 w; w.x = pk2(a[0], a[1]); w.y = pk2(a[2], a[3]); w.z = pk2(b[0], b[1]); w.w = pk2(b[2], b[3]);
    return __builtin_bit_cast(bf16x8, w);
}
__device__ __forceinline__ bf16x8 neg8(bf16x8 v) { u32x4 w = __builtin_bit_cast(u32x4, v); w.x ^= 0x80008000u; w.y ^= 0x80008000u; w.z ^= 0x80008000u; w.w ^= 0x80008000u; return __builtin_bit_cast(bf16x8, w); }
__device__ __forceinline__ bf16x8 zero8() { u32x4 w = {0u, 0u, 0u, 0u}; return __builtin_bit_cast(bf16x8, w); }
__device__ __forceinline__ bf16x8 cat4(u32x2 a, u32x2 b) { u32x4 w; w.x = a.x; w.y = a.y; w.z = b.x; w.w = b.y; return __builtin_bit_cast(bf16x8, w); }
__device__ __forceinline__ f32x4 mfma16(bf16x8 a, bf16x8 b, f32x4 c) { return __builtin_amdgcn_mfma_f32_16x16x32_bf16(a, b, c, 0, 0, 0); }
__device__ __forceinline__ void settle4(f32x4& a, f32x4& b, f32x4& c, f32x4& d) { asm volatile("s_nop 15\n\ts_nop 15" : "+v"(a), "+v"(b), "+v"(c), "+v"(d)); }
__device__ __forceinline__ void settle4m(f32x4& a, f32x4& b, f32x4& c, f32x4& d) { asm volatile("s_nop 7\n\ts_nop 7" : "+v"(a), "+v"(b), "+v"(c), "+v"(d) :: "memory"); }
__device__ __forceinline__ f32x4 mfma16s(bf16x8 a, bf16x8 b, f32x4 c) { asm volatile("s_nop 7" : "+v"(a), "+v"(b)); return __builtin_amdgcn_mfma_f32_16x16x32_bf16(a, b, c, 0, 0, 0); }
__device__ __forceinline__ void settle2(f32x4& a, f32x4& b) { asm volatile("s_nop 15\n\ts_nop 15" : "+v"(a), "+v"(b)); }
__device__ __forceinline__ void settle_in(bf16x8& a, bf16x8& b) { asm volatile("s_nop 3" : "+v"(a), "+v"(b)); }
__device__ __forceinline__ float wave_sum(float v) {
    v += __shfl_xor(v, 1); v += __shfl_xor(v, 2); v += __shfl_xor(v, 4); v += __shfl_xor(v, 8); v += __shfl_xor(v, 16); v += __shfl_xor(v, 32); return v;
}
__device__ __forceinline__ float sigmoidf_(float x) { return 1.0f / (1.0f + __expf(-x)); }
struct cplx { float re, im; };
__device__ __forceinline__ cplx cmul(cplx a, cplx b) { return cplx{a.re * b.re - a.im * b.im, a.re * b.im + a.im * b.re}; }
__device__ __forceinline__ cplx cmad(cplx acc, cplx a, cplx b) { return cplx{acc.re + a.re * b.re - a.im * b.im, acc.im + a.re * b.im + a.im * b.re}; }

struct Args { const float* in[36]; float* out; unsigned char* ws; int ph_lo, ph_hi, part, pad; };
struct Frame {
    const Args& A;
    float* out; unsigned char* ws;
    int tid, lane, wave;
};
#define FP(off, type) ((type*)(F.ws + (off)))

constexpr int PK_N = 23;
constexpr int PK_IDX[PK_N] = {6,8,9,10,11,13,15,16,17,18,19,20,21,22,23,24,26,27,29,30,32,34,35};
constexpr int PK_CNT[PK_N] = {2048,15872,512,512,512,512,512,3720,4096,4096,64,65536,65536,65536,65536,512,1024,2048,2048,2048,8192,2048,1024};
constexpr int pk_off(int k) { int o = 0; for (int i = 0; i < PK_N; ++i) { if (PK_IDX[i] == k) return o; o += PK_CNT[i]; } return -1; }
#define PK(k) (FP(WS_PACK, float) + pk_off(k))
static_assert(pk_off(35) + 1024 <= (int)(2 * MiB / 4), "pack size");

struct EpiU {
    static constexpr bool PERM = false, AFTER_DRAIN = false;
    const Frame& F; int l; int kind; int row_lo;
    __device__ __forceinline__ void operator()(const f32x4 (&acc)[2][2][4][2], const pg8::Unit& u, int wr, int wc, int fr, int fq) const {
        const int c0 = u.pn * 256 + wc * 32 + fq * 4;
        const int r0 = u.pm * 256 + wr * 64 + fr;
        if (kind < 6) {
            bf16_t* base; size_t ldc; const float* bias = nullptr;
            if (kind == 0) { base = FP(WS_PX, bf16_t) + (size_t)r0 * INC + c0; ldc = INC; }
            else if (kind == 1) {
                if (u.pn < 4) { base = FP(WS_VTC, bf16_t) + (size_t)u.pn * 65536 + (size_t)r0 * 256 + (c0 - u.pn * 256); ldc = 256; }
                else { const int tt = u.pn - 4; base = FP(WS_VT, bf16_t) + (size_t)(tt >> 4) * 256 * 4096 + (tt & 15) * 256 + (size_t)r0 * 4096 + (c0 - u.pn * 256); ldc = 4096; }
            }
            else if (kind == 2) { base = FP(WS_MIX, bf16_t) + (size_t)(row_lo + r0) * 768 + c0; ldc = 768; bias = PK(13) + l * 256; }
            else if (kind == 3) { base = FP(WS_MIX, bf16_t) + (size_t)(row_lo + r0) * 768 + 256 + c0; ldc = 768; bias = PK(15) + l * 256; }
            else if (kind == 4) { base = FP(WS_ZS, bf16_t) + (size_t)(row_lo + r0) * 512 + c0; ldc = 512; bias = PK(26) + l * 512; }
            else { base = FP(WS_H, bf16_t) + (size_t)(row_lo + r0) * FFD + c0; ldc = FFD; bias = PK(32) + l * FFD; }
#pragma unroll
            for (int bj = 0; bj < 2; ++bj)
#pragma unroll
                for (int n = 0; n < 2; ++n) {
                    f32x4 bv = f32x4{0.f, 0.f, 0.f, 0.f};
                    if (bias) bv = *(const f32x4*)(bias + c0 + bj * 128 + n * 16);
#pragma unroll
                    for (int ai = 0; ai < 2; ++ai)
#pragma unroll
                        for (int m = 0; m < 4; ++m) {
                            f32x4 v = acc[ai][bj][m][n] + bv;
                            if (kind == 5) {
#pragma unroll
                                for (int j = 0; j < 4; ++j) { const float r = fmaxf(v[j], 0.f); v[j] = r * r; }
                            }
                            u32x2 w; w.x = pk2(v[0], v[1]); w.y = pk2(v[2], v[3]);
                            *(u32x2*)(base + (size_t)(ai * 128 + m * 16) * ldc + bj * 128 + n * 16) = w;
                        }
                }
        } else {
            const int gp = u.pm + (row_lo >> 8); const bool isc = gp < 4; const int lrow0 = isc ? gp * 256 : (gp - 4) * 256; const int br = isc ? 4 : ((gp - 4) >> 4);
            const float* sC; const float* sL; const float* bias; int gate_off;
            if (kind == 6) { sC = l == 0 ? F.A.in[2] : FP(WS_XC, float); sL = l == 0 ? F.A.in[0] : F.out; bias = PK(29) + l * DM; gate_off = 2048; }
            else { sC = FP(WS_XC, float); sL = F.out; bias = PK(34) + l * DM; gate_off = 5120; }
            const size_t roff = (size_t)(lrow0 + wr * 64 + fr) * DM + c0;
            const float* s = (isc ? sC : sL) + roff; float* d = (isc ? FP(WS_XC, float) : F.out) + roff;
            const float* gate = FP(WS_MOD, float) + (l * 5 + br) * 6144 + gate_off;
#pragma unroll
            for (int bj = 0; bj < 2; ++bj)
#pragma unroll
                for (int n = 0; n < 2; ++n) {
                    const int cc = c0 + bj * 128 + n * 16;
                    const f32x4 bv = *(const f32x4*)(bias + cc); const f32x4 gv = *(const f32x4*)(gate + cc);
#pragma unroll
                    for (int ai = 0; ai < 2; ++ai)
#pragma unroll
                        for (int m = 0; m < 4; ++m) {
                            const size_t o = (size_t)(ai * 128 + m * 16) * DM + bj * 128 + n * 16;
                            const f32x4 xv = *(const f32x4*)(s + o);
                            *(f32x4*)(d + o) = xv + gv * (acc[ai][bj][m][n] + bv);
                        }
                }
        }
    }
};

__device__ __forceinline__ void transpose_tile(const float* W, int K, int N, bf16_t* Wt, int tile, float* scr, int tid) {
    const int ntn = N >> 6; const int tk = tile / ntn, tn = tile - tk * ntn; const int k0 = tk * 64, n0 = tn * 64;
    { const int n = tid & 63, kk = tid >> 6;
#pragma unroll
      for (int i = 0; i < 8; ++i) { const int k = kk + 8 * i; scr[k * 65 + n] = W[(size_t)(k0 + k) * N + n0 + n]; } }
    __syncthreads();
    { const int kp = tid & 31, nn = tid >> 5;
#pragma unroll
      for (int i = 0; i < 4; ++i) { const int n = nn + 16 * i; const unsigned v = pk2(scr[(2 * kp) * 65 + n], scr[(2 * kp + 1) * 65 + n]); *(unsigned*)(Wt + (size_t)(n0 + n) * K + k0 + 2 * kp) = v; } }
    __syncthreads();
}
__device__ __forceinline__ void mod_unit(const Frame& F, int unit, float* scr) {
    const int l = unit / 96, cc = unit - l * 96; const int tid = F.tid;
    float* sl = scr; float* red = scr + 5 * 1024;
    for (int i = tid; i < 5 * 1024; i += NTHREADS) { const int r = i >> 10, k = i & 1023; const float c = r < 4 ? F.A.in[1][r * 1024 + k] : F.A.in[3][k]; sl[i] = c * sigmoidf_(c); }
    __syncthreads();
    const int col = tid & 63, kg = tid >> 6;
    const float* w = F.A.in[4] + (size_t)l * DM * 6144 + cc * 64 + col;
    float a0 = 0.f, a1 = 0.f, a2 = 0.f, a3 = 0.f, a4 = 0.f;
    for (int k = kg * 128; k < kg * 128 + 128; ++k) { const float wv = w[(size_t)k * 6144]; a0 += sl[k] * wv; a1 += sl[1024 + k] * wv; a2 += sl[2048 + k] * wv; a3 += sl[3072 + k] * wv; a4 += sl[4096 + k] * wv; }
    red[(kg * 5 + 0) * 64 + col] = a0; red[(kg * 5 + 1) * 64 + col] = a1; red[(kg * 5 + 2) * 64 + col] = a2; red[(kg * 5 + 3) * 64 + col] = a3; red[(kg * 5 + 4) * 64 + col] = a4;
    __syncthreads();
    if (tid < 320) { const int r = tid >> 6, c2 = tid & 63; float s = 0.f;
#pragma unroll
        for (int g = 0; g < 8; ++g) s += red[(g * 5 + r) * 64 + c2];
        FP(WS_MOD, float)[(l * 5 + r) * 6144 + cc * 64 + c2] = s + F.A.in[5][l * 6144 + cc * 64 + c2]; }
    __syncthreads();
}
__device__ __forceinline__ void p0_prologue(const Frame& F, float* scr) {
    const int NT_L = 448 + 16 + 16 + 32 + 256 + 1024 + 1024;
    const int njobs = 193 + 2 * NT_L + PK_N;
    for (int job = blockIdx.x; job < njobs; job += gridDim.x) {
        if (job >= 193 + 2 * NT_L) {
            const int e = job - (193 + 2 * NT_L); const float* src = nullptr; int cnt = 0, off = 0;
#define PKC(i) if (e == i) { src = F.A.in[PK_IDX[i]]; cnt = PK_CNT[i]; off = pk_off(PK_IDX[i]); }
            PKC(0) PKC(1) PKC(2) PKC(3) PKC(4) PKC(5) PKC(6) PKC(7) PKC(8) PKC(9) PKC(10) PKC(11) PKC(12) PKC(13) PKC(14) PKC(15) PKC(16) PKC(17) PKC(18) PKC(19) PKC(20) PKC(21) PKC(22)
#undef PKC
            float* dst = FP(WS_PACK, float) + off;
            for (int i = F.tid; i < cnt; i += NTHREADS) dst[i] = src[i];
        }
        else if (job < 192) { mod_unit(F, job, scr); }
        else if (job == 192) {
            for (int i = F.tid; i < 4096; i += NTHREADS) { const int m = i >> 6, j = i & 63; const float x = (float)((m * j) & 63) * (1.0f / 32.0f);
                FP(WS_CTAB, bf16_t)[i] = (bf16_t)f2bf(cospif(x)); FP(WS_STAB, bf16_t)[i] = (bf16_t)f2bf(sinpif(x)); }
        } else {
            int t = job - 193; const int l = t / NT_L; t -= l * NT_L;
            unsigned char* wl = F.ws + WS_W + (size_t)l * W_LAYER;
            if (t < 448) transpose_tile(F.A.in[7] + (size_t)l * DM * INC, DM, INC, (bf16_t*)(wl + W_IN), t, scr, F.tid);
            else if ((t -= 448) < 16) transpose_tile(F.A.in[12] + (size_t)l * 65536, 256, 256, (bf16_t*)(wl + W_PW), t, scr, F.tid);
            else if ((t -= 16) < 16) transpose_tile(F.A.in[14] + (size_t)l * 65536, 256, 256, (bf16_t*)(wl + W_F), t, scr, F.tid);
            else if ((t -= 16) < 32) transpose_tile(F.A.in[25] + (size_t)l * 131072, 256, 512, (bf16_t*)(wl + W_GLU), t, scr, F.tid);
            else if ((t -= 32) < 256) transpose_tile(F.A.in[28] + (size_t)l * DM * DM, DM, DM, (bf16_t*)(wl + W_OUT), t, scr, F.tid);
            else if ((t -= 256) < 1024) transpose_tile(F.A.in[31] + (size_t)l * DM * FFD, DM, FFD, (bf16_t*)(wl + W_1), t, scr, F.tid);
            else { t -= 1024; transpose_tile(F.A.in[33] + (size_t)l * DM * FFD, FFD, DM, (bf16_t*)(wl + W_2), t, scr, F.tid); }
        }
    }
}

__device__ __forceinline__ void prep_norm_mod(const Frame& F, const float* srcC, const float* srcL, const float* g, const float* modl, int sh_off, int sc_off, bf16_t* XN, int row_lo) {
    const int gw = blockIdx.x * 8 + F.wave, nw = gridDim.x * 8, lane = F.lane;
    for (int row = row_lo + gw; row < T_ALL; row += nw) {
        const bool isc = row < NCTX; const float* x = isc ? srcC + (size_t)row * DM : srcL + (size_t)(row - NCTX) * DM; const int br = isc ? 4 : ((row - NCTX) >> 12);
        const float* sh = modl + br * 6144 + sh_off; const float* sc = modl + br * 6144 + sc_off;
        f32x4 v[4]; float ss = 0.f;
#pragma unroll
        for (int i = 0; i < 4; ++i) { v[i] = *(const f32x4*)(x + i * 256 + lane * 4); ss += v[i][0] * v[i][0] + v[i][1] * v[i][1] + v[i][2] * v[i][2] + v[i][3] * v[i][3]; }
        ss = wave_sum(ss); const float r = rsqrtf(ss * (1.0f / 1024.0f) + EPS);
#pragma unroll
        for (int i = 0; i < 4; ++i) { const int c = i * 256 + lane * 4; const f32x4 gv = *(const f32x4*)(g + c), shv = *(const f32x4*)(sh + c), scv = *(const f32x4*)(sc + c);
            f32x4 y = v[i] * r * gv; y = y * (scv + 1.0f) + shv; u32x2 w; w.x = pk2(y[0], y[1]); w.y = pk2(y[2], y[3]); *(u32x2*)(XN + (size_t)row * DM + c) = w; }
    }
}
__device__ __forceinline__ f32x4 ld_bf4(const bf16_t* p) { const u32x2 w = *(const u32x2*)p; return f32x4{bflo(w.x), bfhi(w.x), bflo(w.y), bfhi(w.y)}; }
__device__ __forceinline__ void prep_group(const Frame& F, int l, int row_lo) {
    const int gw = blockIdx.x * 8 + F.wave, nw = gridDim.x * 8, lane = F.lane;
    const bf16_t* MIX = FP(WS_MIX, bf16_t); const bf16_t* ZS = FP(WS_ZS, bf16_t); bf16_t* O = FP(WS_XN, bf16_t); const float* gg = PK(27) + l * DM;
    for (int row = row_lo + gw; row < T_ALL; row += nw) {
#pragma unroll
        for (int grp = 0; grp < 4; ++grp) {
            f32x4 v;
            if (grp < 3) v = ld_bf4(MIX + (size_t)row * 768 + grp * 256 + lane * 4);
            else { const f32x4 a = ld_bf4(ZS + (size_t)row * 512 + lane * 4), gt = ld_bf4(ZS + (size_t)row * 512 + 256 + lane * 4);
#pragma unroll
                for (int j = 0; j < 4; ++j) v[j] = a[j] * sigmoidf_(gt[j]); }
            float ss = v[0] * v[0] + v[1] * v[1] + v[2] * v[2] + v[3] * v[3]; ss = wave_sum(ss);
            const float r = rsqrtf(ss * (1.0f / 256.0f) + EPS); const f32x4 gv = *(const f32x4*)(gg + grp * 256 + lane * 4); const f32x4 y = v * r * gv;
            u32x2 w; w.x = pk2(y[0], y[1]); w.y = pk2(y[2], y[3]); *(u32x2*)(O + (size_t)row * DM + grp * 256 + lane * 4) = w;
        }
    }
}
__device__ __forceinline__ void final_norm(const Frame& F) {
    const int gw = blockIdx.x * 8 + F.wave, nw = gridDim.x * 8, lane = F.lane; const float* g = PK(35);
    for (int row = gw; row < NLAT; row += nw) {
        float* x = F.out + (size_t)row * DM; f32x4 v[4]; float ss = 0.f;
#pragma unroll
        for (int i = 0; i < 4; ++i) { v[i] = *(const f32x4*)(x + i * 256 + lane * 4); ss += v[i][0] * v[i][0] + v[i][1] * v[i][1] + v[i][2] * v[i][2] + v[i][3] * v[i][3]; }
        ss = wave_sum(ss); const float r = rsqrtf(ss * (1.0f / 1024.0f) + EPS);
#pragma unroll
        for (int i = 0; i < 4; ++i) { const int c = i * 256 + lane * 4; *(f32x4*)(x + c) = v[i] * r * *(const f32x4*)(g + c); }
    }
}

__device__ __forceinline__ void conv_unit(const Frame& F, int l, int unit, float* scr) {
    const bf16_t* PX = FP(WS_PX, bf16_t); bf16_t* CV = FP(WS_CV, bf16_t);
    int prow0, Lseq, t0;
    if (unit < 512) { const int b = unit >> 7; t0 = (unit & 127) * 32; prow0 = NCTX + b * 4096; Lseq = 4096; }
    else { const int uu = unit - 512; const int b = uu >> 3; t0 = (uu & 7) * 32; prow0 = b * 256; Lseq = 256; }
    float* vt = scr; float* ot = scr + 62 * 256; int tid = F.tid; asm volatile("" : "+v"(tid));
    for (int idx = tid; idx < 62 * 256; idx += NTHREADS) { const int rr = idx >> 8, c = idx & 255; const int t = t0 - 15 + rr; float v = 0.f;
        if (t >= 0 && t < Lseq) { const bf16_t* p = PX + (size_t)(prow0 + t) * INC; const float a = bf2f(p[c]), gt = bf2f(p[256 + c]); v = a * sigmoidf_(gt); }
        vt[idx] = v; }
    __syncthreads();
    { const int c = tid & 255, half = tid >> 8; float w[31];
#pragma unroll
      for (int j = 0; j < 31; ++j) w[j] = PK(8)[(l * 31 + j) * 256 + c];
      const float bd = PK(9)[l * 256 + c];
      for (int tt = 0; tt < 16; ++tt) { const int t = half * 16 + tt; float s = bd;
#pragma unroll
          for (int j = 0; j < 31; ++j) s += w[j] * vt[(t + j) * 256 + c];
          ot[t * 256 + c] = s; } }
    __syncthreads();
    { const int lane = tid & 63; const f32x4 lg = *(const f32x4*)(PK(10) + l * 256 + lane * 4), lb = *(const f32x4*)(PK(11) + l * 256 + lane * 4);
      for (int i = 0; i < 4; ++i) { const int t = F.wave * 4 + i; const f32x4 x = *(const f32x4*)(ot + t * 256 + lane * 4);
          const float mu = wave_sum(x[0] + x[1] + x[2] + x[3]) * (1.0f / 256.0f); const f32x4 d = x - mu;
          const float var = wave_sum(d[0] * d[0] + d[1] * d[1] + d[2] * d[2] + d[3] * d[3]) * (1.0f / 256.0f); const float r = rsqrtf(var + EPS);
          f32x4 y = d * r * lg + lb;
#pragma unroll
          for (int j = 0; j < 4; ++j) y[j] = y[j] * sigmoidf_(y[j]);
          u32x2 w; w.x = pk2(y[0], y[1]); w.y = pk2(y[2], y[3]); *(u32x2*)(CV + (size_t)(prow0 + t0 + t) * 256 + lane * 4) = w; } }
    __syncthreads();
}

__device__ __forceinline__ void fnetctx_unit(const Frame& F, int unit, float* scr) {
    const bf16_t* PX = FP(WS_PX, bf16_t); bf16_t* FN = FP(WS_FN, bf16_t);
    const int mh = unit & 1, h = (unit >> 1) & 3, b = unit >> 3; int tid = F.tid; asm volatile("" : "+v"(tid));
    float* zc = scr; float* zs = scr + 8192; float* c64 = scr + 16384; float* s64 = c64 + 64; float* c256 = s64 + 64; float* s256 = c256 + 256;
    if (tid < 64) { const float x = (float)tid * (1.0f / 32.0f); c64[tid] = cospif(x); s64[tid] = sinpif(x); }
    if (tid < 256) { const float x = (float)tid * (1.0f / 128.0f); c256[tid] = cospif(x); s256[tid] = sinpif(x); }
    __syncthreads();
    for (int idx = tid; idx < 8192; idx += NTHREADS) { const int n = idx >> 5, mm = idx & 31, m = mh * 32 + mm; const bf16_t* up = PX + (size_t)(b * 256 + n) * INC + 512 + h * 64;
        float ac = 0.f, as = 0.f;
        for (int j = 0; j < 64; ++j) { const float uv = bf2f(up[j]); const int a = (j * m) & 63; ac += uv * c64[a]; as += uv * s64[a]; }
        zc[idx] = ac; zs[idx] = as; }
    __syncthreads();
    for (int idx = tid; idx < 8192; idx += NTHREADS) { const int k = idx >> 5, mm = idx & 31; float acc = 0.f;
        for (int n = 0; n < 256; ++n) { const int a = (k * n) & 255; acc += c256[a] * zc[n * 32 + mm] - s256[a] * zs[n * 32 + mm]; }
        FN[(size_t)(b * 256 + k) * 256 + h * 64 + mh * 32 + mm] = (bf16_t)f2bf(acc * (1.0f / 128.0f)); }
    __syncthreads();
}
__device__ __forceinline__ void fnetA_unit(const Frame& F, int unit, unsigned char* lds) {
    const bf16_t* PX = FP(WS_PX, bf16_t); const bf16_t* Ct = FP(WS_CTAB, bf16_t); const bf16_t* St = FP(WS_STAB, bf16_t); bf16_t* YB = FP(WS_YB, bf16_t);
    const int oct = unit & 7, h = (unit >> 3) & 3, b = unit >> 5; int tid = F.tid; asm volatile("" : "+v"(tid)); const int lane = tid & 63, fr = lane & 15, fq = lane >> 4; const int n2 = oct * 8 + F.wave;
    bf16x8 ua[4][2];
#pragma unroll
    for (int mi = 0; mi < 4; ++mi)
#pragma unroll
        for (int kk = 0; kk < 2; ++kk) ua[mi][kk] = *(const bf16x8*)(PX + (size_t)(NCTX + b * 4096 + 64 * (16 * mi + fr) + n2) * INC + 512 + h * 64 + kk * 32 + fq * 8);
    bf16x8 zre[2][4], zs[2][4];
#pragma unroll
    for (int ni = 0; ni < 4; ++ni) {
        bf16x8 bc[2], bs[2];
#pragma unroll
        for (int kk = 0; kk < 2; ++kk) { bc[kk] = *(const bf16x8*)(Ct + (16 * ni + fr) * 64 + kk * 32 + fq * 8); bs[kk] = *(const bf16x8*)(St + (16 * ni + fr) * 64 + kk * 32 + fq * 8); }
#pragma unroll
        for (int pr = 0; pr < 2; ++pr) {
            f32x4 c0 = {0.f, 0.f, 0.f, 0.f}, c1 = c0, s0 = c0, s1 = c0;
#pragma unroll
            for (int kk = 0; kk < 2; ++kk) { c0 = mfma16(ua[2 * pr][kk], bc[kk], c0); c1 = mfma16(ua[2 * pr + 1][kk], bc[kk], c1); s0 = mfma16(ua[2 * pr][kk], bs[kk], s0); s1 = mfma16(ua[2 * pr + 1][kk], bs[kk], s1); }
            zre[pr][ni] = pack8(c0, c1); zs[pr][ni] = pack8(s0, s1);
        }
    }
    bf16_t* T = (bf16_t*)lds;
    for (int mi2 = 0; mi2 < 4; ++mi2) {
        bf16x8 cf[2], sf[2], sfn[2];
#pragma unroll
        for (int pr = 0; pr < 2; ++pr) {
            const bf16_t* cp = Ct + (16 * mi2 + fr) * 64 + 32 * pr + 4 * fq; const bf16_t* sp = St + (16 * mi2 + fr) * 64 + 32 * pr + 4 * fq;
            cf[pr] = cat4(*(const u32x2*)cp, *(const u32x2*)(cp + 16)); sf[pr] = cat4(*(const u32x2*)sp, *(const u32x2*)(sp + 16)); sfn[pr] = neg8(sf[pr]);
        }
        float cs[4], sn[4];
#pragma unroll
        for (int j = 0; j < 4; ++j) { const int k1 = 16 * mi2 + 4 * fq + j; const float x = (float)(n2 * k1) * (1.0f / 2048.0f); cs[j] = cospif(x); sn[j] = sinpif(x); }
#pragma unroll
        for (int ni = 0; ni < 4; ++ni) {
            f32x4 yre = {0.f, 0.f, 0.f, 0.f}, yin = yre;
#pragma unroll
            for (int pr = 0; pr < 2; ++pr) { yre = mfma16s(cf[pr], zre[pr][ni], yre); yre = mfma16s(sfn[pr], zs[pr][ni], yre); yin = mfma16s(cf[pr], zs[pr][ni], yin); yin = mfma16s(sf[pr], zre[pr][ni], yin); }
#pragma unroll
            for (int j = 0; j < 4; ++j) { const int k1 = 16 * mi2 + 4 * fq + j; const int m = 16 * ni + fr;
                const float y1 = yre[j] * cs[j] - yin[j] * sn[j], y2 = yin[j] * cs[j] + yre[j] * sn[j];
                T[((0 * 64 + k1) * 64 + m) * 8 + F.wave] = (bf16_t)f2bf(y1); T[((1 * 64 + k1) * 64 + m) * 8 + F.wave] = (bf16_t)f2bf(y2); }
        }
    }
    __syncthreads();
    for (int it = 0; it < 16; ++it) { const int cidx = it * NTHREADS + tid; const int m = cidx & 63, k1 = (cidx >> 6) & 63, plane = cidx >> 12;
        const u32x4 v = *(const u32x4*)(lds + (size_t)cidx * 16);
        *(u32x4*)(YB + ((((size_t)(b * 4 + h) * 64 + k1) * 2 + plane) * 64 + m) * 64 + oct * 8) = v; }
    __syncthreads();
}
__device__ __forceinline__ void fnetB_item(const Frame& F, int item) {
    const bf16_t* Ct = FP(WS_CTAB, bf16_t); const bf16_t* St = FP(WS_STAB, bf16_t); const bf16_t* YB = FP(WS_YB, bf16_t); bf16_t* FN = FP(WS_FN, bf16_t);
    const int k1 = item & 63, h = (item >> 6) & 3, b = item >> 8; int lane = F.lane; asm volatile("" : "+v"(lane)); const int fr = lane & 15, fq = lane >> 4;
    const bf16_t* base = YB + (((size_t)(b * 4 + h) * 64 + k1) * 2) * 4096;
    f32x4 acc[4][4];
#pragma unroll
    for (int mi = 0; mi < 4; ++mi)
#pragma unroll
        for (int ni = 0; ni < 4; ++ni) acc[mi][ni] = f32x4{0.f, 0.f, 0.f, 0.f};
#pragma unroll
    for (int kk = 0; kk < 2; ++kk) {
        bf16x8 bc[4], bsn[4];
#pragma unroll
        for (int ni = 0; ni < 4; ++ni) { bc[ni] = *(const bf16x8*)(Ct + (16 * ni + fr) * 64 + kk * 32 + fq * 8); bsn[ni] = neg8(*(const bf16x8*)(St + (16 * ni + fr) * 64 + kk * 32 + fq * 8)); }
#pragma unroll
        for (int mi = 0; mi < 4; ++mi) {
            const bf16x8 are = *(const bf16x8*)(base + (16 * mi + fr) * 64 + kk * 32 + fq * 8), aim = *(const bf16x8*)(base + 4096 + (16 * mi + fr) * 64 + kk * 32 + fq * 8);
#pragma unroll
            for (int ni = 0; ni < 4; ++ni) { acc[mi][ni] = mfma16(are, bc[ni], acc[mi][ni]); acc[mi][ni] = mfma16s(aim, bsn[ni], acc[mi][ni]); }
        }
    }
#pragma unroll
    for (int mi = 0; mi < 4; ++mi)
#pragma unroll
        for (int ni = 0; ni < 4; ++ni) { const int k = k1 + 64 * (16 * ni + fr); const f32x4 v = acc[mi][ni] * (1.0f / 512.0f);
            u32x2 w; w.x = pk2(v[0], v[1]); w.y = pk2(v[2], v[3]); *(u32x2*)(FN + (size_t)(NCTX + b * 4096 + k) * 256 + h * 64 + 16 * mi + 4 * fq) = w; }
}

template <bool LOCAL>
__device__ __forceinline__ void attn_item(const Frame& F, int l, int item) {
    const bf16_t* PX = FP(WS_PX, bf16_t); const bf16_t* VT = FP(WS_VT, bf16_t); const bf16_t* VTc = FP(WS_VTC, bf16_t); bf16_t* MIX = FP(WS_MIX, bf16_t);
    const float* rpb = PK(16) + l * (4 * 15 * 31);
    int lane = F.lane; asm volatile("" : "+v"(lane)); const int fr = lane & 15, fq = lane >> 4;
    int b, h, r = 0, jb = 0, qrow0;
    if (LOCAL) { h = item & 3; jb = (item >> 2) & 3; r = (item >> 4) & 63; b = item >> 10; qrow0 = NCTX + b * 4096 + r * 64 + jb * 16; }
    else { h = item & 3; const int qb = (item >> 2) & 15; b = item >> 6; qrow0 = b * 256 + qb * 16; }
    constexpr int NT = LOCAL ? 32 : 16;
    const int rs = LOCAL ? min(max(r - 4, 0), 56) : 0; const int kcs = LOCAL ? min(max(16 * jb - 8, 0), 32) : 0;
    bf16x8 qf[2];
#pragma unroll
    for (int kk = 0; kk < 2; ++kk) qf[kk] = *(const bf16x8*)(PX + (size_t)(qrow0 + fr) * INC + 768 + h * 64 + kk * 32 + fq * 8);
    f32x4 s[NT];
#pragma unroll
    for (int t = 0; t < NT; ++t) {
        int krow;
        if (LOCAL && t < 16) krow = NCTX + b * 4096 + (rs + (t >> 1)) * 64 + kcs + (t & 1) * 16 + fr;
        else krow = b * 256 + (t - (LOCAL ? 16 : 0)) * 16 + fr;
        const bf16_t* kp = PX + (size_t)krow * INC + 1024 + h * 64 + fq * 8;
        const bf16x8 k0 = *(const bf16x8*)kp, k1 = *(const bf16x8*)(kp + 32);
        f32x4 a = {0.f, 0.f, 0.f, 0.f}; a = mfma16(k0, qf[0], a); a = mfma16(k1, qf[1], a); s[t] = a;
    }
    float mx = -3.0e38f;
    const int qcol = 16 * jb + fr; const int cstart = min(max(qcol - 8, 0), 48);
#pragma unroll
    for (int t = 0; t < NT; ++t)
#pragma unroll
        for (int j = 0; j < 4; ++j) {
            float v = s[t][j] * 0.125f;
            if (LOCAL && t < 16) { const int kcol = kcs + (t & 1) * 16 + 4 * fq + j; const bool valid = (kcol >= cstart) && (kcol < cstart + 16);
                const int dr = rs + (t >> 1) - r + 7; const int dc = min(max(kcol - qcol + 15, 0), 30);
                v = valid ? v + rpb[(h * 15 + dr) * 31 + dc] : -1.0e30f; }
            s[t][j] = v; mx = fmaxf(mx, v);
        }
    mx = fmaxf(mx, __shfl_xor(mx, 16)); mx = fmaxf(mx, __shfl_xor(mx, 32));
    float sum = 0.f;
#pragma unroll
    for (int t = 0; t < NT; ++t)
#pragma unroll
        for (int j = 0; j < 4; ++j) { const float p = __expf(s[t][j] - mx); s[t][j] = p; sum += p; }
    sum += __shfl_xor(sum, 16); sum += __shfl_xor(sum, 32);
    f32x4 o[4];
#pragma unroll
    for (int di = 0; di < 4; ++di) o[di] = f32x4{0.f, 0.f, 0.f, 0.f};
#pragma unroll
    for (int u = 0; u < NT / 2; ++u) {
        const bf16x8 pb = pack8(s[2 * u], s[2 * u + 1]);
        const bf16_t* vbase; size_t stride;
        if (LOCAL && u < 8) { vbase = VT + (size_t)(b * 256 + h * 64) * 4096 + (rs + u) * 64 + kcs + 4 * fq; stride = 4096; }
        else { const int uu = u - (LOCAL ? 8 : 0); vbase = VTc + (size_t)(b * 256 + h * 64) * 256 + uu * 32 + 4 * fq; stride = 256; }
#pragma unroll
        for (int di = 0; di < 4; ++di) { const bf16_t* vp = vbase + (size_t)(16 * di + fr) * stride; const bf16x8 va = cat4(*(const u32x2*)vp, *(const u32x2*)(vp + 16)); o[di] = mfma16s(va, pb, o[di]); }
    }
    const float inv = 1.0f / sum;
#pragma unroll
    for (int di = 0; di < 4; ++di) { const f32x4 v = o[di] * inv; u32x2 w; w.x = pk2(v[0], v[1]); w.y = pk2(v[2], v[3]);
        *(u32x2*)(MIX + (size_t)(qrow0 + fr) * 768 + 512 + h * 64 + 16 * di + 4 * fq) = w; }
}

__device__ __forceinline__ cplx csel(bool c, cplx a, cplx b) { return cplx{c ? a.re : b.re, c ? a.im : b.im}; }
#define WAITALL() asm volatile("s_waitcnt vmcnt(0) lgkmcnt(0)" ::: "memory")
__device__ __forceinline__ cplx pow_sel(int k, cplx a, cplx a2, cplx a4, cplx a8, cplx a16) {
    cplx r = cplx{1.f, 0.f};
    r = csel((k & 1) != 0, cmul(r, a), r); r = csel((k & 2) != 0, cmul(r, a2), r); r = csel((k & 4) != 0, cmul(r, a4), r); r = csel((k & 8) != 0, cmul(r, a8), r); r = csel((k & 16) != 0, cmul(r, a16), r);
    return r;
}
__device__ __forceinline__ void ssm_consts(float lre, float lim, float dt, cplx& a, cplx& f) {
    const float e = __expf(lre * dt);
    float revs = lim * dt * 0.15915494309189535f; revs -= rintf(revs);
    a = cplx{e * __builtin_amdgcn_cosf(revs), e * __builtin_amdgcn_sinf(revs)};
    const float xr = a.re - 1.0f, xi = a.im, den = __builtin_amdgcn_rcpf(lre * lre + lim * lim);
    f = cplx{(xr * lre + xi * lim) * den, (xi * lre - xr * lim) * den};
}
template <int PASS, int DIR>
__device__ __forceinline__ void ssm_dir(const Frame& F, int lane, int l, int b, int g, int tb, const bf16x8 (&ub)[4], f32x4 (&accy)[4]) {
    const int fr = lane & 15, fq = lane >> 4;
    const int c = DIR == 0 ? tb : (tb < 4 ? 3 - tb : 71 - tb);
    const int pg = (l * 2 + DIR) * 16 + g;
    const float dt = __expf(PK(19)[pg]);
    cplx* Sloc = FP(WS_SLOC, cplx); const cplx* Carry = FP(WS_CARRY, cplx);
    const size_t sbase = ((size_t)((b * 2 + DIR) * 16 + g) * 68 + c) * 64;
    for (int q = 0; q < 4; ++q) {
        bf16x8 are, aim;
        { const int kq = (fq & 1) * 8; const float* pr = PK(20) + ((size_t)pg * 64 + 16 * q + fr) * 16 + kq; const float* pi = PK(21) + ((size_t)pg * 64 + 16 * q + fr) * 16 + kq;
          const f32x4 zz = f32x4{0.f, 0.f, 0.f, 0.f}; const bool on = fq < 2;
          const f32x4 r0 = *(const f32x4*)pr, r1 = *(const f32x4*)(pr + 4), i0 = *(const f32x4*)pi, i1 = *(const f32x4*)(pi + 4);
          WAITALL();
          are = pack8(on ? r0 : zz, on ? r1 : zz); aim = pack8(on ? i0 : zz, on ? i1 : zz); }
        f32x4 bre[4], bim[4];
        asm volatile("s_nop 7" : "+v"(are), "+v"(aim));
#pragma unroll
        for (int ni = 0; ni < 4; ++ni) { bre[ni] = mfma16(are, ub[ni], f32x4{0.f, 0.f, 0.f, 0.f}); bim[ni] = mfma16(aim, ub[ni], f32x4{0.f, 0.f, 0.f, 0.f}); }
        settle4m(bre[0], bre[1], bre[2], bre[3]); settle4m(bim[0], bim[1], bim[2], bim[3]);
#pragma unroll
        for (int j = 0; j < 4; ++j) {
            const int p = 16 * q + 4 * fq + j;
            const float lre = PK(17)[pg * 64 + p], lim = PK(18)[pg * 64 + p];
            WAITALL();
            cplx a, f; ssm_consts(lre, lim, dt, a, f);
            const cplx a2 = cmul(a, a), a4 = cmul(a2, a2), a8 = cmul(a4, a4), a16 = cmul(a8, a8);
            if (PASS == 1) {
                cplx Tt;
                if (DIR == 0) { Tt = cplx{bre[0][j], bim[0][j]}; Tt = cmad(cplx{bre[1][j], bim[1][j]}, Tt, a16); Tt = cmad(cplx{bre[2][j], bim[2][j]}, Tt, a16); Tt = cmad(cplx{bre[3][j], bim[3][j]}, Tt, a16); }
                else { Tt = cplx{bre[3][j], bim[3][j]}; Tt = cmad(cplx{bre[2][j], bim[2][j]}, Tt, a16); Tt = cmad(cplx{bre[1][j], bim[1][j]}, Tt, a16); Tt = cmad(cplx{bre[0][j], bim[0][j]}, Tt, a16); }
                const cplx w = pow_sel(DIR == 0 ? 15 - fr : fr, a, a2, a4, a8, a16);
                Tt = cmul(Tt, w);
                Tt.re += __shfl_xor(Tt.re, 1); Tt.im += __shfl_xor(Tt.im, 1); Tt.re += __shfl_xor(Tt.re, 2); Tt.im += __shfl_xor(Tt.im, 2);
                Tt.re += __shfl_xor(Tt.re, 4); Tt.im += __shfl_xor(Tt.im, 4); Tt.re += __shfl_xor(Tt.re, 8); Tt.im += __shfl_xor(Tt.im, 8);
                Tt = cmul(Tt, f);
                if (fr == 0) Sloc[sbase + p] = Tt;
            } else {
                const cplx w = pow_sel(DIR == 0 ? fr + 1 : 16 - fr, a, a2, a4, a8, a16);
                cplx x[4];
#pragma unroll
                for (int ni = 0; ni < 4; ++ni) {
                    cplx v = cmul(f, cplx{bre[ni][j], bim[ni][j]});
#define RLF(x, ln) __builtin_bit_cast(float, __builtin_amdgcn_readlane(__builtin_bit_cast(int, (x)), (ln)))
#define DPPF(x, ctrl) __builtin_bit_cast(float, __builtin_amdgcn_update_dpp(0, __builtin_bit_cast(int, (x)), (ctrl), 0xf, 0xf, true))
#define KS_STEP(d, ad) { cplx y; if (DIR == 0) { y.re = DPPF(v.re, 0x110 + d); y.im = DPPF(v.im, 0x110 + d); v = csel(fr >= d, cmad(v, ad, y), v); } \
                                   else { y.re = DPPF(v.re, 0x100 + d); y.im = DPPF(v.im, 0x100 + d); v = csel(fr + d <= 15, cmad(v, ad, y), v); } }
                    KS_STEP(1, a) KS_STEP(2, a2) KS_STEP(4, a4) KS_STEP(8, a8)
#undef KS_STEP
                    x[ni] = v;
                }
                cplx E = Carry[sbase + p]; WAITALL();
#pragma unroll
                for (int bi = 0; bi < 4; ++bi) {
                    const int ni = DIR == 0 ? bi : 3 - bi;
                    const cplx hh = cmad(x[ni], w, E);
                    cplx tot;
                    { constexpr int L0 = DIR == 0 ? 15 : 0;
                      const float r0 = RLF(x[ni].re, L0), r1 = RLF(x[ni].re, L0 + 16), r2 = RLF(x[ni].re, L0 + 32), r3 = RLF(x[ni].re, L0 + 48);
                      const float i0 = RLF(x[ni].im, L0), i1 = RLF(x[ni].im, L0 + 16), i2 = RLF(x[ni].im, L0 + 32), i3 = RLF(x[ni].im, L0 + 48);
                      tot.re = fq == 0 ? r0 : fq == 1 ? r1 : fq == 2 ? r2 : r3; tot.im = fq == 0 ? i0 : fq == 1 ? i1 : fq == 2 ? i2 : i3; }
                    E = cmad(tot, a16, E);
                    bre[ni][j] = hh.re; bim[ni][j] = hh.im;
                }
            }
        }
        if (PASS == 3) {
            const float* cr = PK(22) + ((size_t)pg * 16 + fr) * 64 + 16 * q + 4 * fq; const float* ci = PK(23) + ((size_t)pg * 16 + fr) * 64 + 16 * q + 4 * fq;
            const f32x4 cre = *(const f32x4*)cr; const f32x4 cim = *(const f32x4*)ci; WAITALL();
            const bf16x8 ca = pack8(cre, f32x4{-cim[0], -cim[1], -cim[2], -cim[3]});
#pragma unroll
            for (int ni = 0; ni < 4; ++ni) { bf16x8 hb = pack8(bre[ni], bim[ni]); bf16x8 ca2 = ca; asm volatile("s_nop 7" : "+v"(ca2), "+v"(hb)); accy[ni] = mfma16(ca2, hb, accy[ni]); }
            settle4m(accy[0], accy[1], accy[2], accy[3]);
        }
    }
}
template <int PASS>
__device__ __forceinline__ void ssm_item(const Frame& F, int l_u, int item_u) {
    int l = l_u, item = item_u; asm volatile("" : "+v"(l), "+v"(item));
    const bf16_t* PX = FP(WS_PX, bf16_t);
    int lane = F.lane; asm volatile("" : "+v"(lane)); const int fr = lane & 15, fq = lane >> 4;
    const int tb = item % 68; const int g = (item / 68) & 15; const int b = item / (68 * 16);
    const int prow0 = tb < 4 ? b * 256 + tb * 64 : NCTX + b * 4096 + (tb - 4) * 64;
    bf16x8 ub[4];
#pragma unroll
    for (int ni = 0; ni < 4; ++ni) { const bf16x8 ld = *(const bf16x8*)(PX + (size_t)(prow0 + 16 * ni + fr) * INC + 1536 + g * 16 + (fq & 1) * 8); ub[ni] = fq < 2 ? ld : zero8(); }
    f32x4 accy[4];
#pragma unroll
    for (int ni = 0; ni < 4; ++ni) accy[ni] = f32x4{0.f, 0.f, 0.f, 0.f};
    WAITALL();
    ssm_dir<PASS, 0>(F, lane, l, b, g, tb, ub, accy);
    ssm_dir<PASS, 1>(F, lane, l, b, g, tb, ub, accy);
    if (PASS == 3) {
        bf16_t* YS = FP(WS_YS, bf16_t); const f32x4 dv = *(const f32x4*)(PK(24) + l * 256 + g * 16 + 4 * fq);
#pragma unroll
        for (int ni = 0; ni < 4; ++ni) { const int row = prow0 + 16 * ni + fr; const f32x4 uv = ld_bf4(PX + (size_t)row * INC + 1536 + g * 16 + 4 * fq); WAITALL();
            const f32x4 y = accy[ni] + dv * uv; u32x2 w; w.x = pk2(y[0], y[1]); w.y = pk2(y[2], y[3]); *(u32x2*)(YS + (size_t)row * 256 + g * 16 + 4 * fq) = w; }
    }
}
__device__ __forceinline__ void ssm_pass2(const Frame& F, int l) {
    const int idx = blockIdx.x * NTHREADS + F.tid; if (idx >= 8192) return;
    const int p = idx & 63, g = (idx >> 6) & 15, dir = (idx >> 10) & 1, b = idx >> 11;
    const int pg = (l * 2 + dir) * 16 + g; const float dt = __expf(PK(19)[pg]);
    const float lre = PK(17)[pg * 64 + p], lim = PK(18)[pg * 64 + p];
    cplx a, f_unused; ssm_consts(lre, lim, dt, a, f_unused);
#pragma unroll
    for (int i = 0; i < 6; ++i) a = cmul(a, a);
    const cplx* Sloc = FP(WS_SLOC, cplx); cplx* Carry = FP(WS_CARRY, cplx);
    const size_t base = ((size_t)((b * 2 + dir) * 16 + g) * 68) * 64 + p;
    cplx E = cplx{0.f, 0.f};
    for (int c = 0; c < 68; ++c) { Carry[base + (size_t)c * 64] = E; E = cmad(Sloc[base + (size_t)c * 64], a, E); }
}


enum : unsigned { W_PREP1 = 1u << 0, W_GIN = 1u << 1, W_GVT = 1u << 2, W_FC = 1u << 3, W_FA = 1u << 4, W_CV = 1u << 5, W_ATT = 1u << 6, W_SSM1 = 1u << 7, W_GPW = 1u << 8,
                  W_P2 = 1u << 9, W_FB = 1u << 10, W_GFW = 1u << 11, W_SSM3 = 1u << 12, W_GGLU = 1u << 13, W_GN = 1u << 14, W_GOUT = 1u << 15, W_PREP3 = 1u << 16, W_GFF1 = 1u << 17, W_GFF2 = 1u << 18 };
#ifndef PH_FINE
#define PH_FINE 0
#endif
#if PH_FINE
constexpr int NSP = 18;
__host__ __device__ __forceinline__ unsigned phase_mask(int sp) {
    switch (sp) { case 0: return W_PREP1; case 1: return W_GIN; case 2: return W_GVT; case 3: return W_FC; case 4: return W_FA; case 5: return W_CV; case 6: return W_ATT; case 7: return W_SSM1;
                  case 8: return W_GPW; case 9: return W_P2 | W_FB; case 10: return W_GFW; case 11: return W_SSM3; case 12: return W_GGLU; case 13: return W_GN; case 14: return W_GOUT;
                  case 15: return W_PREP3; case 16: return W_GFF1; default: return W_GFF2; }
}
#else
constexpr int NSP = 12;
__host__ __device__ __forceinline__ unsigned phase_mask(int sp) {
    switch (sp) { case 0: return W_PREP1; case 1: return W_GIN | W_GVT; case 2: return W_FC | W_FA | W_CV | W_ATT | W_SSM1; case 3: return W_GPW; case 4: return W_P2 | W_FB;
                  case 5: return W_GFW | W_SSM3; case 6: return W_GGLU; case 7: return W_GN; case 8: return W_GOUT; case 9: return W_PREP3; case 10: return W_GFF1; default: return W_GFF2; }
}
#endif
constexpr int NPH = 2 + 2 * NSP;
#ifndef ZP1
#define ZP1 12
#define ZP2 30
#endif
#define OPQ_S(x) asm volatile("" : "+s"(x))
#define GSYNC() do { __syncthreads(); if (wave_ == 0) { __builtin_amdgcn_fence(__ATOMIC_RELEASE, "agent"); asm volatile("s_waitcnt vmcnt(0) lgkmcnt(0)" ::: "memory"); } \
                     grid.sync(); \
                     if (wave_ == 0) { __builtin_amdgcn_fence(__ATOMIC_ACQUIRE, "agent"); asm volatile("s_waitcnt vmcnt(0) lgkmcnt(0)" ::: "memory"); } __syncthreads(); } while (0)
__global__ void __launch_bounds__(NTHREADS, 2) fwd(Args args) {
    extern __shared__ __attribute__((aligned(16))) unsigned char lds[];

    cg::grid_group grid = cg::this_grid();
    const int tid_ = threadIdx.x;
    const int wave_ = __builtin_amdgcn_readfirstlane(tid_ >> 6);
    float* scr = (float*)lds;
    const int G = gridDim.x, bx = blockIdx.x;
    const int gw = bx * 8 + wave_, nw = G * 8;
    const int lo = args.ph_lo, hi = args.ph_hi;
    if (lo == 0) { const Frame F{args, args.out, args.ws, tid_, tid_ & 63, wave_}; p0_prologue(F, scr); if (hi > 1) GSYNC(); }
#pragma nounroll
    for (int ph0 = (lo == 0 ? 1 : lo); ph0 < hi; ++ph0) {
        int ph = ph0; OPQ_S(ph);
        int tidv = tid_; asm volatile("" : "+v"(tidv));
        __attribute__((address_space(1))) unsigned char* wsg = (__attribute__((address_space(1))) unsigned char*)args.ws; __attribute__((address_space(1))) float* outg = (__attribute__((address_space(1))) float*)args.out;
        OPQ_S(wsg); OPQ_S(outg);
        unsigned char* wsv = (unsigned char*)wsg; float* outv = (float*)outg;
        const Frame F{args, outv, wsv, tidv, tidv & 63, wave_};
        if (ph == NPH - 1) { final_norm(F); continue; }
        const int l = (ph - 1) / NSP; const int sp = (ph - 1) - l * NSP;
        const unsigned wm = phase_mask(sp);
        const int row_lo = l == 0 ? 0 : NCTX;
        const int M_post = T_ALL - row_lo;
        unsigned char* wl = F.ws + WS_W + (size_t)l * W_LAYER;
#pragma nounroll
        for (int kind = 0; kind < 8; ++kind) {
            const unsigned bit = kind == 0 ? W_GIN : kind == 1 ? W_GVT : kind == 2 ? W_GPW : kind == 3 ? W_GFW : kind == 4 ? W_GGLU : kind == 5 ? W_GFF1 : kind == 6 ? W_GOUT : W_GFF2;
            if (!(wm & bit)) continue;
            const bf16_t* A; const bf16_t* Bt; int M, N, K;
            if (kind == 0) { A = FP(WS_XN, bf16_t); Bt = (const bf16_t*)(wl + W_IN); M = T_ALL; N = INC; K = DM; }
            else if (kind == 1) { A = (const bf16_t*)(wl + W_IN) + (size_t)1280 * DM; Bt = FP(WS_XN, bf16_t); M = 256; N = T_ALL; K = DM; }
            else if (kind == 2) { A = FP(WS_CV, bf16_t) + (size_t)row_lo * 256; Bt = (const bf16_t*)(wl + W_PW); M = M_post; N = 256; K = 256; }
            else if (kind == 3) { A = FP(WS_FN, bf16_t) + (size_t)row_lo * 256; Bt = (const bf16_t*)(wl + W_F); M = M_post; N = 256; K = 256; }
            else if (kind == 4) { A = FP(WS_YS, bf16_t) + (size_t)row_lo * 256; Bt = (const bf16_t*)(wl + W_GLU); M = M_post; N = 512; K = 256; }
            else if (kind == 5) { A = FP(WS_XN, bf16_t) + (size_t)row_lo * DM; Bt = (const bf16_t*)(wl + W_1); M = M_post; N = FFD; K = DM; }
            else if (kind == 6) { A = FP(WS_XN, bf16_t) + (size_t)row_lo * DM; Bt = (const bf16_t*)(wl + W_OUT); M = M_post; N = DM; K = DM; }
            else { A = FP(WS_H, bf16_t) + (size_t)row_lo * FFD; Bt = (const bf16_t*)(wl + W_2); M = M_post; N = DM; K = FFD; }
            pg8::Gemm g{A, Bt, M, N, K}; pg8::StaticOrder S; S.init(M, N, G, bx);
            EpiU E{F, l, kind, row_lo};
            pg8::gemm_phase<EpiU, pg8::StaticOrder, true, true>((PG8_LAS unsigned char*)lds, g, S, E);
        }
        if (wm & (W_FC | W_FA | W_CV)) {
            const int n_fc = (l == 0 && (wm & W_FC)) ? 32 : 0, n_fa = (wm & W_FA) ? 128 : 0, n_cv = (wm & W_CV) ? (l == 0 ? 544 : 512) : 0; const int nbu = n_fc + n_fa + n_cv;
#pragma nounroll
            for (int u = bx; u < nbu; u += G) {
                if (u < n_fc) fnetctx_unit(F, u, scr);
                else if (u < n_fc + n_fa) fnetA_unit(F, u - n_fc, lds);
                else conv_unit(F, l, u - n_fc - n_fa, scr);
            }
        }
        if (wm & W_P2) ssm_pass2(F, l);
        if (wm & W_SSM3) {
#pragma nounroll
            for (int it = gw; it < 4096; it += nw) ssm_item<3>(F, l, it);
#pragma nounroll
            for (int it = 4096 + gw; it < 4352; it += nw) ssm_item<3>(F, l, it);
        }
        if (wm & (W_ATT | W_SSM1 | W_FB)) {
            const int n_ac = (l == 0 && (wm & W_ATT)) ? 256 : 0, n_al = (wm & W_ATT) ? 4096 : 0, n_s1 = (wm & W_SSM1) ? 4352 : 0, n_fb = (wm & W_FB) ? 1024 : 0, n_s3 = 0;
            const int e0 = n_ac, e1 = e0 + n_al, e2 = e1 + n_s1, e3 = e2 + n_fb, e4 = e3 + n_s3;
#pragma nounroll
            for (int it = gw; it < e4; it += nw) {
                if (it < e0) attn_item<false>(F, l, it);
                else if (it < e1) attn_item<true>(F, l, it - e0);
                else if (it < e2) ssm_item<1>(F, l, it - e1);
                else if (it < e3) fnetB_item(F, it - e2);
                else { ssm_item<3>(F, l, it - e3); }
            }
        }
        if (wm & W_PREP1) prep_norm_mod(F, l == 0 ? F.A.in[2] : FP(WS_XC, float), l == 0 ? F.A.in[0] : F.out, PK(6) + l * DM, FP(WS_MOD, float) + l * 5 * 6144, 0, 1024, FP(WS_XN, bf16_t), 0);
        if (wm & W_GN) prep_group(F, l, row_lo);
        if (wm & W_PREP3) prep_norm_mod(F, FP(WS_XC, float), F.out, PK(30) + l * DM, FP(WS_MOD, float) + l * 5 * 6144, 3072, 4096, FP(WS_XN, bf16_t), row_lo);
        if (ph0 + 1 < hi) GSYNC();
    }
}

extern "C" void kernel_launch(void* const* d_in, const int* in_sizes, int n_in, void* d_out, int out_size, void* d_ws, size_t ws_size, hipStream_t stream) {
    static int grid = 0;
    if (grid == 0) {
        if (n_in != 36 || ws_size < WS_END) { fprintf(stderr, "kernel_launch: unexpected n_in %d / ws %zu\n", n_in, ws_size); grid = -1; return; }
        int dev = 0, cus = 0, per_cu = 0;
        (void)hipGetDevice(&dev); (void)hipDeviceGetAttribute(&cus, hipDeviceAttributeMultiprocessorCount, dev);
        (void)hipFuncSetAttribute((const void*)fwd, hipFuncAttributeMaxDynamicSharedMemorySize, LDS_BYTES);
        (void)hipOccupancyMaxActiveBlocksPerMultiprocessor(&per_cu, (const void*)fwd, NTHREADS, LDS_BYTES);
        (void)hipGetLastError();
        grid = cus > 0 ? cus : 256;
    }
    if (grid < 0) return;
    Args a{};
    for (int i = 0; i < 36; ++i) a.in[i] = (const float*)d_in[i];
    a.out = (float*)d_out; a.ws = (unsigned char*)d_ws;
#if MODE_COOP
    a.ph_lo = 0; a.ph_hi = NPH; a.part = 15;
    void* kargs[] = {&a};
    hipError_t e = hipLaunchCooperativeKernel((const void*)fwd, dim3(grid), dim3(NTHREADS), kargs, LDS_BYTES, stream);
    if (e != hipSuccess) fprintf(stderr, "cooperative launch failed: %s (grid %d)\n", hipGetErrorString(e), grid);
#else
    for (int ph = 0; ph < NPH; ++ph) { a.ph_lo = ph; a.ph_hi = ph + 1; a.part = 15; hipLaunchKernelGGL(fwd, dim3(grid), dim3(NTHREADS), LDS_BYTES, stream, a); }
#endif
}
```

```cpp
#include <hip/hip_runtime.h>
#include <hip/hip_cooperative_groups.h>
#include <cstdio>
#include <cstdint>
namespace cg = cooperative_groups;
#ifndef MODE_COOP
#define MODE_COOP 1
#endif
namespace pg8 {
#define PG8_LAS __attribute__((address_space(3)))
typedef unsigned short bf16_t;
typedef short bf16x8 __attribute__((ext_vector_type(8)));
typedef float f32x4 __attribute__((ext_vector_type(4)));
typedef unsigned u32x4 __attribute__((ext_vector_type(4)));
constexpr int BM = 256, BK = 64, HALF = 128, HTB = HALF * BK * 2  , STAGE_BYTES = 8 * HTB, NXCD = 8, WGM = 8;

__host__ __device__ __forceinline__ int lds_byte(int r, int c) { const int st = (r >> 4) * 2 + (c >> 5), rr = r & 15, cc = c & 31, ob = rr * 64 + cc * 2; return st * 1024 + (ob ^ (((ob >> 9) & 1) << 5)); }
__host__ __device__ __forceinline__ void stage_rc(int b, int& R, int& C) { const int st = b / 1024, sb = b % 1024, swz = sb ^ (((sb >> 9) & 1) << 5); R = (st >> 1) * 16 + swz / 64; C = (st & 1) * 32 + (swz % 64) / 2; }
__host__ __device__ __forceinline__ int perm32(int rho) { const int n = rho >> 4, i = rho & 15; return 8 * (i >> 2) + 4 * n + (i & 3); }

struct Unit { int pm, pn; };
struct Gemm { const bf16_t* A; const bf16_t* Bt; int M, N, K; };

struct StaticOrder {
    int nM, nN, nwg, G, c;
    __host__ __device__ void init(int M, int N, int G_, int c_) { nM = M / BM; nN = N / BM; nwg = nM * nN; G = G_; c = c_; }
    __host__ __device__ bool next(int i, Unit& u) const {
        const long L = (long)i * G + c; if (L >= nwg) return false;
        int wgid = (int)L; { const int q = nwg / NXCD, r = nwg % NXCD, xcd = wgid % NXCD, off = wgid / NXCD; wgid = (xcd < r ? xcd * (q + 1) : r * (q + 1) + (xcd - r) * q) + off; }
        const int nig = WGM * nN, gid = wgid / nig, fm = gid * WGM, gsz = (nM - fm) < WGM ? (nM - fm) : WGM;
        u.pm = fm + ((wgid % nig) % gsz); u.pn = (wgid % nig) / gsz; return true;
    }
    __device__ __forceinline__ void a_ready(const Unit&) const {}
    __device__ __forceinline__ void done(const Unit&) const {}
};

}
namespace pg8 {
template <class Epi, class Sched, bool ALIGN_EPI = false, bool SP2 = false>
__device__ __forceinline__ void gemm_phase(PG8_LAS unsigned char* lds, const Gemm g, const Sched& S, const Epi& E) {
    const int tid = threadIdx.x, wid = __builtin_amdgcn_readfirstlane(tid >> 6), lane = tid & 63, wr = wid >> 2, wc = wid & 3, fr = lane & 15, fq = lane >> 4;
    const int K = g.K, nt = K / BK;
    unsigned voffA[2], voffB[2];
#pragma unroll
    for (int i = 0; i < 2; ++i) { int R, C; stage_rc(tid * 16 + i * 8192, R, C); const int Rb = Epi::PERM ? ((R & ~31) + perm32(R & 31)) : R;
        voffA[i] = (unsigned)(R * K + C) * 2u; voffB[i] = (unsigned)(Rb * K + C) * 2u; }
    const size_t kstep = (size_t)(BK * 2);
    const size_t hstep = (size_t)HALF * K * 2;
    const size_t tstep = 2 * hstep;
    const unsigned ldsw = (unsigned)wid * 1024u;
    const int aoff = lds_byte(wr * 64 + fr, fq * 8), boff = lds_byte(wc * 32 + fr, fq * 8);
#define PG8_SA(b, h) (((b) * 2 + (h)) * HTB)
#define PG8_SB(b, h) ((4 + (b) * 2 + (h)) * HTB)
#define PG8_STAGE(bufoff, gbase, voff) do { _Pragma("unroll") for (int _i = 0; _i < 2; ++_i) \
        __builtin_amdgcn_global_load_lds((const unsigned*)((const char*)(gbase) + (voff)[_i]), (PG8_LAS unsigned*)(lds + (bufoff) + ldsw + _i * 8192), 16, 0, 0); } while (0)
#define PG8_LDA(dst, b, h) do { _Pragma("unroll") for (int m = 0; m < 4; ++m) _Pragma("unroll") for (int k = 0; k < 2; ++k) dst[m][k] = *(const PG8_LAS bf16x8*)(lds + PG8_SA(b, h) + aoff + m * 2048 + k * 1024); } while (0)
#define PG8_LDB(dst, b, h) do { _Pragma("unroll") for (int n = 0; n < 2; ++n) _Pragma("unroll") for (int k = 0; k < 2; ++k) dst[n][k] = *(const PG8_LAS bf16x8*)(lds + PG8_SB(b, h) + boff + n * 2048 + k * 1024); } while (0)
#define PG8_MMA(ai, bj, At, Bt) do { __builtin_amdgcn_s_setprio(1); _Pragma("unroll") for (int m = 0; m < 4; ++m) _Pragma("unroll") for (int n = 0; n < 2; ++n) _Pragma("unroll") for (int k = 0; k < 2; ++k) \
        acc[ai][bj][m][n] = __builtin_amdgcn_mfma_f32_16x16x32_bf16(Bt[n][k], At[m][k], acc[ai][bj][m][n], 0, 0, 0); __builtin_amdgcn_s_setprio(0); } while (0)
#define PG8_WAIT_V(n) asm volatile("s_waitcnt vmcnt(" #n ")" ::: "memory")
#define PG8_WAIT_L(n) asm volatile("s_waitcnt lgkmcnt(" #n ")" ::: "memory")
#define PG8_BAR __builtin_amdgcn_s_barrier()
#define PG8_SCHED __builtin_amdgcn_sched_barrier(0)
    Unit cur, nxt; int ui = 0;
    if (!S.next(0, cur)) return;
    f32x4 acc[2][2][4][2];
#pragma unroll
    for (int a = 0; a < 2; ++a)
#pragma unroll
        for (int b = 0; b < 2; ++b)
#pragma unroll
            for (int m = 0; m < 4; ++m)
#pragma unroll
                for (int n = 0; n < 2; ++n) acc[a][b][m][n] = (f32x4){0.f, 0.f, 0.f, 0.f};
    bf16x8 At[4][2], B0[2][2], B1[2][2];
    const char* cA = (const char*)g.A + (size_t)cur.pm * tstep; const char* cB = (const char*)g.Bt + (size_t)cur.pn * tstep;
    S.a_ready(cur);
    if constexpr (SP2) {
        PG8_STAGE(PG8_SB(0, 0), cB, voffB); PG8_STAGE(PG8_SB(0, 1), cB + hstep, voffB); PG8_STAGE(PG8_SA(0, 0), cA, voffA); PG8_STAGE(PG8_SA(0, 1), cA + hstep, voffA);
        if (wr == 1) PG8_BAR;
        PG8_WAIT_V(2); PG8_BAR;
        PG8_STAGE(PG8_SB(1, 0), cB + kstep, voffB); PG8_STAGE(PG8_SA(1, 0), cA + kstep, voffA); PG8_STAGE(PG8_SB(1, 1), cB + hstep + kstep, voffB);
        PG8_WAIT_V(6); PG8_BAR;
    } else {
        PG8_STAGE(PG8_SB(0, 0), cB, voffB); PG8_STAGE(PG8_SA(0, 0), cA, voffA); PG8_STAGE(PG8_SB(0, 1), cB + hstep, voffB); PG8_STAGE(PG8_SA(0, 1), cA + hstep, voffA);
        if (wr == 1) PG8_BAR;
        PG8_WAIT_V(4); PG8_BAR;
        PG8_STAGE(PG8_SB(1, 0), cB + kstep, voffB); PG8_STAGE(PG8_SA(1, 0), cA + kstep, voffA); PG8_STAGE(PG8_SB(1, 1), cB + hstep + kstep, voffB);
        PG8_WAIT_V(6); PG8_BAR;
    }
    for (;;) {
        const bool has_next = S.next(ui + 1, nxt);
        const char* nA = has_next ? (const char*)g.A + (size_t)nxt.pm * tstep : cA; const char* nB = has_next ? (const char*)g.Bt + (size_t)nxt.pn * tstep : cB;
        for (int t = 0; t < nt; t += 2) {
            const bool last = (t == nt - 2);
            const char* a1 = cA + (size_t)(t + 1) * kstep;
            const char* a2 = last ? nA : cA + (size_t)(t + 2) * kstep; const char* b2 = last ? nB : cB + (size_t)(t + 2) * kstep;
            const char* a3 = a2 + kstep; const char* b3 = b2 + kstep;
            if (last && has_next) S.a_ready(nxt);
            if constexpr (SP2) {
            PG8_LDB(B0, 0, 0); PG8_LDB(B1, 0, 1); PG8_SCHED; PG8_LDA(At, 0, 0); PG8_STAGE(PG8_SA(1, 1), a1 + hstep, voffA);
            PG8_WAIT_V(8); PG8_WAIT_L(0); PG8_BAR; PG8_MMA(0, 0, At, B0); PG8_MMA(0, 1, At, B1); PG8_BAR; PG8_SCHED;
            PG8_LDA(At, 0, 1); PG8_STAGE(PG8_SB(0, 0), b2, voffB); PG8_STAGE(PG8_SB(0, 1), b2 + hstep, voffB); PG8_STAGE(PG8_SA(0, 0), a2, voffA);
            PG8_WAIT_V(8); PG8_WAIT_L(0); PG8_BAR; PG8_MMA(1, 0, At, B0); PG8_MMA(1, 1, At, B1); PG8_BAR; PG8_SCHED;
            PG8_LDB(B0, 1, 0); PG8_LDB(B1, 1, 1); PG8_SCHED; PG8_LDA(At, 1, 0); PG8_STAGE(PG8_SA(0, 1), a2 + hstep, voffA);
            PG8_WAIT_V(8); PG8_WAIT_L(0); PG8_BAR; PG8_MMA(0, 0, At, B0); PG8_MMA(0, 1, At, B1); PG8_BAR; PG8_SCHED;
            PG8_LDA(At, 1, 1); PG8_STAGE(PG8_SB(1, 0), b3, voffB); PG8_STAGE(PG8_SB(1, 1), b3 + hstep, voffB); PG8_STAGE(PG8_SA(1, 0), a3, voffA);
            PG8_WAIT_V(8); PG8_WAIT_L(0); PG8_BAR; PG8_MMA(1, 0, At, B0); PG8_MMA(1, 1, At, B1); PG8_BAR; PG8_SCHED;
            } else {
            PG8_LDB(B0, 0, 0); PG8_SCHED; PG8_LDA(At, 0, 0); PG8_STAGE(PG8_SA(1, 1), a1 + hstep, voffA);
            PG8_WAIT_L(8); PG8_BAR; PG8_WAIT_L(0); PG8_MMA(0, 0, At, B0); PG8_BAR; PG8_SCHED;
            PG8_LDB(B1, 0, 1); PG8_STAGE(PG8_SB(0, 0), b2, voffB);
            PG8_BAR; PG8_WAIT_L(0); PG8_MMA(0, 1, At, B1); PG8_BAR;
            PG8_LDA(At, 0, 1); PG8_STAGE(PG8_SA(0, 0), a2, voffA);
            PG8_BAR; PG8_WAIT_L(0); PG8_MMA(1, 0, At, B0); PG8_BAR; PG8_SCHED;
            PG8_STAGE(PG8_SB(0, 1), b2 + hstep, voffB);
            PG8_WAIT_V(6); PG8_BAR; PG8_MMA(1, 1, At, B1); PG8_BAR;
            PG8_LDB(B0, 1, 0); PG8_SCHED; PG8_LDA(At, 1, 0); PG8_STAGE(PG8_SA(0, 1), a2 + hstep, voffA);
            PG8_WAIT_L(8); PG8_BAR; PG8_WAIT_L(0); PG8_MMA(0, 0, At, B0); PG8_BAR; PG8_SCHED;
            PG8_LDB(B1, 1, 1); PG8_STAGE(PG8_SB(1, 0), b3, voffB);
            PG8_BAR; PG8_WAIT_L(0); PG8_MMA(0, 1, At, B1); PG8_BAR;
            PG8_LDA(At, 1, 1); PG8_STAGE(PG8_SA(1, 0), a3, voffA);
            PG8_BAR; PG8_WAIT_L(0); PG8_MMA(1, 0, At, B0); PG8_BAR; PG8_SCHED;
            PG8_STAGE(PG8_SB(1, 1), b3 + hstep, voffB);
            PG8_WAIT_V(6); PG8_BAR; PG8_MMA(1, 1, At, B1); PG8_BAR;
            }
        }
        if constexpr (ALIGN_EPI) { if (wr == 0) PG8_BAR; }
        if constexpr (!Epi::AFTER_DRAIN) { E(acc, cur, wr, wc, fr, fq); S.done(cur); }
        if (!has_next) break;
#pragma unroll
        for (int a = 0; a < 2; ++a)
#pragma unroll
            for (int b = 0; b < 2; ++b)
#pragma unroll
                for (int m = 0; m < 4; ++m)
#pragma unroll
                    for (int n = 0; n < 2; ++n) acc[a][b][m][n] = (f32x4){0.f, 0.f, 0.f, 0.f};
        cur = nxt; cA = nA; cB = nB; ++ui;
        if constexpr (ALIGN_EPI) { if (wr == 1) PG8_BAR; }
    }
    PG8_WAIT_V(0);
    if constexpr (!ALIGN_EPI) { if (wr == 0) PG8_BAR; }
    PG8_BAR;
    if constexpr (Epi::AFTER_DRAIN) { E.fused(acc, cur, wr, wc, fr, fq, lds, wid, lane); S.done(cur); }
#undef PG8_SA
#undef PG8_SB
#undef PG8_STAGE
#undef PG8_LDA
#undef PG8_LDB
#undef PG8_MMA
#undef PG8_WAIT_V
#undef PG8_WAIT_L
#undef PG8_BAR
#undef PG8_SCHED
}
}

using pg8::bf16_t; using pg8::bf16x8; using pg8::f32x4;
#define LAS __attribute__((address_space(3)))
typedef short bf16x4 __attribute__((ext_vector_type(4)));
typedef unsigned u32x4 __attribute__((ext_vector_type(4)));
typedef unsigned u32x2 __attribute__((ext_vector_type(2)));

constexpr int NTHREADS = 512;
constexpr int T_ALL = 17408, NCTX = 1024, NLAT = 16384, DM = 1024, INC = 1792, FFD = 4096;
constexpr int LDS_BYTES = 147456;
constexpr float EPS = 1e-6f;

constexpr size_t MiB = 1u << 20;
constexpr size_t WS_MOD = 0;
constexpr size_t WS_CTAB = 256 * 1024;
constexpr size_t WS_STAB = 256 * 1024 + 8192;
constexpr size_t WS_PACK = 1 * MiB;
constexpr size_t WS_SLOC = 3 * MiB;
constexpr size_t WS_CARRY = 7 * MiB + 256 * 1024;
constexpr size_t WS_W = 12 * MiB;
constexpr size_t W_IN = 0, W_PW = W_IN + (size_t)INC * DM * 2, W_F = W_PW + 256 * 256 * 2, W_GLU = W_F + 256 * 256 * 2,
                 W_OUT = W_GLU + 512 * 256 * 2, W_1 = W_OUT + (size_t)DM * DM * 2, W_2 = W_1 + (size_t)FFD * DM * 2, W_LAYER = W_2 + (size_t)FFD * DM * 2;
static_assert(W_LAYER == 22 * MiB, "weights per layer");
constexpr size_t WS_XC = 56 * MiB;
constexpr size_t WS_XN = 60 * MiB;
constexpr size_t WS_BIG = 94 * MiB;
constexpr size_t WS_H = WS_BIG;
constexpr size_t WS_PX = WS_BIG;
constexpr size_t WS_VT = 154 * MiB;
constexpr size_t WS_VTC = 162 * MiB;
constexpr size_t WS_CV = 163 * MiB;
constexpr size_t WS_YB = 172 * MiB;
constexpr size_t WS_FN = 188 * MiB;
constexpr size_t WS_YS = 197 * MiB;
constexpr size_t WS_ZS = 206 * MiB;
constexpr size_t WS_MIX = 223 * MiB;
constexpr size_t WS_END = 256 * MiB;
static_assert(WS_H + (size_t)T_ALL * FFD * 2 <= WS_END && WS_MIX + (size_t)T_ALL * 768 * 2 <= WS_END && WS_PX + (size_t)T_ALL * INC * 2 <= WS_VT, "ws map");

__device__ __forceinline__ unsigned f2bf(float f) { unsigned u = __builtin_bit_cast(unsigned, f); return (u + 0x7fffu + ((u >> 16) & 1u)) >> 16; }
__device__ __forceinline__ unsigned pk2(float lo, float hi) { return f2bf(lo) | (f2bf(hi) << 16); }
__device__ __forceinline__ float bf2f(unsigned h) { return __builtin_bit_cast(float, (h & 0xffffu) << 16); }
__device__ __forceinline__ float bflo(unsigned w) { return __builtin_bit_cast(float, w << 16); }
__device__ __forceinline__ float bfhi(unsigned w) { return __builtin_bit_cast(float, w & 0xffff0000u); }
__device__ __forceinline__ bf16x8 pack8(f32x4 a, f32x4 b) {
    u32x4 w; w.x = pk2(a[0], a[1]); w.y = pk2(a[2], a[3]); w.z = pk2(b[0], b[1]); w.w = pk2(b[2], b[3]);
    return __builtin_bit_cast(bf16x8, w);
}
__device__ __forceinline__ bf16x8 neg8(bf16x8 v) { u32x4 w = __builtin_bit_cast(u32x4, v); w.x ^= 0x80008000u; w.y ^= 0x80008000u; w.z ^= 0x80008000u; w.w ^= 0x80008000u; return __builtin_bit_cast(bf16x8, w); }
__device__ __forceinline__ bf16x8 zero8() { u32x4 w = {0u, 0u, 0u, 0u}; return __builtin_bit_cast(bf16x8, w); }
__device__ __forceinline__ bf16x8 cat4(u32x2 a, u32x2 b) { u32x4 w; w.x = a.x; w.y = a.y; w.z = b.x; w.w = b.y; return __builtin_bit_cast(bf16x8, w); }
__device__ __forceinline__ f32x4 mfma16(bf16x8 a, bf16x8 b, f32x4 c) { return __builtin_amdgcn_mfma_f32_16x16x32_bf16(a, b, c, 0, 0, 0); }
__device__ __forceinline__ void settle4(f32x4& a, f32x4& b, f32x4& c, f32x4& d) { asm volatile("s_nop 15\n\ts_nop 15" : "+v"(a), "+v"(b), "+v"(c), "+v"(d)); }
__device__ __forceinline__ void settle4m(f32x4& a, f32x4& b, f32x4& c, f32x4& d) { asm volatile("s_nop 7\n\ts_nop 7" : "+v"(a), "+v"(b), "+v"(c), "+v"(d) :: "memory"); }
__device__ __forceinline__ f32x4 mfma16s(bf16x8 a, bf16x8 b, f32x4 c) { asm volatile("s_nop 7" : "+v"(a), "+v"(b)); return __builtin_amdgcn_mfma_f32_16x16x32_bf16(a, b, c, 0, 0, 0); }
__device__ __forceinline__ void settle2(f32x4& a, f32x4& b) { asm volatile("s_nop 15\n\ts_nop 15" : "+v"(a), "+v"(b)); }
__device__ __forceinline__ void settle_in(bf16x8& a, bf16x8& b) { asm volatile("s_nop 3" : "+v"(a), "+v"(b)); }
__device__ __forceinline__ float wave_sum(float v) {
    v += __shfl_xor(v, 1); v += __shfl_xor(v, 2); v += __shfl_xor(v, 4); v += __shfl_xor(v, 8); v += __shfl_xor(v, 16); v += __shfl_xor(v, 32); return v;
}
__device__ __forceinline__ float sigmoidf_(float x) { return 1.0f / (1.0f + __expf(-x)); }
struct cplx { float re, im; };
__device__ __forceinline__ cplx cmul(cplx a, cplx b) { return cplx{a.re * b.re - a.im * b.im, a.re * b.im + a.im * b.re}; }
__device__ __forceinline__ cplx cmad(cplx acc, cplx a, cplx b) { return cplx{acc.re + a.re * b.re - a.im * b.im, acc.im + a.re * b.im + a.im * b.re}; }

struct Args { const float* in[36]; float* out; unsigned char* ws; int ph_lo, ph_hi, part, pad; };
struct Frame {
    const Args& A;
    float* out; unsigned char* ws;
    int tid, lane, wave;
};
#define FP(off, type) ((type*)(F.ws + (off)))

constexpr int PK_N = 23;
constexpr int PK_IDX[PK_N] = {6,8,9,10,11,13,15,16,17,18,19,20,21,22,23,24,26,27,29,30,32,34,35};
constexpr int PK_CNT[PK_N] = {2048,15872,512,512,512,512,512,3720,4096,4096,64,65536,65536,65536,65536,512,1024,2048,2048,2048,8192,2048,1024};
constexpr int pk_off(int k) { int o = 0; for (int i = 0; i < PK_N; ++i) { if (PK_IDX[i] == k) return o; o += PK_CNT[i]; } return -1; }
#define PK(k) (FP(WS_PACK, float) + pk_off(k))
static_assert(pk_off(35) + 1024 <= (int)(2 * MiB / 4), "pack size");

struct EpiU {
    static constexpr bool PERM = false, AFTER_DRAIN = false;
    const Frame& F; int l; int kind; int row_lo;
    __device__ __forceinline__ void operator()(const f32x4 (&acc)[2][2][4][2], const pg8::Unit& u, int wr, int wc, int fr, int fq) const {
        const int c0 = u.pn * 256 + wc * 32 + fq * 4;
        const int r0 = u.pm * 256 + wr * 64 + fr;
        if (kind < 6) {
            bf16_t* base; size_t ldc; const float* bias = nullptr;
            if (kind == 0) { base = FP(WS_PX, bf16_t) + (size_t)r0 * INC + c0; ldc = INC; }
            else if (kind == 1) {
                if (u.pn < 4) { base = FP(WS_VTC, bf16_t) + (size_t)u.pn * 65536 + (size_t)r0 * 256 + (c0 - u.pn * 256); ldc = 256; }
                else { const int tt = u.pn - 4; base = FP(WS_VT, bf16_t) + (size_t)(tt >> 4) * 256 * 4096 + (tt & 15) * 256 + (size_t)r0 * 4096 + (c0 - u.pn * 256); ldc = 4096; }
            }
            else if (kind == 2) { base = FP(WS_MIX, bf16_t) + (size_t)(row_lo + r0) * 768 + c0; ldc = 768; bias = PK(13) + l * 256; }
            else if (kind == 3) { base = FP(WS_MIX, bf16_t) + (size_t)(row_lo + r0) * 768 + 256 + c0; ldc = 768; bias = PK(15) + l * 256; }
            else if (kind == 4) { base = FP(WS_ZS, bf16_t) + (size_t)(row_lo + r0) * 512 + c0; ldc = 512; bias = PK(26) + l * 512; }
            else { base = FP(WS_H, bf16_t) + (size_t)(row_lo + r0) * FFD + c0; ldc = FFD; bias = PK(32) + l * FFD; }
#pragma unroll
            for (int bj = 0; bj < 2; ++bj)
#pragma unroll
                for (int n = 0; n < 2; ++n) {
                    f32x4 bv = f32x4{0.f, 0.f, 0.f, 0.f};
                    if (bias) bv = *(const f32x4*)(bias + c0 + bj * 128 + n * 16);
#pragma unroll
                    for (int ai = 0; ai < 2; ++ai)
#pragma unroll
                        for (int m = 0; m < 4; ++m) {
                            f32x4 v = acc[ai][bj][m][n] + bv;
                            if (kind == 5) {
#pragma unroll
                                for (int j = 0; j < 4; ++j) { const float r = fmaxf(v[j], 0.f); v[j] = r * r; }
                            }
                            u32x2 w; w.x = pk2(v[0], v[1]); w.y = pk2(v[2], v[3]);
                            *(u32x2*)(base + (size_t)(ai * 128 + m * 16) * ldc + bj * 128 + n * 16) = w;
                        }
                }
        } else {
            const int gp = u.pm + (row_lo >> 8); const bool isc = gp < 4; const int lrow0 = isc ? gp * 256 : (gp - 4) * 256; const int br = isc ? 4 : ((gp - 4) >> 4);
            const float* sC; const float* sL; const float* bias; int gate_off;
            if (kind == 6) { sC = l == 0 ? F.A.in[2] : FP(WS_XC, float); sL = l == 0 ? F.A.in[0] : F.out; bias = PK(29) + l * DM; gate_off = 2048; }
            else { sC = FP(WS_XC, float); sL = F.out; bias = PK(34) + l * DM; gate_off = 5120; }
            const size_t roff = (size_t)(lrow0 + wr * 64 + fr) * DM + c0;
            const float* s = (isc ? sC : sL) + roff; float* d = (isc ? FP(WS_XC, float) : F.out) + roff;
            const float* gate = FP(WS_MOD, float) + (l * 5 + br) * 6144 + gate_off;
#pragma unroll
            for (int bj = 0; bj < 2; ++bj)
#pragma unroll
                for (int n = 0; n < 2; ++n) {
                    const int cc = c0 + bj * 128 + n * 16;
                    const f32x4 bv = *(const f32x4*)(bias + cc); const f32x4 gv = *(const f32x4*)(gate + cc);
#pragma unroll
                    for (int ai = 0; ai < 2; ++ai)
#pragma unroll
                        for (int m = 0; m < 4; ++m) {
                            const size_t o = (size_t)(ai * 128 + m * 16) * DM + bj * 128 + n * 16;
                            const f32x4 xv = *(const f32x4*)(s + o);
                            *(f32x4*)(d + o) = xv + gv * (acc[ai][bj][m][n] + bv);
                        }
                }
        }
    }
};

__device__ __forceinline__ void transpose_tile(const float* W, int K, int N, bf16_t* Wt, int tile, float* scr, int tid) {
    const int ntn = N >> 6; const int tk = tile / ntn, tn = tile - tk * ntn; const int k0 = tk * 64, n0 = tn * 64;
    { const int n = tid & 63, kk = tid >> 6;
#pragma unroll
      for (int i = 0; i < 8; ++i) { const int k = kk + 8 * i; scr[k * 65 + n] = W[(size_t)(k0 + k) * N + n0 + n]; } }
    __syncthreads();
    { const int kp = tid & 31, nn = tid >> 5;
#pragma unroll
      for (int i = 0; i < 4; ++i) { const int n = nn + 16 * i; const unsigned v = pk2(scr[(2 * kp) * 65 + n], scr[(2 * kp + 1) * 65 + n]); *(unsigned*)(Wt + (size_t)(n0 + n) * K + k0 + 2 * kp) = v; } }
    __syncthreads();
}
__device__ __forceinline__ void mod_unit(const Frame& F, int unit, float* scr) {
    const int l = unit / 96, cc = unit - l * 96; const int tid = F.tid;
    float* sl = scr; float* red = scr + 5 * 1024;
    for (int i = tid; i < 5 * 1024; i += NTHREADS) { const int r = i >> 10, k = i & 1023; const float c = r < 4 ? F.A.in[1][r * 1024 + k] : F.A.in[3][k]; sl[i] = c * sigmoidf_(c); }
    __syncthreads();
    const int col = tid & 63, kg = tid >> 6;
    const float* w = F.A.in[4] + (size_t)l * DM * 6144 + cc * 64 + col;
    float a0 = 0.f, a1 = 0.f, a2 = 0.f, a3 = 0.f, a4 = 0.f;
    for (int k = kg * 128; k < kg * 128 + 128; ++k) { const float wv = w[(size_t)k * 6144]; a0 += sl[k] * wv; a1 += sl[1024 + k] * wv; a2 += sl[2048 + k] * wv; a3 += sl[3072 + k] * wv; a4 += sl[4096 + k] * wv; }
    red[(kg * 5 + 0) * 64 + col] = a0; red[(kg * 5 + 1) * 64 + col] = a1; red[(kg * 5 + 2) * 64 + col] = a2; red[(kg * 5 + 3) * 64 + col] = a3; red[(kg * 5 + 4) * 64 + col] = a4;
    __syncthreads();
    if (tid < 320) { const int r = tid >> 6, c2 = tid & 63; float s = 0.f;
#pragma unroll
        for (int g = 0; g < 8; ++g) s += red[(g * 5 + r) * 64 + c2];
        FP(WS_MOD, float)[(l * 5 + r) * 6144 + cc * 64 + c2] = s + F.A.in[5][l * 6144 + cc * 64 + c2]; }
    __syncthreads();
}
__device__ __forceinline__ void p0_prologue(const Frame& F, float* scr) {
    const int NT_L = 448 + 16 + 16 + 32 + 256 + 1024 + 1024;
    const int njobs = 193 + 2 * NT_L + PK_N;
    for (int job = blockIdx.x; job < njobs; job += gridDim.x) {
        if (job >= 193 + 2 * NT_L) {
            const int e = job - (193 + 2 * NT_L); const float* src = nullptr; int cnt = 0, off = 0;
#define PKC(i) if (e == i) { src = F.A.in[PK_IDX[i]]; cnt = PK_CNT[i]; off = pk_off(PK_IDX[i]); }
            PKC(0) PKC(1) PKC(2) PKC(3) PKC(4) PKC(5) PKC(6) PKC(7) PKC(8) PKC(9) PKC(10) PKC(11) PKC(12) PKC(13) PKC(14) PKC(15) PKC(16) PKC(17) PKC(18) PKC(19) PKC(20) PKC(21) PKC(22)
#undef PKC
            float* dst = FP(WS_PACK, float) + off;
            for (int i = F.tid; i < cnt; i += NTHREADS) dst[i] = src[i];
        }
        else if (job < 192) { mod_unit(F, job, scr); }
        else if (job == 192) {
            for (int i = F.tid; i < 4096; i += NTHREADS) { const int m = i >> 6, j = i & 63; const float x = (float)((m * j) & 63) * (1.0f / 32.0f);
                FP(WS_CTAB, bf16_t)[i] = (bf16_t)f2bf(cospif(x)); FP(WS_STAB, bf16_t)[i] = (bf16_t)f2bf(sinpif(x)); }
        } else {
            int t = job - 193; const int l = t / NT_L; t -= l * NT_L;
            unsigned char* wl = F.ws + WS_W + (size_t)l * W_LAYER;
            if (t < 448) transpose_tile(F.A.in[7] + (size_t)l * DM * INC, DM, INC, (bf16_t*)(wl + W_IN), t, scr, F.tid);
            else if ((t -= 448) < 16) transpose_tile(F.A.in[12] + (size_t)l * 65536, 256, 256, (bf16_t*)(wl + W_PW), t, scr, F.tid);
            else if ((t -= 16) < 16) transpose_tile(F.A.in[14] + (size_t)l * 65536, 256, 256, (bf16_t*)(wl + W_F), t, scr, F.tid);
            else if ((t -= 16) < 32) transpose_tile(F.A.in[25] + (size_t)l * 131072, 256, 512, (bf16_t*)(wl + W_GLU), t, scr, F.tid);
            else if ((t -= 32) < 256) transpose_tile(F.A.in[28] + (size_t)l * DM * DM, DM, DM, (bf16_t*)(wl + W_OUT), t, scr, F.tid);
            else if ((t -= 256) < 1024) transpose_tile(F.A.in[31] + (size_t)l * DM * FFD, DM, FFD, (bf16_t*)(wl + W_1), t, scr, F.tid);
            else { t -= 1024; transpose_tile(F.A.in[33] + (size_t)l * DM * FFD, FFD, DM, (bf16_t*)(wl + W_2), t, scr, F.tid); }
        }
    }
}

__device__ __forceinline__ void prep_norm_mod(const Frame& F, const float* srcC, const float* srcL, const float* g, const float* modl, int sh_off, int sc_off, bf16_t* XN, int row_lo) {
    const int gw = blockIdx.x * 8 + F.wave, nw = gridDim.x * 8, lane = F.lane;
    for (int row = row_lo + gw; row < T_ALL; row += nw) {
        const bool isc = row < NCTX; const float* x = isc ? srcC + (size_t)row * DM : srcL + (size_t)(row - NCTX) * DM; const int br = isc ? 4 : ((row - NCTX) >> 12);
        const float* sh = modl + br * 6144 + sh_off; const float* sc = modl + br * 6144 + sc_off;
        f32x4 v[4]; float ss = 0.f;
#pragma unroll
        for (int i = 0; i < 4; ++i) { v[i] = *(const f32x4*)(x + i * 256 + lane * 4); ss += v[i][0] * v[i][0] + v[i][1] * v[i][1] + v[i][2] * v[i][2] + v[i][3] * v[i][3]; }
        ss = wave_sum(ss); const float r = rsqrtf(ss * (1.0f / 1024.0f) + EPS);
#pragma unroll
        for (int i = 0; i < 4; ++i) { const int c = i * 256 + lane * 4; const f32x4 gv = *(const f32x4*)(g + c), shv = *(const f32x4*)(sh + c), scv = *(const f32x4*)(sc + c);
            f32x4 y = v[i] * r * gv; y = y * (scv + 1.0f) + shv; u32x2 w; w.x = pk2(y[0], y[1]); w.y = pk2(y[2], y[3]); *(u32x2*)(XN + (size_t)row * DM + c) = w; }
    }
}
__device__ __forceinline__ f32x4 ld_bf4(const bf16_t* p) { const u32x2 w = *(const u32x2*)p; return f32x4{bflo(w.x), bfhi(w.x), bflo(w.y), bfhi(w.y)}; }
__device__ __forceinline__ void prep_group(const Frame& F, int l, int row_lo) {
    const int gw = blockIdx.x * 8 + F.wave, nw = gridDim.x * 8, lane = F.lane;
    const bf16_t* MIX = FP(WS_MIX, bf16_t); const bf16_t* ZS = FP(WS_ZS, bf16_t); bf16_t* O = FP(WS_XN, bf16_t); const float* gg = PK(27) + l * DM;
    for (int row = row_lo + gw; row < T_ALL; row += nw) {
#pragma unroll
        for (int grp = 0; grp < 4; ++grp) {
            f32x4 v;
            if (grp < 3) v = ld_bf4(MIX + (size_t)row * 768 + grp * 256 + lane * 4);
            else { const f32x4 a = ld_bf4(ZS + (size_t)row * 512 + lane * 4), gt = ld_bf4(ZS + (size_t)row * 512 + 256 + lane * 4);
#pragma unroll
                for (int j = 0; j < 4; ++j) v[j] = a[j] * sigmoidf_(gt[j]); }
            float ss = v[0] * v[0] + v[1] * v[1] + v[2] * v[2] + v[3] * v[3]; ss = wave_sum(ss);
            const float r = rsqrtf(ss * (1.0f / 256.0f) + EPS); const f32x4 gv = *(const f32x4*)(gg + grp * 256 + lane * 4); const f32x4 y = v * r * gv;
            u32x2 w; w.x = pk2(y[0], y[1]); w.y = pk2(y[2], y[3]); *(u32x2*)(O + (size_t)row * DM + grp * 256 + lane * 4) = w;
        }
    }
}
__device__ __forceinline__ void final_norm(const Frame& F) {
    const int gw = blockIdx.x * 8 + F.wave, nw = gridDim.x * 8, lane = F.lane; const float* g = PK(35);
    for (int row = gw; row < NLAT; row += nw) {
        float* x = F.out + (size_t)row * DM; f32x4 v[4]; float ss = 0.f;
#pragma unroll
        for (int i = 0; i < 4; ++i) { v[i] = *(const f32x4*)(x + i * 256 + lane * 4); ss += v[i][0] * v[i][0] + v[i][1] * v[i][1] + v[i][2] * v[i][2] + v[i][3] * v[i][3]; }
        ss = wave_sum(ss); const float r = rsqrtf(ss * (1.0f / 1024.0f) + EPS);
#pragma unroll
        for (int i = 0; i < 4; ++i) { const int c = i * 256 + lane * 4; *(f32x4*)(x + c) = v[i] * r * *(const f32x4*)(g + c); }
    }
}

__device__ __forceinline__ void conv_unit(const Frame& F, int l, int unit, float* scr) {
    const bf16_t* PX = FP(WS_PX, bf16_t); bf16_t* CV = FP(WS_CV, bf16_t);
    int prow0, Lseq, t0;
    if (unit < 512) { const int b = unit >> 7; t0 = (unit & 127) * 32; prow0 = NCTX + b * 4096; Lseq = 4096; }
    else { const int uu = unit - 512; const int b = uu >> 3; t0 = (uu & 7) * 32; prow0 = b * 256; Lseq = 256; }
    float* vt = scr; float* ot = scr + 62 * 256; int tid = F.tid; asm volatile("" : "+v"(tid));
    for (int idx = tid; idx < 62 * 256; idx += NTHREADS) { const int rr = idx >> 8, c = idx & 255; const int t = t0 - 15 + rr; float v = 0.f;
        if (t >= 0 && t < Lseq) { const bf16_t* p = PX + (size_t)(prow0 + t) * INC; const float a = bf2f(p[c]), gt = bf2f(p[256 + c]); v = a * sigmoidf_(gt); }
        vt[idx] = v; }
    __syncthreads();
    { const int c = tid & 255, half = tid >> 8; float w[31];
#pragma unroll
      for (int j = 0; j < 31; ++j) w[j] = PK(8)[(l * 31 + j) * 256 + c];
      const float bd = PK(9)[l * 256 + c];
      for (int tt = 0; tt < 16; ++tt) { const int t = half * 16 + tt; float s = bd;
#pragma unroll
          for (int j = 0; j < 31; ++j) s += w[j] * vt[(t + j) * 256 + c];
          ot[t * 256 + c] = s; } }
    __syncthreads();
    { const int lane = tid & 63; const f32x4 lg = *(const f32x4*)(PK(10) + l * 256 + lane * 4), lb = *(const f32x4*)(PK(11) + l * 256 + lane * 4);
      for (int i = 0; i < 4; ++i) { const int t = F.wave * 4 + i; const f32x4 x = *(const f32x4*)(ot + t * 256 + lane * 4);
          const float mu = wave_sum(x[0] + x[1] + x[2] + x[3]) * (1.0f / 256.0f); const f32x4 d = x - mu;
          const float var = wave_sum(d[0] * d[0] + d[1] * d[1] + d[2] * d[2] + d[3] * d[3]) * (1.0f / 256.0f); const float r = rsqrtf(var + EPS);
          f32x4 y = d * r * lg + lb;
#pragma unroll
          for (int j = 0; j < 4; ++j) y[j] = y[j] * sigmoidf_(y[j]);
          u32x2 w; w.x = pk2(y[0], y[1]); w.y = pk2(y[2], y[3]); *(u32x2*)(CV + (size_t)(prow0 + t0 + t) * 256 + lane * 4) = w; } }
    __syncthreads();
}

__device__ __forceinline__ void fnetctx_unit(const Frame& F, int unit, float* scr) {
    const bf16_t* PX = FP(WS_PX, bf16_t); bf16_t* FN = FP(WS_FN, bf16_t);
    const int mh = unit & 1, h = (unit >> 1) & 3, b = unit >> 3; int tid = F.tid; asm volatile("" : "+v"(tid));
    float* zc = scr; float* zs = scr + 8192; float* c64 = scr + 16384; float* s64 = c64 + 64; float* c256 = s64 + 64; float* s256 = c256 + 256;
    if (tid < 64) { const float x = (float)tid * (1.0f / 32.0f); c64[tid] = cospif(x); s64[tid] = sinpif(x); }
    if (tid < 256) { const float x = (float)tid * (1.0f / 128.0f); c256[tid] = cospif(x); s256[tid] = sinpif(x); }
    __syncthreads();
    for (int idx = tid; idx < 8192; idx += NTHREADS) { const int n = idx >> 5, mm = idx & 31, m = mh * 32 + mm; const bf16_t* up = PX + (size_t)(b * 256 + n) * INC + 512 + h * 64;
        float ac = 0.f, as = 0.f;
        for (int j = 0; j < 64; ++j) { const float uv = bf2f(up[j]); const int a = (j * m) & 63; ac += uv * c64[a]; as += uv * s64[a]; }
        zc[idx] = ac; zs[idx] = as; }
    __syncthreads();
    for (int idx = tid; idx < 8192; idx += NTHREADS) { const int k = idx >> 5, mm = idx & 31; float acc = 0.f;
        for (int n = 0; n < 256; ++n) { const int a = (k * n) & 255; acc += c256[a] * zc[n * 32 + mm] - s256[a] * zs[n * 32 + mm]; }
        FN[(size_t)(b * 256 + k) * 256 + h * 64 + mh * 32 + mm] = (bf16_t)f2bf(acc * (1.0f / 128.0f)); }
    __syncthreads();
}
__device__ __forceinline__ void fnetA_unit(const Frame& F, int unit, unsigned char* lds) {
    const bf16_t* PX = FP(WS_PX, bf16_t); const bf16_t* Ct = FP(WS_CTAB, bf16_t); const bf16_t* St = FP(WS_STAB, bf16_t); bf16_t* YB = FP(WS_YB, bf16_t);
    const int oct = unit & 7, h = (unit >> 3) & 3, b = unit >> 5; int tid = F.tid; asm volatile("" : "+v"(tid)); const int lane = tid & 63, fr = lane & 15, fq = lane >> 4; const int n2 = oct * 8 + F.wave;
    bf16x8 ua[4][2];
#pragma unroll
    for (int mi = 0; mi < 4; ++mi)
#pragma unroll
        for (int kk = 0; kk < 2; ++kk) ua[mi][kk] = *(const bf16x8*)(PX + (size_t)(NCTX + b * 4096 + 64 * (16 * mi + fr) + n2) * INC + 512 + h * 64 + kk * 32 + fq * 8);
    bf16x8 zre[2][4], zs[2][4];
#pragma unroll
    for (int ni = 0; ni < 4; ++ni) {
        bf16x8 bc[2], bs[2];
#pragma unroll
        for (int kk = 0; kk < 2; ++kk) { bc[kk] = *(const bf16x8*)(Ct + (16 * ni + fr) * 64 + kk * 32 + fq * 8); bs[kk] = *(const bf16x8*)(St + (16 * ni + fr) * 64 + kk * 32 + fq * 8); }
#pragma unroll
        for (int pr = 0; pr < 2; ++pr) {
            f32x4 c0 = {0.f, 0.f, 0.f, 0.f}, c1 = c0, s0 = c0, s1 = c0;
#pragma unroll
            for (int kk = 0; kk < 2; ++kk) { c0 = mfma16(ua[2 * pr][kk], bc[kk], c0); c1 = mfma16(ua[2 * pr + 1][kk], bc[kk], c1); s0 = mfma16(ua[2 * pr][kk], bs[kk], s0); s1 = mfma16(ua[2 * pr + 1][kk], bs[kk], s1); }
            zre[pr][ni] = pack8(c0, c1); zs[pr][ni] = pack8(s0, s1);
        }
    }
    bf16_t* T = (bf16_t*)lds;
    for (int mi2 = 0; mi2 < 4; ++mi2) {
        bf16x8 cf[2], sf[2], sfn[2];
#pragma unroll
        for (int pr = 0; pr < 2; ++pr) {
            const bf16_t* cp = Ct + (16 * mi2 + fr) * 64 + 32 * pr + 4 * fq; const bf16_t* sp = St + (16 * mi2 + fr) * 64 + 32 * pr + 4 * fq;
            cf[pr] = cat4(*(const u32x2*)cp, *(const u32x2*)(cp + 16)); sf[pr] = cat4(*(const u32x2*)sp, *(const u32x2*)(sp + 16)); sfn[pr] = neg8(sf[pr]);
        }
        float cs[4], sn[4];
#pragma unroll
        for (int j = 0; j < 4; ++j) { const int k1 = 16 * mi2 + 4 * fq + j; const float x = (float)(n2 * k1) * (1.0f / 2048.0f); cs[j] = cospif(x); sn[j] = sinpif(x); }
#pragma unroll
        for (int ni = 0; ni < 4; ++ni) {
            f32x4 yre = {0.f, 0.f, 0.f, 0.f}, yin = yre;
#pragma unroll
            for (int pr = 0; pr < 2; ++pr) { yre = mfma16s(cf[pr], zre[pr][ni], yre); yre = mfma16s(sfn[pr], zs[pr][ni], yre); yin = mfma16s(cf[pr], zs[pr][ni], yin); yin = mfma16s(sf[pr], zre[pr][ni], yin); }
#pragma unroll
            for (int j = 0; j < 4; ++j) { const int k1 = 16 * mi2 + 4 * fq + j; const int m = 16 * ni + fr;
                const float y1 = yre[j] * cs[j] - yin[j] * sn[j], y2 = yin[j] * cs[j] + yre[j] * sn[j];
                T[((0 * 64 + k1) * 64 + m) * 8 + F.wave] = (bf16_t)f2bf(y1); T[((1 * 64 + k1) * 64 + m) * 8 + F.wave] = (bf16_t)f2bf(y2); }
        }
    }
    __syncthreads();
    for (int it = 0; it < 16; ++it) { const int cidx = it * NTHREADS + tid; const int m = cidx & 63, k1 = (cidx >> 6) & 63, plane = cidx >> 12;
        const u32x4 v = *(const u32x4*)(lds + (size_t)cidx * 16);
        *(u32x4*)(YB + ((((size_t)(b * 4 + h) * 64 + k1) * 2 + plane) * 64 + m) * 64 + oct * 8) = v; }
    __syncthreads();
}
__device__ __forceinline__ void fnetB_item(const Frame& F, int item) {
    const bf16_t* Ct = FP(WS_CTAB, bf16_t); const bf16_t* St = FP(WS_STAB, bf16_t); const bf16_t* YB = FP(WS_YB, bf16_t); bf16_t* FN = FP(WS_FN, bf16_t);
    const int k1 = item & 63, h = (item >> 6) & 3, b = item >> 8; int lane = F.lane; asm volatile("" : "+v"(lane)); const int fr = lane & 15, fq = lane >> 4;
    const bf16_t* base = YB + (((size_t)(b * 4 + h) * 64 + k1) * 2) * 4096;
    f32x4 acc[4][4];
#pragma unroll
    for (int mi = 0; mi < 4; ++mi)
#pragma unroll
        for (int ni = 0; ni < 4; ++ni) acc[mi][ni] = f32x4{0.f, 0.f, 0.f, 0.f};
#pragma unroll
    for (int kk = 0; kk < 2; ++kk) {
        bf16x8 bc[4], bsn[4];
#pragma unroll
        for (int ni = 0; ni < 4; ++ni) { bc[ni] = *(const bf16x8*)(Ct + (16 * ni + fr) * 64 + kk * 32 + fq * 8); bsn[ni] = neg8(*(const bf16x8*)(St + (16 * ni + fr) * 64 + kk * 32 + fq * 8)); }
#pragma unroll
        for (int mi = 0; mi < 4; ++mi) {
            const bf16x8 are = *(const bf16x8*)(base + (16 * mi + fr) * 64 + kk * 32 + fq * 8), aim = *(const bf16x8*)(base + 4096 + (16 * mi + fr) * 64 + kk * 32 + fq * 8);
#pragma unroll
            for (int ni = 0; ni < 4; ++ni) { acc[mi][ni] = mfma16(are, bc[ni], acc[mi][ni]); acc[mi][ni] = mfma16s(aim, bsn[ni], acc[mi][ni]); }
        }
    }
#pragma unroll
    for (int mi = 0; mi < 4; ++mi)
#pragma unroll
        for (int ni = 0; ni < 4; ++ni) { const int k = k1 + 64 * (16 * ni + fr); const f32x4 v = acc[mi][ni] * (1.0f / 512.0f);
            u32x2 w; w.x = pk2(v[0], v[1]); w.y = pk2(v[2], v[3]); *(u32x2*)(FN + (size_t)(NCTX + b * 4096 + k) * 256 + h * 64 + 16 * mi + 4 * fq) = w; }
}

template <bool LOCAL>
__device__ __forceinline__ void attn_item(const Frame& F, int l, int item) {
    const bf16_t* PX = FP(WS_PX, bf16_t); const bf16_t* VT = FP(WS_VT, bf16_t); const bf16_t* VTc = FP(WS_VTC, bf16_t); bf16_t* MIX = FP(WS_MIX, bf16_t);
    const float* rpb = PK(16) + l * (4 * 15 * 31);
    int lane = F.lane; asm volatile("" : "+v"(lane)); const int fr = lane & 15, fq = lane >> 4;
    int b, h, r = 0, jb = 0, qrow0;
    if (LOCAL) { h = item & 3; jb = (item >> 2) & 3; r = (item >> 4) & 63; b = item >> 10; qrow0 = NCTX + b * 4096 + r * 64 + jb * 16; }
    else { h = item & 3; const int qb = (item >> 2) & 15; b = item >> 6; qrow0 = b * 256 + qb * 16; }
    constexpr int NT = LOCAL ? 32 : 16;
    const int rs = LOCAL ? min(max(r - 4, 0), 56) : 0; const int kcs = LOCAL ? min(max(16 * jb - 8, 0), 32) : 0;
    bf16x8 qf[2];
#pragma unroll
    for (int kk = 0; kk < 2; ++kk) qf[kk] = *(const bf16x8*)(PX + (size_t)(qrow0 + fr) * INC + 768 + h * 64 + kk * 32 + fq * 8);
    f32x4 s[NT];
#pragma unroll
    for (int t = 0; t < NT; ++t) {
        int krow;
        if (LOCAL && t < 16) krow = NCTX + b * 4096 + (rs + (t >> 1)) * 64 + kcs + (t & 1) * 16 + fr;
        else krow = b * 256 + (t - (LOCAL ? 16 : 0)) * 16 + fr;
        const bf16_t* kp = PX + (size_t)krow * INC + 1024 + h * 64 + fq * 8;
        const bf16x8 k0 = *(const bf16x8*)kp, k1 = *(const bf16x8*)(kp + 32);
        f32x4 a = {0.f, 0.f, 0.f, 0.f}; a = mfma16(k0, qf[0], a); a = mfma16(k1, qf[1], a); s[t] = a;
    }
    float mx = -3.0e38f;
    const int qcol = 16 * jb + fr; const int cstart = min(max(qcol - 8, 0), 48);
#pragma unroll
    for (int t = 0; t < NT; ++t)
#pragma unroll
        for (int j = 0; j < 4; ++j) {
            float v = s[t][j] * 0.125f;
            if (LOCAL && t < 16) { const int kcol = kcs + (t & 1) * 16 + 4 * fq + j; const bool valid = (kcol >= cstart) && (kcol < cstart + 16);
                const int dr = rs + (t >> 1) - r + 7; const int dc = min(max(kcol - qcol + 15, 0), 30);
                v = valid ? v + rpb[(h * 15 + dr) * 31 + dc] : -1.0e30f; }
            s[t][j] = v; mx = fmaxf(mx, v);
        }
    mx = fmaxf(mx, __shfl_xor(mx, 16)); mx = fmaxf(mx, __shfl_xor(mx, 32));
    float sum = 0.f;
#pragma unroll
    for (int t = 0; t < NT; ++t)
#pragma unroll
        for (int j = 0; j < 4; ++j) { const float p = __expf(s[t][j] - mx); s[t][j] = p; sum += p; }
    sum += __shfl_xor(sum, 16); sum += __shfl_xor(sum, 32);
    f32x4 o[4];
#pragma unroll
    for (int di = 0; di < 4; ++di) o[di] = f32x4{0.f, 0.f, 0.f, 0.f};
#pragma unroll
    for (int u = 0; u < NT / 2; ++u) {
        const bf16x8 pb = pack8(s[2 * u], s[2 * u + 1]);
        const bf16_t* vbase; size_t stride;
        if (LOCAL && u < 8) { vbase = VT + (size_t)(b * 256 + h * 64) * 4096 + (rs + u) * 64 + kcs + 4 * fq; stride = 4096; }
        else { const int uu = u - (LOCAL ? 8 : 0); vbase = VTc + (size_t)(b * 256 + h * 64) * 256 + uu * 32 + 4 * fq; stride = 256; }
#pragma unroll
        for (int di = 0; di < 4; ++di) { const bf16_t* vp = vbase + (size_t)(16 * di + fr) * stride; const bf16x8 va = cat4(*(const u32x2*)vp, *(const u32x2*)(vp + 16)); o[di] = mfma16s(va, pb, o[di]); }
    }
    const float inv = 1.0f / sum;
#pragma unroll
    for (int di = 0; di < 4; ++di) { const f32x4 v = o[di] * inv; u32x2 w; w.x = pk2(v[0], v[1]); w.y = pk2(v[2], v[3]);
        *(u32x2*)(MIX + (size_t)(qrow0 + fr) * 768 + 512 + h * 64 + 16 * di + 4 * fq) = w; }
}

__device__ __forceinline__ cplx csel(bool c, cplx a, cplx b) { return cplx{c ? a.re : b.re, c ? a.im : b.im}; }
#define WAITALL() asm volatile("s_waitcnt vmcnt(0) lgkmcnt(0)" ::: "memory")
__device__ __forceinline__ cplx pow_sel(int k, cplx a, cplx a2, cplx a4, cplx a8, cplx a16) {
    cplx r = cplx{1.f, 0.f};
    r = csel((k & 1) != 0, cmul(r, a), r); r = csel((k & 2) != 0, cmul(r, a2), r); r = csel((k & 4) != 0, cmul(r, a4), r); r = csel((k & 8) != 0, cmul(r, a8), r); r = csel((k & 16) != 0, cmul(r, a16), r);
    return r;
}
__device__ __forceinline__ void ssm_consts(float lre, float lim, float dt, cplx& a, cplx& f) {
    const float e = __expf(lre * dt);
    float revs = lim * dt * 0.15915494309189535f; revs -= rintf(revs);
    a = cplx{e * __builtin_amdgcn_cosf(revs), e * __builtin_amdgcn_sinf(revs)};
    const float xr = a.re - 1.0f, xi = a.im, den = __builtin_amdgcn_rcpf(lre * lre + lim * lim);
    f = cplx{(xr * lre + xi * lim) * den, (xi * lre - xr * lim) * den};
}
template <int PASS, int DIR>
__device__ __forceinline__ void ssm_dir(const Frame& F, int lane, int l, int b, int g, int tb, const bf16x8 (&ub)[4], f32x4 (&accy)[4]) {
    const int fr = lane & 15, fq = lane >> 4;
    const int c = DIR == 0 ? tb : (tb < 4 ? 3 - tb : 71 - tb);
    const int pg = (l * 2 + DIR) * 16 + g;
    const float dt = __expf(PK(19)[pg]);
    cplx* Sloc = FP(WS_SLOC, cplx); const cplx* Carry = FP(WS_CARRY, cplx);
    const size_t sbase = ((size_t)((b * 2 + DIR) * 16 + g) * 68 + c) * 64;
    for (int q = 0; q < 4; ++q) {
        bf16x8 are, aim;
        { const int kq = (fq & 1) * 8; const float* pr = PK(20) + ((size_t)pg * 64 + 16 * q + fr) * 16 + kq; const float* pi = PK(21) + ((size_t)pg * 64 + 16 * q + fr) * 16 + kq;
          const f32x4 zz = f32x4{0.f, 0.f, 0.f, 0.f}; const bool on = fq < 2;
          const f32x4 r0 = *(const f32x4*)pr, r1 = *(const f32x4*)(pr + 4), i0 = *(const f32x4*)pi, i1 = *(const f32x4*)(pi + 4);
          WAITALL();
          are = pack8(on ? r0 : zz, on ? r1 : zz); aim = pack8(on ? i0 : zz, on ? i1 : zz); }
        f32x4 bre[4], bim[4];
        asm volatile("s_nop 7" : "+v"(are), "+v"(aim));
#pragma unroll
        for (int ni = 0; ni < 4; ++ni) { bre[ni] = mfma16(are, ub[ni], f32x4{0.f, 0.f, 0.f, 0.f}); bim[ni] = mfma16(aim, ub[ni], f32x4{0.f, 0.f, 0.f, 0.f}); }
        settle4m(bre[0], bre[1], bre[2], bre[3]); settle4m(bim[0], bim[1], bim[2], bim[3]);
#pragma unroll
        for (int j = 0; j < 4; ++j) {
            const int p = 16 * q + 4 * fq + j;
            const float lre = PK(17)[pg * 64 + p], lim = PK(18)[pg * 64 + p];
            WAITALL();
            cplx a, f; ssm_consts(lre, lim, dt, a, f);
            const cplx a2 = cmul(a, a), a4 = cmul(a2, a2), a8 = cmul(a4, a4), a16 = cmul(a8, a8);
            if (PASS == 1) {
                cplx Tt;
                if (DIR == 0) { Tt = cplx{bre[0][j], bim[0][j]}; Tt = cmad(cplx{bre[1][j], bim[1][j]}, Tt, a16); Tt = cmad(cplx{bre[2][j], bim[2][j]}, Tt, a16); Tt = cmad(cplx{bre[3][j], bim[3][j]}, Tt, a16); }
                else { Tt = cplx{bre[3][j], bim[3][j]}; Tt = cmad(cplx{bre[2][j], bim[2][j]}, Tt, a16); Tt = cmad(cplx{bre[1][j], bim[1][j]}, Tt, a16); Tt = cmad(cplx{bre[0][j], bim[0][j]}, Tt, a16); }
                const cplx w = pow_sel(DIR == 0 ? 15 - fr : fr, a, a2, a4, a8, a16);
                Tt = cmul(Tt, w);
                Tt.re += __shfl_xor(Tt.re, 1); Tt.im += __shfl_xor(Tt.im, 1); Tt.re += __shfl_xor(Tt.re, 2); Tt.im += __shfl_xor(Tt.im, 2);
                Tt.re += __shfl_xor(Tt.re, 4); Tt.im += __shfl_xor(Tt.im, 4); Tt.re += __shfl_xor(Tt.re, 8); Tt.im += __shfl_xor(Tt.im, 8);
                Tt = cmul(Tt, f);
                if (fr == 0) Sloc[sbase + p] = Tt;
            } else {
                const cplx w = pow_sel(DIR == 0 ? fr + 1 : 16 - fr, a, a2, a4, a8, a16);
                cplx x[4];
#pragma unroll
                for (int ni = 0; ni < 4; ++ni) {
                    cplx v = cmul(f, cplx{bre[ni][j], bim[ni][j]});
#define RLF(x, ln) __builtin_bit_cast(float, __builtin_amdgcn_readlane(__builtin_bit_cast(int, (x)), (ln)))
#define DPPF(x, ctrl) __builtin_bit_cast(float, __builtin_amdgcn_update_dpp(0, __builtin_bit_cast(int, (x)), (ctrl), 0xf, 0xf, true))
#define KS_STEP(d, ad) { cplx y; if (DIR == 0) { y.re = DPPF(v.re, 0x110 + d); y.im = DPPF(v.im, 0x110 + d); v = csel(fr >= d, cmad(v, ad, y), v); } \
                                   else { y.re = DPPF(v.re, 0x100 + d); y.im = DPPF(v.im, 0x100 + d); v = csel(fr + d <= 15, cmad(v, ad, y), v); } }
                    KS_STEP(1, a) KS_STEP(2, a2) KS_STEP(4, a4) KS_STEP(8, a8)
#undef KS_STEP
                    x[ni] = v;
                }
                cplx E = Carry[sbase + p]; WAITALL();
#pragma unroll
                for (int bi = 0; bi < 4; ++bi) {
                    const int ni = DIR == 0 ? bi : 3 - bi;
                    const cplx hh = cmad(x[ni], w, E);
                    cplx tot;
                    { constexpr int L0 = DIR == 0 ? 15 : 0;
                      const float r0 = RLF(x[ni].re, L0), r1 = RLF(x[ni].re, L0 + 16), r2 = RLF(x[ni].re, L0 + 32), r3 = RLF(x[ni].re, L0 + 48);
                      const float i0 = RLF(x[ni].im, L0), i1 = RLF(x[ni].im, L0 + 16), i2 = RLF(x[ni].im, L0 + 32), i3 = RLF(x[ni].im, L0 + 48);
                      tot.re = fq == 0 ? r0 : fq == 1 ? r1 : fq == 2 ? r2 : r3; tot.im = fq == 0 ? i0 : fq == 1 ? i1 : fq == 2 ? i2 : i3; }
                    E = cmad(tot, a16, E);
                    bre[ni][j] = hh.re; bim[ni][j] = hh.im;
                }
            }
        }
        if (PASS == 3) {
            const float* cr = PK(22) + ((size_t)pg * 16 + fr) * 64 + 16 * q + 4 * fq; const float* ci = PK(23) + ((size_t)pg * 16 + fr) * 64 + 16 * q + 4 * fq;
            const f32x4 cre = *(const f32x4*)cr; const f32x4 cim = *(const f32x4*)ci; WAITALL();
            const bf16x8 ca = pack8(cre, f32x4{-cim[0], -cim[1], -cim[2], -cim[3]});
#pragma unroll
            for (int ni = 0; ni < 4; ++ni) { bf16x8 hb = pack8(bre[ni], bim[ni]); bf16x8 ca2 = ca; asm volatile("s_nop 7" : "+v"(ca2), "+v"(hb)); accy[ni] = mfma16(ca2, hb, accy[ni]); }
            settle4m(accy[0], accy[1], accy[2], accy[3]);
        }
    }
}
template <int PASS>
__device__ __forceinline__ void ssm_item(const Frame& F, int l_u, int item_u) {
    int l = l_u, item = item_u; asm volatile("" : "+v"(l), "+v"(item));
    const bf16_t* PX = FP(WS_PX, bf16_t);
    int lane = F.lane; asm volatile("" : "+v"(lane)); const int fr = lane & 15, fq = lane >> 4;
    const int tb = item % 68; const int g = (item / 68) & 15; const int b = item / (68 * 16);
    const int prow0 = tb < 4 ? b * 256 + tb * 64 : NCTX + b * 4096 + (tb - 4) * 64;
    bf16x8 ub[4];
#pragma unroll
    for (int ni = 0; ni < 4; ++ni) { const bf16x8 ld = *(const bf16x8*)(PX + (size_t)(prow0 + 16 * ni + fr) * INC + 1536 + g * 16 + (fq & 1) * 8); ub[ni] = fq < 2 ? ld : zero8(); }
    f32x4 accy[4];
#pragma unroll
    for (int ni = 0; ni < 4; ++ni) accy[ni] = f32x4{0.f, 0.f, 0.f, 0.f};
    WAITALL();
    ssm_dir<PASS, 0>(F, lane, l, b, g, tb, ub, accy);
    ssm_dir<PASS, 1>(F, lane, l, b, g, tb, ub, accy);
    if (PASS == 3) {
        bf16_t* YS = FP(WS_YS, bf16_t); const f32x4 dv = *(const f32x4*)(PK(24) + l * 256 + g * 16 + 4 * fq);
#pragma unroll
        for (int ni = 0; ni < 4; ++ni) { const int row = prow0 + 16 * ni + fr; const f32x4 uv = ld_bf4(PX + (size_t)row * INC + 1536 + g * 16 + 4 * fq); WAITALL();
            const f32x4 y = accy[ni] + dv * uv; u32x2 w; w.x = pk2(y[0], y[1]); w.y = pk2(y[2], y[3]); *(u32x2*)(YS + (size_t)row * 256 + g * 16 + 4 * fq) = w; }
    }
}
__device__ __forceinline__ void ssm_pass2(const Frame& F, int l) {
    const int idx = blockIdx.x * NTHREADS + F.tid; if (idx >= 8192) return;
    const int p = idx & 63, g = (idx >> 6) & 15, dir = (idx >> 10) & 1, b = idx >> 11;
    const int pg = (l * 2 + dir) * 16 + g; const float dt = __expf(PK(19)[pg]);
    const float lre = PK(17)[pg * 64 + p], lim = PK(18)[pg * 64 + p];
    cplx a, f_unused; ssm_consts(lre, lim, dt, a, f_unused);
#pragma unroll
    for (int i = 0; i < 6; ++i) a = cmul(a, a);
    const cplx* Sloc = FP(WS_SLOC, cplx); cplx* Carry = FP(WS_CARRY, cplx);
    const size_t base = ((size_t)((b * 2 + dir) * 16 + g) * 68) * 64 + p;
    cplx E = cplx{0.f, 0.f};
    for (int c0 = 0; c0 < 68; c0 += 4) {
        const cplx s0 = Sloc[base + (size_t)(c0 + 0) * 64], s1 = Sloc[base + (size_t)(c0 + 1) * 64], s2 = Sloc[base + (size_t)(c0 + 2) * 64], s3 = Sloc[base + (size_t)(c0 + 3) * 64];
        Carry[base + (size_t)(c0 + 0) * 64] = E; E = cmad(s0, a, E);
        Carry[base + (size_t)(c0 + 1) * 64] = E; E = cmad(s1, a, E);
        Carry[base + (size_t)(c0 + 2) * 64] = E; E = cmad(s2, a, E);
        Carry[base + (size_t)(c0 + 3) * 64] = E; E = cmad(s3, a, E);
    }
}


enum : unsigned { W_PREP1 = 1u << 0, W_GIN = 1u << 1, W_GVT = 1u << 2, W_FC = 1u << 3, W_FA = 1u << 4, W_CV = 1u << 5, W_ATT = 1u << 6, W_SSM1 = 1u << 7, W_GPW = 1u << 8,
                  W_P2 = 1u << 9, W_FB = 1u << 10, W_GFW = 1u << 11, W_SSM3 = 1u << 12, W_GGLU = 1u << 13, W_GN = 1u << 14, W_GOUT = 1u << 15, W_PREP3 = 1u << 16, W_GFF1 = 1u << 17, W_GFF2 = 1u << 18 };
#ifndef PH_FINE
#define PH_FINE 0
#endif
#if PH_FINE
constexpr int NSP = 18;
__host__ __device__ __forceinline__ unsigned phase_mask(int sp) {
    switch (sp) { case 0: return W_PREP1; case 1: return W_GIN; case 2: return W_GVT; case 3: return W_FC; case 4: return W_FA; case 5: return W_CV; case 6: return W_ATT; case 7: return W_SSM1;
                  case 8: return W_GPW; case 9: return W_P2 | W_FB; case 10: return W_GFW; case 11: return W_SSM3; case 12: return W_GGLU; case 13: return W_GN; case 14: return W_GOUT;
                  case 15: return W_PREP3; case 16: return W_GFF1; default: return W_GFF2; }
}
#else
constexpr int NSP = 11;
__host__ __device__ __forceinline__ unsigned phase_mask(int sp) {
    switch (sp) { case 0: return W_PREP1; case 1: return W_GIN | W_GVT; case 2: return W_FC | W_FA | W_CV | W_ATT | W_SSM1; case 3: return W_GPW | W_P2 | W_FB;
                  case 4: return W_GFW | W_SSM3; case 5: return W_GGLU; case 6: return W_GN; case 7: return W_GOUT; case 8: return W_PREP3; case 9: return W_GFF1; default: return W_GFF2; }
}
#endif
constexpr int NPH = 2 + 2 * NSP;
#ifndef ZP1
#define ZP1 12
#define ZP2 30
#endif
#define OPQ_S(x) asm volatile("" : "+s"(x))
#define GSYNC() do { __syncthreads(); if (wave_ == 0) { __builtin_amdgcn_fence(__ATOMIC_RELEASE, "agent"); asm volatile("s_waitcnt vmcnt(0) lgkmcnt(0)" ::: "memory"); } \
                     grid.sync(); \
                     if (wave_ == 0) { __builtin_amdgcn_fence(__ATOMIC_ACQUIRE, "agent"); asm volatile("s_waitcnt vmcnt(0) lgkmcnt(0)" ::: "memory"); } __syncthreads(); } while (0)
__global__ void __launch_bounds__(NTHREADS, 2) fwd(Args args) {
    extern __shared__ __attribute__((aligned(16))) unsigned char lds[];

    cg::grid_group grid = cg::this_grid();
    const int tid_ = threadIdx.x;
    const int wave_ = __builtin_amdgcn_readfirstlane(tid_ >> 6);
    float* scr = (float*)lds;
    const int G = gridDim.x, bx = blockIdx.x;
    const int gw = bx * 8 + wave_, nw = G * 8;
    const int lo = args.ph_lo, hi = args.ph_hi;
    if (lo == 0) { const Frame F{args, args.out, args.ws, tid_, tid_ & 63, wave_}; p0_prologue(F, scr); if (hi > 1) GSYNC(); }
#pragma nounroll
    for (int ph0 = (lo == 0 ? 1 : lo); ph0 < hi; ++ph0) {
        int ph = ph0; OPQ_S(ph);
        int tidv = tid_; asm volatile("" : "+v"(tidv));
        __attribute__((address_space(1))) unsigned char* wsg = (__attribute__((address_space(1))) unsigned char*)args.ws; __attribute__((address_space(1))) float* outg = (__attribute__((address_space(1))) float*)args.out;
        OPQ_S(wsg); OPQ_S(outg);
        unsigned char* wsv = (unsigned char*)wsg; float* outv = (float*)outg;
        const Frame F{args, outv, wsv, tidv, tidv & 63, wave_};
        if (ph == NPH - 1) { final_norm(F); continue; }
        const int l = (ph - 1) / NSP; const int sp = (ph - 1) - l * NSP;
        const unsigned wm = phase_mask(sp);
        const int row_lo = l == 0 ? 0 : NCTX;
        const int M_post = T_ALL - row_lo;
        unsigned char* wl = F.ws + WS_W + (size_t)l * W_LAYER;
#pragma nounroll
        for (int kind = 0; kind < 8; ++kind) {
            const unsigned bit = kind == 0 ? W_GIN : kind == 1 ? W_GVT : kind == 2 ? W_GPW : kind == 3 ? W_GFW : kind == 4 ? W_GGLU : kind == 5 ? W_GFF1 : kind == 6 ? W_GOUT : W_GFF2;
            if (!(wm & bit)) continue;
            const bf16_t* A; const bf16_t* Bt; int M, N, K;
            if (kind == 0) { A = FP(WS_XN, bf16_t); Bt = (const bf16_t*)(wl + W_IN); M = T_ALL; N = INC; K = DM; }
            else if (kind == 1) { A = (const bf16_t*)(wl + W_IN) + (size_t)1280 * DM; Bt = FP(WS_XN, bf16_t); M = 256; N = T_ALL; K = DM; }
            else if (kind == 2) { A = FP(WS_CV, bf16_t) + (size_t)row_lo * 256; Bt = (const bf16_t*)(wl + W_PW); M = M_post; N = 256; K = 256; }
            else if (kind == 3) { A = FP(WS_FN, bf16_t) + (size_t)row_lo * 256; Bt = (const bf16_t*)(wl + W_F); M = M_post; N = 256; K = 256; }
            else if (kind == 4) { A = FP(WS_YS, bf16_t) + (size_t)row_lo * 256; Bt = (const bf16_t*)(wl + W_GLU); M = M_post; N = 512; K = 256; }
            else if (kind == 5) { A = FP(WS_XN, bf16_t) + (size_t)row_lo * DM; Bt = (const bf16_t*)(wl + W_1); M = M_post; N = FFD; K = DM; }
            else if (kind == 6) { A = FP(WS_XN, bf16_t) + (size_t)row_lo * DM; Bt = (const bf16_t*)(wl + W_OUT); M = M_post; N = DM; K = DM; }
            else { A = FP(WS_H, bf16_t) + (size_t)row_lo * FFD; Bt = (const bf16_t*)(wl + W_2); M = M_post; N = DM; K = FFD; }
            pg8::Gemm g{A, Bt, M, N, K}; pg8::StaticOrder S; S.init(M, N, G, bx);
            EpiU E{F, l, kind, row_lo};
            pg8::gemm_phase<EpiU, pg8::StaticOrder, true, true>((PG8_LAS unsigned char*)lds, g, S, E);
        }
        if (wm & (W_FC | W_FA | W_CV)) {
            const int n_fc = (l == 0 && (wm & W_FC)) ? 32 : 0, n_fa = (wm & W_FA) ? 128 : 0, n_cv = (wm & W_CV) ? (l == 0 ? 544 : 512) : 0; const int nbu = n_fc + n_fa + n_cv;
#pragma nounroll
            for (int u = bx; u < nbu; u += G) {
                if (u < n_fc) fnetctx_unit(F, u, scr);
                else if (u < n_fc + n_fa) fnetA_unit(F, u - n_fc, lds);
                else conv_unit(F, l, u - n_fc - n_fa, scr);
            }
        }
        if (wm & W_P2) ssm_pass2(F, l);
        if (wm & W_SSM3) {
#pragma nounroll
            for (int it = gw; it < 4096; it += nw) ssm_item<3>(F, l, it);
#pragma nounroll
            for (int it = 4096 + gw; it < 4352; it += nw) ssm_item<3>(F, l, it);
        }
        if (wm & (W_ATT | W_SSM1 | W_FB)) {
            const int n_ac = (l == 0 && (wm & W_ATT)) ? 256 : 0, n_al = (wm & W_ATT) ? 4096 : 0, n_s1 = (wm & W_SSM1) ? 4352 : 0, n_fb = (wm & W_FB) ? 1024 : 0, n_s3 = 0;
            const int e0 = n_ac, e1 = e0 + n_al, e2 = e1 + n_s1, e3 = e2 + n_fb, e4 = e3 + n_s3;
#pragma nounroll
            for (int it = gw; it < e4; it += nw) {
                if (it < e0) attn_item<false>(F, l, it);
                else if (it < e1) attn_item<true>(F, l, it - e0);
                else if (it < e2) ssm_item<1>(F, l, it - e1);
                else if (it < e3) fnetB_item(F, it - e2);
                else { ssm_item<3>(F, l, it - e3); }
            }
        }
        if (wm & W_PREP1) prep_norm_mod(F, l == 0 ? F.A.in[2] : FP(WS_XC, float), l == 0 ? F.A.in[0] : F.out, PK(6) + l * DM, FP(WS_MOD, float) + l * 5 * 6144, 0, 1024, FP(WS_XN, bf16_t), 0);
        if (wm & W_GN) prep_group(F, l, row_lo);
        if (wm & W_PREP3) prep_norm_mod(F, FP(WS_XC, float), F.out, PK(30) + l * DM, FP(WS_MOD, float) + l * 5 * 6144, 3072, 4096, FP(WS_XN, bf16_t), row_lo);
        if (ph0 + 1 < hi) GSYNC();
    }
}

extern "C" void kernel_launch(void* const* d_in, const int* in_sizes, int n_in, void* d_out, int out_size, void* d_ws, size_t ws_size, hipStream_t stream) {
    static int grid = 0;
    if (grid == 0) {
        if (n_in != 36 || ws_size < WS_END) { fprintf(stderr, "kernel_launch: unexpected n_in %d / ws %zu\n", n_in, ws_size); grid = -1; return; }
        int dev = 0, cus = 0, per_cu = 0;
        (void)hipGetDevice(&dev); (void)hipDeviceGetAttribute(&cus, hipDeviceAttributeMultiprocessorCount, dev);
        (void)hipFuncSetAttribute((const void*)fwd, hipFuncAttributeMaxDynamicSharedMemorySize, LDS_BYTES);
        (void)hipOccupancyMaxActiveBlocksPerMultiprocessor(&per_cu, (const void*)fwd, NTHREADS, LDS_BYTES);
        (void)hipGetLastError();
        grid = cus > 0 ? cus : 256;
    }
    if (grid < 0) return;
    Args a{};
    for (int i = 0; i < 36; ++i) a.in[i] = (const float*)d_in[i];
    a.out = (float*)d_out; a.ws = (unsigned char*)d_ws;
#if MODE_COOP
    a.ph_lo = 0; a.ph_hi = NPH; a.part = 15;
    void* kargs[] = {&a};
    hipError_t e = hipLaunchCooperativeKernel((const void*)fwd, dim3(grid), dim3(NTHREADS), kargs, LDS_BYTES, stream);
    if (e != hipSuccess) fprintf(stderr, "cooperative launch failed: %s (grid %d)\n", hipGetErrorString(e), grid);
#else
    for (int ph = 0; ph < NPH; ++ph) { a.ph_lo = ph; a.ph_hi = ph + 1; a.part = 15; hipLaunchKernelGGL(fwd, dim3(grid), dim3(NTHREADS), LDS_BYTES, stream, a); }
#endif
}
```

```cpp
#include <hip/hip_runtime.h>
#include <hip/hip_cooperative_groups.h>
#include <cstdio>
#include <cstdint>
namespace cg = cooperative_groups;
#ifndef MODE_COOP
#define MODE_COOP 1
#endif
namespace pg8 {
#define PG8_LAS __attribute__((address_space(3)))
typedef unsigned short bf16_t;
typedef short bf16x8 __attribute__((ext_vector_type(8)));
typedef float f32x4 __attribute__((ext_vector_type(4)));
typedef unsigned u32x4 __attribute__((ext_vector_type(4)));
constexpr int BM = 256, BK = 64, HALF = 128, HTB = HALF * BK * 2  , STAGE_BYTES = 8 * HTB, NXCD = 8, WGM = 8;

__host__ __device__ __forceinline__ int lds_byte(int r, int c) { const int st = (r >> 4) * 2 + (c >> 5), rr = r & 15, cc = c & 31, ob = rr * 64 + cc * 2; return st * 1024 + (ob ^ (((ob >> 9) & 1) << 5)); }
__host__ __device__ __forceinline__ void stage_rc(int b, int& R, int& C) { const int st = b / 1024, sb = b % 1024, swz = sb ^ (((sb >> 9) & 1) << 5); R = (st >> 1) * 16 + swz / 64; C = (st & 1) * 32 + (swz % 64) / 2; }
__host__ __device__ __forceinline__ int perm32(int rho) { const int n = rho >> 4, i = rho & 15; return 8 * (i >> 2) + 4 * n + (i & 3); }

struct Unit { int pm, pn; };
struct Gemm { const bf16_t* A; const bf16_t* Bt; int M, N, K; };

struct StaticOrder {
    int nM, nN, nwg, G, c;
    __host__ __device__ void init(int M, int N, int G_, int c_) { nM = M / BM; nN = N / BM; nwg = nM * nN; G = G_; c = c_; }
    __host__ __device__ bool next(int i, Unit& u) const {
        const long L = (long)i * G + c; if (L >= nwg) return false;
        int wgid = (int)L; { const int q = nwg / NXCD, r = nwg % NXCD, xcd = wgid % NXCD, off = wgid / NXCD; wgid = (xcd < r ? xcd * (q + 1) : r * (q + 1) + (xcd - r) * q) + off; }
        const int nig = WGM * nN, gid = wgid / nig, fm = gid * WGM, gsz = (nM - fm) < WGM ? (nM - fm) : WGM;
        u.pm = fm + ((wgid % nig) % gsz); u.pn = (wgid % nig) / gsz; return true;
    }
    __device__ __forceinline__ void a_ready(const Unit&) const {}
    __device__ __forceinline__ void done(const Unit&) const {}
};

}
namespace pg8 {
template <class Epi, class Sched, bool ALIGN_EPI = false, bool SP2 = false>
__device__ __forceinline__ void gemm_phase(PG8_LAS unsigned char* lds, const Gemm g, const Sched& S, const Epi& E) {
    const int tid = threadIdx.x, wid = __builtin_amdgcn_readfirstlane(tid >> 6), lane = tid & 63, wr = wid >> 2, wc = wid & 3, fr = lane & 15, fq = lane >> 4;
    const int K = g.K, nt = K / BK;
    unsigned voffA[2], voffB[2];
#pragma unroll
    for (int i = 0; i < 2; ++i) { int R, C; stage_rc(tid * 16 + i * 8192, R, C); const int Rb = Epi::PERM ? ((R & ~31) + perm32(R & 31)) : R;
        voffA[i] = (unsigned)(R * K + C) * 2u; voffB[i] = (unsigned)(Rb * K + C) * 2u; }
    const size_t kstep = (size_t)(BK * 2);
    const size_t hstep = (size_t)HALF * K * 2;
    const size_t tstep = 2 * hstep;
    const unsigned ldsw = (unsigned)wid * 1024u;
    const int aoff = lds_byte(wr * 64 + fr, fq * 8), boff = lds_byte(wc * 32 + fr, fq * 8);
#define PG8_SA(b, h) (((b) * 2 + (h)) * HTB)
#define PG8_SB(b, h) ((4 + (b) * 2 + (h)) * HTB)
#define PG8_STAGE(bufoff, gbase, voff) do { _Pragma("unroll") for (int _i = 0; _i < 2; ++_i) \
        __builtin_amdgcn_global_load_lds((const unsigned*)((const char*)(gbase) + (voff)[_i]), (PG8_LAS unsigned*)(lds + (bufoff) + ldsw + _i * 8192), 16, 0, 0); } while (0)
#define PG8_LDA(dst, b, h) do { _Pragma("unroll") for (int m = 0; m < 4; ++m) _Pragma("unroll") for (int k = 0; k < 2; ++k) dst[m][k] = *(const PG8_LAS bf16x8*)(lds + PG8_SA(b, h) + aoff + m * 2048 + k * 1024); } while (0)
#define PG8_LDB(dst, b, h) do { _Pragma("unroll") for (int n = 0; n < 2; ++n) _Pragma("unroll") for (int k = 0; k < 2; ++k) dst[n][k] = *(const PG8_LAS bf16x8*)(lds + PG8_SB(b, h) + boff + n * 2048 + k * 1024); } while (0)
#define PG8_MMA(ai, bj, At, Bt) do { __builtin_amdgcn_s_setprio(1); _Pragma("unroll") for (int m = 0; m < 4; ++m) _Pragma("unroll") for (int n = 0; n < 2; ++n) _Pragma("unroll") for (int k = 0; k < 2; ++k) \
        acc[ai][bj][m][n] = __builtin_amdgcn_mfma_f32_16x16x32_bf16(Bt[n][k], At[m][k], acc[ai][bj][m][n], 0, 0, 0); __builtin_amdgcn_s_setprio(0); } while (0)
#define PG8_WAIT_V(n) asm volatile("s_waitcnt vmcnt(" #n ")" ::: "memory")
#define PG8_WAIT_L(n) asm volatile("s_waitcnt lgkmcnt(" #n ")" ::: "memory")
#define PG8_BAR __builtin_amdgcn_s_barrier()
#define PG8_SCHED __builtin_amdgcn_sched_barrier(0)
    Unit cur, nxt; int ui = 0;
    if (!S.next(0, cur)) return;
    f32x4 acc[2][2][4][2];
#pragma unroll
    for (int a = 0; a < 2; ++a)
#pragma unroll
        for (int b = 0; b < 2; ++b)
#pragma unroll
            for (int m = 0; m < 4; ++m)
#pragma unroll
                for (int n = 0; n < 2; ++n) acc[a][b][m][n] = (f32x4){0.f, 0.f, 0.f, 0.f};
    bf16x8 At[4][2], B0[2][2], B1[2][2];
    const char* cA = (const char*)g.A + (size_t)cur.pm * tstep; const char* cB = (const char*)g.Bt + (size_t)cur.pn * tstep;
    S.a_ready(cur);
    if constexpr (SP2) {
        PG8_STAGE(PG8_SB(0, 0), cB, voffB); PG8_STAGE(PG8_SB(0, 1), cB + hstep, voffB); PG8_STAGE(PG8_SA(0, 0), cA, voffA); PG8_STAGE(PG8_SA(0, 1), cA + hstep, voffA);
        if (wr == 1) PG8_BAR;
        PG8_WAIT_V(2); PG8_BAR;
        PG8_STAGE(PG8_SB(1, 0), cB + kstep, voffB); PG8_STAGE(PG8_SA(1, 0), cA + kstep, voffA); PG8_STAGE(PG8_SB(1, 1), cB + hstep + kstep, voffB);
        PG8_WAIT_V(6); PG8_BAR;
    } else {
        PG8_STAGE(PG8_SB(0, 0), cB, voffB); PG8_STAGE(PG8_SA(0, 0), cA, voffA); PG8_STAGE(PG8_SB(0, 1), cB + hstep, voffB); PG8_STAGE(PG8_SA(0, 1), cA + hstep, voffA);
        if (wr == 1) PG8_BAR;
        PG8_WAIT_V(4); PG8_BAR;
        PG8_STAGE(PG8_SB(1, 0), cB + kstep, voffB); PG8_STAGE(PG8_SA(1, 0), cA + kstep, voffA); PG8_STAGE(PG8_SB(1, 1), cB + hstep + kstep, voffB);
        PG8_WAIT_V(6); PG8_BAR;
    }
    for (;;) {
        const bool has_next = S.next(ui + 1, nxt);
        const char* nA = has_next ? (const char*)g.A + (size_t)nxt.pm * tstep : cA; const char* nB = has_next ? (const char*)g.Bt + (size_t)nxt.pn * tstep : cB;
        for (int t = 0; t < nt; t += 2) {
            const bool last = (t == nt - 2);
            const char* a1 = cA + (size_t)(t + 1) * kstep;
            const char* a2 = last ? nA : cA + (size_t)(t + 2) * kstep; const char* b2 = last ? nB : cB + (size_t)(t + 2) * kstep;
            const char* a3 = a2 + kstep; const char* b3 = b2 + kstep;
            if (last && has_next) S.a_ready(nxt);
            if constexpr (SP2) {
            PG8_LDB(B0, 0, 0); PG8_LDB(B1, 0, 1); PG8_SCHED; PG8_LDA(At, 0, 0); PG8_STAGE(PG8_SA(1, 1), a1 + hstep, voffA);
            PG8_WAIT_V(8); PG8_WAIT_L(0); PG8_BAR; PG8_MMA(0, 0, At, B0); PG8_MMA(0, 1, At, B1); PG8_BAR; PG8_SCHED;
            PG8_LDA(At, 0, 1); PG8_STAGE(PG8_SB(0, 0), b2, voffB); PG8_STAGE(PG8_SB(0, 1), b2 + hstep, voffB); PG8_STAGE(PG8_SA(0, 0), a2, voffA);
            PG8_WAIT_V(8); PG8_WAIT_L(0); PG8_BAR; PG8_MMA(1, 0, At, B0); PG8_MMA(1, 1, At, B1); PG8_BAR; PG8_SCHED;
            PG8_LDB(B0, 1, 0); PG8_LDB(B1, 1, 1); PG8_SCHED; PG8_LDA(At, 1, 0); PG8_STAGE(PG8_SA(0, 1), a2 + hstep, voffA);
            PG8_WAIT_V(8); PG8_WAIT_L(0); PG8_BAR; PG8_MMA(0, 0, At, B0); PG8_MMA(0, 1, At, B1); PG8_BAR; PG8_SCHED;
            PG8_LDA(At, 1, 1); PG8_STAGE(PG8_SB(1, 0), b3, voffB); PG8_STAGE(PG8_SB(1, 1), b3 + hstep, voffB); PG8_STAGE(PG8_SA(1, 0), a3, voffA);
            PG8_WAIT_V(8); PG8_WAIT_L(0); PG8_BAR; PG8_MMA(1, 0, At, B0); PG8_MMA(1, 1, At, B1); PG8_BAR; PG8_SCHED;
            } else {
            PG8_LDB(B0, 0, 0); PG8_SCHED; PG8_LDA(At, 0, 0); PG8_STAGE(PG8_SA(1, 1), a1 + hstep, voffA);
            PG8_WAIT_L(8); PG8_BAR; PG8_WAIT_L(0); PG8_MMA(0, 0, At, B0); PG8_BAR; PG8_SCHED;
            PG8_LDB(B1, 0, 1); PG8_STAGE(PG8_SB(0, 0), b2, voffB);
            PG8_BAR; PG8_WAIT_L(0); PG8_MMA(0, 1, At, B1); PG8_BAR;
            PG8_LDA(At, 0, 1); PG8_STAGE(PG8_SA(0, 0), a2, voffA);
            PG8_BAR; PG8_WAIT_L(0); PG8_MMA(1, 0, At, B0); PG8_BAR; PG8_SCHED;
            PG8_STAGE(PG8_SB(0, 1), b2 + hstep, voffB);
            PG8_WAIT_V(6); PG8_BAR; PG8_MMA(1, 1, At, B1); PG8_BAR;
            PG8_LDB(B0, 1, 0); PG8_SCHED; PG8_LDA(At, 1, 0); PG8_STAGE(PG8_SA(0, 1), a2 + hstep, voffA);
            PG8_WAIT_L(8); PG8_BAR; PG8_WAIT_L(0); PG8_MMA(0, 0, At, B0); PG8_BAR; PG8_SCHED;
            PG8_LDB(B1, 1, 1); PG8_STAGE(PG8_SB(1, 0), b3, voffB);
            PG8_BAR; PG8_WAIT_L(0); PG8_MMA(0, 1, At, B1); PG8_BAR;
            PG8_LDA(At, 1, 1); PG8_STAGE(PG8_SA(1, 0), a3, voffA);
            PG8_BAR; PG8_WAIT_L(0); PG8_MMA(1, 0, At, B0); PG8_BAR; PG8_SCHED;
            PG8_STAGE(PG8_SB(1, 1), b3 + hstep, voffB);
            PG8_WAIT_V(6); PG8_BAR; PG8_MMA(1, 1, At, B1); PG8_BAR;
            }
        }
        if constexpr (ALIGN_EPI) { if (wr == 0) PG8_BAR; }
        if constexpr (!Epi::AFTER_DRAIN) { E(acc, cur, wr, wc, fr, fq); S.done(cur); }
        if (!has_next) break;
#pragma unroll
        for (int a = 0; a < 2; ++a)
#pragma unroll
            for (int b = 0; b < 2; ++b)
#pragma unroll
                for (int m = 0; m < 4; ++m)
#pragma unroll
                    for (int n = 0; n < 2; ++n) acc[a][b][m][n] = (f32x4){0.f, 0.f, 0.f, 0.f};
        cur = nxt; cA = nA; cB = nB; ++ui;
        if constexpr (ALIGN_EPI) { if (wr == 1) PG8_BAR; }
    }
    PG8_WAIT_V(0);
    if constexpr (!ALIGN_EPI) { if (wr == 0) PG8_BAR; }
    PG8_BAR;
    if constexpr (Epi::AFTER_DRAIN) { E.fused(acc, cur, wr, wc, fr, fq, lds, wid, lane); S.done(cur); }
#undef PG8_SA
#undef PG8_SB
#undef PG8_STAGE
#undef PG8_LDA
#undef PG8_LDB
#undef PG8_MMA
#undef PG8_WAIT_V
#undef PG8_WAIT_L
#undef PG8_BAR
#undef PG8_SCHED
}
}

using pg8::bf16_t; using pg8::bf16x8; using pg8::f32x4;
#define LAS __attribute__((address_space(3)))
typedef short bf16x4 __attribute__((ext_vector_type(4)));
typedef unsigned u32x4 __attribute__((ext_vector_type(4)));
typedef unsigned u32x2 __attribute__((ext_vector_type(2)));

constexpr int NTHREADS = 512;
constexpr int T_ALL = 17408, NCTX = 1024, NLAT = 16384, DM = 1024, INC = 1792, FFD = 4096;
constexpr int LDS_BYTES = 147456;
constexpr float EPS = 1e-6f;

constexpr size_t MiB = 1u << 20;
constexpr size_t WS_MOD = 0;
constexpr size_t WS_CTAB = 256 * 1024;
constexpr size_t WS_STAB = 256 * 1024 + 8192;
constexpr size_t WS_PACK = 1 * MiB;
constexpr size_t WS_SLOC = 3 * MiB;
constexpr size_t WS_CARRY = 7 * MiB + 256 * 1024;
constexpr size_t WS_W = 12 * MiB;
constexpr size_t W_IN = 0, W_PW = W_IN + (size_t)INC * DM * 2, W_F = W_PW + 256 * 256 * 2, W_GLU = W_F + 256 * 256 * 2,
                 W_OUT = W_GLU + 512 * 256 * 2, W_1 = W_OUT + (size_t)DM * DM * 2, W_2 = W_1 + (size_t)FFD * DM * 2, W_LAYER = W_2 + (size_t)FFD * DM * 2;
static_assert(W_LAYER == 22 * MiB, "weights per layer");
constexpr size_t WS_XC = 56 * MiB;
constexpr size_t WS_XN = 60 * MiB;
constexpr size_t WS_BIG = 94 * MiB;
constexpr size_t WS_H = WS_BIG;
constexpr size_t WS_PX = WS_BIG;
constexpr size_t WS_VT = 154 * MiB;
constexpr size_t WS_VTC = 162 * MiB;
constexpr size_t WS_CV = 163 * MiB;
constexpr size_t WS_YB = 172 * MiB;
constexpr size_t WS_FN = 188 * MiB;
constexpr size_t WS_YS = 197 * MiB;
constexpr size_t WS_ZS = 206 * MiB;
constexpr size_t WS_MIX = 223 * MiB;
constexpr size_t WS_END = 256 * MiB;
static_assert(WS_H + (size_t)T_ALL * FFD * 2 <= WS_END && WS_MIX + (size_t)T_ALL * 768 * 2 <= WS_END && WS_PX + (size_t)T_ALL * INC * 2 <= WS_VT, "ws map");

__device__ __forceinline__ unsigned f2bf(float f) { unsigned u = __builtin_bit_cast(unsigned, f); return (u + 0x7fffu + ((u >> 16) & 1u)) >> 16; }
__device__ __forceinline__ unsigned pk2(float lo, float hi) { return f2bf(lo) | (f2bf(hi) << 16); }
__device__ __forceinline__ float bf2f(unsigned h) { return __builtin_bit_cast(float, (h & 0xffffu) << 16); }
__device__ __forceinline__ float bflo(unsigned w) { return __builtin_bit_cast(float, w << 16); }
__device__ __forceinline__ float bfhi(unsigned w) { return __builtin_bit_cast(float, w & 0xffff0000u); }
__device__ __forceinline__ bf16x8 pack8(f32x4 a, f32x4 b) {
    u32x4 w; w.x = pk2(a[0], a[1]); w.y = pk2(a[2], a[3]); w.z = pk2(b[0], b[1]); w.w = pk2(b[2], b[3]);
    return __builtin_bit_cast(bf16x8, w);
}
__device__ __forceinline__ bf16x8 neg8(bf16x8 v) { u32x4 w = __builtin_bit_cast(u32x4, v); w.x ^= 0x80008000u; w.y ^= 0x80008000u; w.z ^= 0x80008000u; w.w ^= 0x80008000u; return __builtin_bit_cast(bf16x8, w); }
__device__ __forceinline__ bf16x8 zero8() { u32x4 w = {0u, 0u, 0u, 0u}; return __builtin_bit_cast(bf16x8, w); }
__device__ __forceinline__ bf16x8 cat4(u32x2 a, u32x2 b) { u32x4 w; w.x = a.x; w.y = a.y; w.z = b.x; w.w = b.y; return __builtin_bit_cast(bf16x8, w); }
__device__ __forceinline__ f32x4 mfma16(bf16x8 a, bf16x8 b, f32x4 c) { return __builtin_amdgcn_mfma_f32_16x16x32_bf16(a, b, c, 0, 0, 0); }
__device__ __forceinline__ void settle4(f32x4& a, f32x4& b, f32x4& c, f32x4& d) { asm volatile("s_nop 15\n\ts_nop 15" : "+v"(a), "+v"(b), "+v"(c), "+v"(d)); }
__device__ __forceinline__ void settle4m(f32x4& a, f32x4& b, f32x4& c, f32x4& d) { asm volatile("s_nop 7\n\ts_nop 7" : "+v"(a), "+v"(b), "+v"(c), "+v"(d) :: "memory"); }
__device__ __forceinline__ f32x4 mfma16s(bf16x8 a, bf16x8 b, f32x4 c) { asm volatile("s_nop 7" : "+v"(a), "+v"(b)); return __builtin_amdgcn_mfma_f32_16x16x32_bf16(a, b, c, 0, 0, 0); }
__device__ __forceinline__ void settle2(f32x4& a, f32x4& b) { asm volatile("s_nop 15\n\ts_nop 15" : "+v"(a), "+v"(b)); }
__device__ __forceinline__ void settle_in(bf16x8& a, bf16x8& b) { asm volatile("s_nop 3" : "+v"(a), "+v"(b)); }
__device__ __forceinline__ float wave_sum(float v) {
    v += __shfl_xor(v, 1); v += __shfl_xor(v, 2); v += __shfl_xor(v, 4); v += __shfl_xor(v, 8); v += __shfl_xor(v, 16); v += __shfl_xor(v, 32); return v;
}
__device__ __forceinline__ float sigmoidf_(float x) { return 1.0f / (1.0f + __expf(-x)); }
struct cplx { float re, im; };
__device__ __forceinline__ cplx cmul(cplx a, cplx b) { return cplx{a.re * b.re - a.im * b.im, a.re * b.im + a.im * b.re}; }
__device__ __forceinline__ cplx cmad(cplx acc, cplx a, cplx b) { return cplx{acc.re + a.re * b.re - a.im * b.im, acc.im + a.re * b.im + a.im * b.re}; }

struct Args { const float* in[36]; float* out; unsigned char* ws; int ph_lo, ph_hi, part, pad; };
struct Frame {
    const Args& A;
    float* out; unsigned char* ws;
    int tid, lane, wave;
};
#define FP(off, type) ((type*)(F.ws + (off)))

constexpr int PK_N = 23;
constexpr int PK_IDX[PK_N] = {6,8,9,10,11,13,15,16,17,18,19,20,21,22,23,24,26,27,29,30,32,34,35};
constexpr int PK_CNT[PK_N] = {2048,15872,512,512,512,512,512,3720,4096,4096,64,65536,65536,65536,65536,512,1024,2048,2048,2048,8192,2048,1024};
constexpr int pk_off(int k) { int o = 0; for (int i = 0; i < PK_N; ++i) { if (PK_IDX[i] == k) return o; o += PK_CNT[i]; } return -1; }
#define PK(k) (FP(WS_PACK, float) + pk_off(k))
static_assert(pk_off(35) + 1024 <= (int)(2 * MiB / 4), "pack size");

struct EpiU {
    static constexpr bool PERM = false, AFTER_DRAIN = false;
    const Frame& F; int l; int kind; int row_lo;
    __device__ __forceinline__ void operator()(const f32x4 (&acc)[2][2][4][2], const pg8::Unit& u, int wr, int wc, int fr, int fq) const {
        const int c0 = u.pn * 256 + wc * 32 + fq * 4;
        const int r0 = u.pm * 256 + wr * 64 + fr;
        if (kind < 6) {
            bf16_t* base; size_t ldc; const float* bias = nullptr;
            if (kind == 0) { base = FP(WS_PX, bf16_t) + (size_t)r0 * INC + c0; ldc = INC; }
            else if (kind == 1) {
                if (u.pn < 4) { base = FP(WS_VTC, bf16_t) + (size_t)u.pn * 65536 + (size_t)r0 * 256 + (c0 - u.pn * 256); ldc = 256; }
                else { const int tt = u.pn - 4; base = FP(WS_VT, bf16_t) + (size_t)(tt >> 4) * 256 * 4096 + (tt & 15) * 256 + (size_t)r0 * 4096 + (c0 - u.pn * 256); ldc = 4096; }
            }
            else if (kind == 2) { base = FP(WS_MIX, bf16_t) + (size_t)(row_lo + r0) * 768 + c0; ldc = 768; bias = PK(13) + l * 256; }
            else if (kind == 3) { base = FP(WS_MIX, bf16_t) + (size_t)(row_lo + r0) * 768 + 256 + c0; ldc = 768; bias = PK(15) + l * 256; }
            else if (kind == 4) { base = FP(WS_ZS, bf16_t) + (size_t)(row_lo + r0) * 512 + c0; ldc = 512; bias = PK(26) + l * 512; }
            else { base = FP(WS_H, bf16_t) + (size_t)(row_lo + r0) * FFD + c0; ldc = FFD; bias = PK(32) + l * FFD; }
#pragma unroll
            for (int bj = 0; bj < 2; ++bj)
#pragma unroll
                for (int n = 0; n < 2; ++n) {
                    f32x4 bv = f32x4{0.f, 0.f, 0.f, 0.f};
                    if (bias) bv = *(const f32x4*)(bias + c0 + bj * 128 + n * 16);
#pragma unroll
                    for (int ai = 0; ai < 2; ++ai)
#pragma unroll
                        for (int m = 0; m < 4; ++m) {
                            f32x4 v = acc[ai][bj][m][n] + bv;
                            if (kind == 5) {
#pragma unroll
                                for (int j = 0; j < 4; ++j) { const float r = fmaxf(v[j], 0.f); v[j] = r * r; }
                            }
                            u32x2 w; w.x = pk2(v[0], v[1]); w.y = pk2(v[2], v[3]);
                            *(u32x2*)(base + (size_t)(ai * 128 + m * 16) * ldc + bj * 128 + n * 16) = w;
                        }
                }
        } else {
            const int gp = u.pm + (row_lo >> 8); const bool isc = gp < 4; const int lrow0 = isc ? gp * 256 : (gp - 4) * 256; const int br = isc ? 4 : ((gp - 4) >> 4);
            const float* sC; const float* sL; const float* bias; int gate_off;
            if (kind == 6) { sC = l == 0 ? F.A.in[2] : FP(WS_XC, float); sL = l == 0 ? F.A.in[0] : F.out; bias = PK(29) + l * DM; gate_off = 2048; }
            else { sC = FP(WS_XC, float); sL = F.out; bias = PK(34) + l * DM; gate_off = 5120; }
            const size_t roff = (size_t)(lrow0 + wr * 64 + fr) * DM + c0;
            const float* s = (isc ? sC : sL) + roff; float* d = (isc ? FP(WS_XC, float) : F.out) + roff;
            const float* gate = FP(WS_MOD, float) + (l * 5 + br) * 6144 + gate_off;
#pragma unroll
            for (int bj = 0; bj < 2; ++bj)
#pragma unroll
                for (int n = 0; n < 2; ++n) {
                    const int cc = c0 + bj * 128 + n * 16;
                    const f32x4 bv = *(const f32x4*)(bias + cc); const f32x4 gv = *(const f32x4*)(gate + cc);
#pragma unroll
                    for (int ai = 0; ai < 2; ++ai)
#pragma unroll
                        for (int m = 0; m < 4; ++m) {
                            const size_t o = (size_t)(ai * 128 + m * 16) * DM + bj * 128 + n * 16;
                            const f32x4 xv = *(const f32x4*)(s + o);
                            *(f32x4*)(d + o) = xv + gv * (acc[ai][bj][m][n] + bv);
                        }
                }
        }
    }
};

__device__ __forceinline__ void transpose_tile(const float* W, int K, int N, bf16_t* Wt, int tile, float* scr, int tid) {
    const int ntn = N >> 6; const int tk = tile / ntn, tn = tile - tk * ntn; const int k0 = tk * 64, n0 = tn * 64;
    { const int n = tid & 63, kk = tid >> 6;
#pragma unroll
      for (int i = 0; i < 8; ++i) { const int k = kk + 8 * i; scr[k * 65 + n] = W[(size_t)(k0 + k) * N + n0 + n]; } }
    __syncthreads();
    { const int kp = tid & 31, nn = tid >> 5;
#pragma unroll
      for (int i = 0; i < 4; ++i) { const int n = nn + 16 * i; const unsigned v = pk2(scr[(2 * kp) * 65 + n], scr[(2 * kp + 1) * 65 + n]); *(unsigned*)(Wt + (size_t)(n0 + n) * K + k0 + 2 * kp) = v; } }
    __syncthreads();
}
__device__ __forceinline__ void mod_unit(const Frame& F, int unit, float* scr) {
    const int l = unit / 96, cc = unit - l * 96; const int tid = F.tid;
    float* sl = scr; float* red = scr + 5 * 1024;
    for (int i = tid; i < 5 * 1024; i += NTHREADS) { const int r = i >> 10, k = i & 1023; const float c = r < 4 ? F.A.in[1][r * 1024 + k] : F.A.in[3][k]; sl[i] = c * sigmoidf_(c); }
    __syncthreads();
    const int col = tid & 63, kg = tid >> 6;
    const float* w = F.A.in[4] + (size_t)l * DM * 6144 + cc * 64 + col;
    float a0 = 0.f, a1 = 0.f, a2 = 0.f, a3 = 0.f, a4 = 0.f;
    for (int k = kg * 128; k < kg * 128 + 128; ++k) { const float wv = w[(size_t)k * 6144]; a0 += sl[k] * wv; a1 += sl[1024 + k] * wv; a2 += sl[2048 + k] * wv; a3 += sl[3072 + k] * wv; a4 += sl[4096 + k] * wv; }
    red[(kg * 5 + 0) * 64 + col] = a0; red[(kg * 5 + 1) * 64 + col] = a1; red[(kg * 5 + 2) * 64 + col] = a2; red[(kg * 5 + 3) * 64 + col] = a3; red[(kg * 5 + 4) * 64 + col] = a4;
    __syncthreads();
    if (tid < 320) { const int r = tid >> 6, c2 = tid & 63; float s = 0.f;
#pragma unroll
        for (int g = 0; g < 8; ++g) s += red[(g * 5 + r) * 64 + c2];
        FP(WS_MOD, float)[(l * 5 + r) * 6144 + cc * 64 + c2] = s + F.A.in[5][l * 6144 + cc * 64 + c2]; }
    __syncthreads();
}
__device__ __forceinline__ void p0_prologue(const Frame& F, float* scr) {
    const int NT_L = 448 + 16 + 16 + 32 + 256 + 1024 + 1024;
    const int njobs = 193 + 2 * NT_L + PK_N;
    for (int job = blockIdx.x; job < njobs; job += gridDim.x) {
        if (job >= 193 + 2 * NT_L) {
            const int e = job - (193 + 2 * NT_L); const float* src = nullptr; int cnt = 0, off = 0;
#define PKC(i) if (e == i) { src = F.A.in[PK_IDX[i]]; cnt = PK_CNT[i]; off = pk_off(PK_IDX[i]); }
            PKC(0) PKC(1) PKC(2) PKC(3) PKC(4) PKC(5) PKC(6) PKC(7) PKC(8) PKC(9) PKC(10) PKC(11) PKC(12) PKC(13) PKC(14) PKC(15) PKC(16) PKC(17) PKC(18) PKC(19) PKC(20) PKC(21) PKC(22)
#undef PKC
            float* dst = FP(WS_PACK, float) + off;
            for (int i = F.tid; i < cnt; i += NTHREADS) dst[i] = src[i];
        }
        else if (job < 192) { mod_unit(F, job, scr); }
        else if (job == 192) {
            for (int i = F.tid; i < 4096; i += NTHREADS) { const int m = i >> 6, j = i & 63; const float x = (float)((m * j) & 63) * (1.0f / 32.0f);
                FP(WS_CTAB, bf16_t)[i] = (bf16_t)f2bf(cospif(x)); FP(WS_STAB, bf16_t)[i] = (bf16_t)f2bf(sinpif(x)); }
        } else {
            int t = job - 193; const int l = t / NT_L; t -= l * NT_L;
            unsigned char* wl = F.ws + WS_W + (size_t)l * W_LAYER;
            if (t < 448) transpose_tile(F.A.in[7] + (size_t)l * DM * INC, DM, INC, (bf16_t*)(wl + W_IN), t, scr, F.tid);
            else if ((t -= 448) < 16) transpose_tile(F.A.in[12] + (size_t)l * 65536, 256, 256, (bf16_t*)(wl + W_PW), t, scr, F.tid);
            else if ((t -= 16) < 16) transpose_tile(F.A.in[14] + (size_t)l * 65536, 256, 256, (bf16_t*)(wl + W_F), t, scr, F.tid);
            else if ((t -= 16) < 32) transpose_tile(F.A.in[25] + (size_t)l * 131072, 256, 512, (bf16_t*)(wl + W_GLU), t, scr, F.tid);
            else if ((t -= 32) < 256) transpose_tile(F.A.in[28] + (size_t)l * DM * DM, DM, DM, (bf16_t*)(wl + W_OUT), t, scr, F.tid);
            else if ((t -= 256) < 1024) transpose_tile(F.A.in[31] + (size_t)l * DM * FFD, DM, FFD, (bf16_t*)(wl + W_1), t, scr, F.tid);
            else { t -= 1024; transpose_tile(F.A.in[33] + (size_t)l * DM * FFD, FFD, DM, (bf16_t*)(wl + W_2), t, scr, F.tid); }
        }
    }
}

__device__ __forceinline__ void prep_norm_mod(const Frame& F, const float* srcC, const float* srcL, const float* g, const float* modl, int sh_off, int sc_off, bf16_t* XN, int row_lo) {
    const int gw = blockIdx.x * 8 + F.wave, nw = gridDim.x * 8, lane = F.lane;
    for (int row = row_lo + gw; row < T_ALL; row += nw) {
        const bool isc = row < NCTX; const float* x = isc ? srcC + (size_t)row * DM : srcL + (size_t)(row - NCTX) * DM; const int br = isc ? 4 : ((row - NCTX) >> 12);
        const float* sh = modl + br * 6144 + sh_off; const float* sc = modl + br * 6144 + sc_off;
        f32x4 v[4]; float ss = 0.f;
#pragma unroll
        for (int i = 0; i < 4; ++i) { v[i] = *(const f32x4*)(x + i * 256 + lane * 4); ss += v[i][0] * v[i][0] + v[i][1] * v[i][1] + v[i][2] * v[i][2] + v[i][3] * v[i][3]; }
        ss = wave_sum(ss); const float r = rsqrtf(ss * (1.0f / 1024.0f) + EPS);
#pragma unroll
        for (int i = 0; i < 4; ++i) { const int c = i * 256 + lane * 4; const f32x4 gv = *(const f32x4*)(g + c), shv = *(const f32x4*)(sh + c), scv = *(const f32x4*)(sc + c);
            f32x4 y = v[i] * r * gv; y = y * (scv + 1.0f) + shv; u32x2 w; w.x = pk2(y[0], y[1]); w.y = pk2(y[2], y[3]); *(u32x2*)(XN + (size_t)row * DM + c) = w; }
    }
}
__device__ __forceinline__ f32x4 ld_bf4(const bf16_t* p) { const u32x2 w = *(const u32x2*)p; return f32x4{bflo(w.x), bfhi(w.x), bflo(w.y), bfhi(w.y)}; }
__device__ __forceinline__ void prep_group(const Frame& F, int l, int row_lo) {
    const int gw = blockIdx.x * 8 + F.wave, nw = gridDim.x * 8, lane = F.lane;
    const bf16_t* MIX = FP(WS_MIX, bf16_t); const bf16_t* ZS = FP(WS_ZS, bf16_t); bf16_t* O = FP(WS_XN, bf16_t); const float* gg = PK(27) + l * DM;
    for (int row = row_lo + gw; row < T_ALL; row += nw) {
#pragma unroll
        for (int grp = 0; grp < 4; ++grp) {
            f32x4 v;
            if (grp < 3) v = ld_bf4(MIX + (size_t)row * 768 + grp * 256 + lane * 4);
            else { const f32x4 a = ld_bf4(ZS + (size_t)row * 512 + lane * 4), gt = ld_bf4(ZS + (size_t)row * 512 + 256 + lane * 4);
#pragma unroll
                for (int j = 0; j < 4; ++j) v[j] = a[j] * sigmoidf_(gt[j]); }
            float ss = v[0] * v[0] + v[1] * v[1] + v[2] * v[2] + v[3] * v[3]; ss = wave_sum(ss);
            const float r = rsqrtf(ss * (1.0f / 256.0f) + EPS); const f32x4 gv = *(const f32x4*)(gg + grp * 256 + lane * 4); const f32x4 y = v * r * gv;
            u32x2 w; w.x = pk2(y[0], y[1]); w.y = pk2(y[2], y[3]); *(u32x2*)(O + (size_t)row * DM + grp * 256 + lane * 4) = w;
        }
    }
}
__device__ __forceinline__ void final_norm(const Frame& F) {
    const int gw = blockIdx.x * 8 + F.wave, nw = gridDim.x * 8, lane = F.lane; const float* g = PK(35);
    for (int row = gw; row < NLAT; row += nw) {
        float* x = F.out + (size_t)row * DM; f32x4 v[4]; float ss = 0.f;
#pragma unroll
        for (int i = 0; i < 4; ++i) { v[i] = *(const f32x4*)(x + i * 256 + lane * 4); ss += v[i][0] * v[i][0] + v[i][1] * v[i][1] + v[i][2] * v[i][2] + v[i][3] * v[i][3]; }
        ss = wave_sum(ss); const float r = rsqrtf(ss * (1.0f / 1024.0f) + EPS);
#pragma unroll
        for (int i = 0; i < 4; ++i) { const int c = i * 256 + lane * 4; *(f32x4*)(x + c) = v[i] * r * *(const f32x4*)(g + c); }
    }
}

__device__ __forceinline__ void conv_unit(const Frame& F, int l, int unit, float* scr) {
    const bf16_t* PX = FP(WS_PX, bf16_t); bf16_t* CV = FP(WS_CV, bf16_t);
    int prow0, Lseq, t0;
    if (unit < 512) { const int b = unit >> 7; t0 = (unit & 127) * 32; prow0 = NCTX + b * 4096; Lseq = 4096; }
    else { const int uu = unit - 512; const int b = uu >> 3; t0 = (uu & 7) * 32; prow0 = b * 256; Lseq = 256; }
    float* vt = scr; float* ot = scr + 62 * 256; int tid = F.tid; asm volatile("" : "+v"(tid));
    for (int idx = tid; idx < 62 * 256; idx += NTHREADS) { const int rr = idx >> 8, c = idx & 255; const int t = t0 - 15 + rr; float v = 0.f;
        if (t >= 0 && t < Lseq) { const bf16_t* p = PX + (size_t)(prow0 + t) * INC; const float a = bf2f(p[c]), gt = bf2f(p[256 + c]); v = a * sigmoidf_(gt); }
        vt[idx] = v; }
    __syncthreads();
    { const int c = tid & 255, half = tid >> 8; float w[31];
#pragma unroll
      for (int j = 0; j < 31; ++j) w[j] = PK(8)[(l * 31 + j) * 256 + c];
      const float bd = PK(9)[l * 256 + c];
      for (int tt = 0; tt < 16; ++tt) { const int t = half * 16 + tt; float s = bd;
#pragma unroll
          for (int j = 0; j < 31; ++j) s += w[j] * vt[(t + j) * 256 + c];
          ot[t * 256 + c] = s; } }
    __syncthreads();
    { const int lane = tid & 63; const f32x4 lg = *(const f32x4*)(PK(10) + l * 256 + lane * 4), lb = *(const f32x4*)(PK(11) + l * 256 + lane * 4);
      for (int i = 0; i < 4; ++i) { const int t = F.wave * 4 + i; const f32x4 x = *(const f32x4*)(ot + t * 256 + lane * 4);
          const float mu = wave_sum(x[0] + x[1] + x[2] + x[3]) * (1.0f / 256.0f); const f32x4 d = x - mu;
          const float var = wave_sum(d[0] * d[0] + d[1] * d[1] + d[2] * d[2] + d[3] * d[3]) * (1.0f / 256.0f); const float r = rsqrtf(var + EPS);
          f32x4 y = d * r * lg + lb;
#pragma unroll
          for (int j = 0; j < 4; ++j) y[j] = y[j] * sigmoidf_(y[j]);
          u32x2 w; w.x = pk2(y[0], y[1]); w.y = pk2(y[2], y[3]); *(u32x2*)(CV + (size_t)(prow0 + t0 + t) * 256 + lane * 4) = w; } }
    __syncthreads();
}

__device__ __forceinline__ void fnetctx_unit(const Frame& F, int unit, float* scr) {
    const bf16_t* PX = FP(WS_PX, bf16_t); bf16_t* FN = FP(WS_FN, bf16_t);
    const int mh = unit & 1, h = (unit >> 1) & 3, b = unit >> 3; int tid = F.tid; asm volatile("" : "+v"(tid));
    float* zc = scr; float* zs = scr + 8192; float* c64 = scr + 16384; float* s64 = c64 + 64; float* c256 = s64 + 64; float* s256 = c256 + 256;
    if (tid < 64) { const float x = (float)tid * (1.0f / 32.0f); c64[tid] = cospif(x); s64[tid] = sinpif(x); }
    if (tid < 256) { const float x = (float)tid * (1.0f / 128.0f); c256[tid] = cospif(x); s256[tid] = sinpif(x); }
    __syncthreads();
    for (int idx = tid; idx < 8192; idx += NTHREADS) { const int n = idx >> 5, mm = idx & 31, m = mh * 32 + mm; const bf16_t* up = PX + (size_t)(b * 256 + n) * INC + 512 + h * 64;
        float ac = 0.f, as = 0.f;
        for (int j = 0; j < 64; ++j) { const float uv = bf2f(up[j]); const int a = (j * m) & 63; ac += uv * c64[a]; as += uv * s64[a]; }
        zc[idx] = ac; zs[idx] = as; }
    __syncthreads();
    for (int idx = tid; idx < 8192; idx += NTHREADS) { const int k = idx >> 5, mm = idx & 31; float acc = 0.f;
        for (int n = 0; n < 256; ++n) { const int a = (k * n) & 255; acc += c256[a] * zc[n * 32 + mm] - s256[a] * zs[n * 32 + mm]; }
        FN[(size_t)(b * 256 + k) * 256 + h * 64 + mh * 32 + mm] = (bf16_t)f2bf(acc * (1.0f / 128.0f)); }
    __syncthreads();
}
__device__ __forceinline__ void fnetA_unit(const Frame& F, int unit, unsigned char* lds) {
    const bf16_t* PX = FP(WS_PX, bf16_t); const bf16_t* Ct = FP(WS_CTAB, bf16_t); const bf16_t* St = FP(WS_STAB, bf16_t); bf16_t* YB = FP(WS_YB, bf16_t);
    const int oct = unit & 7, h = (unit >> 3) & 3, b = unit >> 5; int tid = F.tid; asm volatile("" : "+v"(tid)); const int lane = tid & 63, fr = lane & 15, fq = lane >> 4; const int n2 = oct * 8 + F.wave;
    bf16x8 ua[4][2];
#pragma unroll
    for (int mi = 0; mi < 4; ++mi)
#pragma unroll
        for (int kk = 0; kk < 2; ++kk) ua[mi][kk] = *(const bf16x8*)(PX + (size_t)(NCTX + b * 4096 + 64 * (16 * mi + fr) + n2) * INC + 512 + h * 64 + kk * 32 + fq * 8);
    bf16x8 zre[2][4], zs[2][4];
#pragma unroll
    for (int ni = 0; ni < 4; ++ni) {
        bf16x8 bc[2], bs[2];
#pragma unroll
        for (int kk = 0; kk < 2; ++kk) { bc[kk] = *(const bf16x8*)(Ct + (16 * ni + fr) * 64 + kk * 32 + fq * 8); bs[kk] = *(const bf16x8*)(St + (16 * ni + fr) * 64 + kk * 32 + fq * 8); }
#pragma unroll
        for (int pr = 0; pr < 2; ++pr) {
            f32x4 c0 = {0.f, 0.f, 0.f, 0.f}, c1 = c0, s0 = c0, s1 = c0;
#pragma unroll
            for (int kk = 0; kk < 2; ++kk) { c0 = mfma16(ua[2 * pr][kk], bc[kk], c0); c1 = mfma16(ua[2 * pr + 1][kk], bc[kk], c1); s0 = mfma16(ua[2 * pr][kk], bs[kk], s0); s1 = mfma16(ua[2 * pr + 1][kk], bs[kk], s1); }
            zre[pr][ni] = pack8(c0, c1); zs[pr][ni] = pack8(s0, s1);
        }
    }
    bf16_t* T = (bf16_t*)lds;
    for (int mi2 = 0; mi2 < 4; ++mi2) {
        bf16x8 cf[2], sf[2], sfn[2];
#pragma unroll
        for (int pr = 0; pr < 2; ++pr) {
            const bf16_t* cp = Ct + (16 * mi2 + fr) * 64 + 32 * pr + 4 * fq; const bf16_t* sp = St + (16 * mi2 + fr) * 64 + 32 * pr + 4 * fq;
            cf[pr] = cat4(*(const u32x2*)cp, *(const u32x2*)(cp + 16)); sf[pr] = cat4(*(const u32x2*)sp, *(const u32x2*)(sp + 16)); sfn[pr] = neg8(sf[pr]);
        }
        float cs[4], sn[4];
#pragma unroll
        for (int j = 0; j < 4; ++j) { const int k1 = 16 * mi2 + 4 * fq + j; const float x = (float)(n2 * k1) * (1.0f / 2048.0f); cs[j] = cospif(x); sn[j] = sinpif(x); }
#pragma unroll
        for (int ni = 0; ni < 4; ++ni) {
            f32x4 yre = {0.f, 0.f, 0.f, 0.f}, yin = yre;
#pragma unroll
            for (int pr = 0; pr < 2; ++pr) { yre = mfma16s(cf[pr], zre[pr][ni], yre); yre = mfma16s(sfn[pr], zs[pr][ni], yre); yin = mfma16s(cf[pr], zs[pr][ni], yin); yin = mfma16s(sf[pr], zre[pr][ni], yin); }
#pragma unroll
            for (int j = 0; j < 4; ++j) { const int k1 = 16 * mi2 + 4 * fq + j; const int m = 16 * ni + fr;
                const float y1 = yre[j] * cs[j] - yin[j] * sn[j], y2 = yin[j] * cs[j] + yre[j] * sn[j];
                T[((0 * 64 + k1) * 64 + m) * 8 + F.wave] = (bf16_t)f2bf(y1); T[((1 * 64 + k1) * 64 + m) * 8 + F.wave] = (bf16_t)f2bf(y2); }
        }
    }
    __syncthreads();
    for (int it = 0; it < 16; ++it) { const int cidx = it * NTHREADS + tid; const int m = cidx & 63, k1 = (cidx >> 6) & 63, plane = cidx >> 12;
        const u32x4 v = *(const u32x4*)(lds + (size_t)cidx * 16);
        *(u32x4*)(YB + ((((size_t)(b * 4 + h) * 64 + k1) * 2 + plane) * 64 + m) * 64 + oct * 8) = v; }
    __syncthreads();
}
__device__ __forceinline__ void fnetB_item(const Frame& F, int item) {
    const bf16_t* Ct = FP(WS_CTAB, bf16_t); const bf16_t* St = FP(WS_STAB, bf16_t); const bf16_t* YB = FP(WS_YB, bf16_t); bf16_t* FN = FP(WS_FN, bf16_t);
    const int k1 = item & 63, h = (item >> 6) & 3, b = item >> 8; int lane = F.lane; asm volatile("" : "+v"(lane)); const int fr = lane & 15, fq = lane >> 4;
    const bf16_t* base = YB + (((size_t)(b * 4 + h) * 64 + k1) * 2) * 4096;
    f32x4 acc[4][4];
#pragma unroll
    for (int mi = 0; mi < 4; ++mi)
#pragma unroll
        for (int ni = 0; ni < 4; ++ni) acc[mi][ni] = f32x4{0.f, 0.f, 0.f, 0.f};
#pragma unroll
    for (int kk = 0; kk < 2; ++kk) {
        bf16x8 bc[4], bsn[4];
#pragma unroll
        for (int ni = 0; ni < 4; ++ni) { bc[ni] = *(const bf16x8*)(Ct + (16 * ni + fr) * 64 + kk * 32 + fq * 8); bsn[ni] = neg8(*(const bf16x8*)(St + (16 * ni + fr) * 64 + kk * 32 + fq * 8)); }
#pragma unroll
        for (int mi = 0; mi < 4; ++mi) {
            const bf16x8 are = *(const bf16x8*)(base + (16 * mi + fr) * 64 + kk * 32 + fq * 8), aim = *(const bf16x8*)(base + 4096 + (16 * mi + fr) * 64 + kk * 32 + fq * 8);
#pragma unroll
            for (int ni = 0; ni < 4; ++ni) { acc[mi][ni] = mfma16(are, bc[ni], acc[mi][ni]); acc[mi][ni] = mfma16s(aim, bsn[ni], acc[mi][ni]); }
        }
    }
#pragma unroll
    for (int mi = 0; mi < 4; ++mi)
#pragma unroll
        for (int ni = 0; ni < 4; ++ni) { const int k = k1 + 64 * (16 * ni + fr); const f32x4 v = acc[mi][ni] * (1.0f / 512.0f);
            u32x2 w; w.x = pk2(v[0], v[1]); w.y = pk2(v[2], v[3]); *(u32x2*)(FN + (size_t)(NCTX + b * 4096 + k) * 256 + h * 64 + 16 * mi + 4 * fq) = w; }
}

template <bool LOCAL>
__device__ __forceinline__ void attn_item(const Frame& F, int l, int item) {
    const bf16_t* PX = FP(WS_PX, bf16_t); const bf16_t* VT = FP(WS_VT, bf16_t); const bf16_t* VTc = FP(WS_VTC, bf16_t); bf16_t* MIX = FP(WS_MIX, bf16_t);
    const float* rpb = PK(16) + l * (4 * 15 * 31);
    int lane = F.lane; asm volatile("" : "+v"(lane)); const int fr = lane & 15, fq = lane >> 4;
    int b, h, r = 0, jb = 0, qrow0;
    if (LOCAL) { h = item & 3; jb = (item >> 2) & 3; r = (item >> 4) & 63; b = item >> 10; qrow0 = NCTX + b * 4096 + r * 64 + jb * 16; }
    else { h = item & 3; const int qb = (item >> 2) & 15; b = item >> 6; qrow0 = b * 256 + qb * 16; }
    constexpr int NT = LOCAL ? 32 : 16;
    const int rs = LOCAL ? min(max(r - 4, 0), 56) : 0; const int kcs = LOCAL ? min(max(16 * jb - 8, 0), 32) : 0;
    bf16x8 qf[2];
#pragma unroll
    for (int kk = 0; kk < 2; ++kk) qf[kk] = *(const bf16x8*)(PX + (size_t)(qrow0 + fr) * INC + 768 + h * 64 + kk * 32 + fq * 8);
    f32x4 s[NT];
#pragma unroll
    for (int t = 0; t < NT; ++t) {
        int krow;
        if (LOCAL && t < 16) krow = NCTX + b * 4096 + (rs + (t >> 1)) * 64 + kcs + (t & 1) * 16 + fr;
        else krow = b * 256 + (t - (LOCAL ? 16 : 0)) * 16 + fr;
        const bf16_t* kp = PX + (size_t)krow * INC + 1024 + h * 64 + fq * 8;
        const bf16x8 k0 = *(const bf16x8*)kp, k1 = *(const bf16x8*)(kp + 32);
        f32x4 a = {0.f, 0.f, 0.f, 0.f}; a = mfma16(k0, qf[0], a); a = mfma16(k1, qf[1], a); s[t] = a;
    }
    float mx = -3.0e38f;
    const int qcol = 16 * jb + fr; const int cstart = min(max(qcol - 8, 0), 48);
#pragma unroll
    for (int t = 0; t < NT; ++t)
#pragma unroll
        for (int j = 0; j < 4; ++j) {
            float v = s[t][j] * 0.125f;
            if (LOCAL && t < 16) { const int kcol = kcs + (t & 1) * 16 + 4 * fq + j; const bool valid = (kcol >= cstart) && (kcol < cstart + 16);
                const int dr = rs + (t >> 1) - r + 7; const int dc = min(max(kcol - qcol + 15, 0), 30);
                v = valid ? v + rpb[(h * 15 + dr) * 31 + dc] : -1.0e30f; }
            s[t][j] = v; mx = fmaxf(mx, v);
        }
    mx = fmaxf(mx, __shfl_xor(mx, 16)); mx = fmaxf(mx, __shfl_xor(mx, 32));
    float sum = 0.f;
#pragma unroll
    for (int t = 0; t < NT; ++t)
#pragma unroll
        for (int j = 0; j < 4; ++j) { const float p = __expf(s[t][j] - mx); s[t][j] = p; sum += p; }
    sum += __shfl_xor(sum, 16); sum += __shfl_xor(sum, 32);
    f32x4 o[4];
#pragma unroll
    for (int di = 0; di < 4; ++di) o[di] = f32x4{0.f, 0.f, 0.f, 0.f};
#pragma unroll
    for (int u = 0; u < NT / 2; ++u) {
        const bf16x8 pb = pack8(s[2 * u], s[2 * u + 1]);
        const bf16_t* vbase; size_t stride;
        if (LOCAL && u < 8) { vbase = VT + (size_t)(b * 256 + h * 64) * 4096 + (rs + u) * 64 + kcs + 4 * fq; stride = 4096; }
        else { const int uu = u - (LOCAL ? 8 : 0); vbase = VTc + (size_t)(b * 256 + h * 64) * 256 + uu * 32 + 4 * fq; stride = 256; }
#pragma unroll
        for (int di = 0; di < 4; ++di) { const bf16_t* vp = vbase + (size_t)(16 * di + fr) * stride; const bf16x8 va = cat4(*(const u32x2*)vp, *(const u32x2*)(vp + 16)); o[di] = mfma16s(va, pb, o[di]); }
    }
    const float inv = 1.0f / sum;
#pragma unroll
    for (int di = 0; di < 4; ++di) { const f32x4 v = o[di] * inv; u32x2 w; w.x = pk2(v[0], v[1]); w.y = pk2(v[2], v[3]);
        *(u32x2*)(MIX + (size_t)(qrow0 + fr) * 768 + 512 + h * 64 + 16 * di + 4 * fq) = w; }
}

__device__ __forceinline__ cplx csel(bool c, cplx a, cplx b) { return cplx{c ? a.re : b.re, c ? a.im : b.im}; }
#define WAITALL() asm volatile("s_waitcnt vmcnt(0) lgkmcnt(0)" ::: "memory")
__device__ __forceinline__ cplx pow_sel(int k, cplx a, cplx a2, cplx a4, cplx a8, cplx a16) {
    cplx r = cplx{1.f, 0.f};
    r = csel((k & 1) != 0, cmul(r, a), r); r = csel((k & 2) != 0, cmul(r, a2), r); r = csel((k & 4) != 0, cmul(r, a4), r); r = csel((k & 8) != 0, cmul(r, a8), r); r = csel((k & 16) != 0, cmul(r, a16), r);
    return r;
}
__device__ __forceinline__ void ssm_consts(float lre, float lim, float dt, cplx& a, cplx& f) {
    const float e = __expf(lre * dt);
    float revs = lim * dt * 0.15915494309189535f; revs -= rintf(revs);
    a = cplx{e * __builtin_amdgcn_cosf(revs), e * __builtin_amdgcn_sinf(revs)};
    const float xr = a.re - 1.0f, xi = a.im, den = __builtin_amdgcn_rcpf(lre * lre + lim * lim);
    f = cplx{(xr * lre + xi * lim) * den, (xi * lre - xr * lim) * den};
}
template <int PASS, int DIR>
__device__ __forceinline__ void ssm_dir(const Frame& F, int lane, int l, int b, int g, int tb, const bf16x8 (&ub)[4], f32x4 (&accy)[4]) {
    const int fr = lane & 15, fq = lane >> 4;
    const int c = DIR == 0 ? tb : (tb < 4 ? 3 - tb : 71 - tb);
    const int pg = (l * 2 + DIR) * 16 + g;
    const float dt = __expf(PK(19)[pg]);
    cplx* Sloc = FP(WS_SLOC, cplx); const cplx* Carry = FP(WS_CARRY, cplx);
    const size_t sbase = ((size_t)((b * 2 + DIR) * 16 + g) * 68 + c) * 64;
    for (int q = 0; q < 4; ++q) {
        bf16x8 are, aim;
        { const int kq = (fq & 1) * 8; const float* pr = PK(20) + ((size_t)pg * 64 + 16 * q + fr) * 16 + kq; const float* pi = PK(21) + ((size_t)pg * 64 + 16 * q + fr) * 16 + kq;
          const f32x4 zz = f32x4{0.f, 0.f, 0.f, 0.f}; const bool on = fq < 2;
          const f32x4 r0 = *(const f32x4*)pr, r1 = *(const f32x4*)(pr + 4), i0 = *(const f32x4*)pi, i1 = *(const f32x4*)(pi + 4);

          are = pack8(on ? r0 : zz, on ? r1 : zz); aim = pack8(on ? i0 : zz, on ? i1 : zz); }
        f32x4 bre[4], bim[4];
        asm volatile("s_nop 7" : "+v"(are), "+v"(aim));
#pragma unroll
        for (int ni = 0; ni < 4; ++ni) { bre[ni] = mfma16(are, ub[ni], f32x4{0.f, 0.f, 0.f, 0.f}); bim[ni] = mfma16(aim, ub[ni], f32x4{0.f, 0.f, 0.f, 0.f}); }
        settle4m(bre[0], bre[1], bre[2], bre[3]); settle4m(bim[0], bim[1], bim[2], bim[3]);
#pragma unroll
        for (int j = 0; j < 4; ++j) {
            const int p = 16 * q + 4 * fq + j;
            const float lre = PK(17)[pg * 64 + p], lim = PK(18)[pg * 64 + p];

            cplx a, f; ssm_consts(lre, lim, dt, a, f);
            const cplx a2 = cmul(a, a), a4 = cmul(a2, a2), a8 = cmul(a4, a4), a16 = cmul(a8, a8);
            if (PASS == 1) {
                cplx Tt;
                if (DIR == 0) { Tt = cplx{bre[0][j], bim[0][j]}; Tt = cmad(cplx{bre[1][j], bim[1][j]}, Tt, a16); Tt = cmad(cplx{bre[2][j], bim[2][j]}, Tt, a16); Tt = cmad(cplx{bre[3][j], bim[3][j]}, Tt, a16); }
                else { Tt = cplx{bre[3][j], bim[3][j]}; Tt = cmad(cplx{bre[2][j], bim[2][j]}, Tt, a16); Tt = cmad(cplx{bre[1][j], bim[1][j]}, Tt, a16); Tt = cmad(cplx{bre[0][j], bim[0][j]}, Tt, a16); }
                const cplx w = pow_sel(DIR == 0 ? 15 - fr : fr, a, a2, a4, a8, a16);
                Tt = cmul(Tt, w);
                Tt.re += __shfl_xor(Tt.re, 1); Tt.im += __shfl_xor(Tt.im, 1); Tt.re += __shfl_xor(Tt.re, 2); Tt.im += __shfl_xor(Tt.im, 2);
                Tt.re += __shfl_xor(Tt.re, 4); Tt.im += __shfl_xor(Tt.im, 4); Tt.re += __shfl_xor(Tt.re, 8); Tt.im += __shfl_xor(Tt.im, 8);
                Tt = cmul(Tt, f);
                if (fr == 0) Sloc[sbase + p] = Tt;
            } else {
                const cplx w = pow_sel(DIR == 0 ? fr + 1 : 16 - fr, a, a2, a4, a8, a16);
                cplx x[4];
#pragma unroll
                for (int ni = 0; ni < 4; ++ni) {
                    cplx v = cmul(f, cplx{bre[ni][j], bim[ni][j]});
#define RLF(x, ln) __builtin_bit_cast(float, __builtin_amdgcn_readlane(__builtin_bit_cast(int, (x)), (ln)))
#define DPPF(x, ctrl) __builtin_bit_cast(float, __builtin_amdgcn_update_dpp(0, __builtin_bit_cast(int, (x)), (ctrl), 0xf, 0xf, true))
#define KS_STEP(d, ad) { cplx y; if (DIR == 0) { y.re = DPPF(v.re, 0x110 + d); y.im = DPPF(v.im, 0x110 + d); v = csel(fr >= d, cmad(v, ad, y), v); } \
                                   else { y.re = DPPF(v.re, 0x100 + d); y.im = DPPF(v.im, 0x100 + d); v = csel(fr + d <= 15, cmad(v, ad, y), v); } }
                    KS_STEP(1, a) KS_STEP(2, a2) KS_STEP(4, a4) KS_STEP(8, a8)
#undef KS_STEP
                    x[ni] = v;
                }
                cplx E = Carry[sbase + p];
#pragma unroll
                for (int bi = 0; bi < 4; ++bi) {
                    const int ni = DIR == 0 ? bi : 3 - bi;
                    const cplx hh = cmad(x[ni], w, E);
                    cplx tot;
                    { constexpr int L0 = DIR == 0 ? 15 : 0;
                      const float r0 = RLF(x[ni].re, L0), r1 = RLF(x[ni].re, L0 + 16), r2 = RLF(x[ni].re, L0 + 32), r3 = RLF(x[ni].re, L0 + 48);
                      const float i0 = RLF(x[ni].im, L0), i1 = RLF(x[ni].im, L0 + 16), i2 = RLF(x[ni].im, L0 + 32), i3 = RLF(x[ni].im, L0 + 48);
                      tot.re = fq == 0 ? r0 : fq == 1 ? r1 : fq == 2 ? r2 : r3; tot.im = fq == 0 ? i0 : fq == 1 ? i1 : fq == 2 ? i2 : i3; }
                    E = cmad(tot, a16, E);
                    bre[ni][j] = hh.re; bim[ni][j] = hh.im;
                }
            }
        }
        if (PASS == 3) {
            const float* cr = PK(22) + ((size_t)pg * 16 + fr) * 64 + 16 * q + 4 * fq; const float* ci = PK(23) + ((size_t)pg * 16 + fr) * 64 + 16 * q + 4 * fq;
            const f32x4 cre = *(const f32x4*)cr; const f32x4 cim = *(const f32x4*)ci;
            const bf16x8 ca = pack8(cre, f32x4{-cim[0], -cim[1], -cim[2], -cim[3]});
#pragma unroll
            for (int ni = 0; ni < 4; ++ni) { bf16x8 hb = pack8(bre[ni], bim[ni]); bf16x8 ca2 = ca; asm volatile("s_nop 7" : "+v"(ca2), "+v"(hb)); accy[ni] = mfma16(ca2, hb, accy[ni]); }
            settle4m(accy[0], accy[1], accy[2], accy[3]);
        }
    }
}
template <int PASS>
__device__ __forceinline__ void ssm_item(const Frame& F, int l_u, int item_u) {
    int l = l_u, item = item_u; asm volatile("" : "+v"(l), "+v"(item));
    const bf16_t* PX = FP(WS_PX, bf16_t);
    int lane = F.lane; asm volatile("" : "+v"(lane)); const int fr = lane & 15, fq = lane >> 4;
    const int tb = item % 68; const int g = (item / 68) & 15; const int b = item / (68 * 16);
    const int prow0 = tb < 4 ? b * 256 + tb * 64 : NCTX + b * 4096 + (tb - 4) * 64;
    bf16x8 ub[4];
#pragma unroll
    for (int ni = 0; ni < 4; ++ni) { const bf16x8 ld = *(const bf16x8*)(PX + (size_t)(prow0 + 16 * ni + fr) * INC + 1536 + g * 16 + (fq & 1) * 8); ub[ni] = fq < 2 ? ld : zero8(); }
    f32x4 accy[4];
#pragma unroll
    for (int ni = 0; ni < 4; ++ni) accy[ni] = f32x4{0.f, 0.f, 0.f, 0.f};

    ssm_dir<PASS, 0>(F, lane, l, b, g, tb, ub, accy);
    ssm_dir<PASS, 1>(F, lane, l, b, g, tb, ub, accy);
    if (PASS == 3) {
        bf16_t* YS = FP(WS_YS, bf16_t); const f32x4 dv = *(const f32x4*)(PK(24) + l * 256 + g * 16 + 4 * fq);
#pragma unroll
        for (int ni = 0; ni < 4; ++ni) { const int row = prow0 + 16 * ni + fr; const f32x4 uv = ld_bf4(PX + (size_t)row * INC + 1536 + g * 16 + 4 * fq);
            const f32x4 y = accy[ni] + dv * uv; u32x2 w; w.x = pk2(y[0], y[1]); w.y = pk2(y[2], y[3]); *(u32x2*)(YS + (size_t)row * 256 + g * 16 + 4 * fq) = w; }
    }
}
__device__ __forceinline__ void ssm_pass2(const Frame& F, int l) {
    const int idx = blockIdx.x * NTHREADS + F.tid; if (idx >= 8192) return;
    const int p = idx & 63, g = (idx >> 6) & 15, dir = (idx >> 10) & 1, b = idx >> 11;
    const int pg = (l * 2 + dir) * 16 + g; const float dt = __expf(PK(19)[pg]);
    const float lre = PK(17)[pg * 64 + p], lim = PK(18)[pg * 64 + p];
    cplx a, f_unused; ssm_consts(lre, lim, dt, a, f_unused);
#pragma unroll
    for (int i = 0; i < 6; ++i) a = cmul(a, a);
    const cplx* Sloc = FP(WS_SLOC, cplx); cplx* Carry = FP(WS_CARRY, cplx);
    const size_t base = ((size_t)((b * 2 + dir) * 16 + g) * 68) * 64 + p;
    cplx E = cplx{0.f, 0.f};
    for (int c0 = 0; c0 < 68; c0 += 4) {
        const cplx s0 = Sloc[base + (size_t)(c0 + 0) * 64], s1 = Sloc[base + (size_t)(c0 + 1) * 64], s2 = Sloc[base + (size_t)(c0 + 2) * 64], s3 = Sloc[base + (size_t)(c0 + 3) * 64];
        Carry[base + (size_t)(c0 + 0) * 64] = E; E = cmad(s0, a, E);
        Carry[base + (size_t)(c0 + 1) * 64] = E; E = cmad(s1, a, E);
        Carry[base + (size_t)(c0 + 2) * 64] = E; E = cmad(s2, a, E);
        Carry[base + (size_t)(c0 + 3) * 64] = E; E = cmad(s3, a, E);
    }
}


enum : unsigned { W_PREP1 = 1u << 0, W_GIN = 1u << 1, W_GVT = 1u << 2, W_FC = 1u << 3, W_FA = 1u << 4, W_CV = 1u << 5, W_ATT = 1u << 6, W_SSM1 = 1u << 7, W_GPW = 1u << 8,
                  W_P2 = 1u << 9, W_FB = 1u << 10, W_GFW = 1u << 11, W_SSM3 = 1u << 12, W_GGLU = 1u << 13, W_GN = 1u << 14, W_GOUT = 1u << 15, W_PREP3 = 1u << 16, W_GFF1 = 1u << 17, W_GFF2 = 1u << 18 };
#ifndef PH_FINE
#define PH_FINE 0
#endif
#if PH_FINE
constexpr int NSP = 18;
__host__ __device__ __forceinline__ unsigned phase_mask(int sp) {
    switch (sp) { case 0: return W_PREP1; case 1: return W_GIN; case 2: return W_GVT; case 3: return W_FC; case 4: return W_FA; case 5: return W_CV; case 6: return W_ATT; case 7: return W_SSM1;
                  case 8: return W_GPW; case 9: return W_P2 | W_FB; case 10: return W_GFW; case 11: return W_SSM3; case 12: return W_GGLU; case 13: return W_GN; case 14: return W_GOUT;
                  case 15: return W_PREP3; case 16: return W_GFF1; default: return W_GFF2; }
}
#else
constexpr int NSP = 11;
__host__ __device__ __forceinline__ unsigned phase_mask(int sp) {
    switch (sp) { case 0: return W_PREP1; case 1: return W_GIN | W_GVT; case 2: return W_FA | W_CV | W_ATT | W_SSM1; case 3: return W_GPW | W_P2 | W_FB | W_FC;
                  case 4: return W_GFW | W_SSM3; case 5: return W_GGLU; case 6: return W_GN; case 7: return W_GOUT; case 8: return W_PREP3; case 9: return W_GFF1; default: return W_GFF2; }
}
#endif
constexpr int NPH = 2 + 2 * NSP;
#ifndef ZP1
#define ZP1 12
#define ZP2 30
#endif
#define OPQ_S(x) asm volatile("" : "+s"(x))
#define GSYNC() do { __syncthreads(); if (wave_ == 0) { __builtin_amdgcn_fence(__ATOMIC_RELEASE, "agent"); asm volatile("s_waitcnt vmcnt(0) lgkmcnt(0)" ::: "memory"); } \
                     grid.sync(); \
                     if (wave_ == 0) { __builtin_amdgcn_fence(__ATOMIC_ACQUIRE, "agent"); asm volatile("s_waitcnt vmcnt(0) lgkmcnt(0)" ::: "memory"); } __syncthreads(); } while (0)
__global__ void __launch_bounds__(NTHREADS, 2) fwd(Args args) {
    extern __shared__ __attribute__((aligned(16))) unsigned char lds[];

    cg::grid_group grid = cg::this_grid();
    const int tid_ = threadIdx.x;
    const int wave_ = __builtin_amdgcn_readfirstlane(tid_ >> 6);
    float* scr = (float*)lds;
    const int G = gridDim.x, bx = blockIdx.x;
    const int gw = bx * 8 + wave_, nw = G * 8;
    const int lo = args.ph_lo, hi = args.ph_hi;
    if (lo == 0) { const Frame F{args, args.out, args.ws, tid_, tid_ & 63, wave_}; p0_prologue(F, scr); if (hi > 1) GSYNC(); }
#pragma nounroll
    for (int ph0 = (lo == 0 ? 1 : lo); ph0 < hi; ++ph0) {
        int ph = ph0; OPQ_S(ph);
        int tidv = tid_; asm volatile("" : "+v"(tidv));
        __attribute__((address_space(1))) unsigned char* wsg = (__attribute__((address_space(1))) unsigned char*)args.ws; __attribute__((address_space(1))) float* outg = (__attribute__((address_space(1))) float*)args.out;
        OPQ_S(wsg); OPQ_S(outg);
        unsigned char* wsv = (unsigned char*)wsg; float* outv = (float*)outg;
        const Frame F{args, outv, wsv, tidv, tidv & 63, wave_};
        if (ph == NPH - 1) { final_norm(F); continue; }
        const int l = (ph - 1) / NSP; const int sp = (ph - 1) - l * NSP;
        const unsigned wm = phase_mask(sp);
        const int row_lo = l == 0 ? 0 : NCTX;
        const int M_post = T_ALL - row_lo;
        unsigned char* wl = F.ws + WS_W + (size_t)l * W_LAYER;
#pragma nounroll
        for (int kind = 0; kind < 8; ++kind) {
            const unsigned bit = kind == 0 ? W_GIN : kind == 1 ? W_GVT : kind == 2 ? W_GPW : kind == 3 ? W_GFW : kind == 4 ? W_GGLU : kind == 5 ? W_GFF1 : kind == 6 ? W_GOUT : W_GFF2;
            if (!(wm & bit)) continue;
            const bf16_t* A; const bf16_t* Bt; int M, N, K;
            if (kind == 0) { A = FP(WS_XN, bf16_t); Bt = (const bf16_t*)(wl + W_IN); M = T_ALL; N = INC; K = DM; }
            else if (kind == 1) { A = (const bf16_t*)(wl + W_IN) + (size_t)1280 * DM; Bt = FP(WS_XN, bf16_t); M = 256; N = T_ALL; K = DM; }
            else if (kind == 2) { A = FP(WS_CV, bf16_t) + (size_t)row_lo * 256; Bt = (const bf16_t*)(wl + W_PW); M = M_post; N = 256; K = 256; }
            else if (kind == 3) { A = FP(WS_FN, bf16_t) + (size_t)row_lo * 256; Bt = (const bf16_t*)(wl + W_F); M = M_post; N = 256; K = 256; }
            else if (kind == 4) { A = FP(WS_YS, bf16_t) + (size_t)row_lo * 256; Bt = (const bf16_t*)(wl + W_GLU); M = M_post; N = 512; K = 256; }
            else if (kind == 5) { A = FP(WS_XN, bf16_t) + (size_t)row_lo * DM; Bt = (const bf16_t*)(wl + W_1); M = M_post; N = FFD; K = DM; }
            else if (kind == 6) { A = FP(WS_XN, bf16_t) + (size_t)row_lo * DM; Bt = (const bf16_t*)(wl + W_OUT); M = M_post; N = DM; K = DM; }
            else { A = FP(WS_H, bf16_t) + (size_t)row_lo * FFD; Bt = (const bf16_t*)(wl + W_2); M = M_post; N = DM; K = FFD; }
            pg8::Gemm g{A, Bt, M, N, K}; pg8::StaticOrder S; S.init(M, N, G, bx);
            EpiU E{F, l, kind, row_lo};
            pg8::gemm_phase<EpiU, pg8::StaticOrder, true, true>((PG8_LAS unsigned char*)lds, g, S, E);
        }
        if (wm & (W_FC | W_FA | W_CV)) {
            const int n_fc = (l == 0 && (wm & W_FC)) ? 32 : 0, n_fa = (wm & W_FA) ? 128 : 0, n_cv = (wm & W_CV) ? (l == 0 ? 544 : 512) : 0; const int nbu = n_fc + n_fa + n_cv;
            const int ustart = (n_fa + n_cv == 0) ? (G - 1 - bx) : bx;
#pragma nounroll
            for (int u = ustart; u < nbu; u += G) {
                if (u < n_fc) fnetctx_unit(F, u, scr);
                else if (u < n_fc + n_fa) fnetA_unit(F, u - n_fc, lds);
                else conv_unit(F, l, u - n_fc - n_fa, scr);
            }
        }
        if (wm & W_P2) ssm_pass2(F, l);
        if (wm & W_SSM3) {
#pragma nounroll
            for (int it = gw; it < 4096; it += nw) ssm_item<3>(F, l, it);
#pragma nounroll
            for (int it = 4096 + gw; it < 4352; it += nw) ssm_item<3>(F, l, it);
        }
        if (wm & (W_ATT | W_SSM1 | W_FB)) {
            const int n_ac = (l == 0 && (wm & W_ATT)) ? 256 : 0, n_al = (wm & W_ATT) ? 4096 : 0, n_s1 = (wm & W_SSM1) ? 4352 : 0, n_fb = (wm & W_FB) ? 1024 : 0, n_s3 = 0;
            const int e0 = n_ac, e1 = e0 + n_al, e2 = e1 + n_s1, e3 = e2 + n_fb, e4 = e3 + n_s3;
#pragma nounroll
            for (int it = gw; it < e4; it += nw) {
                if (it < e0) attn_item<false>(F, l, it);
                else if (it < e1) attn_item<true>(F, l, it - e0);
                else if (it < e2) ssm_item<1>(F, l, it - e1);
                else if (it < e3) fnetB_item(F, it - e2);
                else { ssm_item<3>(F, l, it - e3); }
            }
        }
        if (wm & W_PREP1) prep_norm_mod(F, l == 0 ? F.A.in[2] : FP(WS_XC, float), l == 0 ? F.A.in[0] : F.out, PK(6) + l * DM, FP(WS_MOD, float) + l * 5 * 6144, 0, 1024, FP(WS_XN, bf16_t), 0);
        if (wm & W_GN) prep_group(F, l, row_lo);
        if (wm & W_PREP3) prep_norm_mod(F, FP(WS_XC, float), F.out, PK(30) + l * DM, FP(WS_MOD, float) + l * 5 * 6144, 3072, 4096, FP(WS_XN, bf16_t), row_lo);
        if (ph0 + 1 < hi) GSYNC();
    }
}

extern "C" void kernel_launch(void* const* d_in, const int* in_sizes, int n_in, void* d_out, int out_size, void* d_ws, size_t ws_size, hipStream_t stream) {
    static int grid = 0;
    if (grid == 0) {
        if (n_in != 36 || ws_size < WS_END) { fprintf(stderr, "kernel_launch: unexpected n_in %d / ws %zu\n", n_in, ws_size); grid = -1; return; }
        int dev = 0, cus = 0, per_cu = 0;
        (void)hipGetDevice(&dev); (void)hipDeviceGetAttribute(&cus, hipDeviceAttributeMultiprocessorCount, dev);
        (void)hipFuncSetAttribute((const void*)fwd, hipFuncAttributeMaxDynamicSharedMemorySize, LDS_BYTES);
        (void)hipOccupancyMaxActiveBlocksPerMultiprocessor(&per_cu, (const void*)fwd, NTHREADS, LDS_BYTES);
        (void)hipGetLastError();
        grid = cus > 0 ? cus : 256;
    }
    if (grid < 0) return;
    Args a{};
    for (int i = 0; i < 36; ++i) a.in[i] = (const float*)d_in[i];
    a.out = (float*)d_out; a.ws = (unsigned char*)d_ws;
#if MODE_COOP
    a.ph_lo = 0; a.ph_hi = NPH; a.part = 15;
    void* kargs[] = {&a};
    hipError_t e = hipLaunchCooperativeKernel((const void*)fwd, dim3(grid), dim3(NTHREADS), kargs, LDS_BYTES, stream);
    if (e != hipSuccess) fprintf(stderr, "cooperative launch failed: %s (grid %d)\n", hipGetErrorString(e), grid);
#else
    for (int ph = 0; ph < NPH; ++ph) { a.ph_lo = ph; a.ph_hi = ph + 1; a.part = 15; hipLaunchKernelGGL(fwd, dim3(grid), dim3(NTHREADS), LDS_BYTES, stream, a); }
#endif
}
```

```cpp
#include <hip/hip_runtime.h>
#include <hip/hip_cooperative_groups.h>
#include <cstdio>
#include <cstdint>
namespace cg = cooperative_groups;
#ifndef MODE_COOP
#define MODE_COOP 1
#endif
namespace pg8 {
#define PG8_LAS __attribute__((address_space(3)))
typedef unsigned short bf16_t;
typedef short bf16x8 __attribute__((ext_vector_type(8)));
typedef float f32x4 __attribute__((ext_vector_type(4)));
typedef unsigned u32x4 __attribute__((ext_vector_type(4)));
constexpr int BM = 256, BK = 64, HALF = 128, HTB = HALF * BK * 2  , STAGE_BYTES = 8 * HTB, NXCD = 8, WGM = 8;

__host__ __device__ __forceinline__ int lds_byte(int r, int c) { const int st = (r >> 4) * 2 + (c >> 5), rr = r & 15, cc = c & 31, ob = rr * 64 + cc * 2; return st * 1024 + (ob ^ (((ob >> 9) & 1) << 5)); }
__host__ __device__ __forceinline__ void stage_rc(int b, int& R, int& C) { const int st = b / 1024, sb = b % 1024, swz = sb ^ (((sb >> 9) & 1) << 5); R = (st >> 1) * 16 + swz / 64; C = (st & 1) * 32 + (swz % 64) / 2; }
__host__ __device__ __forceinline__ int perm32(int rho) { const int n = rho >> 4, i = rho & 15; return 8 * (i >> 2) + 4 * n + (i & 3); }

struct Unit { int pm, pn; };
struct Gemm { const bf16_t* A; const bf16_t* Bt; int M, N, K; };

struct StaticOrder {
    int nM, nN, nwg, G, c;
    __host__ __device__ void init(int M, int N, int G_, int c_) { nM = M / BM; nN = N / BM; nwg = nM * nN; G = G_; c = c_; }
    __host__ __device__ bool next(int i, Unit& u) const {
        const long L = (long)i * G + c; if (L >= nwg) return false;
        int wgid = (int)L; { const int q = nwg / NXCD, r = nwg % NXCD, xcd = wgid % NXCD, off = wgid / NXCD; wgid = (xcd < r ? xcd * (q + 1) : r * (q + 1) + (xcd - r) * q) + off; }
        const int nig = WGM * nN, gid = wgid / nig, fm = gid * WGM, gsz = (nM - fm) < WGM ? (nM - fm) : WGM;
        u.pm = fm + ((wgid % nig) % gsz); u.pn = (wgid % nig) / gsz; return true;
    }
    __device__ __forceinline__ void a_ready(const Unit&) const {}
    __device__ __forceinline__ void done(const Unit&) const {}
};

}
namespace pg8 {
template <class Epi, class Sched, bool ALIGN_EPI = false, bool SP2 = false>
__device__ __forceinline__ void gemm_phase(PG8_LAS unsigned char* lds, const Gemm g, const Sched& S, const Epi& E) {
    const int tid = threadIdx.x, wid = __builtin_amdgcn_readfirstlane(tid >> 6), lane = tid & 63, wr = wid >> 2, wc = wid & 3, fr = lane & 15, fq = lane >> 4;
    const int K = g.K, nt = K / BK;
    unsigned voffA[2], voffB[2];
#pragma unroll
    for (int i = 0; i < 2; ++i) { int R, C; stage_rc(tid * 16 + i * 8192, R, C); const int Rb = Epi::PERM ? ((R & ~31) + perm32(R & 31)) : R;
        voffA[i] = (unsigned)(R * K + C) * 2u; voffB[i] = (unsigned)(Rb * K + C) * 2u; }
    const size_t kstep = (size_t)(BK * 2);
    const size_t hstep = (size_t)HALF * K * 2;
    const size_t tstep = 2 * hstep;
    const unsigned ldsw = (unsigned)wid * 1024u;
    const int aoff = lds_byte(wr * 64 + fr, fq * 8), boff = lds_byte(wc * 32 + fr, fq * 8);
#define PG8_SA(b, h) (((b) * 2 + (h)) * HTB)
#define PG8_SB(b, h) ((4 + (b) * 2 + (h)) * HTB)
#define PG8_STAGE(bufoff, gbase, voff) do { _Pragma("unroll") for (int _i = 0; _i < 2; ++_i) \
        __builtin_amdgcn_global_load_lds((const unsigned*)((const char*)(gbase) + (voff)[_i]), (PG8_LAS unsigned*)(lds + (bufoff) + ldsw + _i * 8192), 16, 0, 0); } while (0)
#define PG8_LDA(dst, b, h) do { _Pragma("unroll") for (int m = 0; m < 4; ++m) _Pragma("unroll") for (int k = 0; k < 2; ++k) dst[m][k] = *(const PG8_LAS bf16x8*)(lds + PG8_SA(b, h) + aoff + m * 2048 + k * 1024); } while (0)
#define PG8_LDB(dst, b, h) do { _Pragma("unroll") for (int n = 0; n < 2; ++n) _Pragma("unroll") for (int k = 0; k < 2; ++k) dst[n][k] = *(const PG8_LAS bf16x8*)(lds + PG8_SB(b, h) + boff + n * 2048 + k * 1024); } while (0)
#define PG8_MMA(ai, bj, At, Bt) do { __builtin_amdgcn_s_setprio(1); _Pragma("unroll") for (int m = 0; m < 4; ++m) _Pragma("unroll") for (int n = 0; n < 2; ++n) _Pragma("unroll") for (int k = 0; k < 2; ++k) \
        acc[ai][bj][m][n] = __builtin_amdgcn_mfma_f32_16x16x32_bf16(Bt[n][k], At[m][k], acc[ai][bj][m][n], 0, 0, 0); __builtin_amdgcn_s_setprio(0); } while (0)
#define PG8_WAIT_V(n) asm volatile("s_waitcnt vmcnt(" #n ")" ::: "memory")
#define PG8_WAIT_L(n) asm volatile("s_waitcnt lgkmcnt(" #n ")" ::: "memory")
#define PG8_BAR __builtin_amdgcn_s_barrier()
#define PG8_SCHED __builtin_amdgcn_sched_barrier(0)
    Unit cur, nxt; int ui = 0;
    if (!S.next(0, cur)) return;
    f32x4 acc[2][2][4][2];
#pragma unroll
    for (int a = 0; a < 2; ++a)
#pragma unroll
        for (int b = 0; b < 2; ++b)
#pragma unroll
            for (int m = 0; m < 4; ++m)
#pragma unroll
                for (int n = 0; n < 2; ++n) acc[a][b][m][n] = (f32x4){0.f, 0.f, 0.f, 0.f};
    bf16x8 At[4][2], B0[2][2], B1[2][2];
    const char* cA = (const char*)g.A + (size_t)cur.pm * tstep; const char* cB = (const char*)g.Bt + (size_t)cur.pn * tstep;
    S.a_ready(cur);
    if constexpr (SP2) {
        PG8_STAGE(PG8_SB(0, 0), cB, voffB); PG8_STAGE(PG8_SB(0, 1), cB + hstep, voffB); PG8_STAGE(PG8_SA(0, 0), cA, voffA); PG8_STAGE(PG8_SA(0, 1), cA + hstep, voffA);
        if (wr == 1) PG8_BAR;
        PG8_WAIT_V(2); PG8_BAR;
        PG8_STAGE(PG8_SB(1, 0), cB + kstep, voffB); PG8_STAGE(PG8_SA(1, 0), cA + kstep, voffA); PG8_STAGE(PG8_SB(1, 1), cB + hstep + kstep, voffB);
        PG8_WAIT_V(6); PG8_BAR;
    } else {
        PG8_STAGE(PG8_SB(0, 0), cB, voffB); PG8_STAGE(PG8_SA(0, 0), cA, voffA); PG8_STAGE(PG8_SB(0, 1), cB + hstep, voffB); PG8_STAGE(PG8_SA(0, 1), cA + hstep, voffA);
        if (wr == 1) PG8_BAR;
        PG8_WAIT_V(4); PG8_BAR;
        PG8_STAGE(PG8_SB(1, 0), cB + kstep, voffB); PG8_STAGE(PG8_SA(1, 0), cA + kstep, voffA); PG8_STAGE(PG8_SB(1, 1), cB + hstep + kstep, voffB);
        PG8_WAIT_V(6); PG8_BAR;
    }
    for (;;) {
        const bool has_next = S.next(ui + 1, nxt);
        const char* nA = has_next ? (const char*)g.A + (size_t)nxt.pm * tstep : cA; const char* nB = has_next ? (const char*)g.Bt + (size_t)nxt.pn * tstep : cB;
        for (int t = 0; t < nt; t += 2) {
            const bool last = (t == nt - 2);
            const char* a1 = cA + (size_t)(t + 1) * kstep;
            const char* a2 = last ? nA : cA + (size_t)(t + 2) * kstep; const char* b2 = last ? nB : cB + (size_t)(t + 2) * kstep;
            const char* a3 = a2 + kstep; const char* b3 = b2 + kstep;
            if (last && has_next) S.a_ready(nxt);
            if constexpr (SP2) {
            PG8_LDB(B0, 0, 0); PG8_LDB(B1, 0, 1); PG8_SCHED; PG8_LDA(At, 0, 0); PG8_STAGE(PG8_SA(1, 1), a1 + hstep, voffA);
            PG8_WAIT_V(8); PG8_WAIT_L(0); PG8_BAR; PG8_MMA(0, 0, At, B0); PG8_MMA(0, 1, At, B1); PG8_BAR; PG8_SCHED;
            PG8_LDA(At, 0, 1); PG8_STAGE(PG8_SB(0, 0), b2, voffB); PG8_STAGE(PG8_SB(0, 1), b2 + hstep, voffB); PG8_STAGE(PG8_SA(0, 0), a2, voffA);
            PG8_WAIT_V(8); PG8_WAIT_L(0); PG8_BAR; PG8_MMA(1, 0, At, B0); PG8_MMA(1, 1, At, B1); PG8_BAR; PG8_SCHED;
            PG8_LDB(B0, 1, 0); PG8_LDB(B1, 1, 1); PG8_SCHED; PG8_LDA(At, 1, 0); PG8_STAGE(PG8_SA(0, 1), a2 + hstep, voffA);
            PG8_WAIT_V(8); PG8_WAIT_L(0); PG8_BAR; PG8_MMA(0, 0, At, B0); PG8_MMA(0, 1, At, B1); PG8_BAR; PG8_SCHED;
            PG8_LDA(At, 1, 1); PG8_STAGE(PG8_SB(1, 0), b3, voffB); PG8_STAGE(PG8_SB(1, 1), b3 + hstep, voffB); PG8_STAGE(PG8_SA(1, 0), a3, voffA);
            PG8_WAIT_V(8); PG8_WAIT_L(0); PG8_BAR; PG8_MMA(1, 0, At, B0); PG8_MMA(1, 1, At, B1); PG8_BAR; PG8_SCHED;
            } else {
            PG8_LDB(B0, 0, 0); PG8_SCHED; PG8_LDA(At, 0, 0); PG8_STAGE(PG8_SA(1, 1), a1 + hstep, voffA);
            PG8_WAIT_L(8); PG8_BAR; PG8_WAIT_L(0); PG8_MMA(0, 0, At, B0); PG8_BAR; PG8_SCHED;
            PG8_LDB(B1, 0, 1); PG8_STAGE(PG8_SB(0, 0), b2, voffB);
            PG8_BAR; PG8_WAIT_L(0); PG8_MMA(0, 1, At, B1); PG8_BAR;
            PG8_LDA(At, 0, 1); PG8_STAGE(PG8_SA(0, 0), a2, voffA);
            PG8_BAR; PG8_WAIT_L(0); PG8_MMA(1, 0, At, B0); PG8_BAR; PG8_SCHED;
            PG8_STAGE(PG8_SB(0, 1), b2 + hstep, voffB);
            PG8_WAIT_V(6); PG8_BAR; PG8_MMA(1, 1, At, B1); PG8_BAR;
            PG8_LDB(B0, 1, 0); PG8_SCHED; PG8_LDA(At, 1, 0); PG8_STAGE(PG8_SA(0, 1), a2 + hstep, voffA);
            PG8_WAIT_L(8); PG8_BAR; PG8_WAIT_L(0); PG8_MMA(0, 0, At, B0); PG8_BAR; PG8_SCHED;
            PG8_LDB(B1, 1, 1); PG8_STAGE(PG8_SB(1, 0), b3, voffB);
            PG8_BAR; PG8_WAIT_L(0); PG8_MMA(0, 1, At, B1); PG8_BAR;
            PG8_LDA(At, 1, 1); PG8_STAGE(PG8_SA(1, 0), a3, voffA);
            PG8_BAR; PG8_WAIT_L(0); PG8_MMA(1, 0, At, B0); PG8_BAR; PG8_SCHED;
            PG8_STAGE(PG8_SB(1, 1), b3 + hstep, voffB);
            PG8_WAIT_V(6); PG8_BAR; PG8_MMA(1, 1, At, B1); PG8_BAR;
            }
        }
        if constexpr (ALIGN_EPI) { if (wr == 0) PG8_BAR; }
        if constexpr (!Epi::AFTER_DRAIN) { E(acc, cur, wr, wc, fr, fq); S.done(cur); }
        if (!has_next) break;
#pragma unroll
        for (int a = 0; a < 2; ++a)
#pragma unroll
            for (int b = 0; b < 2; ++b)
#pragma unroll
                for (int m = 0; m < 4; ++m)
#pragma unroll
                    for (int n = 0; n < 2; ++n) acc[a][b][m][n] = (f32x4){0.f, 0.f, 0.f, 0.f};
        cur = nxt; cA = nA; cB = nB; ++ui;
        if constexpr (ALIGN_EPI) { if (wr == 1) PG8_BAR; }
    }
    PG8_WAIT_V(0);
    if constexpr (!ALIGN_EPI) { if (wr == 0) PG8_BAR; }
    PG8_BAR;
    if constexpr (Epi::AFTER_DRAIN) { E.fused(acc, cur, wr, wc, fr, fq, lds, wid, lane); S.done(cur); }
#undef PG8_SA
#undef PG8_SB
#undef PG8_STAGE
#undef PG8_LDA
#undef PG8_LDB
#undef PG8_MMA
#undef PG8_WAIT_V
#undef PG8_WAIT_L
#undef PG8_BAR
#undef PG8_SCHED
}
}

using pg8::bf16_t; using pg8::bf16x8; using pg8::f32x4;
#define LAS __attribute__((address_space(3)))
typedef short bf16x4 __attribute__((ext_vector_type(4)));
typedef unsigned u32x4 __attribute__((ext_vector_type(4)));
typedef unsigned u32x2 __attribute__((ext_vector_type(2)));

constexpr int NTHREADS = 512;
constexpr int T_ALL = 17408, NCTX = 1024, NLAT = 16384, DM = 1024, INC = 1792, FFD = 4096;
constexpr int LDS_BYTES = 147456;
constexpr float EPS = 1e-6f;

constexpr size_t MiB = 1u << 20;
constexpr size_t WS_MOD = 0;
constexpr size_t WS_CTAB = 256 * 1024;
constexpr size_t WS_STAB = 256 * 1024 + 8192;
constexpr size_t WS_PACK = 1 * MiB;
constexpr size_t WS_SLOC = 3 * MiB;
constexpr size_t WS_CARRY = 7 * MiB + 256 * 1024;
constexpr size_t WS_W = 12 * MiB;
constexpr size_t W_IN = 0, W_PW = W_IN + (size_t)INC * DM * 2, W_F = W_PW + 256 * 256 * 2, W_GLU = W_F + 256 * 256 * 2,
                 W_OUT = W_GLU + 512 * 256 * 2, W_1 = W_OUT + (size_t)DM * DM * 2, W_2 = W_1 + (size_t)FFD * DM * 2, W_LAYER = W_2 + (size_t)FFD * DM * 2;
static_assert(W_LAYER == 22 * MiB, "weights per layer");
constexpr size_t WS_XC = 56 * MiB;
constexpr size_t WS_XN = 60 * MiB;
constexpr size_t WS_BIG = 94 * MiB;
constexpr size_t WS_H = WS_BIG;
constexpr size_t WS_PX = WS_BIG;
constexpr size_t WS_VT = 154 * MiB;
constexpr size_t WS_VTC = 162 * MiB;
constexpr size_t WS_CV = 163 * MiB;
constexpr size_t WS_YB = 172 * MiB;
constexpr size_t WS_FN = 188 * MiB;
constexpr size_t WS_YS = 197 * MiB;
constexpr size_t WS_ZS = 206 * MiB;
constexpr size_t WS_MIX = 223 * MiB;
constexpr size_t WS_END = 256 * MiB;
static_assert(WS_H + (size_t)T_ALL * FFD * 2 <= WS_END && WS_MIX + (size_t)T_ALL * 768 * 2 <= WS_END && WS_PX + (size_t)T_ALL * INC * 2 <= WS_VT, "ws map");

__device__ __forceinline__ unsigned f2bf(float f) { unsigned u = __builtin_bit_cast(unsigned, f); return (u + 0x7fffu + ((u >> 16) & 1u)) >> 16; }
__device__ __forceinline__ unsigned pk2(float lo, float hi) { return f2bf(lo) | (f2bf(hi) << 16); }
__device__ __forceinline__ float bf2f(unsigned h) { return __builtin_bit_cast(float, (h & 0xffffu) << 16); }
__device__ __forceinline__ float bflo(unsigned w) { return __builtin_bit_cast(float, w << 16); }
__device__ __forceinline__ float bfhi(unsigned w) { return __builtin_bit_cast(float, w & 0xffff0000u); }
__device__ __forceinline__ bf16x8 pack8(f32x4 a, f32x4 b) {
    u32x4 w; w.x = pk2(a[0], a[1]); w.y = pk2(a[2], a[3]); w.z = pk2(b[0], b[1]); w.w = pk2(b[2], b[3]);
    return __builtin_bit_cast(bf16x8, w);
}
__device__ __forceinline__ bf16x8 neg8(bf16x8 v) { u32x4 w = __builtin_bit_cast(u32x4, v); w.x ^= 0x80008000u; w.y ^= 0x80008000u; w.z ^= 0x80008000u; w.w ^= 0x80008000u; return __builtin_bit_cast(bf16x8, w); }
__device__ __forceinline__ bf16x8 zero8() { u32x4 w = {0u, 0u, 0u, 0u}; return __builtin_bit_cast(bf16x8, w); }
__device__ __forceinline__ bf16x8 cat4(u32x2 a, u32x2 b) { u32x4 w; w.x = a.x; w.y = a.y; w.z = b.x; w.w = b.y; return __builtin_bit_cast(bf16x8, w); }
__device__ __forceinline__ f32x4 mfma16(bf16x8 a, bf16x8 b, f32x4 c) { return __builtin_amdgcn_mfma_f32_16x16x32_bf16(a, b, c, 0, 0, 0); }
__device__ __forceinline__ void settle4(f32x4& a, f32x4& b, f32x4& c, f32x4& d) { asm volatile("s_nop 15\n\ts_nop 15" : "+v"(a), "+v"(b), "+v"(c), "+v"(d)); }
__device__ __forceinline__ void settle4m(f32x4& a, f32x4& b, f32x4& c, f32x4& d) { asm volatile("s_nop 7\n\ts_nop 7" : "+v"(a), "+v"(b), "+v"(c), "+v"(d) :: "memory"); }
__device__ __forceinline__ f32x4 mfma16s(bf16x8 a, bf16x8 b, f32x4 c) { asm volatile("s_nop 7" : "+v"(a), "+v"(b)); return __builtin_amdgcn_mfma_f32_16x16x32_bf16(a, b, c, 0, 0, 0); }
__device__ __forceinline__ void settle2(f32x4& a, f32x4& b) { asm volatile("s_nop 15\n\ts_nop 15" : "+v"(a), "+v"(b)); }
__device__ __forceinline__ void settle_in(bf16x8& a, bf16x8& b) { asm volatile("s_nop 3" : "+v"(a), "+v"(b)); }
__device__ __forceinline__ float wave_sum(float v) {
    v += __shfl_xor(v, 1); v += __shfl_xor(v, 2); v += __shfl_xor(v, 4); v += __shfl_xor(v, 8); v += __shfl_xor(v, 16); v += __shfl_xor(v, 32); return v;
}
__device__ __forceinline__ float sigmoidf_(float x) { return 1.0f / (1.0f + __expf(-x)); }
struct cplx { float re, im; };
__device__ __forceinline__ cplx cmul(cplx a, cplx b) { return cplx{a.re * b.re - a.im * b.im, a.re * b.im + a.im * b.re}; }
__device__ __forceinline__ cplx cmad(cplx acc, cplx a, cplx b) { return cplx{acc.re + a.re * b.re - a.im * b.im, acc.im + a.re * b.im + a.im * b.re}; }

struct Args { const float* in[36]; float* out; unsigned char* ws; int ph_lo, ph_hi, part, pad; };
struct Frame {
    const Args& A;
    float* out; unsigned char* ws;
    int tid, lane, wave;
};
#define FP(off, type) ((type*)(F.ws + (off)))

constexpr int PK_N = 23;
constexpr int PK_IDX[PK_N] = {6,8,9,10,11,13,15,16,17,18,19,20,21,22,23,24,26,27,29,30,32,34,35};
constexpr int PK_CNT[PK_N] = {2048,15872,512,512,512,512,512,3720,4096,4096,64,65536,65536,65536,65536,512,1024,2048,2048,2048,8192,2048,1024};
constexpr int pk_off(int k) { int o = 0; for (int i = 0; i < PK_N; ++i) { if (PK_IDX[i] == k) return o; o += PK_CNT[i]; } return -1; }
#define PK(k) (FP(WS_PACK, float) + pk_off(k))
static_assert(pk_off(35) + 1024 <= (int)(2 * MiB / 4), "pack size");

struct EpiU {
    static constexpr bool PERM = false, AFTER_DRAIN = false;
    const Frame& F; int l; int kind; int row_lo;
    __device__ __forceinline__ void operator()(const f32x4 (&acc)[2][2][4][2], const pg8::Unit& u, int wr, int wc, int fr, int fq) const {
        const int c0 = u.pn * 256 + wc * 32 + fq * 4;
        const int r0 = u.pm * 256 + wr * 64 + fr;
        if (kind < 6) {
            bf16_t* base; size_t ldc; const float* bias = nullptr;
            if (kind == 0) { base = FP(WS_PX, bf16_t) + (size_t)r0 * INC + c0; ldc = INC; }
            else if (kind == 1) {
                if (u.pn < 4) { base = FP(WS_VTC, bf16_t) + (size_t)u.pn * 65536 + (size_t)r0 * 256 + (c0 - u.pn * 256); ldc = 256; }
                else { const int tt = u.pn - 4; base = FP(WS_VT, bf16_t) + (size_t)(tt >> 4) * 256 * 4096 + (tt & 15) * 256 + (size_t)r0 * 4096 + (c0 - u.pn * 256); ldc = 4096; }
            }
            else if (kind == 2) { base = FP(WS_MIX, bf16_t) + (size_t)(row_lo + r0) * 768 + c0; ldc = 768; bias = PK(13) + l * 256; }
            else if (kind == 3) { base = FP(WS_MIX, bf16_t) + (size_t)(row_lo + r0) * 768 + 256 + c0; ldc = 768; bias = PK(15) + l * 256; }
            else if (kind == 4) { base = FP(WS_ZS, bf16_t) + (size_t)(row_lo + r0) * 512 + c0; ldc = 512; bias = PK(26) + l * 512; }
            else { base = FP(WS_H, bf16_t) + (size_t)(row_lo + r0) * FFD + c0; ldc = FFD; bias = PK(32) + l * FFD; }
#pragma unroll
            for (int bj = 0; bj < 2; ++bj)
#pragma unroll
                for (int n = 0; n < 2; ++n) {
                    f32x4 bv = f32x4{0.f, 0.f, 0.f, 0.f};
                    if (bias) bv = *(const f32x4*)(bias + c0 + bj * 128 + n * 16);
#pragma unroll
                    for (int ai = 0; ai < 2; ++ai)
#pragma unroll
                        for (int m = 0; m < 4; ++m) {
                            f32x4 v = acc[ai][bj][m][n] + bv;
                            if (kind == 5) {
#pragma unroll
                                for (int j = 0; j < 4; ++j) { const float r = fmaxf(v[j], 0.f); v[j] = r * r; }
                            }
                            u32x2 w; w.x = pk2(v[0], v[1]); w.y = pk2(v[2], v[3]);
                            *(u32x2*)(base + (size_t)(ai * 128 + m * 16) * ldc + bj * 128 + n * 16) = w;
                        }
                }
        } else {
            const int gp = u.pm + (row_lo >> 8); const bool isc = gp < 4; const int lrow0 = isc ? gp * 256 : (gp - 4) * 256; const int br = isc ? 4 : ((gp - 4) >> 4);
            const float* sC; const float* sL; const float* bias; int gate_off;
            if (kind == 6) { sC = l == 0 ? F.A.in[2] : FP(WS_XC, float); sL = l == 0 ? F.A.in[0] : F.out; bias = PK(29) + l * DM; gate_off = 2048; }
            else { sC = FP(WS_XC, float); sL = F.out; bias = PK(34) + l * DM; gate_off = 5120; }
            const size_t roff = (size_t)(lrow0 + wr * 64 + fr) * DM + c0;
            const float* s = (isc ? sC : sL) + roff; float* d = (isc ? FP(WS_XC, float) : F.out) + roff;
            const float* gate = FP(WS_MOD, float) + (l * 5 + br) * 6144 + gate_off;
#pragma unroll
            for (int bj = 0; bj < 2; ++bj)
#pragma unroll
                for (int n = 0; n < 2; ++n) {
                    const int cc = c0 + bj * 128 + n * 16;
                    const f32x4 bv = *(const f32x4*)(bias + cc); const f32x4 gv = *(const f32x4*)(gate + cc);
#pragma unroll
                    for (int ai = 0; ai < 2; ++ai)
#pragma unroll
                        for (int m = 0; m < 4; ++m) {
                            const size_t o = (size_t)(ai * 128 + m * 16) * DM + bj * 128 + n * 16;
                            const f32x4 xv = *(const f32x4*)(s + o);
                            *(f32x4*)(d + o) = xv + gv * (acc[ai][bj][m][n] + bv);
                        }
                }
        }
    }
};

__device__ __forceinline__ void transpose_tile(const float* W, int K, int N, bf16_t* Wt, int tile, float* scr, int tid) {
    const int ntn = N >> 6; const int tk = tile / ntn, tn = tile - tk * ntn; const int k0 = tk * 64, n0 = tn * 64;
    { const int n = tid & 63, kk = tid >> 6;
#pragma unroll
      for (int i = 0; i < 8; ++i) { const int k = kk + 8 * i; scr[k * 65 + n] = W[(size_t)(k0 + k) * N + n0 + n]; } }
    __syncthreads();
    { const int kp = tid & 31, nn = tid >> 5;
#pragma unroll
      for (int i = 0; i < 4; ++i) { const int n = nn + 16 * i; const unsigned v = pk2(scr[(2 * kp) * 65 + n], scr[(2 * kp + 1) * 65 + n]); *(unsigned*)(Wt + (size_t)(n0 + n) * K + k0 + 2 * kp) = v; } }
    __syncthreads();
}
__device__ __forceinline__ void mod_unit(const Frame& F, int unit, float* scr) {
    const int l = unit / 96, cc = unit - l * 96; const int tid = F.tid;
    float* sl = scr; float* red = scr + 5 * 1024;
    for (int i = tid; i < 5 * 1024; i += NTHREADS) { const int r = i >> 10, k = i & 1023; const float c = r < 4 ? F.A.in[1][r * 1024 + k] : F.A.in[3][k]; sl[i] = c * sigmoidf_(c); }
    __syncthreads();
    const int col = tid & 63, kg = tid >> 6;
    const float* w = F.A.in[4] + (size_t)l * DM * 6144 + cc * 64 + col;
    float a0 = 0.f, a1 = 0.f, a2 = 0.f, a3 = 0.f, a4 = 0.f;
    for (int k = kg * 128; k < kg * 128 + 128; ++k) { const float wv = w[(size_t)k * 6144]; a0 += sl[k] * wv; a1 += sl[1024 + k] * wv; a2 += sl[2048 + k] * wv; a3 += sl[3072 + k] * wv; a4 += sl[4096 + k] * wv; }
    red[(kg * 5 + 0) * 64 + col] = a0; red[(kg * 5 + 1) * 64 + col] = a1; red[(kg * 5 + 2) * 64 + col] = a2; red[(kg * 5 + 3) * 64 + col] = a3; red[(kg * 5 + 4) * 64 + col] = a4;
    __syncthreads();
    if (tid < 320) { const int r = tid >> 6, c2 = tid & 63; float s = 0.f;
#pragma unroll
        for (int g = 0; g < 8; ++g) s += red[(g * 5 + r) * 64 + c2];
        FP(WS_MOD, float)[(l * 5 + r) * 6144 + cc * 64 + c2] = s + F.A.in[5][l * 6144 + cc * 64 + c2]; }
    __syncthreads();
}
__device__ __forceinline__ void p0_prologue(const Frame& F, float* scr) {
    const int NT_L = 448 + 16 + 16 + 32 + 256 + 1024 + 1024;
    const int njobs = 193 + 2 * NT_L + PK_N;
    for (int job = blockIdx.x; job < njobs; job += gridDim.x) {
        if (job >= 193 + 2 * NT_L) {
            const int e = job - (193 + 2 * NT_L); const float* src = nullptr; int cnt = 0, off = 0;
#define PKC(i) if (e == i) { src = F.A.in[PK_IDX[i]]; cnt = PK_CNT[i]; off = pk_off(PK_IDX[i]); }
            PKC(0) PKC(1) PKC(2) PKC(3) PKC(4) PKC(5) PKC(6) PKC(7) PKC(8) PKC(9) PKC(10) PKC(11) PKC(12) PKC(13) PKC(14) PKC(15) PKC(16) PKC(17) PKC(18) PKC(19) PKC(20) PKC(21) PKC(22)
#undef PKC
            float* dst = FP(WS_PACK, float) + off;
            for (int i = F.tid; i < cnt; i += NTHREADS) dst[i] = src[i];
        }
        else if (job < 192) { mod_unit(F, job, scr); }
        else if (job == 192) {
            for (int i = F.tid; i < 4096; i += NTHREADS) { const int m = i >> 6, j = i & 63; const float x = (float)((m * j) & 63) * (1.0f / 32.0f);
                FP(WS_CTAB, bf16_t)[i] = (bf16_t)f2bf(cospif(x)); FP(WS_STAB, bf16_t)[i] = (bf16_t)f2bf(sinpif(x)); }
        } else {
            int t = job - 193; const int l = t / NT_L; t -= l * NT_L;
            unsigned char* wl = F.ws + WS_W + (size_t)l * W_LAYER;
            if (t < 448) transpose_tile(F.A.in[7] + (size_t)l * DM * INC, DM, INC, (bf16_t*)(wl + W_IN), t, scr, F.tid);
            else if ((t -= 448) < 16) transpose_tile(F.A.in[12] + (size_t)l * 65536, 256, 256, (bf16_t*)(wl + W_PW), t, scr, F.tid);
            else if ((t -= 16) < 16) transpose_tile(F.A.in[14] + (size_t)l * 65536, 256, 256, (bf16_t*)(wl + W_F), t, scr, F.tid);
            else if ((t -= 16) < 32) transpose_tile(F.A.in[25] + (size_t)l * 131072, 256, 512, (bf16_t*)(wl + W_GLU), t, scr, F.tid);
            else if ((t -= 32) < 256) transpose_tile(F.A.in[28] + (size_t)l * DM * DM, DM, DM, (bf16_t*)(wl + W_OUT), t, scr, F.tid);
            else if ((t -= 256) < 1024) transpose_tile(F.A.in[31] + (size_t)l * DM * FFD, DM, FFD, (bf16_t*)(wl + W_1), t, scr, F.tid);
            else { t -= 1024; transpose_tile(F.A.in[33] + (size_t)l * DM * FFD, FFD, DM, (bf16_t*)(wl + W_2), t, scr, F.tid); }
        }
    }
}

__device__ __forceinline__ void prep_norm_mod(const Frame& F, const float* srcC, const float* srcL, const float* g, const float* modl, int sh_off, int sc_off, bf16_t* XN, int row_lo) {
    const int gw = blockIdx.x * 8 + F.wave, nw = gridDim.x * 8, lane = F.lane;
    for (int row = row_lo + gw; row < T_ALL; row += nw) {
        const bool isc = row < NCTX; const float* x = isc ? srcC + (size_t)row * DM : srcL + (size_t)(row - NCTX) * DM; const int br = isc ? 4 : ((row - NCTX) >> 12);
        const float* sh = modl + br * 6144 + sh_off; const float* sc = modl + br * 6144 + sc_off;
        f32x4 v[4]; float ss = 0.f;
#pragma unroll
        for (int i = 0; i < 4; ++i) { v[i] = *(const f32x4*)(x + i * 256 + lane * 4); ss += v[i][0] * v[i][0] + v[i][1] * v[i][1] + v[i][2] * v[i][2] + v[i][3] * v[i][3]; }
        ss = wave_sum(ss); const float r = rsqrtf(ss * (1.0f / 1024.0f) + EPS);
#pragma unroll
        for (int i = 0; i < 4; ++i) { const int c = i * 256 + lane * 4; const f32x4 gv = *(const f32x4*)(g + c), shv = *(const f32x4*)(sh + c), scv = *(const f32x4*)(sc + c);
            f32x4 y = v[i] * r * gv; y = y * (scv + 1.0f) + shv; u32x2 w; w.x = pk2(y[0], y[1]); w.y = pk2(y[2], y[3]); *(u32x2*)(XN + (size_t)row * DM + c) = w; }
    }
}
__device__ __forceinline__ f32x4 ld_bf4(const bf16_t* p) { const u32x2 w = *(const u32x2*)p; return f32x4{bflo(w.x), bfhi(w.x), bflo(w.y), bfhi(w.y)}; }
__device__ __forceinline__ void prep_group(const Frame& F, int l, int row_lo) {
    const int gw = blockIdx.x * 8 + F.wave, nw = gridDim.x * 8, lane = F.lane;
    const bf16_t* MIX = FP(WS_MIX, bf16_t); const bf16_t* ZS = FP(WS_ZS, bf16_t); bf16_t* O = FP(WS_XN, bf16_t); const float* gg = PK(27) + l * DM;
    for (int row = row_lo + gw; row < T_ALL; row += nw) {
#pragma unroll
        for (int grp = 0; grp < 4; ++grp) {
            f32x4 v;
            if (grp < 3) v = ld_bf4(MIX + (size_t)row * 768 + grp * 256 + lane * 4);
            else { const f32x4 a = ld_bf4(ZS + (size_t)row * 512 + lane * 4), gt = ld_bf4(ZS + (size_t)row * 512 + 256 + lane * 4);
#pragma unroll
                for (int j = 0; j < 4; ++j) v[j] = a[j] * sigmoidf_(gt[j]); }
            float ss = v[0] * v[0] + v[1] * v[1] + v[2] * v[2] + v[3] * v[3]; ss = wave_sum(ss);
            const float r = rsqrtf(ss * (1.0f / 256.0f) + EPS); const f32x4 gv = *(const f32x4*)(gg + grp * 256 + lane * 4); const f32x4 y = v * r * gv;
            u32x2 w; w.x = pk2(y[0], y[1]); w.y = pk2(y[2], y[3]); *(u32x2*)(O + (size_t)row * DM + grp * 256 + lane * 4) = w;
        }
    }
}
__device__ __forceinline__ void final_norm(const Frame& F) {
    const int gw = blockIdx.x * 8 + F.wave, nw = gridDim.x * 8, lane = F.lane; const float* g = PK(35);
    for (int row = gw; row < NLAT; row += nw) {
        float* x = F.out + (size_t)row * DM; f32x4 v[4]; float ss = 0.f;
#pragma unroll
        for (int i = 0; i < 4; ++i) { v[i] = *(const f32x4*)(x + i * 256 + lane * 4); ss += v[i][0] * v[i][0] + v[i][1] * v[i][1] + v[i][2] * v[i][2] + v[i][3] * v[i][3]; }
        ss = wave_sum(ss); const float r = rsqrtf(ss * (1.0f / 1024.0f) + EPS);
#pragma unroll
        for (int i = 0; i < 4; ++i) { const int c = i * 256 + lane * 4; *(f32x4*)(x + c) = v[i] * r * *(const f32x4*)(g + c); }
    }
}

__device__ __forceinline__ void conv_unit(const Frame& F, int l, int unit, float* scr) {
    const bf16_t* PX = FP(WS_PX, bf16_t); bf16_t* CV = FP(WS_CV, bf16_t);
    int prow0, Lseq, t0;
    if (unit < 512) { const int b = unit >> 7; t0 = (unit & 127) * 32; prow0 = NCTX + b * 4096; Lseq = 4096; }
    else { const int uu = unit - 512; const int b = uu >> 3; t0 = (uu & 7) * 32; prow0 = b * 256; Lseq = 256; }
    float* vt = scr; float* ot = scr + 62 * 256; int tid = F.tid; asm volatile("" : "+v"(tid));
    for (int idx = tid; idx < 62 * 256; idx += NTHREADS) { const int rr = idx >> 8, c = idx & 255; const int t = t0 - 15 + rr; float v = 0.f;
        if (t >= 0 && t < Lseq) { const bf16_t* p = PX + (size_t)(prow0 + t) * INC; const float a = bf2f(p[c]), gt = bf2f(p[256 + c]); v = a * sigmoidf_(gt); }
        vt[idx] = v; }
    __syncthreads();
    { const int c = tid & 255, half = tid >> 8; float w[31];
#pragma unroll
      for (int j = 0; j < 31; ++j) w[j] = PK(8)[(l * 31 + j) * 256 + c];
      const float bd = PK(9)[l * 256 + c];
      for (int tt = 0; tt < 16; ++tt) { const int t = half * 16 + tt; float s = bd;
#pragma unroll
          for (int j = 0; j < 31; ++j) s += w[j] * vt[(t + j) * 256 + c];
          ot[t * 256 + c] = s; } }
    __syncthreads();
    { const int lane = tid & 63; const f32x4 lg = *(const f32x4*)(PK(10) + l * 256 + lane * 4), lb = *(const f32x4*)(PK(11) + l * 256 + lane * 4);
      for (int i = 0; i < 4; ++i) { const int t = F.wave * 4 + i; const f32x4 x = *(const f32x4*)(ot + t * 256 + lane * 4);
          const float mu = wave_sum(x[0] + x[1] + x[2] + x[3]) * (1.0f / 256.0f); const f32x4 d = x - mu;
          const float var = wave_sum(d[0] * d[0] + d[1] * d[1] + d[2] * d[2] + d[3] * d[3]) * (1.0f / 256.0f); const float r = rsqrtf(var + EPS);
          f32x4 y = d * r * lg + lb;
#pragma unroll
          for (int j = 0; j < 4; ++j) y[j] = y[j] * sigmoidf_(y[j]);
          u32x2 w; w.x = pk2(y[0], y[1]); w.y = pk2(y[2], y[3]); *(u32x2*)(CV + (size_t)(prow0 + t0 + t) * 256 + lane * 4) = w; } }
    __syncthreads();
}

__device__ __forceinline__ void fnetctx_unit(const Frame& F, int unit, float* scr) {
    const bf16_t* PX = FP(WS_PX, bf16_t); bf16_t* FN = FP(WS_FN, bf16_t);
    const int mh = unit & 1, h = (unit >> 1) & 3, b = unit >> 3; int tid = F.tid; asm volatile("" : "+v"(tid));
    float* zc = scr; float* zs = scr + 8192; float* c64 = scr + 16384; float* s64 = c64 + 64; float* c256 = s64 + 64; float* s256 = c256 + 256;
    if (tid < 64) { const float x = (float)tid * (1.0f / 32.0f); c64[tid] = cospif(x); s64[tid] = sinpif(x); }
    if (tid < 256) { const float x = (float)tid * (1.0f / 128.0f); c256[tid] = cospif(x); s256[tid] = sinpif(x); }
    __syncthreads();
    for (int idx = tid; idx < 8192; idx += NTHREADS) { const int n = idx >> 5, mm = idx & 31, m = mh * 32 + mm; const bf16_t* up = PX + (size_t)(b * 256 + n) * INC + 512 + h * 64;
        float ac = 0.f, as = 0.f;
        for (int j = 0; j < 64; ++j) { const float uv = bf2f(up[j]); const int a = (j * m) & 63; ac += uv * c64[a]; as += uv * s64[a]; }
        zc[idx] = ac; zs[idx] = as; }
    __syncthreads();
    for (int idx = tid; idx < 8192; idx += NTHREADS) { const int k = idx >> 5, mm = idx & 31; float acc = 0.f;
        for (int n = 0; n < 256; ++n) { const int a = (k * n) & 255; acc += c256[a] * zc[n * 32 + mm] - s256[a] * zs[n * 32 + mm]; }
        FN[(size_t)(b * 256 + k) * 256 + h * 64 + mh * 32 + mm] = (bf16_t)f2bf(acc * (1.0f / 128.0f)); }
    __syncthreads();
}
__device__ __forceinline__ void fnetA_unit(const Frame& F, int unit, unsigned char* lds) {
    const bf16_t* PX = FP(WS_PX, bf16_t); const bf16_t* Ct = FP(WS_CTAB, bf16_t); const bf16_t* St = FP(WS_STAB, bf16_t); bf16_t* YB = FP(WS_YB, bf16_t);
    const int oct = unit & 7, h = (unit >> 3) & 3, b = unit >> 5; int tid = F.tid; asm volatile("" : "+v"(tid)); const int lane = tid & 63, fr = lane & 15, fq = lane >> 4; const int n2 = oct * 8 + F.wave;
    bf16x8 ua[4][2];
#pragma unroll
    for (int mi = 0; mi < 4; ++mi)
#pragma unroll
        for (int kk = 0; kk < 2; ++kk) ua[mi][kk] = *(const bf16x8*)(PX + (size_t)(NCTX + b * 4096 + 64 * (16 * mi + fr) + n2) * INC + 512 + h * 64 + kk * 32 + fq * 8);
    bf16x8 zre[2][4], zs[2][4];
#pragma unroll
    for (int ni = 0; ni < 4; ++ni) {
        bf16x8 bc[2], bs[2];
#pragma unroll
        for (int kk = 0; kk < 2; ++kk) { bc[kk] = *(const bf16x8*)(Ct + (16 * ni + fr) * 64 + kk * 32 + fq * 8); bs[kk] = *(const bf16x8*)(St + (16 * ni + fr) * 64 + kk * 32 + fq * 8); }
#pragma unroll
        for (int pr = 0; pr < 2; ++pr) {
            f32x4 c0 = {0.f, 0.f, 0.f, 0.f}, c1 = c0, s0 = c0, s1 = c0;
#pragma unroll
            for (int kk = 0; kk < 2; ++kk) { c0 = mfma16(ua[2 * pr][kk], bc[kk], c0); c1 = mfma16(ua[2 * pr + 1][kk], bc[kk], c1); s0 = mfma16(ua[2 * pr][kk], bs[kk], s0); s1 = mfma16(ua[2 * pr + 1][kk], bs[kk], s1); }
            zre[pr][ni] = pack8(c0, c1); zs[pr][ni] = pack8(s0, s1);
        }
    }
    bf16_t* T = (bf16_t*)lds;
    for (int mi2 = 0; mi2 < 4; ++mi2) {
        bf16x8 cf[2], sf[2], sfn[2];
#pragma unroll
        for (int pr = 0; pr < 2; ++pr) {
            const bf16_t* cp = Ct + (16 * mi2 + fr) * 64 + 32 * pr + 4 * fq; const bf16_t* sp = St + (16 * mi2 + fr) * 64 + 32 * pr + 4 * fq;
            cf[pr] = cat4(*(const u32x2*)cp, *(const u32x2*)(cp + 16)); sf[pr] = cat4(*(const u32x2*)sp, *(const u32x2*)(sp + 16)); sfn[pr] = neg8(sf[pr]);
        }
        float cs[4], sn[4];
#pragma unroll
        for (int j = 0; j < 4; ++j) { const int k1 = 16 * mi2 + 4 * fq + j; const float x = (float)(n2 * k1) * (1.0f / 2048.0f); cs[j] = cospif(x); sn[j] = sinpif(x); }
#pragma unroll
        for (int ni = 0; ni < 4; ++ni) {
            f32x4 yre = {0.f, 0.f, 0.f, 0.f}, yin = yre;
#pragma unroll
            for (int pr = 0; pr < 2; ++pr) { yre = mfma16s(cf[pr], zre[pr][ni], yre); yre = mfma16s(sfn[pr], zs[pr][ni], yre); yin = mfma16s(cf[pr], zs[pr][ni], yin); yin = mfma16s(sf[pr], zre[pr][ni], yin); }
#pragma unroll
            for (int j = 0; j < 4; ++j) { const int k1 = 16 * mi2 + 4 * fq + j; const int m = 16 * ni + fr;
                const float y1 = yre[j] * cs[j] - yin[j] * sn[j], y2 = yin[j] * cs[j] + yre[j] * sn[j];
                T[((0 * 64 + k1) * 64 + m) * 8 + F.wave] = (bf16_t)f2bf(y1); T[((1 * 64 + k1) * 64 + m) * 8 + F.wave] = (bf16_t)f2bf(y2); }
        }
    }
    __syncthreads();
    for (int it = 0; it < 16; ++it) { const int cidx = it * NTHREADS + tid; const int m = cidx & 63, k1 = (cidx >> 6) & 63, plane = cidx >> 12;
        const u32x4 v = *(const u32x4*)(lds + (size_t)cidx * 16);
        *(u32x4*)(YB + ((((size_t)(b * 4 + h) * 64 + k1) * 2 + plane) * 64 + m) * 64 + oct * 8) = v; }
    __syncthreads();
}
__device__ __forceinline__ void fnetB_item(const Frame& F, int item) {
    const bf16_t* Ct = FP(WS_CTAB, bf16_t); const bf16_t* St = FP(WS_STAB, bf16_t); const bf16_t* YB = FP(WS_YB, bf16_t); bf16_t* FN = FP(WS_FN, bf16_t);
    const int k1 = item & 63, h = (item >> 6) & 3, b = item >> 8; int lane = F.lane; asm volatile("" : "+v"(lane)); const int fr = lane & 15, fq = lane >> 4;
    const bf16_t* base = YB + (((size_t)(b * 4 + h) * 64 + k1) * 2) * 4096;
    f32x4 acc[4][4];
#pragma unroll
    for (int mi = 0; mi < 4; ++mi)
#pragma unroll
        for (int ni = 0; ni < 4; ++ni) acc[mi][ni] = f32x4{0.f, 0.f, 0.f, 0.f};
#pragma unroll
    for (int kk = 0; kk < 2; ++kk) {
        bf16x8 bc[4], bsn[4];
#pragma unroll
        for (int ni = 0; ni < 4; ++ni) { bc[ni] = *(const bf16x8*)(Ct + (16 * ni + fr) * 64 + kk * 32 + fq * 8); bsn[ni] = neg8(*(const bf16x8*)(St + (16 * ni + fr) * 64 + kk * 32 + fq * 8)); }
#pragma unroll
        for (int mi = 0; mi < 4; ++mi) {
            const bf16x8 are = *(const bf16x8*)(base + (16 * mi + fr) * 64 + kk * 32 + fq * 8), aim = *(const bf16x8*)(base + 4096 + (16 * mi + fr) * 64 + kk * 32 + fq * 8);
#pragma unroll
            for (int ni = 0; ni < 4; ++ni) { acc[mi][ni] = mfma16(are, bc[ni], acc[mi][ni]); acc[mi][ni] = mfma16s(aim, bsn[ni], acc[mi][ni]); }
        }
    }
#pragma unroll
    for (int mi = 0; mi < 4; ++mi)
#pragma unroll
        for (int ni = 0; ni < 4; ++ni) { const int k = k1 + 64 * (16 * ni + fr); const f32x4 v = acc[mi][ni] * (1.0f / 512.0f);
            u32x2 w; w.x = pk2(v[0], v[1]); w.y = pk2(v[2], v[3]); *(u32x2*)(FN + (size_t)(NCTX + b * 4096 + k) * 256 + h * 64 + 16 * mi + 4 * fq) = w; }
}

template <bool LOCAL>
__device__ __forceinline__ void attn_item(const Frame& F, int l, int item) {
    const bf16_t* PX = FP(WS_PX, bf16_t); const bf16_t* VT = FP(WS_VT, bf16_t); const bf16_t* VTc = FP(WS_VTC, bf16_t); bf16_t* MIX = FP(WS_MIX, bf16_t);
    const float* rpb = PK(16) + l * (4 * 15 * 31);
    int lane = F.lane; asm volatile("" : "+v"(lane)); const int fr = lane & 15, fq = lane >> 4;
    int b, h, r = 0, jb = 0, qrow0;
    if (LOCAL) { h = item & 3; jb = (item >> 2) & 3; r = (item >> 4) & 63; b = item >> 10; qrow0 = NCTX + b * 4096 + r * 64 + jb * 16; }
    else { h = item & 3; const int qb = (item >> 2) & 15; b = item >> 6; qrow0 = b * 256 + qb * 16; }
    constexpr int NT = LOCAL ? 32 : 16;
    const int rs = LOCAL ? min(max(r - 4, 0), 56) : 0; const int kcs = LOCAL ? min(max(16 * jb - 8, 0), 32) : 0;
    bf16x8 qf[2];
#pragma unroll
    for (int kk = 0; kk < 2; ++kk) qf[kk] = *(const bf16x8*)(PX + (size_t)(qrow0 + fr) * INC + 768 + h * 64 + kk * 32 + fq * 8);
    f32x4 s[NT];
#pragma unroll
    for (int t = 0; t < NT; ++t) {
        int krow;
        if (LOCAL && t < 16) krow = NCTX + b * 4096 + (rs + (t >> 1)) * 64 + kcs + (t & 1) * 16 + fr;
        else krow = b * 256 + (t - (LOCAL ? 16 : 0)) * 16 + fr;
        const bf16_t* kp = PX + (size_t)krow * INC + 1024 + h * 64 + fq * 8;
        const bf16x8 k0 = *(const bf16x8*)kp, k1 = *(const bf16x8*)(kp + 32);
        f32x4 a = {0.f, 0.f, 0.f, 0.f}; a = mfma16(k0, qf[0], a); a = mfma16(k1, qf[1], a); s[t] = a;
    }
    float mx = -3.0e38f;
    const int qcol = 16 * jb + fr; const int cstart = min(max(qcol - 8, 0), 48);
#pragma unroll
    for (int t = 0; t < NT; ++t)
#pragma unroll
        for (int j = 0; j < 4; ++j) {
            float v = s[t][j] * 0.125f;
            if (LOCAL && t < 16) { const int kcol = kcs + (t & 1) * 16 + 4 * fq + j; const bool valid = (kcol >= cstart) && (kcol < cstart + 16);
                const int dr = rs + (t >> 1) - r + 7; const int dc = min(max(kcol - qcol + 15, 0), 30);
                v = valid ? v + rpb[(h * 15 + dr) * 31 + dc] : -1.0e30f; }
            s[t][j] = v; mx = fmaxf(mx, v);
        }
    mx = fmaxf(mx, __shfl_xor(mx, 16)); mx = fmaxf(mx, __shfl_xor(mx, 32));
    float sum = 0.f;
#pragma unroll
    for (int t = 0; t < NT; ++t)
#pragma unroll
        for (int j = 0; j < 4; ++j) { const float p = __expf(s[t][j] - mx); s[t][j] = p; sum += p; }
    sum += __shfl_xor(sum, 16); sum += __shfl_xor(sum, 32);
    f32x4 o[4];
#pragma unroll
    for (int di = 0; di < 4; ++di) o[di] = f32x4{0.f, 0.f, 0.f, 0.f};
#pragma unroll
    for (int u = 0; u < NT / 2; ++u) {
        const bf16x8 pb = pack8(s[2 * u], s[2 * u + 1]);
        const bf16_t* vbase; size_t stride;
        if (LOCAL && u < 8) { vbase = VT + (size_t)(b * 256 + h * 64) * 4096 + (rs + u) * 64 + kcs + 4 * fq; stride = 4096; }
        else { const int uu = u - (LOCAL ? 8 : 0); vbase = VTc + (size_t)(b * 256 + h * 64) * 256 + uu * 32 + 4 * fq; stride = 256; }
#pragma unroll
        for (int di = 0; di < 4; ++di) { const bf16_t* vp = vbase + (size_t)(16 * di + fr) * stride; const bf16x8 va = cat4(*(const u32x2*)vp, *(const u32x2*)(vp + 16)); o[di] = mfma16s(va, pb, o[di]); }
    }
    const float inv = 1.0f / sum;
#pragma unroll
    for (int di = 0; di < 4; ++di) { const f32x4 v = o[di] * inv; u32x2 w; w.x = pk2(v[0], v[1]); w.y = pk2(v[2], v[3]);
        *(u32x2*)(MIX + (size_t)(qrow0 + fr) * 768 + 512 + h * 64 + 16 * di + 4 * fq) = w; }
}

__device__ __forceinline__ cplx csel(bool c, cplx a, cplx b) { return cplx{c ? a.re : b.re, c ? a.im : b.im}; }
#define WAITALL() asm volatile("s_waitcnt vmcnt(0) lgkmcnt(0)" ::: "memory")
__device__ __forceinline__ cplx pow_sel(int k, cplx a, cplx a2, cplx a4, cplx a8, cplx a16) {
    cplx r = cplx{1.f, 0.f};
    r = csel((k & 1) != 0, cmul(r, a), r); r = csel((k & 2) != 0, cmul(r, a2), r); r = csel((k & 4) != 0, cmul(r, a4), r); r = csel((k & 8) != 0, cmul(r, a8), r); r = csel((k & 16) != 0, cmul(r, a16), r);
    return r;
}
__device__ __forceinline__ void ssm_consts(float lre, float lim, float dt, cplx& a, cplx& f) {
    const float e = __expf(lre * dt);
    float revs = lim * dt * 0.15915494309189535f; revs -= rintf(revs);
    a = cplx{e * __builtin_amdgcn_cosf(revs), e * __builtin_amdgcn_sinf(revs)};
    const float xr = a.re - 1.0f, xi = a.im, den = __builtin_amdgcn_rcpf(lre * lre + lim * lim);
    f = cplx{(xr * lre + xi * lim) * den, (xi * lre - xr * lim) * den};
}
template <int PASS, int DIR>
__device__ __forceinline__ void ssm_dir(const Frame& F, int lane, int l, int b, int g, int tb, const bf16x8 (&ub)[4], f32x4 (&accy)[4]) {
    const int fr = lane & 15, fq = lane >> 4;
    const int c = DIR == 0 ? tb : (tb < 4 ? 3 - tb : 71 - tb);
    const int pg = (l * 2 + DIR) * 16 + g;
    const float dt = __expf(PK(19)[pg]);
    cplx* Sloc = FP(WS_SLOC, cplx); const cplx* Carry = FP(WS_CARRY, cplx);
    const size_t sbase = ((size_t)((b * 2 + DIR) * 16 + g) * 68 + c) * 64;
    for (int q = 0; q < 4; ++q) {
        bf16x8 are, aim;
        { const int kq = (fq & 1) * 8; const float* pr = PK(20) + ((size_t)pg * 64 + 16 * q + fr) * 16 + kq; const float* pi = PK(21) + ((size_t)pg * 64 + 16 * q + fr) * 16 + kq;
          const f32x4 zz = f32x4{0.f, 0.f, 0.f, 0.f}; const bool on = fq < 2;
          const f32x4 r0 = *(const f32x4*)pr, r1 = *(const f32x4*)(pr + 4), i0 = *(const f32x4*)pi, i1 = *(const f32x4*)(pi + 4);

          are = pack8(on ? r0 : zz, on ? r1 : zz); aim = pack8(on ? i0 : zz, on ? i1 : zz); }
        f32x4 bre[4], bim[4];
        asm volatile("s_nop 7" : "+v"(are), "+v"(aim));
#pragma unroll
        for (int ni = 0; ni < 4; ++ni) { bre[ni] = mfma16(are, ub[ni], f32x4{0.f, 0.f, 0.f, 0.f}); bim[ni] = mfma16(aim, ub[ni], f32x4{0.f, 0.f, 0.f, 0.f}); }
        settle4m(bre[0], bre[1], bre[2], bre[3]); settle4m(bim[0], bim[1], bim[2], bim[3]);
#pragma unroll
        for (int j = 0; j < 4; ++j) {
            const int p = 16 * q + 4 * fq + j;
            const float lre = PK(17)[pg * 64 + p], lim = PK(18)[pg * 64 + p];

            cplx a, f; ssm_consts(lre, lim, dt, a, f);
            const cplx a2 = cmul(a, a), a4 = cmul(a2, a2), a8 = cmul(a4, a4), a16 = cmul(a8, a8);
            if (PASS == 1) {
                cplx Tt;
                if (DIR == 0) { Tt = cplx{bre[0][j], bim[0][j]}; Tt = cmad(cplx{bre[1][j], bim[1][j]}, Tt, a16); Tt = cmad(cplx{bre[2][j], bim[2][j]}, Tt, a16); Tt = cmad(cplx{bre[3][j], bim[3][j]}, Tt, a16); }
                else { Tt = cplx{bre[3][j], bim[3][j]}; Tt = cmad(cplx{bre[2][j], bim[2][j]}, Tt, a16); Tt = cmad(cplx{bre[1][j], bim[1][j]}, Tt, a16); Tt = cmad(cplx{bre[0][j], bim[0][j]}, Tt, a16); }
                const cplx w = pow_sel(DIR == 0 ? 15 - fr : fr, a, a2, a4, a8, a16);
                Tt = cmul(Tt, w);
                Tt.re += __shfl_xor(Tt.re, 1); Tt.im += __shfl_xor(Tt.im, 1); Tt.re += __shfl_xor(Tt.re, 2); Tt.im += __shfl_xor(Tt.im, 2);
                Tt.re += __shfl_xor(Tt.re, 4); Tt.im += __shfl_xor(Tt.im, 4); Tt.re += __shfl_xor(Tt.re, 8); Tt.im += __shfl_xor(Tt.im, 8);
                Tt = cmul(Tt, f);
                if (fr == 0) Sloc[sbase + p] = Tt;
            } else {
                const cplx w = pow_sel(DIR == 0 ? fr + 1 : 16 - fr, a, a2, a4, a8, a16);
                cplx x[4];
#pragma unroll
                for (int ni = 0; ni < 4; ++ni) {
                    cplx v = cmul(f, cplx{bre[ni][j], bim[ni][j]});
#define RLF(x, ln) __builtin_bit_cast(float, __builtin_amdgcn_readlane(__builtin_bit_cast(int, (x)), (ln)))
#define DPPF(x, ctrl) __builtin_bit_cast(float, __builtin_amdgcn_update_dpp(0, __builtin_bit_cast(int, (x)), (ctrl), 0xf, 0xf, true))
#define KS_STEP(d, ad) { cplx y; if (DIR == 0) { y.re = DPPF(v.re, 0x110 + d); y.im = DPPF(v.im, 0x110 + d); v = csel(fr >= d, cmad(v, ad, y), v); } \
                                   else { y.re = DPPF(v.re, 0x100 + d); y.im = DPPF(v.im, 0x100 + d); v = csel(fr + d <= 15, cmad(v, ad, y), v); } }
                    KS_STEP(1, a) KS_STEP(2, a2) KS_STEP(4, a4) KS_STEP(8, a8)
#undef KS_STEP
                    x[ni] = v;
                }
                cplx E = Carry[sbase + p];
#pragma unroll
                for (int bi = 0; bi < 4; ++bi) {
                    const int ni = DIR == 0 ? bi : 3 - bi;
                    const cplx hh = cmad(x[ni], w, E);
                    cplx tot;
                    { constexpr int L0 = DIR == 0 ? 15 : 0;
                      const float r0 = RLF(x[ni].re, L0), r1 = RLF(x[ni].re, L0 + 16), r2 = RLF(x[ni].re, L0 + 32), r3 = RLF(x[ni].re, L0 + 48);
                      const float i0 = RLF(x[ni].im, L0), i1 = RLF(x[ni].im, L0 + 16), i2 = RLF(x[ni].im, L0 + 32), i3 = RLF(x[ni].im, L0 + 48);
                      tot.re = fq == 0 ? r0 : fq == 1 ? r1 : fq == 2 ? r2 : r3; tot.im = fq == 0 ? i0 : fq == 1 ? i1 : fq == 2 ? i2 : i3; }
                    E = cmad(tot, a16, E);
                    bre[ni][j] = hh.re; bim[ni][j] = hh.im;
                }
            }
        }
        if (PASS == 3) {
            const float* cr = PK(22) + ((size_t)pg * 16 + fr) * 64 + 16 * q + 4 * fq; const float* ci = PK(23) + ((size_t)pg * 16 + fr) * 64 + 16 * q + 4 * fq;
            const f32x4 cre = *(const f32x4*)cr; const f32x4 cim = *(const f32x4*)ci;
            const bf16x8 ca = pack8(cre, f32x4{-cim[0], -cim[1], -cim[2], -cim[3]});
#pragma unroll
            for (int ni = 0; ni < 4; ++ni) { bf16x8 hb = pack8(bre[ni], bim[ni]); bf16x8 ca2 = ca; asm volatile("s_nop 7" : "+v"(ca2), "+v"(hb)); accy[ni] = mfma16(ca2, hb, accy[ni]); }
            settle4m(accy[0], accy[1], accy[2], accy[3]);
        }
    }
}
template <int PASS>
__device__ __forceinline__ void ssm_item(const Frame& F, int l_u, int item_u) {
    int l = l_u, item = item_u; asm volatile("" : "+v"(l), "+v"(item));
    const bf16_t* PX = FP(WS_PX, bf16_t);
    int lane = F.lane; asm volatile("" : "+v"(lane)); const int fr = lane & 15, fq = lane >> 4;
    const int tb = item % 68; const int g = (item / 68) & 15; const int b = item / (68 * 16);
    const int prow0 = tb < 4 ? b * 256 + tb * 64 : NCTX + b * 4096 + (tb - 4) * 64;
    bf16x8 ub[4];
#pragma unroll
    for (int ni = 0; ni < 4; ++ni) { const bf16x8 ld = *(const bf16x8*)(PX + (size_t)(prow0 + 16 * ni + fr) * INC + 1536 + g * 16 + (fq & 1) * 8); ub[ni] = fq < 2 ? ld : zero8(); }
    f32x4 accy[4];
#pragma unroll
    for (int ni = 0; ni < 4; ++ni) accy[ni] = f32x4{0.f, 0.f, 0.f, 0.f};

    ssm_dir<PASS, 0>(F, lane, l, b, g, tb, ub, accy);
    ssm_dir<PASS, 1>(F, lane, l, b, g, tb, ub, accy);
    if (PASS == 3) {
        bf16_t* YS = FP(WS_YS, bf16_t); const f32x4 dv = *(const f32x4*)(PK(24) + l * 256 + g * 16 + 4 * fq);
#pragma unroll
        for (int ni = 0; ni < 4; ++ni) { const int row = prow0 + 16 * ni + fr; const f32x4 uv = ld_bf4(PX + (size_t)row * INC + 1536 + g * 16 + 4 * fq);
            const f32x4 y = accy[ni] + dv * uv; u32x2 w; w.x = pk2(y[0], y[1]); w.y = pk2(y[2], y[3]); *(u32x2*)(YS + (size_t)row * 256 + g * 16 + 4 * fq) = w; }
    }
}
__device__ __forceinline__ void ssm_pass2(const Frame& F, int l) {
    const int idx = blockIdx.x * NTHREADS + F.tid; if (idx >= 8192) return;
    const int p = idx & 63, g = (idx >> 6) & 15, dir = (idx >> 10) & 1, b = idx >> 11;
    const int pg = (l * 2 + dir) * 16 + g; const float dt = __expf(PK(19)[pg]);
    const float lre = PK(17)[pg * 64 + p], lim = PK(18)[pg * 64 + p];
    cplx a, f_unused; ssm_consts(lre, lim, dt, a, f_unused);
#pragma unroll
    for (int i = 0; i < 6; ++i) a = cmul(a, a);
    const cplx* Sloc = FP(WS_SLOC, cplx); cplx* Carry = FP(WS_CARRY, cplx);
    const size_t base = ((size_t)((b * 2 + dir) * 16 + g) * 68) * 64 + p;
    cplx E = cplx{0.f, 0.f};
    for (int c0 = 0; c0 < 68; c0 += 4) {
        const cplx s0 = Sloc[base + (size_t)(c0 + 0) * 64], s1 = Sloc[base + (size_t)(c0 + 1) * 64], s2 = Sloc[base + (size_t)(c0 + 2) * 64], s3 = Sloc[base + (size_t)(c0 + 3) * 64];
        Carry[base + (size_t)(c0 + 0) * 64] = E; E = cmad(s0, a, E);
        Carry[base + (size_t)(c0 + 1) * 64] = E; E = cmad(s1, a, E);
        Carry[base + (size_t)(c0 + 2) * 64] = E; E = cmad(s2, a, E);
        Carry[base + (size_t)(c0 + 3) * 64] = E; E = cmad(s3, a, E);
    }
}


constexpr size_t WS_BAR = 512 * 1024;
#define XB_TMO      128
#define XB_XCNT(j)  (256  + 64 * (j))
#define XB_XSUB(j)  (1280 + 64 * (j))
#define XB_XGEN(j)  (2304 + 64 * (j))
#define XB_TOP      3328
#define XB_TOPGEN   3392
#define XCD_BAR_WORDS 3456
#define XB_SPIN_CAP (1u << 18)

__device__ __forceinline__ unsigned xb_ld(unsigned* p)              { return __hip_atomic_load(p, __ATOMIC_RELAXED, __HIP_MEMORY_SCOPE_AGENT); }
__device__ __forceinline__ unsigned xb_add(unsigned* p, unsigned v) { return __hip_atomic_fetch_add(p, v, __ATOMIC_RELAXED, __HIP_MEMORY_SCOPE_AGENT); }
__device__ __forceinline__ unsigned xb_xcc_id() { return (unsigned)__builtin_amdgcn_s_getreg((3 << 11) | 20) & 0xFu; }
#define XB_SPIN(cond, bar) do { unsigned _sp = 0; while (cond) { __builtin_amdgcn_s_sleep(1); \
    if ((++_sp & 255u) == 0u) { if (xb_ld(&(bar)[XB_TMO])) break; if (_sp > XB_SPIN_CAP) { atomicAdd(&(bar)[XB_TMO], 1u); break; } } } } while (0)

struct XcdBarrier {
    unsigned* bar; unsigned x;
    volatile LAS unsigned* st;
};

__device__ __forceinline__ XcdBarrier xcd_barrier_post(unsigned* bar, volatile LAS unsigned* st) {
    XcdBarrier b; b.bar = bar; b.x = xb_xcc_id(); b.st = st;
    if (threadIdx.x == 0) (void)xb_add(&bar[XB_XCNT(b.x)], 1u);
    return b;
}
__device__ __forceinline__ void xcd_barrier_complete(unsigned* bar, unsigned x, unsigned& nloc, unsigned& nx) {
    const unsigned G = gridDim.x * gridDim.y * gridDim.z;
    unsigned sum, cnt, mine, sp = 0u;
    for (;;) {
        sum = 0u; cnt = 0u; mine = 0u;
#pragma unroll
        for (unsigned j = 0; j < 16; ++j) { const unsigned c = xb_ld(&bar[XB_XCNT(j)]); sum += c; cnt += (c > 0u) ? 1u : 0u; mine = (j == x) ? c : mine; }
        if (sum == G) break;
        __builtin_amdgcn_s_sleep(1);
        if ((++sp & 255u) == 0u) { if (xb_ld(&bar[XB_TMO])) break; if (sp > XB_SPIN_CAP) { atomicAdd(&bar[XB_TMO], 1u); break; } }
    }
    nloc = mine > 0u ? mine : 1u; nx = cnt > 0u ? cnt : 1u;
}

__device__ __forceinline__ void xcd_barrier(const XcdBarrier& b) {
    asm volatile("s_waitcnt vmcnt(0)" ::: "memory");
    __syncthreads();
    if (threadIdx.x == 0) {
        unsigned* bar = b.bar;
        __builtin_amdgcn_s_waitcnt(0);
        unsigned nloc = b.st[0], nx = b.st[1];
        if (nloc == 0u) { xcd_barrier_complete(bar, b.x, nloc, nx); b.st[0] = nloc; b.st[1] = nx; }
        const unsigned old = xb_add(&bar[XB_XSUB(b.x)], 1u);
        const unsigned gen = old / nloc;
        if (old + 1u == (gen + 1u) * nloc) {
            __builtin_amdgcn_fence(__ATOMIC_RELEASE, "agent");
            asm volatile("s_waitcnt vmcnt(0)" ::: "memory");
            const unsigned og = xb_add(&bar[XB_TOP], 1u);
            const unsigned tg = og / nx;
            if (og + 1u == (tg + 1u) * nx) xb_add(&bar[XB_TOPGEN], 1u);
            else XB_SPIN(xb_ld(&bar[XB_TOPGEN]) == tg, bar);
            __builtin_amdgcn_fence(__ATOMIC_ACQUIRE, "agent");
            xb_add(&bar[XB_XGEN(b.x)], 1u);
            asm volatile("s_waitcnt vmcnt(0)" ::: "memory");
        } else {
            XB_SPIN(xb_ld(&bar[XB_XGEN(b.x)]) == gen, bar);
            __builtin_amdgcn_fence(__ATOMIC_ACQUIRE, "agent");
            asm volatile("s_waitcnt vmcnt(0)" ::: "memory");
        }
    }
    __syncthreads();
}
enum : unsigned { W_PREP1 = 1u << 0, W_GIN = 1u << 1, W_GVT = 1u << 2, W_FC = 1u << 3, W_FA = 1u << 4, W_CV = 1u << 5, W_ATT = 1u << 6, W_SSM1 = 1u << 7, W_GPW = 1u << 8,
                  W_P2 = 1u << 9, W_FB = 1u << 10, W_GFW = 1u << 11, W_SSM3 = 1u << 12, W_GGLU = 1u << 13, W_GN = 1u << 14, W_GOUT = 1u << 15, W_PREP3 = 1u << 16, W_GFF1 = 1u << 17, W_GFF2 = 1u << 18 };
#ifndef PH_FINE
#define PH_FINE 0
#endif
#if PH_FINE
constexpr int NSP = 18;
__host__ __device__ __forceinline__ unsigned phase_mask(int sp) {
    switch (sp) { case 0: return W_PREP1; case 1: return W_GIN; case 2: return W_GVT; case 3: return W_FC; case 4: return W_FA; case 5: return W_CV; case 6: return W_ATT; case 7: return W_SSM1;
                  case 8: return W_GPW; case 9: return W_P2 | W_FB; case 10: return W_GFW; case 11: return W_SSM3; case 12: return W_GGLU; case 13: return W_GN; case 14: return W_GOUT;
                  case 15: return W_PREP3; case 16: return W_GFF1; default: return W_GFF2; }
}
#else
constexpr int NSP = 11;
__host__ __device__ __forceinline__ unsigned phase_mask(int sp) {
    switch (sp) { case 0: return W_PREP1; case 1: return W_GIN | W_GVT; case 2: return W_FA | W_CV | W_ATT | W_SSM1; case 3: return W_GPW | W_P2 | W_FB | W_FC;
                  case 4: return W_GFW | W_SSM3; case 5: return W_GGLU; case 6: return W_GN; case 7: return W_GOUT; case 8: return W_PREP3; case 9: return W_GFF1; default: return W_GFF2; }
}
#endif
constexpr int NPH = 2 + 2 * NSP;
#ifndef ZP1
#define ZP1 12
#define ZP2 30
#endif
#define OPQ_S(x) asm volatile("" : "+s"(x))
#define GSYNC() xcd_barrier(xb)
__global__ void __launch_bounds__(NTHREADS, 2) fwd(Args args) {
    extern __shared__ __attribute__((aligned(16))) unsigned char lds[];

    cg::grid_group grid = cg::this_grid();
    const int tid_ = threadIdx.x;
    const int wave_ = __builtin_amdgcn_readfirstlane(tid_ >> 6);
    float* scr = (float*)lds;
    const int G = gridDim.x, bx = blockIdx.x;
    const int gw = bx * 8 + wave_, nw = G * 8;
    const int lo = args.ph_lo, hi = args.ph_hi;
    if (lo < 0) grid.sync();
    volatile LAS unsigned* xb_st = (volatile LAS unsigned*)((LAS unsigned char*)lds + (LDS_BYTES - 64));
    if (tid_ == 0) { xb_st[0] = 0u; xb_st[1] = 0u; }
    __syncthreads();
    const XcdBarrier xb = xcd_barrier_post((unsigned*)(args.ws + WS_BAR), xb_st);
    if (lo == 0) { const Frame F{args, args.out, args.ws, tid_, tid_ & 63, wave_}; p0_prologue(F, scr); if (hi > 1) GSYNC(); }
#pragma nounroll
    for (int ph0 = (lo == 0 ? 1 : lo); ph0 < hi; ++ph0) {
        int ph = ph0; OPQ_S(ph);
        int tidv = tid_; asm volatile("" : "+v"(tidv));
        __attribute__((address_space(1))) unsigned char* wsg = (__attribute__((address_space(1))) unsigned char*)args.ws; __attribute__((address_space(1))) float* outg = (__attribute__((address_space(1))) float*)args.out;
        OPQ_S(wsg); OPQ_S(outg);
        unsigned char* wsv = (unsigned char*)wsg; float* outv = (float*)outg;
        const Frame F{args, outv, wsv, tidv, tidv & 63, wave_};
        if (ph == NPH - 1) { final_norm(F); continue; }
        const int l = (ph - 1) / NSP; const int sp = (ph - 1) - l * NSP;
        const unsigned wm = phase_mask(sp);
        const int row_lo = l == 0 ? 0 : NCTX;
        const int M_post = T_ALL - row_lo;
        unsigned char* wl = F.ws + WS_W + (size_t)l * W_LAYER;
#pragma nounroll
        for (int kind = 0; kind < 8; ++kind) {
            const unsigned bit = kind == 0 ? W_GIN : kind == 1 ? W_GVT : kind == 2 ? W_GPW : kind == 3 ? W_GFW : kind == 4 ? W_GGLU : kind == 5 ? W_GFF1 : kind == 6 ? W_GOUT : W_GFF2;
            if (!(wm & bit)) continue;
            const bf16_t* A; const bf16_t* Bt; int M, N, K;
            if (kind == 0) { A = FP(WS_XN, bf16_t); Bt = (const bf16_t*)(wl + W_IN); M = T_ALL; N = INC; K = DM; }
            else if (kind == 1) { A = (const bf16_t*)(wl + W_IN) + (size_t)1280 * DM; Bt = FP(WS_XN, bf16_t); M = 256; N = T_ALL; K = DM; }
            else if (kind == 2) { A = FP(WS_CV, bf16_t) + (size_t)row_lo * 256; Bt = (const bf16_t*)(wl + W_PW); M = M_post; N = 256; K = 256; }
            else if (kind == 3) { A = FP(WS_FN, bf16_t) + (size_t)row_lo * 256; Bt = (const bf16_t*)(wl + W_F); M = M_post; N = 256; K = 256; }
            else if (kind == 4) { A = FP(WS_YS, bf16_t) + (size_t)row_lo * 256; Bt = (const bf16_t*)(wl + W_GLU); M = M_post; N = 512; K = 256; }
            else if (kind == 5) { A = FP(WS_XN, bf16_t) + (size_t)row_lo * DM; Bt = (const bf16_t*)(wl + W_1); M = M_post; N = FFD; K = DM; }
            else if (kind == 6) { A = FP(WS_XN, bf16_t) + (size_t)row_lo * DM; Bt = (const bf16_t*)(wl + W_OUT); M = M_post; N = DM; K = DM; }
            else { A = FP(WS_H, bf16_t) + (size_t)row_lo * FFD; Bt = (const bf16_t*)(wl + W_2); M = M_post; N = DM; K = FFD; }
            pg8::Gemm g{A, Bt, M, N, K}; pg8::StaticOrder S; S.init(M, N, G, bx);
            EpiU E{F, l, kind, row_lo};
            pg8::gemm_phase<EpiU, pg8::StaticOrder, true, true>((PG8_LAS unsigned char*)lds, g, S, E);
        }
        if (wm & (W_FC | W_FA | W_CV)) {
            const int n_fc = (l == 0 && (wm & W_FC)) ? 32 : 0, n_fa = (wm & W_FA) ? 128 : 0, n_cv = (wm & W_CV) ? (l == 0 ? 544 : 512) : 0; const int nbu = n_fc + n_fa + n_cv;
            const int ustart = (n_fa + n_cv == 0) ? (G - 1 - bx) : bx;
#pragma nounroll
            for (int u = ustart; u < nbu; u += G) {
                if (u < n_fc) fnetctx_unit(F, u, scr);
                else if (u < n_fc + n_fa) fnetA_unit(F, u - n_fc, lds);
                else conv_unit(F, l, u - n_fc - n_fa, scr);
            }
        }
        if (wm & W_P2) ssm_pass2(F, l);
        if (wm & W_SSM3) {
#pragma nounroll
            for (int it = gw; it < 4096; it += nw) ssm_item<3>(F, l, it);
#pragma nounroll
            for (int it = 4096 + gw; it < 4352; it += nw) ssm_item<3>(F, l, it);
        }
        if (wm & (W_ATT | W_SSM1 | W_FB)) {
            const int n_ac = (l == 0 && (wm & W_ATT)) ? 256 : 0, n_al = (wm & W_ATT) ? 4096 : 0, n_s1 = (wm & W_SSM1) ? 4352 : 0, n_fb = (wm & W_FB) ? 1024 : 0, n_s3 = 0;
            const int e0 = n_ac, e1 = e0 + n_al, e2 = e1 + n_s1, e3 = e2 + n_fb, e4 = e3 + n_s3;
#pragma nounroll
            for (int it = gw; it < e4; it += nw) {
                if (it < e0) attn_item<false>(F, l, it);
                else if (it < e1) attn_item<true>(F, l, it - e0);
                else if (it < e2) ssm_item<1>(F, l, it - e1);
                else if (it < e3) fnetB_item(F, it - e2);
                else { ssm_item<3>(F, l, it - e3); }
            }
        }
        if (wm & W_PREP1) prep_norm_mod(F, l == 0 ? F.A.in[2] : FP(WS_XC, float), l == 0 ? F.A.in[0] : F.out, PK(6) + l * DM, FP(WS_MOD, float) + l * 5 * 6144, 0, 1024, FP(WS_XN, bf16_t), 0);
        if (wm & W_GN) prep_group(F, l, row_lo);
        if (wm & W_PREP3) prep_norm_mod(F, FP(WS_XC, float), F.out, PK(30) + l * DM, FP(WS_MOD, float) + l * 5 * 6144, 3072, 4096, FP(WS_XN, bf16_t), row_lo);
        if (ph0 + 1 < hi) GSYNC();
    }
}

extern "C" void kernel_launch(void* const* d_in, const int* in_sizes, int n_in, void* d_out, int out_size, void* d_ws, size_t ws_size, hipStream_t stream) {
    static int grid = 0;
    if (grid == 0) {
        if (n_in != 36 || ws_size < WS_END) { fprintf(stderr, "kernel_launch: unexpected n_in %d / ws %zu\n", n_in, ws_size); grid = -1; return; }
        int dev = 0, cus = 0, per_cu = 0;
        (void)hipGetDevice(&dev); (void)hipDeviceGetAttribute(&cus, hipDeviceAttributeMultiprocessorCount, dev);
        (void)hipFuncSetAttribute((const void*)fwd, hipFuncAttributeMaxDynamicSharedMemorySize, LDS_BYTES);
        (void)hipOccupancyMaxActiveBlocksPerMultiprocessor(&per_cu, (const void*)fwd, NTHREADS, LDS_BYTES);
        (void)hipGetLastError();
        grid = cus > 0 ? cus : 256;
    }
    if (grid < 0) return;
    Args a{};
    for (int i = 0; i < 36; ++i) a.in[i] = (const float*)d_in[i];
    a.out = (float*)d_out; a.ws = (unsigned char*)d_ws;
#if MODE_COOP
    (void)hipMemsetAsync((unsigned char*)d_ws + WS_BAR, 0, 16384, stream);
    a.ph_lo = 0; a.ph_hi = NPH; a.part = 15;
    void* kargs[] = {&a};
    hipError_t e = hipLaunchCooperativeKernel((const void*)fwd, dim3(grid), dim3(NTHREADS), kargs, LDS_BYTES, stream);
    if (e != hipSuccess) fprintf(stderr, "cooperative launch failed: %s (grid %d)\n", hipGetErrorString(e), grid);
#else
    for (int ph = 0; ph < NPH; ++ph) { a.ph_lo = ph; a.ph_hi = ph + 1; a.part = 15; hipLaunchKernelGGL(fwd, dim3(grid), dim3(NTHREADS), LDS_BYTES, stream, a); }
#endif
}
```

```cpp
#include <hip/hip_runtime.h>
#include <hip/hip_cooperative_groups.h>
#include <cstdio>
#include <cstdint>
namespace cg = cooperative_groups;
#ifndef MODE_COOP
#define MODE_COOP 1
#endif
namespace pg8 {
#define PG8_LAS __attribute__((address_space(3)))
typedef unsigned short bf16_t;
typedef short bf16x8 __attribute__((ext_vector_type(8)));
typedef float f32x4 __attribute__((ext_vector_type(4)));
typedef unsigned u32x4 __attribute__((ext_vector_type(4)));
constexpr int BM = 256, BK = 64, HALF = 128, HTB = HALF * BK * 2  , STAGE_BYTES = 8 * HTB, NXCD = 8, WGM = 8;

__host__ __device__ __forceinline__ int lds_byte(int r, int c) { const int st = (r >> 4) * 2 + (c >> 5), rr = r & 15, cc = c & 31, ob = rr * 64 + cc * 2; return st * 1024 + (ob ^ (((ob >> 9) & 1) << 5)); }
__host__ __device__ __forceinline__ void stage_rc(int b, int& R, int& C) { const int st = b / 1024, sb = b % 1024, swz = sb ^ (((sb >> 9) & 1) << 5); R = (st >> 1) * 16 + swz / 64; C = (st & 1) * 32 + (swz % 64) / 2; }
__host__ __device__ __forceinline__ int perm32(int rho) { const int n = rho >> 4, i = rho & 15; return 8 * (i >> 2) + 4 * n + (i & 3); }

struct Unit { int pm, pn; };
struct Gemm { const bf16_t* A; const bf16_t* Bt; int M, N, K; };

struct StaticOrder {
    int nM, nN, nwg, G, c;
    __host__ __device__ void init(int M, int N, int G_, int c_) { nM = M / BM; nN = N / BM; nwg = nM * nN; G = G_; c = c_; }
    __host__ __device__ bool next(int i, Unit& u) const {
        const long L = (long)i * G + c; if (L >= nwg) return false;
        int wgid = (int)L; { const int q = nwg / NXCD, r = nwg % NXCD, xcd = wgid % NXCD, off = wgid / NXCD; wgid = (xcd < r ? xcd * (q + 1) : r * (q + 1) + (xcd - r) * q) + off; }
        const int nig = WGM * nN, gid = wgid / nig, fm = gid * WGM, gsz = (nM - fm) < WGM ? (nM - fm) : WGM;
        u.pm = fm + ((wgid % nig) % gsz); u.pn = (wgid % nig) / gsz; return true;
    }
    __device__ __forceinline__ void a_ready(const Unit&) const {}
    __device__ __forceinline__ void done(const Unit&) const {}
};

}
namespace pg8 {
template <class Epi, class Sched, bool ALIGN_EPI = false, bool SP2 = false>
__device__ __forceinline__ void gemm_phase(PG8_LAS unsigned char* lds, const Gemm g, const Sched& S, const Epi& E) {
    const int tid = threadIdx.x, wid = __builtin_amdgcn_readfirstlane(tid >> 6), lane = tid & 63, wr = wid >> 2, wc = wid & 3, fr = lane & 15, fq = lane >> 4;
    const int K = g.K, nt = K / BK;
    unsigned voffA[2], voffB[2];
#pragma unroll
    for (int i = 0; i < 2; ++i) { int R, C; stage_rc(tid * 16 + i * 8192, R, C); const int Rb = Epi::PERM ? ((R & ~31) + perm32(R & 31)) : R;
        voffA[i] = (unsigned)(R * K + C) * 2u; voffB[i] = (unsigned)(Rb * K + C) * 2u; }
    const size_t kstep = (size_t)(BK * 2);
    const size_t hstep = (size_t)HALF * K * 2;
    const size_t tstep = 2 * hstep;
    const unsigned ldsw = (unsigned)wid * 1024u;
    const int aoff = lds_byte(wr * 64 + fr, fq * 8), boff = lds_byte(wc * 32 + fr, fq * 8);
#define PG8_SA(b, h) (((b) * 2 + (h)) * HTB)
#define PG8_SB(b, h) ((4 + (b) * 2 + (h)) * HTB)
#define PG8_STAGE(bufoff, gbase, voff) do { _Pragma("unroll") for (int _i = 0; _i < 2; ++_i) \
        __builtin_amdgcn_global_load_lds((const unsigned*)((const char*)(gbase) + (voff)[_i]), (PG8_LAS unsigned*)(lds + (bufoff) + ldsw + _i * 8192), 16, 0, 0); } while (0)
#define PG8_LDA(dst, b, h) do { _Pragma("unroll") for (int m = 0; m < 4; ++m) _Pragma("unroll") for (int k = 0; k < 2; ++k) dst[m][k] = *(const PG8_LAS bf16x8*)(lds + PG8_SA(b, h) + aoff + m * 2048 + k * 1024); } while (0)
#define PG8_LDB(dst, b, h) do { _Pragma("unroll") for (int n = 0; n < 2; ++n) _Pragma("unroll") for (int k = 0; k < 2; ++k) dst[n][k] = *(const PG8_LAS bf16x8*)(lds + PG8_SB(b, h) + boff + n * 2048 + k * 1024); } while (0)
#define PG8_MMA(ai, bj, At, Bt) do { __builtin_amdgcn_s_setprio(1); _Pragma("unroll") for (int m = 0; m < 4; ++m) _Pragma("unroll") for (int n = 0; n < 2; ++n) _Pragma("unroll") for (int k = 0; k < 2; ++k) \
        acc[ai][bj][m][n] = __builtin_amdgcn_mfma_f32_16x16x32_bf16(Bt[n][k], At[m][k], acc[ai][bj][m][n], 0, 0, 0); __builtin_amdgcn_s_setprio(0); } while (0)
#define PG8_WAIT_V(n) asm volatile("s_waitcnt vmcnt(" #n ")" ::: "memory")
#define PG8_WAIT_L(n) asm volatile("s_waitcnt lgkmcnt(" #n ")" ::: "memory")
#define PG8_BAR __builtin_amdgcn_s_barrier()
#define PG8_SCHED __builtin_amdgcn_sched_barrier(0)
    Unit cur, nxt; int ui = 0;
    if (!S.next(0, cur)) return;
    f32x4 acc[2][2][4][2];
#pragma unroll
    for (int a = 0; a < 2; ++a)
#pragma unroll
        for (int b = 0; b < 2; ++b)
#pragma unroll
            for (int m = 0; m < 4; ++m)
#pragma unroll
                for (int n = 0; n < 2; ++n) acc[a][b][m][n] = (f32x4){0.f, 0.f, 0.f, 0.f};
    bf16x8 At[4][2], B0[2][2], B1[2][2];
    const char* cA = (const char*)g.A + (size_t)cur.pm * tstep; const char* cB = (const char*)g.Bt + (size_t)cur.pn * tstep;
    S.a_ready(cur);
    if constexpr (SP2) {
        PG8_STAGE(PG8_SB(0, 0), cB, voffB); PG8_STAGE(PG8_SB(0, 1), cB + hstep, voffB); PG8_STAGE(PG8_SA(0, 0), cA, voffA); PG8_STAGE(PG8_SA(0, 1), cA + hstep, voffA);
        if (wr == 1) PG8_BAR;
        PG8_WAIT_V(2); PG8_BAR;
        PG8_STAGE(PG8_SB(1, 0), cB + kstep, voffB); PG8_STAGE(PG8_SA(1, 0), cA + kstep, voffA); PG8_STAGE(PG8_SB(1, 1), cB + hstep + kstep, voffB);
        PG8_WAIT_V(6); PG8_BAR;
    } else {
        PG8_STAGE(PG8_SB(0, 0), cB, voffB); PG8_STAGE(PG8_SA(0, 0), cA, voffA); PG8_STAGE(PG8_SB(0, 1), cB + hstep, voffB); PG8_STAGE(PG8_SA(0, 1), cA + hstep, voffA);
        if (wr == 1) PG8_BAR;
        PG8_WAIT_V(4); PG8_BAR;
        PG8_STAGE(PG8_SB(1, 0), cB + kstep, voffB); PG8_STAGE(PG8_SA(1, 0), cA + kstep, voffA); PG8_STAGE(PG8_SB(1, 1), cB + hstep + kstep, voffB);
        PG8_WAIT_V(6); PG8_BAR;
    }
    for (;;) {
        const bool has_next = S.next(ui + 1, nxt);
        const char* nA = has_next ? (const char*)g.A + (size_t)nxt.pm * tstep : cA; const char* nB = has_next ? (const char*)g.Bt + (size_t)nxt.pn * tstep : cB;
        for (int t = 0; t < nt; t += 2) {
            const bool last = (t == nt - 2);
            const char* a1 = cA + (size_t)(t + 1) * kstep;
            const char* a2 = last ? nA : cA + (size_t)(t + 2) * kstep; const char* b2 = last ? nB : cB + (size_t)(t + 2) * kstep;
            const char* a3 = a2 + kstep; const char* b3 = b2 + kstep;
            if (last && has_next) S.a_ready(nxt);
            if constexpr (SP2) {
            PG8_LDB(B0, 0, 0); PG8_LDB(B1, 0, 1); PG8_SCHED; PG8_LDA(At, 0, 0); PG8_STAGE(PG8_SA(1, 1), a1 + hstep, voffA);
            PG8_WAIT_V(8); PG8_WAIT_L(0); PG8_BAR; PG8_MMA(0, 0, At, B0); PG8_MMA(0, 1, At, B1); PG8_BAR; PG8_SCHED;
            PG8_LDA(At, 0, 1); PG8_STAGE(PG8_SB(0, 0), b2, voffB); PG8_STAGE(PG8_SB(0, 1), b2 + hstep, voffB); PG8_STAGE(PG8_SA(0, 0), a2, voffA);
            PG8_WAIT_V(8); PG8_WAIT_L(0); PG8_BAR; PG8_MMA(1, 0, At, B0); PG8_MMA(1, 1, At, B1); PG8_BAR; PG8_SCHED;
            PG8_LDB(B0, 1, 0); PG8_LDB(B1, 1, 1); PG8_SCHED; PG8_LDA(At, 1, 0); PG8_STAGE(PG8_SA(0, 1), a2 + hstep, voffA);
            PG8_WAIT_V(8); PG8_WAIT_L(0); PG8_BAR; PG8_MMA(0, 0, At, B0); PG8_MMA(0, 1, At, B1); PG8_BAR; PG8_SCHED;
            PG8_LDA(At, 1, 1); PG8_STAGE(PG8_SB(1, 0), b3, voffB); PG8_STAGE(PG8_SB(1, 1), b3 + hstep, voffB); PG8_STAGE(PG8_SA(1, 0), a3, voffA);
            PG8_WAIT_V(8); PG8_WAIT_L(0); PG8_BAR; PG8_MMA(1, 0, At, B0); PG8_MMA(1, 1, At, B1); PG8_BAR; PG8_SCHED;
            } else {
            PG8_LDB(B0, 0, 0); PG8_SCHED; PG8_LDA(At, 0, 0); PG8_STAGE(PG8_SA(1, 1), a1 + hstep, voffA);
            PG8_WAIT_L(8); PG8_BAR; PG8_WAIT_L(0); PG8_MMA(0, 0, At, B0); PG8_BAR; PG8_SCHED;
            PG8_LDB(B1, 0, 1); PG8_STAGE(PG8_SB(0, 0), b2, voffB);
            PG8_BAR; PG8_WAIT_L(0); PG8_MMA(0, 1, At, B1); PG8_BAR;
            PG8_LDA(At, 0, 1); PG8_STAGE(PG8_SA(0, 0), a2, voffA);
            PG8_BAR; PG8_WAIT_L(0); PG8_MMA(1, 0, At, B0); PG8_BAR; PG8_SCHED;
            PG8_STAGE(PG8_SB(0, 1), b2 + hstep, voffB);
            PG8_WAIT_V(6); PG8_BAR; PG8_MMA(1, 1, At, B1); PG8_BAR;
            PG8_LDB(B0, 1, 0); PG8_SCHED; PG8_LDA(At, 1, 0); PG8_STAGE(PG8_SA(0, 1), a2 + hstep, voffA);
            PG8_WAIT_L(8); PG8_BAR; PG8_WAIT_L(0); PG8_MMA(0, 0, At, B0); PG8_BAR; PG8_SCHED;
            PG8_LDB(B1, 1, 1); PG8_STAGE(PG8_SB(1, 0), b3, voffB);
            PG8_BAR; PG8_WAIT_L(0); PG8_MMA(0, 1, At, B1); PG8_BAR;
            PG8_LDA(At, 1, 1); PG8_STAGE(PG8_SA(1, 0), a3, voffA);
            PG8_BAR; PG8_WAIT_L(0); PG8_MMA(1, 0, At, B0); PG8_BAR; PG8_SCHED;
            PG8_STAGE(PG8_SB(1, 1), b3 + hstep, voffB);
            PG8_WAIT_V(6); PG8_BAR; PG8_MMA(1, 1, At, B1); PG8_BAR;
            }
        }
        if constexpr (ALIGN_EPI) { if (wr == 0) PG8_BAR; }
        if constexpr (!Epi::AFTER_DRAIN) { E(acc, cur, wr, wc, fr, fq); S.done(cur); }
        if (!has_next) break;
#pragma unroll
        for (int a = 0; a < 2; ++a)
#pragma unroll
            for (int b = 0; b < 2; ++b)
#pragma unroll
                for (int m = 0; m < 4; ++m)
#pragma unroll
                    for (int n = 0; n < 2; ++n) acc[a][b][m][n] = (f32x4){0.f, 0.f, 0.f, 0.f};
        cur = nxt; cA = nA; cB = nB; ++ui;
        if constexpr (ALIGN_EPI) { if (wr == 1) PG8_BAR; }
    }
    PG8_WAIT_V(0);
    if constexpr (!ALIGN_EPI) { if (wr == 0) PG8_BAR; }
    PG8_BAR;
    if constexpr (Epi::AFTER_DRAIN) { E.fused(acc, cur, wr, wc, fr, fq, lds, wid, lane); S.done(cur); }
#undef PG8_SA
#undef PG8_SB
#undef PG8_STAGE
#undef PG8_LDA
#undef PG8_LDB
#undef PG8_MMA
#undef PG8_WAIT_V
#undef PG8_WAIT_L
#undef PG8_BAR
#undef PG8_SCHED
}
}

using pg8::bf16_t; using pg8::bf16x8; using pg8::f32x4;
#define LAS __attribute__((address_space(3)))
typedef short bf16x4 __attribute__((ext_vector_type(4)));
typedef unsigned u32x4 __attribute__((ext_vector_type(4)));
typedef unsigned u32x2 __attribute__((ext_vector_type(2)));

constexpr int NTHREADS = 512;
constexpr int T_ALL = 17408, NCTX = 1024, NLAT = 16384, DM = 1024, INC = 1792, FFD = 4096;
constexpr int LDS_BYTES = 147456;
constexpr float EPS = 1e-6f;

constexpr size_t MiB = 1u << 20;
constexpr size_t WS_MOD = 0;
constexpr size_t WS_CTAB = 256 * 1024;
constexpr size_t WS_STAB = 256 * 1024 + 8192;
constexpr size_t WS_PACK = 1 * MiB;
constexpr size_t WS_SLOC = 3 * MiB;
constexpr size_t WS_CARRY = 7 * MiB + 256 * 1024;
constexpr size_t WS_W = 12 * MiB;
constexpr size_t W_IN = 0, W_PW = W_IN + (size_t)INC * DM * 2, W_F = W_PW + 256 * 256 * 2, W_GLU = W_F + 256 * 256 * 2,
                 W_OUT = W_GLU + 512 * 256 * 2, W_1 = W_OUT + (size_t)DM * DM * 2, W_2 = W_1 + (size_t)FFD * DM * 2, W_LAYER = W_2 + (size_t)FFD * DM * 2;
static_assert(W_LAYER == 22 * MiB, "weights per layer");
constexpr size_t WS_XC = 56 * MiB;
constexpr size_t WS_XN = 60 * MiB;
constexpr size_t WS_BIG = 94 * MiB;
constexpr size_t WS_H = WS_BIG;
constexpr size_t WS_PX = WS_BIG;
constexpr size_t WS_VT = 154 * MiB;
constexpr size_t WS_VTC = 162 * MiB;
constexpr size_t WS_CV = 163 * MiB;
constexpr size_t WS_YB = 172 * MiB;
constexpr size_t WS_FN = 188 * MiB;
constexpr size_t WS_YS = 197 * MiB;
constexpr size_t WS_ZS = 206 * MiB;
constexpr size_t WS_MIX = 223 * MiB;
constexpr size_t WS_END = 256 * MiB;
static_assert(WS_H + (size_t)T_ALL * FFD * 2 <= WS_END && WS_MIX + (size_t)T_ALL * 768 * 2 <= WS_END && WS_PX + (size_t)T_ALL * INC * 2 <= WS_VT, "ws map");

__device__ __forceinline__ unsigned f2bf(float f) { unsigned u = __builtin_bit_cast(unsigned, f); return (u + 0x7fffu + ((u >> 16) & 1u)) >> 16; }
__device__ __forceinline__ unsigned pk2(float lo, float hi) { return f2bf(lo) | (f2bf(hi) << 16); }
__device__ __forceinline__ float bf2f(unsigned h) { return __builtin_bit_cast(float, (h & 0xffffu) << 16); }
__device__ __forceinline__ float bflo(unsigned w) { return __builtin_bit_cast(float, w << 16); }
__device__ __forceinline__ float bfhi(unsigned w) { return __builtin_bit_cast(float, w & 0xffff0000u); }
__device__ __forceinline__ bf16x8 pack8(f32x4 a, f32x4 b) {
    u32x4 w; w.x = pk2(a[0], a[1]); w.y = pk2(a[2], a[3]); w.z = pk2(b[0], b[1]); w.w = pk2(b[2], b[3]);
    return __builtin_bit_cast(bf16x8, w);
}
__device__ __forceinline__ bf16x8 neg8(bf16x8 v) { u32x4 w = __builtin_bit_cast(u32x4, v); w.x ^= 0x80008000u; w.y ^= 0x80008000u; w.z ^= 0x80008000u; w.w ^= 0x80008000u; return __builtin_bit_cast(bf16x8, w); }
__device__ __forceinline__ bf16x8 zero8() { u32x4 w = {0u, 0u, 0u, 0u}; return __builtin_bit_cast(bf16x8, w); }
__device__ __forceinline__ bf16x8 cat4(u32x2 a, u32x2 b) { u32x4 w; w.x = a.x; w.y = a.y; w.z = b.x; w.w = b.y; return __builtin_bit_cast(bf16x8, w); }
__device__ __forceinline__ f32x4 mfma16(bf16x8 a, bf16x8 b, f32x4 c) { return __builtin_amdgcn_mfma_f32_16x16x32_bf16(a, b, c, 0, 0, 0); }
__device__ __forceinline__ void settle4(f32x4& a, f32x4& b, f32x4& c, f32x4& d) { asm volatile("s_nop 15\n\ts_nop 15" : "+v"(a), "+v"(b), "+v"(c), "+v"(d)); }
__device__ __forceinline__ void settle4m(f32x4& a, f32x4& b, f32x4& c, f32x4& d) { asm volatile("s_nop 7\n\ts_nop 7" : "+v"(a), "+v"(b), "+v"(c), "+v"(d) :: "memory"); }
__device__ __forceinline__ f32x4 mfma16s(bf16x8 a, bf16x8 b, f32x4 c) { asm volatile("s_nop 7" : "+v"(a), "+v"(b)); return __builtin_amdgcn_mfma_f32_16x16x32_bf16(a, b, c, 0, 0, 0); }
__device__ __forceinline__ void settle2(f32x4& a, f32x4& b) { asm volatile("s_nop 15\n\ts_nop 15" : "+v"(a), "+v"(b)); }
__device__ __forceinline__ void settle_in(bf16x8& a, bf16x8& b) { asm volatile("s_nop 3" : "+v"(a), "+v"(b)); }
__device__ __forceinline__ float wave_sum(float v) {
    v += __shfl_xor(v, 1); v += __shfl_xor(v, 2); v += __shfl_xor(v, 4); v += __shfl_xor(v, 8); v += __shfl_xor(v, 16); v += __shfl_xor(v, 32); return v;
}
__device__ __forceinline__ float sigmoidf_(float x) { return 1.0f / (1.0f + __expf(-x)); }
struct cplx { float re, im; };
__device__ __forceinline__ cplx cmul(cplx a, cplx b) { return cplx{a.re * b.re - a.im * b.im, a.re * b.im + a.im * b.re}; }
__device__ __forceinline__ cplx cmad(cplx acc, cplx a, cplx b) { return cplx{acc.re + a.re * b.re - a.im * b.im, acc.im + a.re * b.im + a.im * b.re}; }

struct Args { const float* in[36]; float* out; unsigned char* ws; int ph_lo, ph_hi, part, pad; };
struct Frame {
    const Args& A;
    float* out; unsigned char* ws;
    int tid, lane, wave;
};
#define FP(off, type) ((type*)(F.ws + (off)))

constexpr int PK_N = 23;
constexpr int PK_IDX[PK_N] = {6,8,9,10,11,13,15,16,17,18,19,20,21,22,23,24,26,27,29,30,32,34,35};
constexpr int PK_CNT[PK_N] = {2048,15872,512,512,512,512,512,3720,4096,4096,64,65536,65536,65536,65536,512,1024,2048,2048,2048,8192,2048,1024};
constexpr int pk_off(int k) { int o = 0; for (int i = 0; i < PK_N; ++i) { if (PK_IDX[i] == k) return o; o += PK_CNT[i]; } return -1; }
#define PK(k) (FP(WS_PACK, float) + pk_off(k))
static_assert(pk_off(35) + 1024 <= (int)(2 * MiB / 4), "pack size");

struct EpiU {
    static constexpr bool PERM = false, AFTER_DRAIN = false;
    const Frame& F; int l; int kind; int row_lo;
    __device__ __forceinline__ void operator()(const f32x4 (&acc)[2][2][4][2], const pg8::Unit& u, int wr, int wc, int fr, int fq) const {
        const int c0 = u.pn * 256 + wc * 32 + fq * 4;
        const int r0 = u.pm * 256 + wr * 64 + fr;
        if (kind < 6) {
            bf16_t* base; size_t ldc; const float* bias = nullptr;
            if (kind == 0) { base = FP(WS_PX, bf16_t) + (size_t)r0 * INC + c0; ldc = INC; }
            else if (kind == 1) {
                if (u.pn < 4) { base = FP(WS_VTC, bf16_t) + (size_t)u.pn * 65536 + (size_t)r0 * 256 + (c0 - u.pn * 256); ldc = 256; }
                else { const int tt = u.pn - 4; base = FP(WS_VT, bf16_t) + (size_t)(tt >> 4) * 256 * 4096 + (tt & 15) * 256 + (size_t)r0 * 4096 + (c0 - u.pn * 256); ldc = 4096; }
            }
            else if (kind == 2) { base = FP(WS_MIX, bf16_t) + (size_t)(row_lo + r0) * 768 + c0; ldc = 768; bias = PK(13) + l * 256; }
            else if (kind == 3) { base = FP(WS_MIX, bf16_t) + (size_t)(row_lo + r0) * 768 + 256 + c0; ldc = 768; bias = PK(15) + l * 256; }
            else if (kind == 4) { base = FP(WS_ZS, bf16_t) + (size_t)(row_lo + r0) * 512 + c0; ldc = 512; bias = PK(26) + l * 512; }
            else { base = FP(WS_H, bf16_t) + (size_t)(row_lo + r0) * FFD + c0; ldc = FFD; bias = PK(32) + l * FFD; }
#pragma unroll
            for (int bj = 0; bj < 2; ++bj)
#pragma unroll
                for (int n = 0; n < 2; ++n) {
                    f32x4 bv = f32x4{0.f, 0.f, 0.f, 0.f};
                    if (bias) bv = *(const f32x4*)(bias + c0 + bj * 128 + n * 16);
#pragma unroll
                    for (int ai = 0; ai < 2; ++ai)
#pragma unroll
                        for (int m = 0; m < 4; ++m) {
                            f32x4 v = acc[ai][bj][m][n] + bv;
                            if (kind == 5) {
#pragma unroll
                                for (int j = 0; j < 4; ++j) { const float r = fmaxf(v[j], 0.f); v[j] = r * r; }
                            }
                            u32x2 w; w.x = pk2(v[0], v[1]); w.y = pk2(v[2], v[3]);
                            *(u32x2*)(base + (size_t)(ai * 128 + m * 16) * ldc + bj * 128 + n * 16) = w;
                        }
                }
        } else {
            const int gp = u.pm + (row_lo >> 8); const bool isc = gp < 4; const int lrow0 = isc ? gp * 256 : (gp - 4) * 256; const int br = isc ? 4 : ((gp - 4) >> 4);
            const float* sC; const float* sL; const float* bias; int gate_off;
            if (kind == 6) { sC = l == 0 ? F.A.in[2] : FP(WS_XC, float); sL = l == 0 ? F.A.in[0] : F.out; bias = PK(29) + l * DM; gate_off = 2048; }
            else { sC = FP(WS_XC, float); sL = F.out; bias = PK(34) + l * DM; gate_off = 5120; }
            const size_t roff = (size_t)(lrow0 + wr * 64 + fr) * DM + c0;
            const float* s = (isc ? sC : sL) + roff; float* d = (isc ? FP(WS_XC, float) : F.out) + roff;
            const float* gate = FP(WS_MOD, float) + (l * 5 + br) * 6144 + gate_off;
#pragma unroll
            for (int bj = 0; bj < 2; ++bj)
#pragma unroll
                for (int n = 0; n < 2; ++n) {
                    const int cc = c0 + bj * 128 + n * 16;
                    const f32x4 bv = *(const f32x4*)(bias + cc); const f32x4 gv = *(const f32x4*)(gate + cc);
#pragma unroll
                    for (int ai = 0; ai < 2; ++ai)
#pragma unroll
                        for (int m = 0; m < 4; ++m) {
                            const size_t o = (size_t)(ai * 128 + m * 16) * DM + bj * 128 + n * 16;
                            const f32x4 xv = *(const f32x4*)(s + o);
                            *(f32x4*)(d + o) = xv + gv * (acc[ai][bj][m][n] + bv);
                        }
                }
        }
    }
};

__device__ __forceinline__ void transpose_tile(const float* W, int K, int N, bf16_t* Wt, int tile, float* scr, int tid) {
    const int ntn = N >> 6; const int tk = tile / ntn, tn = tile - tk * ntn; const int k0 = tk * 64, n0 = tn * 64;
    { const int n = tid & 63, kk = tid >> 6;
#pragma unroll
      for (int i = 0; i < 8; ++i) { const int k = kk + 8 * i; scr[k * 65 + n] = W[(size_t)(k0 + k) * N + n0 + n]; } }
    __syncthreads();
    { const int kp = tid & 31, nn = tid >> 5;
#pragma unroll
      for (int i = 0; i < 4; ++i) { const int n = nn + 16 * i; const unsigned v = pk2(scr[(2 * kp) * 65 + n], scr[(2 * kp + 1) * 65 + n]); *(unsigned*)(Wt + (size_t)(n0 + n) * K + k0 + 2 * kp) = v; } }
    __syncthreads();
}
__device__ __forceinline__ void mod_unit(const Frame& F, int unit, float* scr) {
    const int l = unit / 96, cc = unit - l * 96; const int tid = F.tid;
    float* sl = scr; float* red = scr + 5 * 1024;
    for (int i = tid; i < 5 * 1024; i += NTHREADS) { const int r = i >> 10, k = i & 1023; const float c = r < 4 ? F.A.in[1][r * 1024 + k] : F.A.in[3][k]; sl[i] = c * sigmoidf_(c); }
    __syncthreads();
    const int col = tid & 63, kg = tid >> 6;
    const float* w = F.A.in[4] + (size_t)l * DM * 6144 + cc * 64 + col;
    float a0 = 0.f, a1 = 0.f, a2 = 0.f, a3 = 0.f, a4 = 0.f;
    for (int k = kg * 128; k < kg * 128 + 128; ++k) { const float wv = w[(size_t)k * 6144]; a0 += sl[k] * wv; a1 += sl[1024 + k] * wv; a2 += sl[2048 + k] * wv; a3 += sl[3072 + k] * wv; a4 += sl[4096 + k] * wv; }
    red[(kg * 5 + 0) * 64 + col] = a0; red[(kg * 5 + 1) * 64 + col] = a1; red[(kg * 5 + 2) * 64 + col] = a2; red[(kg * 5 + 3) * 64 + col] = a3; red[(kg * 5 + 4) * 64 + col] = a4;
    __syncthreads();
    if (tid < 320) { const int r = tid >> 6, c2 = tid & 63; float s = 0.f;
#pragma unroll
        for (int g = 0; g < 8; ++g) s += red[(g * 5 + r) * 64 + c2];
        FP(WS_MOD, float)[(l * 5 + r) * 6144 + cc * 64 + c2] = s + F.A.in[5][l * 6144 + cc * 64 + c2]; }
    __syncthreads();
}
__device__ __forceinline__ void p0_prologue(const Frame& F, float* scr) {
    const int NT_L = 448 + 16 + 16 + 32 + 256 + 1024 + 1024;
    const int njobs = 193 + 2 * NT_L + PK_N;
    for (int job = blockIdx.x; job < njobs; job += gridDim.x) {
        if (job >= 193 + 2 * NT_L) {
            const int e = job - (193 + 2 * NT_L); const float* src = nullptr; int cnt = 0, off = 0;
#define PKC(i) if (e == i) { src = F.A.in[PK_IDX[i]]; cnt = PK_CNT[i]; off = pk_off(PK_IDX[i]); }
            PKC(0) PKC(1) PKC(2) PKC(3) PKC(4) PKC(5) PKC(6) PKC(7) PKC(8) PKC(9) PKC(10) PKC(11) PKC(12) PKC(13) PKC(14) PKC(15) PKC(16) PKC(17) PKC(18) PKC(19) PKC(20) PKC(21) PKC(22)
#undef PKC
            float* dst = FP(WS_PACK, float) + off;
            for (int i = F.tid; i < cnt; i += NTHREADS) dst[i] = src[i];
        }
        else if (job < 192) { mod_unit(F, job, scr); }
        else if (job == 192) {
            for (int i = F.tid; i < 4096; i += NTHREADS) { const int m = i >> 6, j = i & 63; const float x = (float)((m * j) & 63) * (1.0f / 32.0f);
                FP(WS_CTAB, bf16_t)[i] = (bf16_t)f2bf(cospif(x)); FP(WS_STAB, bf16_t)[i] = (bf16_t)f2bf(sinpif(x)); }
        } else {
            int t = job - 193; const int l = t / NT_L; t -= l * NT_L;
            unsigned char* wl = F.ws + WS_W + (size_t)l * W_LAYER;
            if (t < 448) transpose_tile(F.A.in[7] + (size_t)l * DM * INC, DM, INC, (bf16_t*)(wl + W_IN), t, scr, F.tid);
            else if ((t -= 448) < 16) transpose_tile(F.A.in[12] + (size_t)l * 65536, 256, 256, (bf16_t*)(wl + W_PW), t, scr, F.tid);
            else if ((t -= 16) < 16) transpose_tile(F.A.in[14] + (size_t)l * 65536, 256, 256, (bf16_t*)(wl + W_F), t, scr, F.tid);
            else if ((t -= 16) < 32) transpose_tile(F.A.in[25] + (size_t)l * 131072, 256, 512, (bf16_t*)(wl + W_GLU), t, scr, F.tid);
            else if ((t -= 32) < 256) transpose_tile(F.A.in[28] + (size_t)l * DM * DM, DM, DM, (bf16_t*)(wl + W_OUT), t, scr, F.tid);
            else if ((t -= 256) < 1024) transpose_tile(F.A.in[31] + (size_t)l * DM * FFD, DM, FFD, (bf16_t*)(wl + W_1), t, scr, F.tid);
            else { t -= 1024; transpose_tile(F.A.in[33] + (size_t)l * DM * FFD, FFD, DM, (bf16_t*)(wl + W_2), t, scr, F.tid); }
        }
    }
}

__device__ __forceinline__ void prep_norm_mod(const Frame& F, const float* srcC, const float* srcL, const float* g, const float* modl, int sh_off, int sc_off, bf16_t* XN, int row_lo) {
    const int gw = blockIdx.x * 8 + F.wave, nw = gridDim.x * 8, lane = F.lane;
    for (int row = row_lo + gw; row < T_ALL; row += nw) {
        const bool isc = row < NCTX; const float* x = isc ? srcC + (size_t)row * DM : srcL + (size_t)(row - NCTX) * DM; const int br = isc ? 4 : ((row - NCTX) >> 12);
        const float* sh = modl + br * 6144 + sh_off; const float* sc = modl + br * 6144 + sc_off;
        f32x4 v[4]; float ss = 0.f;
#pragma unroll
        for (int i = 0; i < 4; ++i) { v[i] = *(const f32x4*)(x + i * 256 + lane * 4); ss += v[i][0] * v[i][0] + v[i][1] * v[i][1] + v[i][2] * v[i][2] + v[i][3] * v[i][3]; }
        ss = wave_sum(ss); const float r = rsqrtf(ss * (1.0f / 1024.0f) + EPS);
#pragma unroll
        for (int i = 0; i < 4; ++i) { const int c = i * 256 + lane * 4; const f32x4 gv = *(const f32x4*)(g + c), shv = *(const f32x4*)(sh + c), scv = *(const f32x4*)(sc + c);
            f32x4 y = v[i] * r * gv; y = y * (scv + 1.0f) + shv; u32x2 w; w.x = pk2(y[0], y[1]); w.y = pk2(y[2], y[3]); *(u32x2*)(XN + (size_t)row * DM + c) = w; }
    }
}
__device__ __forceinline__ f32x4 ld_bf4(const bf16_t* p) { const u32x2 w = *(const u32x2*)p; return f32x4{bflo(w.x), bfhi(w.x), bflo(w.y), bfhi(w.y)}; }
__device__ __forceinline__ void prep_group(const Frame& F, int l, int row_lo) {
    const int gw = blockIdx.x * 8 + F.wave, nw = gridDim.x * 8, lane = F.lane;
    const bf16_t* MIX = FP(WS_MIX, bf16_t); const bf16_t* ZS = FP(WS_ZS, bf16_t); bf16_t* O = FP(WS_XN, bf16_t); const float* gg = PK(27) + l * DM;
    for (int row = row_lo + gw; row < T_ALL; row += nw) {
#pragma unroll
        for (int grp = 0; grp < 4; ++grp) {
            f32x4 v;
            if (grp < 3) v = ld_bf4(MIX + (size_t)row * 768 + grp * 256 + lane * 4);
            else { const f32x4 a = ld_bf4(ZS + (size_t)row * 512 + lane * 4), gt = ld_bf4(ZS + (size_t)row * 512 + 256 + lane * 4);
#pragma unroll
                for (int j = 0; j < 4; ++j) v[j] = a[j] * sigmoidf_(gt[j]); }
            float ss = v[0] * v[0] + v[1] * v[1] + v[2] * v[2] + v[3] * v[3]; ss = wave_sum(ss);
            const float r = rsqrtf(ss * (1.0f / 256.0f) + EPS); const f32x4 gv = *(const f32x4*)(gg + grp * 256 + lane * 4); const f32x4 y = v * r * gv;
            u32x2 w; w.x = pk2(y[0], y[1]); w.y = pk2(y[2], y[3]); *(u32x2*)(O + (size_t)row * DM + grp * 256 + lane * 4) = w;
        }
    }
}
__device__ __forceinline__ void final_norm(const Frame& F) {
    const int gw = blockIdx.x * 8 + F.wave, nw = gridDim.x * 8, lane = F.lane; const float* g = PK(35);
    for (int row = gw; row < NLAT; row += nw) {
        float* x = F.out + (size_t)row * DM; f32x4 v[4]; float ss = 0.f;
#pragma unroll
        for (int i = 0; i < 4; ++i) { v[i] = *(const f32x4*)(x + i * 256 + lane * 4); ss += v[i][0] * v[i][0] + v[i][1] * v[i][1] + v[i][2] * v[i][2] + v[i][3] * v[i][3]; }
        ss = wave_sum(ss); const float r = rsqrtf(ss * (1.0f / 1024.0f) + EPS);
#pragma unroll
        for (int i = 0; i < 4; ++i) { const int c = i * 256 + lane * 4; *(f32x4*)(x + c) = v[i] * r * *(const f32x4*)(g + c); }
    }
}

__device__ __forceinline__ void conv_unit(const Frame& F, int l, int unit, float* scr) {
    const bf16_t* PX = FP(WS_PX, bf16_t); bf16_t* CV = FP(WS_CV, bf16_t);
    int prow0, Lseq, t0;
    if (unit < 512) { const int b = unit >> 7; t0 = (unit & 127) * 32; prow0 = NCTX + b * 4096; Lseq = 4096; }
    else { const int uu = unit - 512; const int b = uu >> 3; t0 = (uu & 7) * 32; prow0 = b * 256; Lseq = 256; }
    float* vt = scr; float* ot = scr + 62 * 256; int tid = F.tid; asm volatile("" : "+v"(tid));
    for (int idx = tid; idx < 62 * 256; idx += NTHREADS) { const int rr = idx >> 8, c = idx & 255; const int t = t0 - 15 + rr; float v = 0.f;
        if (t >= 0 && t < Lseq) { const bf16_t* p = PX + (size_t)(prow0 + t) * INC; const float a = bf2f(p[c]), gt = bf2f(p[256 + c]); v = a * sigmoidf_(gt); }
        vt[idx] = v; }
    __syncthreads();
    { const int c = tid & 255, half = tid >> 8; float w[31];
#pragma unroll
      for (int j = 0; j < 31; ++j) w[j] = PK(8)[(l * 31 + j) * 256 + c];
      const float bd = PK(9)[l * 256 + c];
      for (int tt = 0; tt < 16; ++tt) { const int t = half * 16 + tt; float s = bd;
#pragma unroll
          for (int j = 0; j < 31; ++j) s += w[j] * vt[(t + j) * 256 + c];
          ot[t * 256 + c] = s; } }
    __syncthreads();
    { const int lane = tid & 63; const f32x4 lg = *(const f32x4*)(PK(10) + l * 256 + lane * 4), lb = *(const f32x4*)(PK(11) + l * 256 + lane * 4);
      for (int i = 0; i < 4; ++i) { const int t = F.wave * 4 + i; const f32x4 x = *(const f32x4*)(ot + t * 256 + lane * 4);
          const float mu = wave_sum(x[0] + x[1] + x[2] + x[3]) * (1.0f / 256.0f); const f32x4 d = x - mu;
          const float var = wave_sum(d[0] * d[0] + d[1] * d[1] + d[2] * d[2] + d[3] * d[3]) * (1.0f / 256.0f); const float r = rsqrtf(var + EPS);
          f32x4 y = d * r * lg + lb;
#pragma unroll
          for (int j = 0; j < 4; ++j) y[j] = y[j] * sigmoidf_(y[j]);
          u32x2 w; w.x = pk2(y[0], y[1]); w.y = pk2(y[2], y[3]); *(u32x2*)(CV + (size_t)(prow0 + t0 + t) * 256 + lane * 4) = w; } }
    __syncthreads();
}

__device__ __forceinline__ void fnetctx_unit(const Frame& F, int unit, float* scr) {
    const bf16_t* PX = FP(WS_PX, bf16_t); bf16_t* FN = FP(WS_FN, bf16_t);
    const int mh = unit & 1, kh = (unit >> 1) & 1, h = (unit >> 2) & 3, b = unit >> 4; int tid = F.tid; asm volatile("" : "+v"(tid));
    float* zc = scr; float* zs = scr + 8192; float* c64 = scr + 16384; float* s64 = c64 + 64; float* c256 = s64 + 64; float* s256 = c256 + 256;
    if (tid < 64) { const float x = (float)tid * (1.0f / 32.0f); c64[tid] = cospif(x); s64[tid] = sinpif(x); }
    if (tid < 256) { const float x = (float)tid * (1.0f / 128.0f); c256[tid] = cospif(x); s256[tid] = sinpif(x); }
    __syncthreads();
    for (int idx = tid; idx < 8192; idx += NTHREADS) { const int n = idx >> 5, mm = idx & 31, m = mh * 32 + mm; const bf16_t* up = PX + (size_t)(b * 256 + n) * INC + 512 + h * 64;
        float ac = 0.f, as = 0.f;
        for (int j = 0; j < 64; ++j) { const float uv = bf2f(up[j]); const int a = (j * m) & 63; ac += uv * c64[a]; as += uv * s64[a]; }
        zc[idx] = ac; zs[idx] = as; }
    __syncthreads();
    for (int idx = tid; idx < 4096; idx += NTHREADS) { const int k = kh * 128 + (idx >> 5), mm = idx & 31; float acc = 0.f;
        for (int n = 0; n < 256; ++n) { const int a = (k * n) & 255; acc += c256[a] * zc[n * 32 + mm] - s256[a] * zs[n * 32 + mm]; }
        FN[(size_t)(b * 256 + k) * 256 + h * 64 + mh * 32 + mm] = (bf16_t)f2bf(acc * (1.0f / 128.0f)); }
    __syncthreads();
}
__device__ __forceinline__ void fnetA_unit(const Frame& F, int unit, unsigned char* lds) {
    const bf16_t* PX = FP(WS_PX, bf16_t); const bf16_t* Ct = FP(WS_CTAB, bf16_t); const bf16_t* St = FP(WS_STAB, bf16_t); bf16_t* YB = FP(WS_YB, bf16_t);
    const int oct = unit & 7, h = (unit >> 3) & 3, b = unit >> 5; int tid = F.tid; asm volatile("" : "+v"(tid)); const int lane = tid & 63, fr = lane & 15, fq = lane >> 4; const int n2 = oct * 8 + F.wave;
    bf16x8 ua[4][2];
#pragma unroll
    for (int mi = 0; mi < 4; ++mi)
#pragma unroll
        for (int kk = 0; kk < 2; ++kk) ua[mi][kk] = *(const bf16x8*)(PX + (size_t)(NCTX + b * 4096 + 64 * (16 * mi + fr) + n2) * INC + 512 + h * 64 + kk * 32 + fq * 8);
    bf16x8 zre[2][4], zs[2][4];
#pragma unroll
    for (int ni = 0; ni < 4; ++ni) {
        bf16x8 bc[2], bs[2];
#pragma unroll
        for (int kk = 0; kk < 2; ++kk) { bc[kk] = *(const bf16x8*)(Ct + (16 * ni + fr) * 64 + kk * 32 + fq * 8); bs[kk] = *(const bf16x8*)(St + (16 * ni + fr) * 64 + kk * 32 + fq * 8); }
#pragma unroll
        for (int pr = 0; pr < 2; ++pr) {
            f32x4 c0 = {0.f, 0.f, 0.f, 0.f}, c1 = c0, s0 = c0, s1 = c0;
#pragma unroll
            for (int kk = 0; kk < 2; ++kk) { c0 = mfma16(ua[2 * pr][kk], bc[kk], c0); c1 = mfma16(ua[2 * pr + 1][kk], bc[kk], c1); s0 = mfma16(ua[2 * pr][kk], bs[kk], s0); s1 = mfma16(ua[2 * pr + 1][kk], bs[kk], s1); }
            zre[pr][ni] = pack8(c0, c1); zs[pr][ni] = pack8(s0, s1);
        }
    }
    bf16_t* T = (bf16_t*)lds;
    for (int mi2 = 0; mi2 < 4; ++mi2) {
        bf16x8 cf[2], sf[2], sfn[2];
#pragma unroll
        for (int pr = 0; pr < 2; ++pr) {
            const bf16_t* cp = Ct + (16 * mi2 + fr) * 64 + 32 * pr + 4 * fq; const bf16_t* sp = St + (16 * mi2 + fr) * 64 + 32 * pr + 4 * fq;
            cf[pr] = cat4(*(const u32x2*)cp, *(const u32x2*)(cp + 16)); sf[pr] = cat4(*(const u32x2*)sp, *(const u32x2*)(sp + 16)); sfn[pr] = neg8(sf[pr]);
        }
        float cs[4], sn[4];
#pragma unroll
        for (int j = 0; j < 4; ++j) { const int k1 = 16 * mi2 + 4 * fq + j; const float x = (float)(n2 * k1) * (1.0f / 2048.0f); cs[j] = cospif(x); sn[j] = sinpif(x); }
#pragma unroll
        for (int ni = 0; ni < 4; ++ni) {
            f32x4 yre = {0.f, 0.f, 0.f, 0.f}, yin = yre;
#pragma unroll
            for (int pr = 0; pr < 2; ++pr) { yre = mfma16s(cf[pr], zre[pr][ni], yre); yre = mfma16s(sfn[pr], zs[pr][ni], yre); yin = mfma16s(cf[pr], zs[pr][ni], yin); yin = mfma16s(sf[pr], zre[pr][ni], yin); }
#pragma unroll
            for (int j = 0; j < 4; ++j) { const int k1 = 16 * mi2 + 4 * fq + j; const int m = 16 * ni + fr;
                const float y1 = yre[j] * cs[j] - yin[j] * sn[j], y2 = yin[j] * cs[j] + yre[j] * sn[j];
                T[((0 * 64 + k1) * 64 + m) * 8 + F.wave] = (bf16_t)f2bf(y1); T[((1 * 64 + k1) * 64 + m) * 8 + F.wave] = (bf16_t)f2bf(y2); }
        }
    }
    __syncthreads();
    for (int it = 0; it < 16; ++it) { const int cidx = it * NTHREADS + tid; const int m = cidx & 63, k1 = (cidx >> 6) & 63, plane = cidx >> 12;
        const u32x4 v = *(const u32x4*)(lds + (size_t)cidx * 16);
        *(u32x4*)(YB + ((((size_t)(b * 4 + h) * 64 + k1) * 2 + plane) * 64 + m) * 64 + oct * 8) = v; }
    __syncthreads();
}
__device__ __forceinline__ void fnetB_item(const Frame& F, int item) {
    const bf16_t* Ct = FP(WS_CTAB, bf16_t); const bf16_t* St = FP(WS_STAB, bf16_t); const bf16_t* YB = FP(WS_YB, bf16_t); bf16_t* FN = FP(WS_FN, bf16_t);
    const int k1 = item & 63, h = (item >> 6) & 3, b = item >> 8; int lane = F.lane; asm volatile("" : "+v"(lane)); const int fr = lane & 15, fq = lane >> 4;
    const bf16_t* base = YB + (((size_t)(b * 4 + h) * 64 + k1) * 2) * 4096;
    f32x4 acc[4][4];
#pragma unroll
    for (int mi = 0; mi < 4; ++mi)
#pragma unroll
        for (int ni = 0; ni < 4; ++ni) acc[mi][ni] = f32x4{0.f, 0.f, 0.f, 0.f};
#pragma unroll
    for (int kk = 0; kk < 2; ++kk) {
        bf16x8 bc[4], bsn[4];
#pragma unroll
        for (int ni = 0; ni < 4; ++ni) { bc[ni] = *(const bf16x8*)(Ct + (16 * ni + fr) * 64 + kk * 32 + fq * 8); bsn[ni] = neg8(*(const bf16x8*)(St + (16 * ni + fr) * 64 + kk * 32 + fq * 8)); }
#pragma unroll
        for (int mi = 0; mi < 4; ++mi) {
            const bf16x8 are = *(const bf16x8*)(base + (16 * mi + fr) * 64 + kk * 32 + fq * 8), aim = *(const bf16x8*)(base + 4096 + (16 * mi + fr) * 64 + kk * 32 + fq * 8);
#pragma unroll
            for (int ni = 0; ni < 4; ++ni) { acc[mi][ni] = mfma16(are, bc[ni], acc[mi][ni]); acc[mi][ni] = mfma16s(aim, bsn[ni], acc[mi][ni]); }
        }
    }
#pragma unroll
    for (int mi = 0; mi < 4; ++mi)
#pragma unroll
        for (int ni = 0; ni < 4; ++ni) { const int k = k1 + 64 * (16 * ni + fr); const f32x4 v = acc[mi][ni] * (1.0f / 512.0f);
            u32x2 w; w.x = pk2(v[0], v[1]); w.y = pk2(v[2], v[3]); *(u32x2*)(FN + (size_t)(NCTX + b * 4096 + k) * 256 + h * 64 + 16 * mi + 4 * fq) = w; }
}

template <bool LOCAL>
__device__ __forceinline__ void attn_item(const Frame& F, int l, int item) {
    const bf16_t* PX = FP(WS_PX, bf16_t); const bf16_t* VT = FP(WS_VT, bf16_t); const bf16_t* VTc = FP(WS_VTC, bf16_t); bf16_t* MIX = FP(WS_MIX, bf16_t);
    const float* rpb = PK(16) + l * (4 * 15 * 31);
    int lane = F.lane; asm volatile("" : "+v"(lane)); const int fr = lane & 15, fq = lane >> 4;
    int b, h, r = 0, jb = 0, qrow0;
    if (LOCAL) { h = item & 3; jb = (item >> 2) & 3; r = (item >> 4) & 63; b = item >> 10; qrow0 = NCTX + b * 4096 + r * 64 + jb * 16; }
    else { h = item & 3; const int qb = (item >> 2) & 15; b = item >> 6; qrow0 = b * 256 + qb * 16; }
    constexpr int NT = LOCAL ? 32 : 16;
    const int rs = LOCAL ? min(max(r - 4, 0), 56) : 0; const int kcs = LOCAL ? min(max(16 * jb - 8, 0), 32) : 0;
    bf16x8 qf[2];
#pragma unroll
    for (int kk = 0; kk < 2; ++kk) qf[kk] = *(const bf16x8*)(PX + (size_t)(qrow0 + fr) * INC + 768 + h * 64 + kk * 32 + fq * 8);
    f32x4 s[NT];
#pragma unroll
    for (int t = 0; t < NT; ++t) {
        int krow;
        if (LOCAL && t < 16) krow = NCTX + b * 4096 + (rs + (t >> 1)) * 64 + kcs + (t & 1) * 16 + fr;
        else krow = b * 256 + (t - (LOCAL ? 16 : 0)) * 16 + fr;
        const bf16_t* kp = PX + (size_t)krow * INC + 1024 + h * 64 + fq * 8;
        const bf16x8 k0 = *(const bf16x8*)kp, k1 = *(const bf16x8*)(kp + 32);
        f32x4 a = {0.f, 0.f, 0.f, 0.f}; a = mfma16(k0, qf[0], a); a = mfma16(k1, qf[1], a); s[t] = a;
    }
    float mx = -3.0e38f;
    const int qcol = 16 * jb + fr; const int cstart = min(max(qcol - 8, 0), 48);
#pragma unroll
    for (int t = 0; t < NT; ++t)
#pragma unroll
        for (int j = 0; j < 4; ++j) {
            float v = s[t][j] * 0.125f;
            if (LOCAL && t < 16) { const int kcol = kcs + (t & 1) * 16 + 4 * fq + j; const bool valid = (kcol >= cstart) && (kcol < cstart + 16);
                const int dr = rs + (t >> 1) - r + 7; const int dc = min(max(kcol - qcol + 15, 0), 30);
                v = valid ? v + rpb[(h * 15 + dr) * 31 + dc] : -1.0e30f; }
            s[t][j] = v; mx = fmaxf(mx, v);
        }
    mx = fmaxf(mx, __shfl_xor(mx, 16)); mx = fmaxf(mx, __shfl_xor(mx, 32));
    float sum = 0.f;
#pragma unroll
    for (int t = 0; t < NT; ++t)
#pragma unroll
        for (int j = 0; j < 4; ++j) { const float p = __expf(s[t][j] - mx); s[t][j] = p; sum += p; }
    sum += __shfl_xor(sum, 16); sum += __shfl_xor(sum, 32);
    f32x4 o[4];
#pragma unroll
    for (int di = 0; di < 4; ++di) o[di] = f32x4{0.f, 0.f, 0.f, 0.f};
#pragma unroll
    for (int u = 0; u < NT / 2; ++u) {
        const bf16x8 pb = pack8(s[2 * u], s[2 * u + 1]);
        const bf16_t* vbase; size_t stride;
        if (LOCAL && u < 8) { vbase = VT + (size_t)(b * 256 + h * 64) * 4096 + (rs + u) * 64 + kcs + 4 * fq; stride = 4096; }
        else { const int uu = u - (LOCAL ? 8 : 0); vbase = VTc + (size_t)(b * 256 + h * 64) * 256 + uu * 32 + 4 * fq; stride = 256; }
#pragma unroll
        for (int di = 0; di < 4; ++di) { const bf16_t* vp = vbase + (size_t)(16 * di + fr) * stride; const bf16x8 va = cat4(*(const u32x2*)vp, *(const u32x2*)(vp + 16)); o[di] = mfma16s(va, pb, o[di]); }
    }
    const float inv = 1.0f / sum;
#pragma unroll
    for (int di = 0; di < 4; ++di) { const f32x4 v = o[di] * inv; u32x2 w; w.x = pk2(v[0], v[1]); w.y = pk2(v[2], v[3]);
        *(u32x2*)(MIX + (size_t)(qrow0 + fr) * 768 + 512 + h * 64 + 16 * di + 4 * fq) = w; }
}

__device__ __forceinline__ cplx csel(bool c, cplx a, cplx b) { return cplx{c ? a.re : b.re, c ? a.im : b.im}; }
#define WAITALL() asm volatile("s_waitcnt vmcnt(0) lgkmcnt(0)" ::: "memory")
__device__ __forceinline__ cplx pow_sel(int k, cplx a, cplx a2, cplx a4, cplx a8, cplx a16) {
    cplx r = cplx{1.f, 0.f};
    r = csel((k & 1) != 0, cmul(r, a), r); r = csel((k & 2) != 0, cmul(r, a2), r); r = csel((k & 4) != 0, cmul(r, a4), r); r = csel((k & 8) != 0, cmul(r, a8), r); r = csel((k & 16) != 0, cmul(r, a16), r);
    return r;
}
__device__ __forceinline__ void ssm_consts(float lre, float lim, float dt, cplx& a, cplx& f) {
    const float e = __expf(lre * dt);
    float revs = lim * dt * 0.15915494309189535f; revs -= rintf(revs);
    a = cplx{e * __builtin_amdgcn_cosf(revs), e * __builtin_amdgcn_sinf(revs)};
    const float xr = a.re - 1.0f, xi = a.im, den = __builtin_amdgcn_rcpf(lre * lre + lim * lim);
    f = cplx{(xr * lre + xi * lim) * den, (xi * lre - xr * lim) * den};
}
template <int PASS, int DIR>
__device__ __forceinline__ void ssm_dir(const Frame& F, int lane, int l, int b, int g, int tb, const bf16x8 (&ub)[4], f32x4 (&accy)[4]) {
    const int fr = lane & 15, fq = lane >> 4;
    const int c = DIR == 0 ? tb : (tb < 4 ? 3 - tb : 71 - tb);
    const int pg = (l * 2 + DIR) * 16 + g;
    const float dt = __expf(PK(19)[pg]);
    cplx* Sloc = FP(WS_SLOC, cplx); const cplx* Carry = FP(WS_CARRY, cplx);
    const size_t sbase = ((size_t)((b * 2 + DIR) * 16 + g) * 68 + c) * 64;
    for (int q = 0; q < 4; ++q) {
        bf16x8 are, aim;
        { const int kq = (fq & 1) * 8; const float* pr = PK(20) + ((size_t)pg * 64 + 16 * q + fr) * 16 + kq; const float* pi = PK(21) + ((size_t)pg * 64 + 16 * q + fr) * 16 + kq;
          const f32x4 zz = f32x4{0.f, 0.f, 0.f, 0.f}; const bool on = fq < 2;
          const f32x4 r0 = *(const f32x4*)pr, r1 = *(const f32x4*)(pr + 4), i0 = *(const f32x4*)pi, i1 = *(const f32x4*)(pi + 4);

          are = pack8(on ? r0 : zz, on ? r1 : zz); aim = pack8(on ? i0 : zz, on ? i1 : zz); }
        f32x4 bre[4], bim[4];
        asm volatile("s_nop 7" : "+v"(are), "+v"(aim));
#pragma unroll
        for (int ni = 0; ni < 4; ++ni) { bre[ni] = mfma16(are, ub[ni], f32x4{0.f, 0.f, 0.f, 0.f}); bim[ni] = mfma16(aim, ub[ni], f32x4{0.f, 0.f, 0.f, 0.f}); }
        settle4m(bre[0], bre[1], bre[2], bre[3]); settle4m(bim[0], bim[1], bim[2], bim[3]);
#pragma unroll
        for (int j = 0; j < 4; ++j) {
            const int p = 16 * q + 4 * fq + j;
            const float lre = PK(17)[pg * 64 + p], lim = PK(18)[pg * 64 + p];

            cplx a, f; ssm_consts(lre, lim, dt, a, f);
            const cplx a2 = cmul(a, a), a4 = cmul(a2, a2), a8 = cmul(a4, a4), a16 = cmul(a8, a8);
            if (PASS == 1) {
                cplx Tt;
                if (DIR == 0) { Tt = cplx{bre[0][j], bim[0][j]}; Tt = cmad(cplx{bre[1][j], bim[1][j]}, Tt, a16); Tt = cmad(cplx{bre[2][j], bim[2][j]}, Tt, a16); Tt = cmad(cplx{bre[3][j], bim[3][j]}, Tt, a16); }
                else { Tt = cplx{bre[3][j], bim[3][j]}; Tt = cmad(cplx{bre[2][j], bim[2][j]}, Tt, a16); Tt = cmad(cplx{bre[1][j], bim[1][j]}, Tt, a16); Tt = cmad(cplx{bre[0][j], bim[0][j]}, Tt, a16); }
                const cplx w = pow_sel(DIR == 0 ? 15 - fr : fr, a, a2, a4, a8, a16);
                Tt = cmul(Tt, w);
                Tt.re += __shfl_xor(Tt.re, 1); Tt.im += __shfl_xor(Tt.im, 1); Tt.re += __shfl_xor(Tt.re, 2); Tt.im += __shfl_xor(Tt.im, 2);
                Tt.re += __shfl_xor(Tt.re, 4); Tt.im += __shfl_xor(Tt.im, 4); Tt.re += __shfl_xor(Tt.re, 8); Tt.im += __shfl_xor(Tt.im, 8);
                Tt = cmul(Tt, f);
                if (fr == 0) Sloc[sbase + p] = Tt;
            } else {
                const cplx w = pow_sel(DIR == 0 ? fr + 1 : 16 - fr, a, a2, a4, a8, a16);
                cplx x[4];
#pragma unroll
                for (int ni = 0; ni < 4; ++ni) {
                    cplx v = cmul(f, cplx{bre[ni][j], bim[ni][j]});
#define RLF(x, ln) __builtin_bit_cast(float, __builtin_amdgcn_readlane(__builtin_bit_cast(int, (x)), (ln)))
#define DPPF(x, ctrl) __builtin_bit_cast(float, __builtin_amdgcn_update_dpp(0, __builtin_bit_cast(int, (x)), (ctrl), 0xf, 0xf, true))
#define KS_STEP(d, ad) { cplx y; if (DIR == 0) { y.re = DPPF(v.re, 0x110 + d); y.im = DPPF(v.im, 0x110 + d); v = csel(fr >= d, cmad(v, ad, y), v); } \
                                   else { y.re = DPPF(v.re, 0x100 + d); y.im = DPPF(v.im, 0x100 + d); v = csel(fr + d <= 15, cmad(v, ad, y), v); } }
                    KS_STEP(1, a) KS_STEP(2, a2) KS_STEP(4, a4) KS_STEP(8, a8)
#undef KS_STEP
                    x[ni] = v;
                }
                cplx E = Carry[sbase + p];
#pragma unroll
                for (int bi = 0; bi < 4; ++bi) {
                    const int ni = DIR == 0 ? bi : 3 - bi;
                    const cplx hh = cmad(x[ni], w, E);
                    cplx tot;
                    { constexpr int L0 = DIR == 0 ? 15 : 0;
                      const float r0 = RLF(x[ni].re, L0), r1 = RLF(x[ni].re, L0 + 16), r2 = RLF(x[ni].re, L0 + 32), r3 = RLF(x[ni].re, L0 + 48);
                      const float i0 = RLF(x[ni].im, L0), i1 = RLF(x[ni].im, L0 + 16), i2 = RLF(x[ni].im, L0 + 32), i3 = RLF(x[ni].im, L0 + 48);
                      tot.re = fq == 0 ? r0 : fq == 1 ? r1 : fq == 2 ? r2 : r3; tot.im = fq == 0 ? i0 : fq == 1 ? i1 : fq == 2 ? i2 : i3; }
                    E = cmad(tot, a16, E);
                    bre[ni][j] = hh.re; bim[ni][j] = hh.im;
                }
            }
        }
        if (PASS == 3) {
            const float* cr = PK(22) + ((size_t)pg * 16 + fr) * 64 + 16 * q + 4 * fq; const float* ci = PK(23) + ((size_t)pg * 16 + fr) * 64 + 16 * q + 4 * fq;
            const f32x4 cre = *(const f32x4*)cr; const f32x4 cim = *(const f32x4*)ci;
            const bf16x8 ca = pack8(cre, f32x4{-cim[0], -cim[1], -cim[2], -cim[3]});
#pragma unroll
            for (int ni = 0; ni < 4; ++ni) { bf16x8 hb = pack8(bre[ni], bim[ni]); bf16x8 ca2 = ca; asm volatile("s_nop 7" : "+v"(ca2), "+v"(hb)); accy[ni] = mfma16(ca2, hb, accy[ni]); }
            settle4m(accy[0], accy[1], accy[2], accy[3]);
        }
    }
}
template <int PASS>
__device__ __forceinline__ void ssm_item(const Frame& F, int l_u, int item_u) {
    int l = l_u, item = item_u; asm volatile("" : "+v"(l), "+v"(item));
    const bf16_t* PX = FP(WS_PX, bf16_t);
    int lane = F.lane; asm volatile("" : "+v"(lane)); const int fr = lane & 15, fq = lane >> 4;
    const int tb = item % 68; const int g = (item / 68) & 15; const int b = item / (68 * 16);
    const int prow0 = tb < 4 ? b * 256 + tb * 64 : NCTX + b * 4096 + (tb - 4) * 64;
    bf16x8 ub[4];
#pragma unroll
    for (int ni = 0; ni < 4; ++ni) { const bf16x8 ld = *(const bf16x8*)(PX + (size_t)(prow0 + 16 * ni + fr) * INC + 1536 + g * 16 + (fq & 1) * 8); ub[ni] = fq < 2 ? ld : zero8(); }
    f32x4 accy[4];
#pragma unroll
    for (int ni = 0; ni < 4; ++ni) accy[ni] = f32x4{0.f, 0.f, 0.f, 0.f};

    ssm_dir<PASS, 0>(F, lane, l, b, g, tb, ub, accy);
    ssm_dir<PASS, 1>(F, lane, l, b, g, tb, ub, accy);
    if (PASS == 3) {
        bf16_t* YS = FP(WS_YS, bf16_t); const f32x4 dv = *(const f32x4*)(PK(24) + l * 256 + g * 16 + 4 * fq);
#pragma unroll
        for (int ni = 0; ni < 4; ++ni) { const int row = prow0 + 16 * ni + fr; const f32x4 uv = ld_bf4(PX + (size_t)row * INC + 1536 + g * 16 + 4 * fq);
            const f32x4 y = accy[ni] + dv * uv; u32x2 w; w.x = pk2(y[0], y[1]); w.y = pk2(y[2], y[3]); *(u32x2*)(YS + (size_t)row * 256 + g * 16 + 4 * fq) = w; }
    }
}
__device__ __forceinline__ void ssm_pass2(const Frame& F, int l) {
    const int idx = blockIdx.x * NTHREADS + F.tid; if (idx >= 8192) return;
    const int p = idx & 63, g = (idx >> 6) & 15, dir = (idx >> 10) & 1, b = idx >> 11;
    const int pg = (l * 2 + dir) * 16 + g; const float dt = __expf(PK(19)[pg]);
    const float lre = PK(17)[pg * 64 + p], lim = PK(18)[pg * 64 + p];
    cplx a, f_unused; ssm_consts(lre, lim, dt, a, f_unused);
#pragma unroll
    for (int i = 0; i < 6; ++i) a = cmul(a, a);
    const cplx* Sloc = FP(WS_SLOC, cplx); cplx* Carry = FP(WS_CARRY, cplx);
    const size_t base = ((size_t)((b * 2 + dir) * 16 + g) * 68) * 64 + p;
    cplx E = cplx{0.f, 0.f};
    for (int c0 = 0; c0 < 68; c0 += 4) {
        const cplx s0 = Sloc[base + (size_t)(c0 + 0) * 64], s1 = Sloc[base + (size_t)(c0 + 1) * 64], s2 = Sloc[base + (size_t)(c0 + 2) * 64], s3 = Sloc[base + (size_t)(c0 + 3) * 64];
        Carry[base + (size_t)(c0 + 0) * 64] = E; E = cmad(s0, a, E);
        Carry[base + (size_t)(c0 + 1) * 64] = E; E = cmad(s1, a, E);
        Carry[base + (size_t)(c0 + 2) * 64] = E; E = cmad(s2, a, E);
        Carry[base + (size_t)(c0 + 3) * 64] = E; E = cmad(s3, a, E);
    }
}


constexpr size_t WS_BAR = 512 * 1024;
#define XB_TMO      128
#define XB_XCNT(j)  (256  + 64 * (j))
#define XB_XSUB(j)  (1280 + 64 * (j))
#define XB_XGEN(j)  (2304 + 64 * (j))
#define XB_TOP      3328
#define XB_TOPGEN   3392
#define XCD_BAR_WORDS 3456
#define XB_SPIN_CAP (1u << 18)

__device__ __forceinline__ unsigned xb_ld(unsigned* p)              { return __hip_atomic_load(p, __ATOMIC_RELAXED, __HIP_MEMORY_SCOPE_AGENT); }
__device__ __forceinline__ unsigned xb_add(unsigned* p, unsigned v) { return __hip_atomic_fetch_add(p, v, __ATOMIC_RELAXED, __HIP_MEMORY_SCOPE_AGENT); }
__device__ __forceinline__ unsigned xb_xcc_id() { return (unsigned)__builtin_amdgcn_s_getreg((3 << 11) | 20) & 0xFu; }
#define XB_SPIN(cond, bar) do { unsigned _sp = 0; while (cond) { __builtin_amdgcn_s_sleep(1); \
    if ((++_sp & 255u) == 0u) { if (xb_ld(&(bar)[XB_TMO])) break; if (_sp > XB_SPIN_CAP) { atomicAdd(&(bar)[XB_TMO], 1u); break; } } } } while (0)

struct XcdBarrier {
    unsigned* bar; unsigned x;
    volatile LAS unsigned* st;
};

__device__ __forceinline__ XcdBarrier xcd_barrier_post(unsigned* bar, volatile LAS unsigned* st) {
    XcdBarrier b; b.bar = bar; b.x = xb_xcc_id(); b.st = st;
    if (threadIdx.x == 0) (void)xb_add(&bar[XB_XCNT(b.x)], 1u);
    return b;
}
__device__ __forceinline__ void xcd_barrier_complete(unsigned* bar, unsigned x, unsigned& nloc, unsigned& nx) {
    const unsigned G = gridDim.x * gridDim.y * gridDim.z;
    unsigned sum, cnt, mine, sp = 0u;
    for (;;) {
        sum = 0u; cnt = 0u; mine = 0u;
#pragma unroll
        for (unsigned j = 0; j < 16; ++j) { const unsigned c = xb_ld(&bar[XB_XCNT(j)]); sum += c; cnt += (c > 0u) ? 1u : 0u; mine = (j == x) ? c : mine; }
        if (sum == G) break;
        __builtin_amdgcn_s_sleep(1);
        if ((++sp & 255u) == 0u) { if (xb_ld(&bar[XB_TMO])) break; if (sp > XB_SPIN_CAP) { atomicAdd(&bar[XB_TMO], 1u); break; } }
    }
    nloc = mine > 0u ? mine : 1u; nx = cnt > 0u ? cnt : 1u;
}

__device__ __forceinline__ void xcd_barrier(const XcdBarrier& b) {
    asm volatile("s_waitcnt vmcnt(0)" ::: "memory");
    __syncthreads();
    if (threadIdx.x == 0) {
        unsigned* bar = b.bar;
        __builtin_amdgcn_s_waitcnt(0);
        unsigned nloc = b.st[0], nx = b.st[1];
        if (nloc == 0u) { xcd_barrier_complete(bar, b.x, nloc, nx); b.st[0] = nloc; b.st[1] = nx; }
        const unsigned old = xb_add(&bar[XB_XSUB(b.x)], 1u);
        const unsigned gen = old / nloc;
        if (old + 1u == (gen + 1u) * nloc) {
            __builtin_amdgcn_fence(__ATOMIC_RELEASE, "agent");
            asm volatile("s_waitcnt vmcnt(0)" ::: "memory");
            const unsigned og = xb_add(&bar[XB_TOP], 1u);
            const unsigned tg = og / nx;
            if (og + 1u == (tg + 1u) * nx) xb_add(&bar[XB_TOPGEN], 1u);
            else XB_SPIN(xb_ld(&bar[XB_TOPGEN]) == tg, bar);
            __builtin_amdgcn_fence(__ATOMIC_ACQUIRE, "agent");
            xb_add(&bar[XB_XGEN(b.x)], 1u);
            asm volatile("s_waitcnt vmcnt(0)" ::: "memory");
        } else {
            XB_SPIN(xb_ld(&bar[XB_XGEN(b.x)]) == gen, bar);
            __builtin_amdgcn_fence(__ATOMIC_ACQUIRE, "agent");
            asm volatile("s_waitcnt vmcnt(0)" ::: "memory");
        }
    }
    __syncthreads();
}
enum : unsigned { W_PREP1 = 1u << 0, W_GIN = 1u << 1, W_GVT = 1u << 2, W_FC = 1u << 3, W_FA = 1u << 4, W_CV = 1u << 5, W_ATT = 1u << 6, W_SSM1 = 1u << 7, W_GPW = 1u << 8,
                  W_P2 = 1u << 9, W_FB = 1u << 10, W_GFW = 1u << 11, W_SSM3 = 1u << 12, W_GGLU = 1u << 13, W_GN = 1u << 14, W_GOUT = 1u << 15, W_PREP3 = 1u << 16, W_GFF1 = 1u << 17, W_GFF2 = 1u << 18 };
#ifndef PH_FINE
#define PH_FINE 0
#endif
#if PH_FINE
constexpr int NSP = 18;
__host__ __device__ __forceinline__ unsigned phase_mask(int sp) {
    switch (sp) { case 0: return W_PREP1; case 1: return W_GIN; case 2: return W_GVT; case 3: return W_FC; case 4: return W_FA; case 5: return W_CV; case 6: return W_ATT; case 7: return W_SSM1;
                  case 8: return W_GPW; case 9: return W_P2 | W_FB; case 10: return W_GFW; case 11: return W_SSM3; case 12: return W_GGLU; case 13: return W_GN; case 14: return W_GOUT;
                  case 15: return W_PREP3; case 16: return W_GFF1; default: return W_GFF2; }
}
#else
constexpr int NSP = 11;
__host__ __device__ __forceinline__ unsigned phase_mask(int sp) {
    switch (sp) { case 0: return W_PREP1; case 1: return W_GIN | W_GVT; case 2: return W_FA | W_CV | W_ATT | W_SSM1; case 3: return W_GPW | W_P2 | W_FB | W_FC;
                  case 4: return W_GFW | W_SSM3; case 5: return W_GGLU; case 6: return W_GN; case 7: return W_GOUT; case 8: return W_PREP3; case 9: return W_GFF1; default: return W_GFF2; }
}
#endif
constexpr int NPH = 2 + 2 * NSP;
#ifndef ZP1
#define ZP1 12
#define ZP2 30
#endif
#define OPQ_S(x) asm volatile("" : "+s"(x))
#define GSYNC() xcd_barrier(xb)
__global__ void __launch_bounds__(NTHREADS, 2) fwd(Args args) {
    extern __shared__ __attribute__((aligned(16))) unsigned char lds[];

    cg::grid_group grid = cg::this_grid();
    const int tid_ = threadIdx.x;
    const int wave_ = __builtin_amdgcn_readfirstlane(tid_ >> 6);
    float* scr = (float*)lds;
    const int G = gridDim.x, bx = blockIdx.x;
    const int gw = bx * 8 + wave_, nw = G * 8;
    const int lo = args.ph_lo, hi = args.ph_hi;
    if (lo < 0) grid.sync();
    volatile LAS unsigned* xb_st = (volatile LAS unsigned*)((LAS unsigned char*)lds + (LDS_BYTES - 64));
    if (tid_ == 0) { xb_st[0] = 0u; xb_st[1] = 0u; }
    __syncthreads();
    const XcdBarrier xb = xcd_barrier_post((unsigned*)(args.ws + WS_BAR), xb_st);
    if (lo == 0) { const Frame F{args, args.out, args.ws, tid_, tid_ & 63, wave_}; p0_prologue(F, scr); if (hi > 1) GSYNC(); }
#pragma nounroll
    for (int ph0 = (lo == 0 ? 1 : lo); ph0 < hi; ++ph0) {
        int ph = ph0; OPQ_S(ph);
        int tidv = tid_; asm volatile("" : "+v"(tidv));
        __attribute__((address_space(1))) unsigned char* wsg = (__attribute__((address_space(1))) unsigned char*)args.ws; __attribute__((address_space(1))) float* outg = (__attribute__((address_space(1))) float*)args.out;
        OPQ_S(wsg); OPQ_S(outg);
        unsigned char* wsv = (unsigned char*)wsg; float* outv = (float*)outg;
        const Frame F{args, outv, wsv, tidv, tidv & 63, wave_};
        if (ph == NPH - 1) { final_norm(F); continue; }
        const int l = (ph - 1) / NSP; const int sp = (ph - 1) - l * NSP;
        const unsigned wm = phase_mask(sp);
        const int row_lo = l == 0 ? 0 : NCTX;
        const int M_post = T_ALL - row_lo;
        unsigned char* wl = F.ws + WS_W + (size_t)l * W_LAYER;
#pragma nounroll
        for (int kind = 0; kind < 8; ++kind) {
            const unsigned bit = kind == 0 ? W_GIN : kind == 1 ? W_GVT : kind == 2 ? W_GPW : kind == 3 ? W_GFW : kind == 4 ? W_GGLU : kind == 5 ? W_GFF1 : kind == 6 ? W_GOUT : W_GFF2;
            if (!(wm & bit)) continue;
            const bf16_t* A; const bf16_t* Bt; int M, N, K;
            if (kind == 0) { A = FP(WS_XN, bf16_t); Bt = (const bf16_t*)(wl + W_IN); M = T_ALL; N = INC; K = DM; }
            else if (kind == 1) { A = (const bf16_t*)(wl + W_IN) + (size_t)1280 * DM; Bt = FP(WS_XN, bf16_t); M = 256; N = T_ALL; K = DM; }
            else if (kind == 2) { A = FP(WS_CV, bf16_t) + (size_t)row_lo * 256; Bt = (const bf16_t*)(wl + W_PW); M = M_post; N = 256; K = 256; }
            else if (kind == 3) { A = FP(WS_FN, bf16_t) + (size_t)row_lo * 256; Bt = (const bf16_t*)(wl + W_F); M = M_post; N = 256; K = 256; }
            else if (kind == 4) { A = FP(WS_YS, bf16_t) + (size_t)row_lo * 256; Bt = (const bf16_t*)(wl + W_GLU); M = M_post; N = 512; K = 256; }
            else if (kind == 5) { A = FP(WS_XN, bf16_t) + (size_t)row_lo * DM; Bt = (const bf16_t*)(wl + W_1); M = M_post; N = FFD; K = DM; }
            else if (kind == 6) { A = FP(WS_XN, bf16_t) + (size_t)row_lo * DM; Bt = (const bf16_t*)(wl + W_OUT); M = M_post; N = DM; K = DM; }
            else { A = FP(WS_H, bf16_t) + (size_t)row_lo * FFD; Bt = (const bf16_t*)(wl + W_2); M = M_post; N = DM; K = FFD; }
            pg8::Gemm g{A, Bt, M, N, K}; pg8::StaticOrder S; S.init(M, N, G, bx);
            EpiU E{F, l, kind, row_lo};
            pg8::gemm_phase<EpiU, pg8::StaticOrder, true, true>((PG8_LAS unsigned char*)lds, g, S, E);
        }
        if (wm & (W_FC | W_FA | W_CV)) {
            const int n_fc = (l == 0 && (wm & W_FC)) ? 64 : 0, n_fa = (wm & W_FA) ? 128 : 0, n_cv = (wm & W_CV) ? (l == 0 ? 544 : 512) : 0; const int nbu = n_fc + n_fa + n_cv;
            const int ustart = (n_fa + n_cv == 0) ? (G - 1 - bx) : bx;
#pragma nounroll
            for (int u = ustart; u < nbu; u += G) {
                if (u < n_fc) fnetctx_unit(F, u, scr);
                else if (u < n_fc + n_fa) fnetA_unit(F, u - n_fc, lds);
                else conv_unit(F, l, u - n_fc - n_fa, scr);
            }
        }
        if (wm & W_P2) ssm_pass2(F, l);
        if (wm & W_SSM3) {
#pragma nounroll
            for (int it = gw; it < 4096; it += nw) ssm_item<3>(F, l, it);
#pragma nounroll
            for (int it = 4096 + gw; it < 4352; it += nw) ssm_item<3>(F, l, it);
        }
        if (wm & (W_ATT | W_SSM1 | W_FB)) {
            const int n_ac = (l == 0 && (wm & W_ATT)) ? 256 : 0, n_al = (wm & W_ATT) ? 4096 : 0, n_s1 = (wm & W_SSM1) ? 4352 : 0, n_fb = (wm & W_FB) ? 1024 : 0, n_s3 = 0;
            const int e0 = n_ac, e1 = e0 + n_al, e2 = e1 + n_s1, e3 = e2 + n_fb, e4 = e3 + n_s3;
#pragma nounroll
            for (int it = gw; it < e4; it += nw) {
                if (it < e0) attn_item<false>(F, l, it);
                else if (it < e1) attn_item<true>(F, l, it - e0);
                else if (it < e2) ssm_item<1>(F, l, it - e1);
                else if (it < e3) fnetB_item(F, it - e2);
                else { ssm_item<3>(F, l, it - e3); }
            }
        }
        if (wm & W_PREP1) prep_norm_mod(F, l == 0 ? F.A.in[2] : FP(WS_XC, float), l == 0 ? F.A.in[0] : F.out, PK(6) + l * DM, FP(WS_MOD, float) + l * 5 * 6144, 0, 1024, FP(WS_XN, bf16_t), 0);
        if (wm & W_GN) prep_group(F, l, row_lo);
        if (wm & W_PREP3) prep_norm_mod(F, FP(WS_XC, float), F.out, PK(30) + l * DM, FP(WS_MOD, float) + l * 5 * 6144, 3072, 4096, FP(WS_XN, bf16_t), row_lo);
        if (ph0 + 1 < hi) GSYNC();
    }
}

extern "C" void kernel_launch(void* const* d_in, const int* in_sizes, int n_in, void* d_out, int out_size, void* d_ws, size_t ws_size, hipStream_t stream) {
    static int grid = 0;
    if (grid == 0) {
        if (n_in != 36 || ws_size < WS_END) { fprintf(stderr, "kernel_launch: unexpected n_in %d / ws %zu\n", n_in, ws_size); grid = -1; return; }
        int dev = 0, cus = 0, per_cu = 0;
        (void)hipGetDevice(&dev); (void)hipDeviceGetAttribute(&cus, hipDeviceAttributeMultiprocessorCount, dev);
        (void)hipFuncSetAttribute((const void*)fwd, hipFuncAttributeMaxDynamicSharedMemorySize, LDS_BYTES);
        (void)hipOccupancyMaxActiveBlocksPerMultiprocessor(&per_cu, (const void*)fwd, NTHREADS, LDS_BYTES);
        (void)hipGetLastError();
        grid = cus > 0 ? cus : 256;
    }
    if (grid < 0) return;
    Args a{};
    for (int i = 0; i < 36; ++i) a.in[i] = (const float*)d_in[i];
    a.out = (float*)d_out; a.ws = (unsigned char*)d_ws;
#if MODE_COOP
    (void)hipMemsetAsync((unsigned char*)d_ws + WS_BAR, 0, 16384, stream);
    a.ph_lo = 0; a.ph_hi = NPH; a.part = 15;
    void* kargs[] = {&a};
    hipError_t e = hipLaunchCooperativeKernel((const void*)fwd, dim3(grid), dim3(NTHREADS), kargs, LDS_BYTES, stream);
    if (e != hipSuccess) fprintf(stderr, "cooperative launch failed: %s (grid %d)\n", hipGetErrorString(e), grid);
#else
    for (int ph = 0; ph < NPH; ++ph) { a.ph_lo = ph; a.ph_hi = ph + 1; a.part = 15; hipLaunchKernelGGL(fwd, dim3(grid), dim3(NTHREADS), LDS_BYTES, stream, a); }
#endif
}
```

```cpp
#include <hip/hip_runtime.h>
#include <hip/hip_cooperative_groups.h>
#include <cstdio>
#include <cstdint>
namespace cg = cooperative_groups;
#ifndef MODE_COOP
#define MODE_COOP 1
#endif
namespace pg8 {
#define PG8_LAS __attribute__((address_space(3)))
typedef unsigned short bf16_t;
typedef short bf16x8 __attribute__((ext_vector_type(8)));
typedef float f32x4 __attribute__((ext_vector_type(4)));
typedef unsigned u32x4 __attribute__((ext_vector_type(4)));
constexpr int BM = 256, BK = 64, HALF = 128, HTB = HALF * BK * 2  , STAGE_BYTES = 8 * HTB, NXCD = 8, WGM = 8;

__host__ __device__ __forceinline__ int lds_byte(int r, int c) { const int st = (r >> 4) * 2 + (c >> 5), rr = r & 15, cc = c & 31, ob = rr * 64 + cc * 2; return st * 1024 + (ob ^ (((ob >> 9) & 1) << 5)); }
__host__ __device__ __forceinline__ void stage_rc(int b, int& R, int& C) { const int st = b / 1024, sb = b % 1024, swz = sb ^ (((sb >> 9) & 1) << 5); R = (st >> 1) * 16 + swz / 64; C = (st & 1) * 32 + (swz % 64) / 2; }
__host__ __device__ __forceinline__ int perm32(int rho) { const int n = rho >> 4, i = rho & 15; return 8 * (i >> 2) + 4 * n + (i & 3); }

struct Unit { int pm, pn; };
struct Gemm { const bf16_t* A; const bf16_t* Bt; int M, N, K; };

struct StaticOrder {
    int nM, nN, nwg, G, c;
    __host__ __device__ void init(int M, int N, int G_, int c_) { nM = M / BM; nN = N / BM; nwg = nM * nN; G = G_; c = c_; }
    __host__ __device__ bool next(int i, Unit& u) const {
        const long L = (long)i * G + c; if (L >= nwg) return false;
        int wgid = (int)L; { const int q = nwg / NXCD, r = nwg % NXCD, xcd = wgid % NXCD, off = wgid / NXCD; wgid = (xcd < r ? xcd * (q + 1) : r * (q + 1) + (xcd - r) * q) + off; }
        const int nig = WGM * nN, gid = wgid / nig, fm = gid * WGM, gsz = (nM - fm) < WGM ? (nM - fm) : WGM;
        u.pm = fm + ((wgid % nig) % gsz); u.pn = (wgid % nig) / gsz; return true;
    }
    __device__ __forceinline__ void a_ready(const Unit&) const {}
    __device__ __forceinline__ void done(const Unit&) const {}
};

}
namespace pg8 {
template <class Epi, class Sched, bool ALIGN_EPI = false, bool SP2 = false>
__device__ __forceinline__ void gemm_phase(PG8_LAS unsigned char* lds, const Gemm g, const Sched& S, const Epi& E) {
    const int tid = threadIdx.x, wid = __builtin_amdgcn_readfirstlane(tid >> 6), lane = tid & 63, wr = wid >> 2, wc = wid & 3, fr = lane & 15, fq = lane >> 4;
    const int K = g.K, nt = K / BK;
    unsigned voffA[2], voffB[2];
#pragma unroll
    for (int i = 0; i < 2; ++i) { int R, C; stage_rc(tid * 16 + i * 8192, R, C); const int Rb = Epi::PERM ? ((R & ~31) + perm32(R & 31)) : R;
        voffA[i] = (unsigned)(R * K + C) * 2u; voffB[i] = (unsigned)(Rb * K + C) * 2u; }
    const size_t kstep = (size_t)(BK * 2);
    const size_t hstep = (size_t)HALF * K * 2;
    const size_t tstep = 2 * hstep;
    const unsigned ldsw = (unsigned)wid * 1024u;
    const int aoff = lds_byte(wr * 64 + fr, fq * 8), boff = lds_byte(wc * 32 + fr, fq * 8);
#define PG8_SA(b, h) (((b) * 2 + (h)) * HTB)
#define PG8_SB(b, h) ((4 + (b) * 2 + (h)) * HTB)
#define PG8_STAGE(bufoff, gbase, voff) do { _Pragma("unroll") for (int _i = 0; _i < 2; ++_i) \
        __builtin_amdgcn_global_load_lds((const unsigned*)((const char*)(gbase) + (voff)[_i]), (PG8_LAS unsigned*)(lds + (bufoff) + ldsw + _i * 8192), 16, 0, 0); } while (0)
#define PG8_LDA(dst, b, h) do { _Pragma("unroll") for (int m = 0; m < 4; ++m) _Pragma("unroll") for (int k = 0; k < 2; ++k) dst[m][k] = *(const PG8_LAS bf16x8*)(lds + PG8_SA(b, h) + aoff + m * 2048 + k * 1024); } while (0)
#define PG8_LDB(dst, b, h) do { _Pragma("unroll") for (int n = 0; n < 2; ++n) _Pragma("unroll") for (int k = 0; k < 2; ++k) dst[n][k] = *(const PG8_LAS bf16x8*)(lds + PG8_SB(b, h) + boff + n * 2048 + k * 1024); } while (0)
#define PG8_MMA(ai, bj, At, Bt) do { __builtin_amdgcn_s_setprio(1); _Pragma("unroll") for (int m = 0; m < 4; ++m) _Pragma("unroll") for (int n = 0; n < 2; ++n) _Pragma("unroll") for (int k = 0; k < 2; ++k) \
        acc[ai][bj][m][n] = __builtin_amdgcn_mfma_f32_16x16x32_bf16(Bt[n][k], At[m][k], acc[ai][bj][m][n], 0, 0, 0); __builtin_amdgcn_s_setprio(0); } while (0)
#define PG8_WAIT_V(n) asm volatile("s_waitcnt vmcnt(" #n ")" ::: "memory")
#define PG8_WAIT_L(n) asm volatile("s_waitcnt lgkmcnt(" #n ")" ::: "memory")
#define PG8_BAR __builtin_amdgcn_s_barrier()
#define PG8_SCHED __builtin_amdgcn_sched_barrier(0)
    Unit cur, nxt; int ui = 0;
    if (!S.next(0, cur)) return;
    f32x4 acc[2][2][4][2];
#pragma unroll
    for (int a = 0; a < 2; ++a)
#pragma unroll
        for (int b = 0; b < 2; ++b)
#pragma unroll
            for (int m = 0; m < 4; ++m)
#pragma unroll
                for (int n = 0; n < 2; ++n) acc[a][b][m][n] = (f32x4){0.f, 0.f, 0.f, 0.f};
    bf16x8 At[4][2], B0[2][2], B1[2][2];
    const char* cA = (const char*)g.A + (size_t)cur.pm * tstep; const char* cB = (const char*)g.Bt + (size_t)cur.pn * tstep;
    S.a_ready(cur);
    if constexpr (SP2) {
        PG8_STAGE(PG8_SB(0, 0), cB, voffB); PG8_STAGE(PG8_SB(0, 1), cB + hstep, voffB); PG8_STAGE(PG8_SA(0, 0), cA, voffA); PG8_STAGE(PG8_SA(0, 1), cA + hstep, voffA);
        if (wr == 1) PG8_BAR;
        PG8_WAIT_V(2); PG8_BAR;
        PG8_STAGE(PG8_SB(1, 0), cB + kstep, voffB); PG8_STAGE(PG8_SA(1, 0), cA + kstep, voffA); PG8_STAGE(PG8_SB(1, 1), cB + hstep + kstep, voffB);
        PG8_WAIT_V(6); PG8_BAR;
    } else {
        PG8_STAGE(PG8_SB(0, 0), cB, voffB); PG8_STAGE(PG8_SA(0, 0), cA, voffA); PG8_STAGE(PG8_SB(0, 1), cB + hstep, voffB); PG8_STAGE(PG8_SA(0, 1), cA + hstep, voffA);
        if (wr == 1) PG8_BAR;
        PG8_WAIT_V(4); PG8_BAR;
        PG8_STAGE(PG8_SB(1, 0), cB + kstep, voffB); PG8_STAGE(PG8_SA(1, 0), cA + kstep, voffA); PG8_STAGE(PG8_SB(1, 1), cB + hstep + kstep, voffB);
        PG8_WAIT_V(6); PG8_BAR;
    }
    for (;;) {
        const bool has_next = S.next(ui + 1, nxt);
        const char* nA = has_next ? (const char*)g.A + (size_t)nxt.pm * tstep : cA; const char* nB = has_next ? (const char*)g.Bt + (size_t)nxt.pn * tstep : cB;
        for (int t = 0; t < nt; t += 2) {
            const bool last = (t == nt - 2);
            const char* a1 = cA + (size_t)(t + 1) * kstep;
            const char* a2 = last ? nA : cA + (size_t)(t + 2) * kstep; const char* b2 = last ? nB : cB + (size_t)(t + 2) * kstep;
            const char* a3 = a2 + kstep; const char* b3 = b2 + kstep;
            if (last && has_next) S.a_ready(nxt);
            if constexpr (SP2) {
            PG8_LDB(B0, 0, 0); PG8_LDB(B1, 0, 1); PG8_SCHED; PG8_LDA(At, 0, 0); PG8_STAGE(PG8_SA(1, 1), a1 + hstep, voffA);
            PG8_WAIT_V(8); PG8_WAIT_L(0); PG8_BAR; PG8_MMA(0, 0, At, B0); PG8_MMA(0, 1, At, B1); PG8_BAR; PG8_SCHED;
            PG8_LDA(At, 0, 1); PG8_STAGE(PG8_SB(0, 0), b2, voffB); PG8_STAGE(PG8_SB(0, 1), b2 + hstep, voffB); PG8_STAGE(PG8_SA(0, 0), a2, voffA);
            PG8_WAIT_V(8); PG8_WAIT_L(0); PG8_BAR; PG8_MMA(1, 0, At, B0); PG8_MMA(1, 1, At, B1); PG8_BAR; PG8_SCHED;
            PG8_LDB(B0, 1, 0); PG8_LDB(B1, 1, 1); PG8_SCHED; PG8_LDA(At, 1, 0); PG8_STAGE(PG8_SA(0, 1), a2 + hstep, voffA);
            PG8_WAIT_V(8); PG8_WAIT_L(0); PG8_BAR; PG8_MMA(0, 0, At, B0); PG8_MMA(0, 1, At, B1); PG8_BAR; PG8_SCHED;
            PG8_LDA(At, 1, 1); PG8_STAGE(PG8_SB(1, 0), b3, voffB); PG8_STAGE(PG8_SB(1, 1), b3 + hstep, voffB); PG8_STAGE(PG8_SA(1, 0), a3, voffA);
            PG8_WAIT_V(8); PG8_WAIT_L(0); PG8_BAR; PG8_MMA(1, 0, At, B0); PG8_MMA(1, 1, At, B1); PG8_BAR; PG8_SCHED;
            } else {
            PG8_LDB(B0, 0, 0); PG8_SCHED; PG8_LDA(At, 0, 0); PG8_STAGE(PG8_SA(1, 1), a1 + hstep, voffA);
            PG8_WAIT_L(8); PG8_BAR; PG8_WAIT_L(0); PG8_MMA(0, 0, At, B0); PG8_BAR; PG8_SCHED;
            PG8_LDB(B1, 0, 1); PG8_STAGE(PG8_SB(0, 0), b2, voffB);
            PG8_BAR; PG8_WAIT_L(0); PG8_MMA(0, 1, At, B1); PG8_BAR;
            PG8_LDA(At, 0, 1); PG8_STAGE(PG8_SA(0, 0), a2, voffA);
            PG8_BAR; PG8_WAIT_L(0); PG8_MMA(1, 0, At, B0); PG8_BAR; PG8_SCHED;
            PG8_STAGE(PG8_SB(0, 1), b2 + hstep, voffB);
            PG8_WAIT_V(6); PG8_BAR; PG8_MMA(1, 1, At, B1); PG8_BAR;
            PG8_LDB(B0, 1, 0); PG8_SCHED; PG8_LDA(At, 1, 0); PG8_STAGE(PG8_SA(0, 1), a2 + hstep, voffA);
            PG8_WAIT_L(8); PG8_BAR; PG8_WAIT_L(0); PG8_MMA(0, 0, At, B0); PG8_BAR; PG8_SCHED;
            PG8_LDB(B1, 1, 1); PG8_STAGE(PG8_SB(1, 0), b3, voffB);
            PG8_BAR; PG8_WAIT_L(0); PG8_MMA(0, 1, At, B1); PG8_BAR;
            PG8_LDA(At, 1, 1); PG8_STAGE(PG8_SA(1, 0), a3, voffA);
            PG8_BAR; PG8_WAIT_L(0); PG8_MMA(1, 0, At, B0); PG8_BAR; PG8_SCHED;
            PG8_STAGE(PG8_SB(1, 1), b3 + hstep, voffB);
            PG8_WAIT_V(6); PG8_BAR; PG8_MMA(1, 1, At, B1); PG8_BAR;
            }
        }
        if constexpr (ALIGN_EPI) { if (wr == 0) PG8_BAR; }
        if constexpr (!Epi::AFTER_DRAIN) { E(acc, cur, wr, wc, fr, fq); S.done(cur); }
        if (!has_next) break;
#pragma unroll
        for (int a = 0; a < 2; ++a)
#pragma unroll
            for (int b = 0; b < 2; ++b)
#pragma unroll
                for (int m = 0; m < 4; ++m)
#pragma unroll
                    for (int n = 0; n < 2; ++n) acc[a][b][m][n] = (f32x4){0.f, 0.f, 0.f, 0.f};
        cur = nxt; cA = nA; cB = nB; ++ui;
        if constexpr (ALIGN_EPI) { if (wr == 1) PG8_BAR; }
    }
    PG8_WAIT_V(0);
    if constexpr (!ALIGN_EPI) { if (wr == 0) PG8_BAR; }
    PG8_BAR;
    if constexpr (Epi::AFTER_DRAIN) { E.fused(acc, cur, wr, wc, fr, fq, lds, wid, lane); S.done(cur); }
#undef PG8_SA
#undef PG8_SB
#undef PG8_STAGE
#undef PG8_LDA
#undef PG8_LDB
#undef PG8_MMA
#undef PG8_WAIT_V
#undef PG8_WAIT_L
#undef PG8_BAR
#undef PG8_SCHED
}
}

using pg8::bf16_t; using pg8::bf16x8; using pg8::f32x4;
#define LAS __attribute__((address_space(3)))
typedef short bf16x4 __attribute__((ext_vector_type(4)));
typedef unsigned u32x4 __attribute__((ext_vector_type(4)));
typedef unsigned u32x2 __attribute__((ext_vector_type(2)));

constexpr int NTHREADS = 512;
constexpr int T_ALL = 17408, NCTX = 1024, NLAT = 16384, DM = 1024, INC = 1792, FFD = 4096;
constexpr int LDS_BYTES = 147456;
constexpr float EPS = 1e-6f;

constexpr size_t MiB = 1u << 20;
constexpr size_t WS_MOD = 0;
constexpr size_t WS_CTAB = 256 * 1024;
constexpr size_t WS_STAB = 256 * 1024 + 8192;
constexpr size_t WS_PACK = 1 * MiB;
constexpr size_t WS_SLOC = 3 * MiB;
constexpr size_t WS_CARRY = 7 * MiB + 256 * 1024;
constexpr size_t WS_W = 12 * MiB;
constexpr size_t W_IN = 0, W_PW = W_IN + (size_t)INC * DM * 2, W_F = W_PW + 256 * 256 * 2, W_GLU = W_F + 256 * 256 * 2,
                 W_OUT = W_GLU + 512 * 256 * 2, W_1 = W_OUT + (size_t)DM * DM * 2, W_2 = W_1 + (size_t)FFD * DM * 2, W_LAYER = W_2 + (size_t)FFD * DM * 2;
static_assert(W_LAYER == 22 * MiB, "weights per layer");
constexpr size_t WS_XC = 56 * MiB;
constexpr size_t WS_XN = 60 * MiB;
constexpr size_t WS_BIG = 94 * MiB;
constexpr size_t WS_H = WS_BIG;
constexpr size_t WS_PX = WS_BIG;
constexpr size_t WS_VT = 154 * MiB;
constexpr size_t WS_VTC = 162 * MiB;
constexpr size_t WS_CV = 163 * MiB;
constexpr size_t WS_YB = 172 * MiB;
constexpr size_t WS_FN = 188 * MiB;
constexpr size_t WS_YS = 197 * MiB;
constexpr size_t WS_ZS = 206 * MiB;
constexpr size_t WS_MIX = 223 * MiB;
constexpr size_t WS_END = 256 * MiB;
static_assert(WS_H + (size_t)T_ALL * FFD * 2 <= WS_END && WS_MIX + (size_t)T_ALL * 768 * 2 <= WS_END && WS_PX + (size_t)T_ALL * INC * 2 <= WS_VT, "ws map");

__device__ __forceinline__ unsigned f2bf(float f) { unsigned u = __builtin_bit_cast(unsigned, f); return (u + 0x7fffu + ((u >> 16) & 1u)) >> 16; }
__device__ __forceinline__ unsigned pk2(float lo, float hi) { return f2bf(lo) | (f2bf(hi) << 16); }
__device__ __forceinline__ float bf2f(unsigned h) { return __builtin_bit_cast(float, (h & 0xffffu) << 16); }
__device__ __forceinline__ float bflo(unsigned w) { return __builtin_bit_cast(float, w << 16); }
__device__ __forceinline__ float bfhi(unsigned w) { return __builtin_bit_cast(float, w & 0xffff0000u); }
__device__ __forceinline__ bf16x8 pack8(f32x4 a, f32x4 b) {
    u32x4 w; w.x = pk2(a[0], a[1]); w.y = pk2(a[2], a[3]); w.z = pk2(b[0], b[1]); w.w = pk2(b[2], b[3]);
    return __builtin_bit_cast(bf16x8, w);
}
__device__ __forceinline__ bf16x8 neg8(bf16x8 v) { u32x4 w = __builtin_bit_cast(u32x4, v); w.x ^= 0x80008000u; w.y ^= 0x80008000u; w.z ^= 0x80008000u; w.w ^= 0x80008000u; return __builtin_bit_cast(bf16x8, w); }
__device__ __forceinline__ bf16x8 zero8() { u32x4 w = {0u, 0u, 0u, 0u}; return __builtin_bit_cast(bf16x8, w); }
__device__ __forceinline__ bf16x8 cat4(u32x2 a, u32x2 b) { u32x4 w; w.x = a.x; w.y = a.y; w.z = b.x; w.w = b.y; return __builtin_bit_cast(bf16x8, w); }
__device__ __forceinline__ f32x4 mfma16(bf16x8 a, bf16x8 b, f32x4 c) { return __builtin_amdgcn_mfma_f32_16x16x32_bf16(a, b, c, 0, 0, 0); }
__device__ __forceinline__ void settle4(f32x4& a, f32x4& b, f32x4& c, f32x4& d) { asm volatile("s_nop 15\n\ts_nop 15" : "+v"(a), "+v"(b), "+v"(c), "+v"(d)); }
__device__ __forceinline__ void settle4m(f32x4& a, f32x4& b, f32x4& c, f32x4& d) { asm volatile("s_nop 7\n\ts_nop 7" : "+v"(a), "+v"(b), "+v"(c), "+v"(d) :: "memory"); }
__device__ __forceinline__ f32x4 mfma16s(bf16x8 a, bf16x8 b, f32x4 c) { asm volatile("s_nop 7" : "+v"(a), "+v"(b)); return __builtin_amdgcn_mfma_f32_16x16x32_bf16(a, b, c, 0, 0, 0); }
__device__ __forceinline__ void settle2(f32x4& a, f32x4& b) { asm volatile("s_nop 15\n\ts_nop 15" : "+v"(a), "+v"(b)); }
__device__ __forceinline__ void settle_in(bf16x8& a, bf16x8& b) { asm volatile("s_nop 3" : "+v"(a), "+v"(b)); }
__device__ __forceinline__ float wave_sum(float v) {
    v += __shfl_xor(v, 1); v += __shfl_xor(v, 2); v += __shfl_xor(v, 4); v += __shfl_xor(v, 8); v += __shfl_xor(v, 16); v += __shfl_xor(v, 32); return v;
}
__device__ __forceinline__ float sigmoidf_(float x) { return 1.0f / (1.0f + __expf(-x)); }
struct cplx { float re, im; };
__device__ __forceinline__ cplx cmul(cplx a, cplx b) { return cplx{a.re * b.re - a.im * b.im, a.re * b.im + a.im * b.re}; }
__device__ __forceinline__ cplx cmad(cplx acc, cplx a, cplx b) { return cplx{acc.re + a.re * b.re - a.im * b.im, acc.im + a.re * b.im + a.im * b.re}; }

struct Args { const float* in[36]; float* out; unsigned char* ws; int ph_lo, ph_hi, part, pad; };
struct Frame {
    const Args& A;
    float* out; unsigned char* ws;
    int tid, lane, wave;
};
#define FP(off, type) ((type*)(F.ws + (off)))

constexpr int PK_N = 23;
constexpr int PK_IDX[PK_N] = {6,8,9,10,11,13,15,16,17,18,19,20,21,22,23,24,26,27,29,30,32,34,35};
constexpr int PK_CNT[PK_N] = {2048,15872,512,512,512,512,512,3720,4096,4096,64,65536,65536,65536,65536,512,1024,2048,2048,2048,8192,2048,1024};
constexpr int pk_off(int k) { int o = 0; for (int i = 0; i < PK_N; ++i) { if (PK_IDX[i] == k) return o; o += PK_CNT[i]; } return -1; }
#define PK(k) (FP(WS_PACK, float) + pk_off(k))
static_assert(pk_off(35) + 1024 <= (int)(2 * MiB / 4), "pack size");

struct EpiU {
    static constexpr bool PERM = false, AFTER_DRAIN = false;
    const Frame& F; int l; int kind; int row_lo;
    __device__ __forceinline__ void operator()(const f32x4 (&acc)[2][2][4][2], const pg8::Unit& u, int wr, int wc, int fr, int fq) const {
        const int c0 = u.pn * 256 + wc * 32 + fq * 4;
        const int r0 = u.pm * 256 + wr * 64 + fr;
        if (kind < 6) {
            bf16_t* base; size_t ldc; const float* bias = nullptr;
            if (kind == 0) { base = FP(WS_PX, bf16_t) + (size_t)r0 * INC + c0; ldc = INC; }
            else if (kind == 1) {
                if (u.pn < 4) { base = FP(WS_VTC, bf16_t) + (size_t)u.pn * 65536 + (size_t)r0 * 256 + (c0 - u.pn * 256); ldc = 256; }
                else { const int tt = u.pn - 4; base = FP(WS_VT, bf16_t) + (size_t)(tt >> 4) * 256 * 4096 + (tt & 15) * 256 + (size_t)r0 * 4096 + (c0 - u.pn * 256); ldc = 4096; }
            }
            else if (kind == 2) { base = FP(WS_MIX, bf16_t) + (size_t)(row_lo + r0) * 768 + c0; ldc = 768; bias = PK(13) + l * 256; }
            else if (kind == 3) { base = FP(WS_MIX, bf16_t) + (size_t)(row_lo + r0) * 768 + 256 + c0; ldc = 768; bias = PK(15) + l * 256; }
            else if (kind == 4) { base = FP(WS_ZS, bf16_t) + (size_t)(row_lo + r0) * 512 + c0; ldc = 512; bias = PK(26) + l * 512; }
            else { base = FP(WS_H, bf16_t) + (size_t)(row_lo + r0) * FFD + c0; ldc = FFD; bias = PK(32) + l * FFD; }
#pragma unroll
            for (int bj = 0; bj < 2; ++bj)
#pragma unroll
                for (int n = 0; n < 2; ++n) {
                    f32x4 bv = f32x4{0.f, 0.f, 0.f, 0.f};
                    if (bias) bv = *(const f32x4*)(bias + c0 + bj * 128 + n * 16);
#pragma unroll
                    for (int ai = 0; ai < 2; ++ai)
#pragma unroll
                        for (int m = 0; m < 4; ++m) {
                            f32x4 v = acc[ai][bj][m][n] + bv;
                            if (kind == 5) {
#pragma unroll
                                for (int j = 0; j < 4; ++j) { const float r = fmaxf(v[j], 0.f); v[j] = r * r; }
                            }
                            u32x2 w; w.x = pk2(v[0], v[1]); w.y = pk2(v[2], v[3]);
                            *(u32x2*)(base + (size_t)(ai * 128 + m * 16) * ldc + bj * 128 + n * 16) = w;
                        }
                }
        } else {
            const int gp = u.pm + (row_lo >> 8); const bool isc = gp < 4; const int lrow0 = isc ? gp * 256 : (gp - 4) * 256; const int br = isc ? 4 : ((gp - 4) >> 4);
            const float* sC; const float* sL; const float* bias; int gate_off;
            if (kind == 6) { sC = l == 0 ? F.A.in[2] : FP(WS_XC, float); sL = l == 0 ? F.A.in[0] : F.out; bias = PK(29) + l * DM; gate_off = 2048; }
            else { sC = FP(WS_XC, float); sL = F.out; bias = PK(34) + l * DM; gate_off = 5120; }
            const size_t roff = (size_t)(lrow0 + wr * 64 + fr) * DM + c0;
            const float* s = (isc ? sC : sL) + roff; float* d = (isc ? FP(WS_XC, float) : F.out) + roff;
            const float* gate = FP(WS_MOD, float) + (l * 5 + br) * 6144 + gate_off;
#pragma unroll
            for (int bj = 0; bj < 2; ++bj)
#pragma unroll
                for (int n = 0; n < 2; ++n) {
                    const int cc = c0 + bj * 128 + n * 16;
                    const f32x4 bv = *(const f32x4*)(bias + cc); const f32x4 gv = *(const f32x4*)(gate + cc);
#pragma unroll
                    for (int ai = 0; ai < 2; ++ai)
#pragma unroll
                        for (int m = 0; m < 4; ++m) {
                            const size_t o = (size_t)(ai * 128 + m * 16) * DM + bj * 128 + n * 16;
                            const f32x4 xv = *(const f32x4*)(s + o);
                            *(f32x4*)(d + o) = xv + gv * (acc[ai][bj][m][n] + bv);
                        }
                }
        }
    }
};

__device__ __forceinline__ void transpose_tile(const float* W, int K, int N, bf16_t* Wt, int tile, float* scr, int tid) {
    const int ntn = N >> 6; const int tk = tile / ntn, tn = tile - tk * ntn; const int k0 = tk * 64, n0 = tn * 64;
    { const int n = tid & 63, kk = tid >> 6;
#pragma unroll
      for (int i = 0; i < 8; ++i) { const int k = kk + 8 * i; scr[k * 65 + n] = W[(size_t)(k0 + k) * N + n0 + n]; } }
    __syncthreads();
    { const int kp = tid & 31, nn = tid >> 5;
#pragma unroll
      for (int i = 0; i < 4; ++i) { const int n = nn + 16 * i; const unsigned v = pk2(scr[(2 * kp) * 65 + n], scr[(2 * kp + 1) * 65 + n]); *(unsigned*)(Wt + (size_t)(n0 + n) * K + k0 + 2 * kp) = v; } }
    __syncthreads();
}
__device__ __forceinline__ void mod_unit(const Frame& F, int unit, float* scr) {
    const int l = unit / 96, cc = unit - l * 96; const int tid = F.tid;
    float* sl = scr; float* red = scr + 5 * 1024;
    for (int i = tid; i < 5 * 1024; i += NTHREADS) { const int r = i >> 10, k = i & 1023; const float c = r < 4 ? F.A.in[1][r * 1024 + k] : F.A.in[3][k]; sl[i] = c * sigmoidf_(c); }
    __syncthreads();
    const int col = tid & 63, kg = tid >> 6;
    const float* w = F.A.in[4] + (size_t)l * DM * 6144 + cc * 64 + col;
    float a0 = 0.f, a1 = 0.f, a2 = 0.f, a3 = 0.f, a4 = 0.f;
    for (int k = kg * 128; k < kg * 128 + 128; ++k) { const float wv = w[(size_t)k * 6144]; a0 += sl[k] * wv; a1 += sl[1024 + k] * wv; a2 += sl[2048 + k] * wv; a3 += sl[3072 + k] * wv; a4 += sl[4096 + k] * wv; }
    red[(kg * 5 + 0) * 64 + col] = a0; red[(kg * 5 + 1) * 64 + col] = a1; red[(kg * 5 + 2) * 64 + col] = a2; red[(kg * 5 + 3) * 64 + col] = a3; red[(kg * 5 + 4) * 64 + col] = a4;
    __syncthreads();
    if (tid < 320) { const int r = tid >> 6, c2 = tid & 63; float s = 0.f;
#pragma unroll
        for (int g = 0; g < 8; ++g) s += red[(g * 5 + r) * 64 + c2];
        FP(WS_MOD, float)[(l * 5 + r) * 6144 + cc * 64 + c2] = s + F.A.in[5][l * 6144 + cc * 64 + c2]; }
    __syncthreads();
}
__device__ __forceinline__ void p0_prologue(const Frame& F, float* scr) {
    const int NT_L = 448 + 16 + 16 + 32 + 256 + 1024 + 1024;
    const int njobs = 193 + 2 * NT_L + PK_N;
    for (int job = blockIdx.x; job < njobs; job += gridDim.x) {
        if (job >= 193 + 2 * NT_L) {
            const int e = job - (193 + 2 * NT_L); const float* src = nullptr; int cnt = 0, off = 0;
#define PKC(i) if (e == i) { src = F.A.in[PK_IDX[i]]; cnt = PK_CNT[i]; off = pk_off(PK_IDX[i]); }
            PKC(0) PKC(1) PKC(2) PKC(3) PKC(4) PKC(5) PKC(6) PKC(7) PKC(8) PKC(9) PKC(10) PKC(11) PKC(12) PKC(13) PKC(14) PKC(15) PKC(16) PKC(17) PKC(18) PKC(19) PKC(20) PKC(21) PKC(22)
#undef PKC
            float* dst = FP(WS_PACK, float) + off;
            for (int i = F.tid; i < cnt; i += NTHREADS) dst[i] = src[i];
        }
        else if (job < 192) { mod_unit(F, job, scr); }
        else if (job == 192) {
            for (int i = F.tid; i < 4096; i += NTHREADS) { const int m = i >> 6, j = i & 63; const float x = (float)((m * j) & 63) * (1.0f / 32.0f);
                FP(WS_CTAB, bf16_t)[i] = (bf16_t)f2bf(cospif(x)); FP(WS_STAB, bf16_t)[i] = (bf16_t)f2bf(sinpif(x)); }
        } else {
            int t = job - 193; const int l = t / NT_L; t -= l * NT_L;
            unsigned char* wl = F.ws + WS_W + (size_t)l * W_LAYER;
            if (t < 448) transpose_tile(F.A.in[7] + (size_t)l * DM * INC, DM, INC, (bf16_t*)(wl + W_IN), t, scr, F.tid);
            else if ((t -= 448) < 16) transpose_tile(F.A.in[12] + (size_t)l * 65536, 256, 256, (bf16_t*)(wl + W_PW), t, scr, F.tid);
            else if ((t -= 16) < 16) transpose_tile(F.A.in[14] + (size_t)l * 65536, 256, 256, (bf16_t*)(wl + W_F), t, scr, F.tid);
            else if ((t -= 16) < 32) transpose_tile(F.A.in[25] + (size_t)l * 131072, 256, 512, (bf16_t*)(wl + W_GLU), t, scr, F.tid);
            else if ((t -= 32) < 256) transpose_tile(F.A.in[28] + (size_t)l * DM * DM, DM, DM, (bf16_t*)(wl + W_OUT), t, scr, F.tid);
            else if ((t -= 256) < 1024) transpose_tile(F.A.in[31] + (size_t)l * DM * FFD, DM, FFD, (bf16_t*)(wl + W_1), t, scr, F.tid);
            else { t -= 1024; transpose_tile(F.A.in[33] + (size_t)l * DM * FFD, FFD, DM, (bf16_t*)(wl + W_2), t, scr, F.tid); }
        }
    }
}

__device__ __forceinline__ void prep_norm_mod(const Frame& F, const float* srcC, const float* srcL, const float* g, const float* modl, int sh_off, int sc_off, bf16_t* XN, int row_lo) {
    const int gw = blockIdx.x * 8 + F.wave, nw = gridDim.x * 8, lane = F.lane;
    for (int row = row_lo + gw; row < T_ALL; row += nw) {
        const bool isc = row < NCTX; const float* x = isc ? srcC + (size_t)row * DM : srcL + (size_t)(row - NCTX) * DM; const int br = isc ? 4 : ((row - NCTX) >> 12);
        const float* sh = modl + br * 6144 + sh_off; const float* sc = modl + br * 6144 + sc_off;
        f32x4 v[4]; float ss = 0.f;
#pragma unroll
        for (int i = 0; i < 4; ++i) { v[i] = *(const f32x4*)(x + i * 256 + lane * 4); ss += v[i][0] * v[i][0] + v[i][1] * v[i][1] + v[i][2] * v[i][2] + v[i][3] * v[i][3]; }
        ss = wave_sum(ss); const float r = rsqrtf(ss * (1.0f / 1024.0f) + EPS);
#pragma unroll
        for (int i = 0; i < 4; ++i) { const int c = i * 256 + lane * 4; const f32x4 gv = *(const f32x4*)(g + c), shv = *(const f32x4*)(sh + c), scv = *(const f32x4*)(sc + c);
            f32x4 y = v[i] * r * gv; y = y * (scv + 1.0f) + shv; u32x2 w; w.x = pk2(y[0], y[1]); w.y = pk2(y[2], y[3]); *(u32x2*)(XN + (size_t)row * DM + c) = w; }
    }
}
__device__ __forceinline__ f32x4 ld_bf4(const bf16_t* p) { const u32x2 w = *(const u32x2*)p; return f32x4{bflo(w.x), bfhi(w.x), bflo(w.y), bfhi(w.y)}; }
__device__ __forceinline__ void prep_group(const Frame& F, int l, int row_lo) {
    const int gw = blockIdx.x * 8 + F.wave, nw = gridDim.x * 8, lane = F.lane;
    const bf16_t* MIX = FP(WS_MIX, bf16_t); const bf16_t* ZS = FP(WS_ZS, bf16_t); bf16_t* O = FP(WS_XN, bf16_t); const float* gg = PK(27) + l * DM;
    for (int row = row_lo + gw; row < T_ALL; row += nw) {
#pragma unroll
        for (int grp = 0; grp < 4; ++grp) {
            f32x4 v;
            if (grp < 3) v = ld_bf4(MIX + (size_t)row * 768 + grp * 256 + lane * 4);
            else { const f32x4 a = ld_bf4(ZS + (size_t)row * 512 + lane * 4), gt = ld_bf4(ZS + (size_t)row * 512 + 256 + lane * 4);
#pragma unroll
                for (int j = 0; j < 4; ++j) v[j] = a[j] * sigmoidf_(gt[j]); }
            float ss = v[0] * v[0] + v[1] * v[1] + v[2] * v[2] + v[3] * v[3]; ss = wave_sum(ss);
            const float r = rsqrtf(ss * (1.0f / 256.0f) + EPS); const f32x4 gv = *(const f32x4*)(gg + grp * 256 + lane * 4); const f32x4 y = v * r * gv;
            u32x2 w; w.x = pk2(y[0], y[1]); w.y = pk2(y[2], y[3]); *(u32x2*)(O + (size_t)row * DM + grp * 256 + lane * 4) = w;
        }
    }
}
__device__ __forceinline__ void final_norm(const Frame& F) {
    const int gw = blockIdx.x * 8 + F.wave, nw = gridDim.x * 8, lane = F.lane; const float* g = PK(35);
    for (int row = gw; row < NLAT; row += nw) {
        float* x = F.out + (size_t)row * DM; f32x4 v[4]; float ss = 0.f;
#pragma unroll
        for (int i = 0; i < 4; ++i) { v[i] = *(const f32x4*)(x + i * 256 + lane * 4); ss += v[i][0] * v[i][0] + v[i][1] * v[i][1] + v[i][2] * v[i][2] + v[i][3] * v[i][3]; }
        ss = wave_sum(ss); const float r = rsqrtf(ss * (1.0f / 1024.0f) + EPS);
#pragma unroll
        for (int i = 0; i < 4; ++i) { const int c = i * 256 + lane * 4; *(f32x4*)(x + c) = v[i] * r * *(const f32x4*)(g + c); }
    }
}

__device__ __forceinline__ void conv_unit(const Frame& F, int l, int unit, float* scr) {
    const bf16_t* PX = FP(WS_PX, bf16_t); bf16_t* CV = FP(WS_CV, bf16_t);
    int prow0, Lseq, t0;
    if (unit < 512) { const int b = unit >> 7; t0 = (unit & 127) * 32; prow0 = NCTX + b * 4096; Lseq = 4096; }
    else { const int uu = unit - 512; const int b = uu >> 3; t0 = (uu & 7) * 32; prow0 = b * 256; Lseq = 256; }
    float* vt = scr; float* ot = scr + 62 * 256; int tid = F.tid; asm volatile("" : "+v"(tid));
    for (int idx = tid; idx < 62 * 256; idx += NTHREADS) { const int rr = idx >> 8, c = idx & 255; const int t = t0 - 15 + rr; float v = 0.f;
        if (t >= 0 && t < Lseq) { const bf16_t* p = PX + (size_t)(prow0 + t) * INC; const float a = bf2f(p[c]), gt = bf2f(p[256 + c]); v = a * sigmoidf_(gt); }
        vt[idx] = v; }
    __syncthreads();
    { const int c = tid & 255, half = tid >> 8; float w[31];
#pragma unroll
      for (int j = 0; j < 31; ++j) w[j] = PK(8)[(l * 31 + j) * 256 + c];
      const float bd = PK(9)[l * 256 + c];
      for (int tt = 0; tt < 16; ++tt) { const int t = half * 16 + tt; float s = bd;
#pragma unroll
          for (int j = 0; j < 31; ++j) s += w[j] * vt[(t + j) * 256 + c];
          ot[t * 256 + c] = s; } }
    __syncthreads();
    { const int lane = tid & 63; const f32x4 lg = *(const f32x4*)(PK(10) + l * 256 + lane * 4), lb = *(const f32x4*)(PK(11) + l * 256 + lane * 4);
      for (int i = 0; i < 4; ++i) { const int t = F.wave * 4 + i; const f32x4 x = *(const f32x4*)(ot + t * 256 + lane * 4);
          const float mu = wave_sum(x[0] + x[1] + x[2] + x[3]) * (1.0f / 256.0f); const f32x4 d = x - mu;
          const float var = wave_sum(d[0] * d[0] + d[1] * d[1] + d[2] * d[2] + d[3] * d[3]) * (1.0f / 256.0f); const float r = rsqrtf(var + EPS);
          f32x4 y = d * r * lg + lb;
#pragma unroll
          for (int j = 0; j < 4; ++j) y[j] = y[j] * sigmoidf_(y[j]);
          u32x2 w; w.x = pk2(y[0], y[1]); w.y = pk2(y[2], y[3]); *(u32x2*)(CV + (size_t)(prow0 + t0 + t) * 256 + lane * 4) = w; } }
    __syncthreads();
}

__device__ __forceinline__ void fnetctx_unit(const Frame& F, int unit, float* scr) {
    const bf16_t* PX = FP(WS_PX, bf16_t); bf16_t* FN = FP(WS_FN, bf16_t);
    const int mh = unit & 1, kh = (unit >> 1) & 3, h = (unit >> 3) & 3, b = unit >> 5; int tid = F.tid; asm volatile("" : "+v"(tid));
    float* zc = scr; float* zs = scr + 8192; float* c64 = scr + 16384; float* s64 = c64 + 64; float* c256 = s64 + 64; float* s256 = c256 + 256;
    if (tid < 64) { const float x = (float)tid * (1.0f / 32.0f); c64[tid] = cospif(x); s64[tid] = sinpif(x); }
    if (tid < 256) { const float x = (float)tid * (1.0f / 128.0f); c256[tid] = cospif(x); s256[tid] = sinpif(x); }
    __syncthreads();
    for (int idx = tid; idx < 8192; idx += NTHREADS) { const int n = idx >> 5, mm = idx & 31, m = mh * 32 + mm; const bf16_t* up = PX + (size_t)(b * 256 + n) * INC + 512 + h * 64;
        float ac = 0.f, as = 0.f;
        for (int j = 0; j < 64; ++j) { const float uv = bf2f(up[j]); const int a = (j * m) & 63; ac += uv * c64[a]; as += uv * s64[a]; }
        zc[idx] = ac; zs[idx] = as; }
    __syncthreads();
    for (int idx = tid; idx < 2048; idx += NTHREADS) { const int k = kh * 64 + (idx >> 5), mm = idx & 31; float acc = 0.f;
        for (int n = 0; n < 256; ++n) { const int a = (k * n) & 255; acc += c256[a] * zc[n * 32 + mm] - s256[a] * zs[n * 32 + mm]; }
        FN[(size_t)(b * 256 + k) * 256 + h * 64 + mh * 32 + mm] = (bf16_t)f2bf(acc * (1.0f / 128.0f)); }
    __syncthreads();
}
__device__ __forceinline__ void fnetA_unit(const Frame& F, int unit, unsigned char* lds) {
    const bf16_t* PX = FP(WS_PX, bf16_t); const bf16_t* Ct = FP(WS_CTAB, bf16_t); const bf16_t* St = FP(WS_STAB, bf16_t); bf16_t* YB = FP(WS_YB, bf16_t);
    const int oct = unit & 7, h = (unit >> 3) & 3, b = unit >> 5; int tid = F.tid; asm volatile("" : "+v"(tid)); const int lane = tid & 63, fr = lane & 15, fq = lane >> 4; const int n2 = oct * 8 + F.wave;
    bf16x8 ua[4][2];
#pragma unroll
    for (int mi = 0; mi < 4; ++mi)
#pragma unroll
        for (int kk = 0; kk < 2; ++kk) ua[mi][kk] = *(const bf16x8*)(PX + (size_t)(NCTX + b * 4096 + 64 * (16 * mi + fr) + n2) * INC + 512 + h * 64 + kk * 32 + fq * 8);
    bf16x8 zre[2][4], zs[2][4];
#pragma unroll
    for (int ni = 0; ni < 4; ++ni) {
        bf16x8 bc[2], bs[2];
#pragma unroll
        for (int kk = 0; kk < 2; ++kk) { bc[kk] = *(const bf16x8*)(Ct + (16 * ni + fr) * 64 + kk * 32 + fq * 8); bs[kk] = *(const bf16x8*)(St + (16 * ni + fr) * 64 + kk * 32 + fq * 8); }
#pragma unroll
        for (int pr = 0; pr < 2; ++pr) {
            f32x4 c0 = {0.f, 0.f, 0.f, 0.f}, c1 = c0, s0 = c0, s1 = c0;
#pragma unroll
            for (int kk = 0; kk < 2; ++kk) { c0 = mfma16(ua[2 * pr][kk], bc[kk], c0); c1 = mfma16(ua[2 * pr + 1][kk], bc[kk], c1); s0 = mfma16(ua[2 * pr][kk], bs[kk], s0); s1 = mfma16(ua[2 * pr + 1][kk], bs[kk], s1); }
            zre[pr][ni] = pack8(c0, c1); zs[pr][ni] = pack8(s0, s1);
        }
    }
    bf16_t* T = (bf16_t*)lds;
    for (int mi2 = 0; mi2 < 4; ++mi2) {
        bf16x8 cf[2], sf[2], sfn[2];
#pragma unroll
        for (int pr = 0; pr < 2; ++pr) {
            const bf16_t* cp = Ct + (16 * mi2 + fr) * 64 + 32 * pr + 4 * fq; const bf16_t* sp = St + (16 * mi2 + fr) * 64 + 32 * pr + 4 * fq;
            cf[pr] = cat4(*(const u32x2*)cp, *(const u32x2*)(cp + 16)); sf[pr] = cat4(*(const u32x2*)sp, *(const u32x2*)(sp + 16)); sfn[pr] = neg8(sf[pr]);
        }
        float cs[4], sn[4];
#pragma unroll
        for (int j = 0; j < 4; ++j) { const int k1 = 16 * mi2 + 4 * fq + j; const float x = (float)(n2 * k1) * (1.0f / 2048.0f); cs[j] = cospif(x); sn[j] = sinpif(x); }
#pragma unroll
        for (int ni = 0; ni < 4; ++ni) {
            f32x4 yre = {0.f, 0.f, 0.f, 0.f}, yin = yre;
#pragma unroll
            for (int pr = 0; pr < 2; ++pr) { yre = mfma16s(cf[pr], zre[pr][ni], yre); yre = mfma16s(sfn[pr], zs[pr][ni], yre); yin = mfma16s(cf[pr], zs[pr][ni], yin); yin = mfma16s(sf[pr], zre[pr][ni], yin); }
#pragma unroll
            for (int j = 0; j < 4; ++j) { const int k1 = 16 * mi2 + 4 * fq + j; const int m = 16 * ni + fr;
                const float y1 = yre[j] * cs[j] - yin[j] * sn[j], y2 = yin[j] * cs[j] + yre[j] * sn[j];
                T[((0 * 64 + k1) * 64 + m) * 8 + F.wave] = (bf16_t)f2bf(y1); T[((1 * 64 + k1) * 64 + m) * 8 + F.wave] = (bf16_t)f2bf(y2); }
        }
    }
    __syncthreads();
    for (int it = 0; it < 16; ++it) { const int cidx = it * NTHREADS + tid; const int m = cidx & 63, k1 = (cidx >> 6) & 63, plane = cidx >> 12;
        const u32x4 v = *(const u32x4*)(lds + (size_t)cidx * 16);
        *(u32x4*)(YB + ((((size_t)(b * 4 + h) * 64 + k1) * 2 + plane) * 64 + m) * 64 + oct * 8) = v; }
    __syncthreads();
}
__device__ __forceinline__ void fnetB_item(const Frame& F, int item) {
    const bf16_t* Ct = FP(WS_CTAB, bf16_t); const bf16_t* St = FP(WS_STAB, bf16_t); const bf16_t* YB = FP(WS_YB, bf16_t); bf16_t* FN = FP(WS_FN, bf16_t);
    const int k1 = item & 63, h = (item >> 6) & 3, b = item >> 8; int lane = F.lane; asm volatile("" : "+v"(lane)); const int fr = lane & 15, fq = lane >> 4;
    const bf16_t* base = YB + (((size_t)(b * 4 + h) * 64 + k1) * 2) * 4096;
    f32x4 acc[4][4];
#pragma unroll
    for (int mi = 0; mi < 4; ++mi)
#pragma unroll
        for (int ni = 0; ni < 4; ++ni) acc[mi][ni] = f32x4{0.f, 0.f, 0.f, 0.f};
#pragma unroll
    for (int kk = 0; kk < 2; ++kk) {
        bf16x8 bc[4], bsn[4];
#pragma unroll
        for (int ni = 0; ni < 4; ++ni) { bc[ni] = *(const bf16x8*)(Ct + (16 * ni + fr) * 64 + kk * 32 + fq * 8); bsn[ni] = neg8(*(const bf16x8*)(St + (16 * ni + fr) * 64 + kk * 32 + fq * 8)); }
#pragma unroll
        for (int mi = 0; mi < 4; ++mi) {
            const bf16x8 are = *(const bf16x8*)(base + (16 * mi + fr) * 64 + kk * 32 + fq * 8), aim = *(const bf16x8*)(base + 4096 + (16 * mi + fr) * 64 + kk * 32 + fq * 8);
#pragma unroll
            for (int ni = 0; ni < 4; ++ni) { acc[mi][ni] = mfma16(are, bc[ni], acc[mi][ni]); acc[mi][ni] = mfma16s(aim, bsn[ni], acc[mi][ni]); }
        }
    }
#pragma unroll
    for (int mi = 0; mi < 4; ++mi)
#pragma unroll
        for (int ni = 0; ni < 4; ++ni) { const int k = k1 + 64 * (16 * ni + fr); const f32x4 v = acc[mi][ni] * (1.0f / 512.0f);
            u32x2 w; w.x = pk2(v[0], v[1]); w.y = pk2(v[2], v[3]); *(u32x2*)(FN + (size_t)(NCTX + b * 4096 + k) * 256 + h * 64 + 16 * mi + 4 * fq) = w; }
}

template <bool LOCAL>
__device__ __forceinline__ void attn_item(const Frame& F, int l, int item) {
    const bf16_t* PX = FP(WS_PX, bf16_t); const bf16_t* VT = FP(WS_VT, bf16_t); const bf16_t* VTc = FP(WS_VTC, bf16_t); bf16_t* MIX = FP(WS_MIX, bf16_t);
    const float* rpb = PK(16) + l * (4 * 15 * 31);
    int lane = F.lane; asm volatile("" : "+v"(lane)); const int fr = lane & 15, fq = lane >> 4;
    int b, h, r = 0, jb = 0, qrow0;
    if (LOCAL) { h = item & 3; jb = (item >> 2) & 3; r = (item >> 4) & 63; b = item >> 10; qrow0 = NCTX + b * 4096 + r * 64 + jb * 16; }
    else { h = item & 3; const int qb = (item >> 2) & 15; b = item >> 6; qrow0 = b * 256 + qb * 16; }
    constexpr int NT = LOCAL ? 32 : 16;
    const int rs = LOCAL ? min(max(r - 4, 0), 56) : 0; const int kcs = LOCAL ? min(max(16 * jb - 8, 0), 32) : 0;
    bf16x8 qf[2];
#pragma unroll
    for (int kk = 0; kk < 2; ++kk) qf[kk] = *(const bf16x8*)(PX + (size_t)(qrow0 + fr) * INC + 768 + h * 64 + kk * 32 + fq * 8);
    f32x4 s[NT];
#pragma unroll
    for (int t = 0; t < NT; ++t) {
        int krow;
        if (LOCAL && t < 16) krow = NCTX + b * 4096 + (rs + (t >> 1)) * 64 + kcs + (t & 1) * 16 + fr;
        else krow = b * 256 + (t - (LOCAL ? 16 : 0)) * 16 + fr;
        const bf16_t* kp = PX + (size_t)krow * INC + 1024 + h * 64 + fq * 8;
        const bf16x8 k0 = *(const bf16x8*)kp, k1 = *(const bf16x8*)(kp + 32);
        f32x4 a = {0.f, 0.f, 0.f, 0.f}; a = mfma16(k0, qf[0], a); a = mfma16(k1, qf[1], a); s[t] = a;
    }
    float mx = -3.0e38f;
    const int qcol = 16 * jb + fr; const int cstart = min(max(qcol - 8, 0), 48);
#pragma unroll
    for (int t = 0; t < NT; ++t)
#pragma unroll
        for (int j = 0; j < 4; ++j) {
            float v = s[t][j] * 0.125f;
            if (LOCAL && t < 16) { const int kcol = kcs + (t & 1) * 16 + 4 * fq + j; const bool valid = (kcol >= cstart) && (kcol < cstart + 16);
                const int dr = rs + (t >> 1) - r + 7; const int dc = min(max(kcol - qcol + 15, 0), 30);
                v = valid ? v + rpb[(h * 15 + dr) * 31 + dc] : -1.0e30f; }
            s[t][j] = v; mx = fmaxf(mx, v);
        }
    mx = fmaxf(mx, __shfl_xor(mx, 16)); mx = fmaxf(mx, __shfl_xor(mx, 32));
    float sum = 0.f;
#pragma unroll
    for (int t = 0; t < NT; ++t)
#pragma unroll
        for (int j = 0; j < 4; ++j) { const float p = __expf(s[t][j] - mx); s[t][j] = p; sum += p; }
    sum += __shfl_xor(sum, 16); sum += __shfl_xor(sum, 32);
    f32x4 o[4];
#pragma unroll
    for (int di = 0; di < 4; ++di) o[di] = f32x4{0.f, 0.f, 0.f, 0.f};
#pragma unroll
    for (int u = 0; u < NT / 2; ++u) {
        const bf16x8 pb = pack8(s[2 * u], s[2 * u + 1]);
        const bf16_t* vbase; size_t stride;
        if (LOCAL && u < 8) { vbase = VT + (size_t)(b * 256 + h * 64) * 4096 + (rs + u) * 64 + kcs + 4 * fq; stride = 4096; }
        else { const int uu = u - (LOCAL ? 8 : 0); vbase = VTc + (size_t)(b * 256 + h * 64) * 256 + uu * 32 + 4 * fq; stride = 256; }
#pragma unroll
        for (int di = 0; di < 4; ++di) { const bf16_t* vp = vbase + (size_t)(16 * di + fr) * stride; const bf16x8 va = cat4(*(const u32x2*)vp, *(const u32x2*)(vp + 16)); o[di] = mfma16s(va, pb, o[di]); }
    }
    const float inv = 1.0f / sum;
#pragma unroll
    for (int di = 0; di < 4; ++di) { const f32x4 v = o[di] * inv; u32x2 w; w.x = pk2(v[0], v[1]); w.y = pk2(v[2], v[3]);
        *(u32x2*)(MIX + (size_t)(qrow0 + fr) * 768 + 512 + h * 64 + 16 * di + 4 * fq) = w; }
}

__device__ __forceinline__ cplx csel(bool c, cplx a, cplx b) { return cplx{c ? a.re : b.re, c ? a.im : b.im}; }
#define WAITALL() asm volatile("s_waitcnt vmcnt(0) lgkmcnt(0)" ::: "memory")
__device__ __forceinline__ cplx pow_sel(int k, cplx a, cplx a2, cplx a4, cplx a8, cplx a16) {
    cplx r = cplx{1.f, 0.f};
    r = csel((k & 1) != 0, cmul(r, a), r); r = csel((k & 2) != 0, cmul(r, a2), r); r = csel((k & 4) != 0, cmul(r, a4), r); r = csel((k & 8) != 0, cmul(r, a8), r); r = csel((k & 16) != 0, cmul(r, a16), r);
    return r;
}
__device__ __forceinline__ void ssm_consts(float lre, float lim, float dt, cplx& a, cplx& f) {
    const float e = __expf(lre * dt);
    float revs = lim * dt * 0.15915494309189535f; revs -= rintf(revs);
    a = cplx{e * __builtin_amdgcn_cosf(revs), e * __builtin_amdgcn_sinf(revs)};
    const float xr = a.re - 1.0f, xi = a.im, den = __builtin_amdgcn_rcpf(lre * lre + lim * lim);
    f = cplx{(xr * lre + xi * lim) * den, (xi * lre - xr * lim) * den};
}
template <int PASS, int DIR>
__device__ __forceinline__ void ssm_dir(const Frame& F, int lane, int l, int b, int g, int tb, const bf16x8 (&ub)[4], f32x4 (&accy)[4]) {
    const int fr = lane & 15, fq = lane >> 4;
    const int c = DIR == 0 ? tb : (tb < 4 ? 3 - tb : 71 - tb);
    const int pg = (l * 2 + DIR) * 16 + g;
    const float dt = __expf(PK(19)[pg]);
    cplx* Sloc = FP(WS_SLOC, cplx); const cplx* Carry = FP(WS_CARRY, cplx);
    const size_t sbase = ((size_t)((b * 2 + DIR) * 16 + g) * 68 + c) * 64;
    for (int q = 0; q < 4; ++q) {
        bf16x8 are, aim;
        { const int kq = (fq & 1) * 8; const float* pr = PK(20) + ((size_t)pg * 64 + 16 * q + fr) * 16 + kq; const float* pi = PK(21) + ((size_t)pg * 64 + 16 * q + fr) * 16 + kq;
          const f32x4 zz = f32x4{0.f, 0.f, 0.f, 0.f}; const bool on = fq < 2;
          const f32x4 r0 = *(const f32x4*)pr, r1 = *(const f32x4*)(pr + 4), i0 = *(const f32x4*)pi, i1 = *(const f32x4*)(pi + 4);

          are = pack8(on ? r0 : zz, on ? r1 : zz); aim = pack8(on ? i0 : zz, on ? i1 : zz); }
        f32x4 bre[4], bim[4];
        asm volatile("s_nop 7" : "+v"(are), "+v"(aim));
#pragma unroll
        for (int ni = 0; ni < 4; ++ni) { bre[ni] = mfma16(are, ub[ni], f32x4{0.f, 0.f, 0.f, 0.f}); bim[ni] = mfma16(aim, ub[ni], f32x4{0.f, 0.f, 0.f, 0.f}); }
        settle4m(bre[0], bre[1], bre[2], bre[3]); settle4m(bim[0], bim[1], bim[2], bim[3]);
#pragma unroll
        for (int j = 0; j < 4; ++j) {
            const int p = 16 * q + 4 * fq + j;
            const float lre = PK(17)[pg * 64 + p], lim = PK(18)[pg * 64 + p];

            cplx a, f; ssm_consts(lre, lim, dt, a, f);
            const cplx a2 = cmul(a, a), a4 = cmul(a2, a2), a8 = cmul(a4, a4), a16 = cmul(a8, a8);
            if (PASS == 1) {
                cplx Tt;
                if (DIR == 0) { Tt = cplx{bre[0][j], bim[0][j]}; Tt = cmad(cplx{bre[1][j], bim[1][j]}, Tt, a16); Tt = cmad(cplx{bre[2][j], bim[2][j]}, Tt, a16); Tt = cmad(cplx{bre[3][j], bim[3][j]}, Tt, a16); }
                else { Tt = cplx{bre[3][j], bim[3][j]}; Tt = cmad(cplx{bre[2][j], bim[2][j]}, Tt, a16); Tt = cmad(cplx{bre[1][j], bim[1][j]}, Tt, a16); Tt = cmad(cplx{bre[0][j], bim[0][j]}, Tt, a16); }
                const cplx w = pow_sel(DIR == 0 ? 15 - fr : fr, a, a2, a4, a8, a16);
                Tt = cmul(Tt, w);
                Tt.re += __shfl_xor(Tt.re, 1); Tt.im += __shfl_xor(Tt.im, 1); Tt.re += __shfl_xor(Tt.re, 2); Tt.im += __shfl_xor(Tt.im, 2);
                Tt.re += __shfl_xor(Tt.re, 4); Tt.im += __shfl_xor(Tt.im, 4); Tt.re += __shfl_xor(Tt.re, 8); Tt.im += __shfl_xor(Tt.im, 8);
                Tt = cmul(Tt, f);
                if (fr == 0) Sloc[sbase + p] = Tt;
            } else {
                const cplx w = pow_sel(DIR == 0 ? fr + 1 : 16 - fr, a, a2, a4, a8, a16);
                cplx x[4];
#pragma unroll
                for (int ni = 0; ni < 4; ++ni) {
                    cplx v = cmul(f, cplx{bre[ni][j], bim[ni][j]});
#define RLF(x, ln) __builtin_bit_cast(float, __builtin_amdgcn_readlane(__builtin_bit_cast(int, (x)), (ln)))
#define DPPF(x, ctrl) __builtin_bit_cast(float, __builtin_amdgcn_update_dpp(0, __builtin_bit_cast(int, (x)), (ctrl), 0xf, 0xf, true))
#define KS_STEP(d, ad) { cplx y; if (DIR == 0) { y.re = DPPF(v.re, 0x110 + d); y.im = DPPF(v.im, 0x110 + d); v = csel(fr >= d, cmad(v, ad, y), v); } \
                                   else { y.re = DPPF(v.re, 0x100 + d); y.im = DPPF(v.im, 0x100 + d); v = csel(fr + d <= 15, cmad(v, ad, y), v); } }
                    KS_STEP(1, a) KS_STEP(2, a2) KS_STEP(4, a4) KS_STEP(8, a8)
#undef KS_STEP
                    x[ni] = v;
                }
                cplx E = Carry[sbase + p];
#pragma unroll
                for (int bi = 0; bi < 4; ++bi) {
                    const int ni = DIR == 0 ? bi : 3 - bi;
                    const cplx hh = cmad(x[ni], w, E);
                    cplx tot;
                    { constexpr int L0 = DIR == 0 ? 15 : 0;
                      const float r0 = RLF(x[ni].re, L0), r1 = RLF(x[ni].re, L0 + 16), r2 = RLF(x[ni].re, L0 + 32), r3 = RLF(x[ni].re, L0 + 48);
                      const float i0 = RLF(x[ni].im, L0), i1 = RLF(x[ni].im, L0 + 16), i2 = RLF(x[ni].im, L0 + 32), i3 = RLF(x[ni].im, L0 + 48);
                      tot.re = fq == 0 ? r0 : fq == 1 ? r1 : fq == 2 ? r2 : r3; tot.im = fq == 0 ? i0 : fq == 1 ? i1 : fq == 2 ? i2 : i3; }
                    E = cmad(tot, a16, E);
                    bre[ni][j] = hh.re; bim[ni][j] = hh.im;
                }
            }
        }
        if (PASS == 3) {
            const float* cr = PK(22) + ((size_t)pg * 16 + fr) * 64 + 16 * q + 4 * fq; const float* ci = PK(23) + ((size_t)pg * 16 + fr) * 64 + 16 * q + 4 * fq;
            const f32x4 cre = *(const f32x4*)cr; const f32x4 cim = *(const f32x4*)ci;
            const bf16x8 ca = pack8(cre, f32x4{-cim[0], -cim[1], -cim[2], -cim[3]});
#pragma unroll
            for (int ni = 0; ni < 4; ++ni) { bf16x8 hb = pack8(bre[ni], bim[ni]); bf16x8 ca2 = ca; asm volatile("s_nop 7" : "+v"(ca2), "+v"(hb)); accy[ni] = mfma16(ca2, hb, accy[ni]); }
            settle4m(accy[0], accy[1], accy[2], accy[3]);
        }
    }
}
template <int PASS>
__device__ __forceinline__ void ssm_item(const Frame& F, int l_u, int item_u) {
    int l = l_u, item = item_u; asm volatile("" : "+v"(l), "+v"(item));
    const bf16_t* PX = FP(WS_PX, bf16_t);
    int lane = F.lane; asm volatile("" : "+v"(lane)); const int fr = lane & 15, fq = lane >> 4;
    const int tb = item % 68; const int g = (item / 68) & 15; const int b = item / (68 * 16);
    const int prow0 = tb < 4 ? b * 256 + tb * 64 : NCTX + b * 4096 + (tb - 4) * 64;
    bf16x8 ub[4];
#pragma unroll
    for (int ni = 0; ni < 4; ++ni) { const bf16x8 ld = *(const bf16x8*)(PX + (size_t)(prow0 + 16 * ni + fr) * INC + 1536 + g * 16 + (fq & 1) * 8); ub[ni] = fq < 2 ? ld : zero8(); }
    f32x4 accy[4];
#pragma unroll
    for (int ni = 0; ni < 4; ++ni) accy[ni] = f32x4{0.f, 0.f, 0.f, 0.f};

    ssm_dir<PASS, 0>(F, lane, l, b, g, tb, ub, accy);
    ssm_dir<PASS, 1>(F, lane, l, b, g, tb, ub, accy);
    if (PASS == 3) {
        bf16_t* YS = FP(WS_YS, bf16_t); const f32x4 dv = *(const f32x4*)(PK(24) + l * 256 + g * 16 + 4 * fq);
#pragma unroll
        for (int ni = 0; ni < 4; ++ni) { const int row = prow0 + 16 * ni + fr; const f32x4 uv = ld_bf4(PX + (size_t)row * INC + 1536 + g * 16 + 4 * fq);
            const f32x4 y = accy[ni] + dv * uv; u32x2 w; w.x = pk2(y[0], y[1]); w.y = pk2(y[2], y[3]); *(u32x2*)(YS + (size_t)row * 256 + g * 16 + 4 * fq) = w; }
    }
}
__device__ __forceinline__ void ssm_pass2(const Frame& F, int l) {
    const int idx = blockIdx.x * NTHREADS + F.tid; if (idx >= 8192) return;
    const int p = idx & 63, g = (idx >> 6) & 15, dir = (idx >> 10) & 1, b = idx >> 11;
    const int pg = (l * 2 + dir) * 16 + g; const float dt = __expf(PK(19)[pg]);
    const float lre = PK(17)[pg * 64 + p], lim = PK(18)[pg * 64 + p];
    cplx a, f_unused; ssm_consts(lre, lim, dt, a, f_unused);
#pragma unroll
    for (int i = 0; i < 6; ++i) a = cmul(a, a);
    const cplx* Sloc = FP(WS_SLOC, cplx); cplx* Carry = FP(WS_CARRY, cplx);
    const size_t base = ((size_t)((b * 2 + dir) * 16 + g) * 68) * 64 + p;
    cplx E = cplx{0.f, 0.f};
    for (int c0 = 0; c0 < 68; c0 += 4) {
        const cplx s0 = Sloc[base + (size_t)(c0 + 0) * 64], s1 = Sloc[base + (size_t)(c0 + 1) * 64], s2 = Sloc[base + (size_t)(c0 + 2) * 64], s3 = Sloc[base + (size_t)(c0 + 3) * 64];
        Carry[base + (size_t)(c0 + 0) * 64] = E; E = cmad(s0, a, E);
        Carry[base + (size_t)(c0 + 1) * 64] = E; E = cmad(s1, a, E);
        Carry[base + (size_t)(c0 + 2) * 64] = E; E = cmad(s2, a, E);
        Carry[base + (size_t)(c0 + 3) * 64] = E; E = cmad(s3, a, E);
    }
}


constexpr size_t WS_BAR = 512 * 1024;
#define XB_TMO      128
#define XB_XCNT(j)  (256  + 64 * (j))
#define XB_XSUB(j)  (1280 + 64 * (j))
#define XB_XGEN(j)  (2304 + 64 * (j))
#define XB_TOP      3328
#define XB_TOPGEN   3392
#define XCD_BAR_WORDS 3456
#define XB_SPIN_CAP (1u << 18)

__device__ __forceinline__ unsigned xb_ld(unsigned* p)              { return __hip_atomic_load(p, __ATOMIC_RELAXED, __HIP_MEMORY_SCOPE_AGENT); }
__device__ __forceinline__ unsigned xb_add(unsigned* p, unsigned v) { return __hip_atomic_fetch_add(p, v, __ATOMIC_RELAXED, __HIP_MEMORY_SCOPE_AGENT); }
__device__ __forceinline__ unsigned xb_xcc_id() { return (unsigned)__builtin_amdgcn_s_getreg((3 << 11) | 20) & 0xFu; }
#define XB_SPIN(cond, bar) do { unsigned _sp = 0; while (cond) { __builtin_amdgcn_s_sleep(1); \
    if ((++_sp & 255u) == 0u) { if (xb_ld(&(bar)[XB_TMO])) break; if (_sp > XB_SPIN_CAP) { atomicAdd(&(bar)[XB_TMO], 1u); break; } } } } while (0)

struct XcdBarrier {
    unsigned* bar; unsigned x;
    volatile LAS unsigned* st;
};

__device__ __forceinline__ XcdBarrier xcd_barrier_post(unsigned* bar, volatile LAS unsigned* st) {
    XcdBarrier b; b.bar = bar; b.x = xb_xcc_id(); b.st = st;
    if (threadIdx.x == 0) (void)xb_add(&bar[XB_XCNT(b.x)], 1u);
    return b;
}
__device__ __forceinline__ void xcd_barrier_complete(unsigned* bar, unsigned x, unsigned& nloc, unsigned& nx) {
    const unsigned G = gridDim.x * gridDim.y * gridDim.z;
    unsigned sum, cnt, mine, sp = 0u;
    for (;;) {
        sum = 0u; cnt = 0u; mine = 0u;
#pragma unroll
        for (unsigned j = 0; j < 16; ++j) { const unsigned c = xb_ld(&bar[XB_XCNT(j)]); sum += c; cnt += (c > 0u) ? 1u : 0u; mine = (j == x) ? c : mine; }
        if (sum == G) break;
        __builtin_amdgcn_s_sleep(1);
        if ((++sp & 255u) == 0u) { if (xb_ld(&bar[XB_TMO])) break; if (sp > XB_SPIN_CAP) { atomicAdd(&bar[XB_TMO], 1u); break; } }
    }
    nloc = mine > 0u ? mine : 1u; nx = cnt > 0u ? cnt : 1u;
}

__device__ __forceinline__ void xcd_barrier(const XcdBarrier& b) {
    asm volatile("s_waitcnt vmcnt(0)" ::: "memory");
    __syncthreads();
    if (threadIdx.x == 0) {
        unsigned* bar = b.bar;
        __builtin_amdgcn_s_waitcnt(0);
        unsigned nloc = b.st[0], nx = b.st[1];
        if (nloc == 0u) { xcd_barrier_complete(bar, b.x, nloc, nx); b.st[0] = nloc; b.st[1] = nx; }
        const unsigned old = xb_add(&bar[XB_XSUB(b.x)], 1u);
        const unsigned gen = old / nloc;
        if (old + 1u == (gen + 1u) * nloc) {
            __builtin_amdgcn_fence(__ATOMIC_RELEASE, "agent");
            asm volatile("s_waitcnt vmcnt(0)" ::: "memory");
            const unsigned og = xb_add(&bar[XB_TOP], 1u);
            const unsigned tg = og / nx;
            if (og + 1u == (tg + 1u) * nx) xb_add(&bar[XB_TOPGEN], 1u);
            else XB_SPIN(xb_ld(&bar[XB_TOPGEN]) == tg, bar);
            __builtin_amdgcn_fence(__ATOMIC_ACQUIRE, "agent");
            xb_add(&bar[XB_XGEN(b.x)], 1u);
            asm volatile("s_waitcnt vmcnt(0)" ::: "memory");
        } else {
            XB_SPIN(xb_ld(&bar[XB_XGEN(b.x)]) == gen, bar);
            __builtin_amdgcn_fence(__ATOMIC_ACQUIRE, "agent");
            asm volatile("s_waitcnt vmcnt(0)" ::: "memory");
        }
    }
    __syncthreads();
}
enum : unsigned { W_PREP1 = 1u << 0, W_GIN = 1u << 1, W_GVT = 1u << 2, W_FC = 1u << 3, W_FA = 1u << 4, W_CV = 1u << 5, W_ATT = 1u << 6, W_SSM1 = 1u << 7, W_GPW = 1u << 8,
                  W_P2 = 1u << 9, W_FB = 1u << 10, W_GFW = 1u << 11, W_SSM3 = 1u << 12, W_GGLU = 1u << 13, W_GN = 1u << 14, W_GOUT = 1u << 15, W_PREP3 = 1u << 16, W_GFF1 = 1u << 17, W_GFF2 = 1u << 18 };
#ifndef PH_FINE
#define PH_FINE 0
#endif
#if PH_FINE
constexpr int NSP = 18;
__host__ __device__ __forceinline__ unsigned phase_mask(int sp) {
    switch (sp) { case 0: return W_PREP1; case 1: return W_GIN; case 2: return W_GVT; case 3: return W_FC; case 4: return W_FA; case 5: return W_CV; case 6: return W_ATT; case 7: return W_SSM1;
                  case 8: return W_GPW; case 9: return W_P2 | W_FB; case 10: return W_GFW; case 11: return W_SSM3; case 12: return W_GGLU; case 13: return W_GN; case 14: return W_GOUT;
                  case 15: return W_PREP3; case 16: return W_GFF1; default: return W_GFF2; }
}
#else
constexpr int NSP = 11;
__host__ __device__ __forceinline__ unsigned phase_mask(int sp) {
    switch (sp) { case 0: return W_PREP1; case 1: return W_GIN | W_GVT; case 2: return W_FA | W_CV | W_ATT | W_SSM1; case 3: return W_GPW | W_P2 | W_FB | W_FC;
                  case 4: return W_GFW | W_SSM3; case 5: return W_GGLU; case 6: return W_GN; case 7: return W_GOUT; case 8: return W_PREP3; case 9: return W_GFF1; default: return W_GFF2; }
}
#endif
constexpr int NPH = 2 + 2 * NSP;
#ifndef ZP1
#define ZP1 12
#define ZP2 30
#endif
#define OPQ_S(x) asm volatile("" : "+s"(x))
#define GSYNC() xcd_barrier(xb)
__global__ void __launch_bounds__(NTHREADS, 2) fwd(Args args) {
    extern __shared__ __attribute__((aligned(16))) unsigned char lds[];

    cg::grid_group grid = cg::this_grid();
    const int tid_ = threadIdx.x;
    const int wave_ = __builtin_amdgcn_readfirstlane(tid_ >> 6);
    float* scr = (float*)lds;
    const int G = gridDim.x, bx = blockIdx.x;
    const int gw = bx * 8 + wave_, nw = G * 8;
    const int lo = args.ph_lo, hi = args.ph_hi;
    if (lo < 0) grid.sync();
    volatile LAS unsigned* xb_st = (volatile LAS unsigned*)((LAS unsigned char*)lds + (LDS_BYTES - 64));
    if (tid_ == 0) { xb_st[0] = 0u; xb_st[1] = 0u; }
    __syncthreads();
    const XcdBarrier xb = xcd_barrier_post((unsigned*)(args.ws + WS_BAR), xb_st);
    if (lo == 0) { const Frame F{args, args.out, args.ws, tid_, tid_ & 63, wave_}; p0_prologue(F, scr); if (hi > 1) GSYNC(); }
#pragma nounroll
    for (int ph0 = (lo == 0 ? 1 : lo); ph0 < hi; ++ph0) {
        int ph = ph0; OPQ_S(ph);
        int tidv = tid_; asm volatile("" : "+v"(tidv));
        __attribute__((address_space(1))) unsigned char* wsg = (__attribute__((address_space(1))) unsigned char*)args.ws; __attribute__((address_space(1))) float* outg = (__attribute__((address_space(1))) float*)args.out;
        OPQ_S(wsg); OPQ_S(outg);
        unsigned char* wsv = (unsigned char*)wsg; float* outv = (float*)outg;
        const Frame F{args, outv, wsv, tidv, tidv & 63, wave_};
        if (ph == NPH - 1) { final_norm(F); continue; }
        const int l = (ph - 1) / NSP; const int sp = (ph - 1) - l * NSP;
        const unsigned wm = phase_mask(sp);
        const int row_lo = l == 0 ? 0 : NCTX;
        const int M_post = T_ALL - row_lo;
        unsigned char* wl = F.ws + WS_W + (size_t)l * W_LAYER;
#pragma nounroll
        for (int kind = 0; kind < 8; ++kind) {
            const unsigned bit = kind == 0 ? W_GIN : kind == 1 ? W_GVT : kind == 2 ? W_GPW : kind == 3 ? W_GFW : kind == 4 ? W_GGLU : kind == 5 ? W_GFF1 : kind == 6 ? W_GOUT : W_GFF2;
            if (!(wm & bit)) continue;
            const bf16_t* A; const bf16_t* Bt; int M, N, K;
            if (kind == 0) { A = FP(WS_XN, bf16_t); Bt = (const bf16_t*)(wl + W_IN); M = T_ALL; N = INC; K = DM; }
            else if (kind == 1) { A = (const bf16_t*)(wl + W_IN) + (size_t)1280 * DM; Bt = FP(WS_XN, bf16_t); M = 256; N = T_ALL; K = DM; }
            else if (kind == 2) { A = FP(WS_CV, bf16_t) + (size_t)row_lo * 256; Bt = (const bf16_t*)(wl + W_PW); M = M_post; N = 256; K = 256; }
            else if (kind == 3) { A = FP(WS_FN, bf16_t) + (size_t)row_lo * 256; Bt = (const bf16_t*)(wl + W_F); M = M_post; N = 256; K = 256; }
            else if (kind == 4) { A = FP(WS_YS, bf16_t) + (size_t)row_lo * 256; Bt = (const bf16_t*)(wl + W_GLU); M = M_post; N = 512; K = 256; }
            else if (kind == 5) { A = FP(WS_XN, bf16_t) + (size_t)row_lo * DM; Bt = (const bf16_t*)(wl + W_1); M = M_post; N = FFD; K = DM; }
            else if (kind == 6) { A = FP(WS_XN, bf16_t) + (size_t)row_lo * DM; Bt = (const bf16_t*)(wl + W_OUT); M = M_post; N = DM; K = DM; }
            else { A = FP(WS_H, bf16_t) + (size_t)row_lo * FFD; Bt = (const bf16_t*)(wl + W_2); M = M_post; N = DM; K = FFD; }
            pg8::Gemm g{A, Bt, M, N, K}; pg8::StaticOrder S; S.init(M, N, G, bx);
            EpiU E{F, l, kind, row_lo};
            pg8::gemm_phase<EpiU, pg8::StaticOrder, true, true>((PG8_LAS unsigned char*)lds, g, S, E);
        }
        if (wm & (W_FC | W_FA | W_CV)) {
            const int n_fc = (l == 0 && (wm & W_FC)) ? 128 : 0, n_fa = (wm & W_FA) ? 128 : 0, n_cv = (wm & W_CV) ? (l == 0 ? 544 : 512) : 0; const int nbu = n_fc + n_fa + n_cv;
            const int ustart = (n_fa + n_cv == 0) ? (G - 1 - bx) : bx;
#pragma nounroll
            for (int u = ustart; u < nbu; u += G) {
                if (u < n_fc) fnetctx_unit(F, u, scr);
                else if (u < n_fc + n_fa) fnetA_unit(F, u - n_fc, lds);
                else conv_unit(F, l, u - n_fc - n_fa, scr);
            }
        }
        if (wm & W_P2) ssm_pass2(F, l);
        if (wm & W_SSM3) {
#pragma nounroll
            for (int it = gw; it < 4096; it += nw) ssm_item<3>(F, l, it);
#pragma nounroll
            for (int it = 4096 + gw; it < 4352; it += nw) ssm_item<3>(F, l, it);
        }
        if (wm & (W_ATT | W_SSM1 | W_FB)) {
            const int n_ac = (l == 0 && (wm & W_ATT)) ? 256 : 0, n_al = (wm & W_ATT) ? 4096 : 0, n_s1 = (wm & W_SSM1) ? 4352 : 0, n_fb = (wm & W_FB) ? 1024 : 0, n_s3 = 0;
            const int e0 = n_ac, e1 = e0 + n_al, e2 = e1 + n_s1, e3 = e2 + n_fb, e4 = e3 + n_s3;
#pragma nounroll
            for (int it = gw; it < e4; it += nw) {
                if (it < e0) attn_item<false>(F, l, it);
                else if (it < e1) attn_item<true>(F, l, it - e0);
                else if (it < e2) ssm_item<1>(F, l, it - e1);
                else if (it < e3) fnetB_item(F, it - e2);
                else { ssm_item<3>(F, l, it - e3); }
            }
        }
        if (wm & W_PREP1) prep_norm_mod(F, l == 0 ? F.A.in[2] : FP(WS_XC, float), l == 0 ? F.A.in[0] : F.out, PK(6) + l * DM, FP(WS_MOD, float) + l * 5 * 6144, 0, 1024, FP(WS_XN, bf16_t), 0);
        if (wm & W_GN) prep_group(F, l, row_lo);
        if (wm & W_PREP3) prep_norm_mod(F, FP(WS_XC, float), F.out, PK(30) + l * DM, FP(WS_MOD, float) + l * 5 * 6144, 3072, 4096, FP(WS_XN, bf16_t), row_lo);
        if (ph0 + 1 < hi) GSYNC();
    }
}

extern "C" void kernel_launch(void* const* d_in, const int* in_sizes, int n_in, void* d_out, int out_size, void* d_ws, size_t ws_size, hipStream_t stream) {
    static int grid = 0;
    if (grid == 0) {
        if (n_in != 36 || ws_size < WS_END) { fprintf(stderr, "kernel_launch: unexpected n_in %d / ws %zu\n", n_in, ws_size); grid = -1; return; }
        int dev = 0, cus = 0, per_cu = 0;
        (void)hipGetDevice(&dev); (void)hipDeviceGetAttribute(&cus, hipDeviceAttributeMultiprocessorCount, dev);
        (void)hipFuncSetAttribute((const void*)fwd, hipFuncAttributeMaxDynamicSharedMemorySize, LDS_BYTES);
        (void)hipOccupancyMaxActiveBlocksPerMultiprocessor(&per_cu, (const void*)fwd, NTHREADS, LDS_BYTES);
        (void)hipGetLastError();
        grid = cus > 0 ? cus : 256;
    }
    if (grid < 0) return;
    Args a{};
    for (int i = 0; i < 36; ++i) a.in[i] = (const float*)d_in[i];
    a.out = (float*)d_out; a.ws = (unsigned char*)d_ws;
#if MODE_COOP
    (void)hipMemsetAsync((unsigned char*)d_ws + WS_BAR, 0, 16384, stream);
    a.ph_lo = 0; a.ph_hi = NPH; a.part = 15;
    void* kargs[] = {&a};
    hipError_t e = hipLaunchCooperativeKernel((const void*)fwd, dim3(grid), dim3(NTHREADS), kargs, LDS_BYTES, stream);
    if (e != hipSuccess) fprintf(stderr, "cooperative launch failed: %s (grid %d)\n", hipGetErrorString(e), grid);
#else
    for (int ph = 0; ph < NPH; ++ph) { a.ph_lo = ph; a.ph_hi = ph + 1; a.part = 15; hipLaunchKernelGGL(fwd, dim3(grid), dim3(NTHREADS), LDS_BYTES, stream, a); }
#endif
}
```

```cpp
#include <hip/hip_runtime.h>
#include <hip/hip_cooperative_groups.h>
#include <cstdio>
#include <cstdint>
namespace cg = cooperative_groups;
#ifndef MODE_COOP
#define MODE_COOP 1
#endif
namespace pg8 {
#define PG8_LAS __attribute__((address_space(3)))
typedef unsigned short bf16_t;
typedef short bf16x8 __attribute__((ext_vector_type(8)));
typedef float f32x4 __attribute__((ext_vector_type(4)));
typedef unsigned u32x4 __attribute__((ext_vector_type(4)));
constexpr int BM = 256, BK = 64, HALF = 128, HTB = HALF * BK * 2  , STAGE_BYTES = 8 * HTB, NXCD = 8, WGM = 8;

__host__ __device__ __forceinline__ int lds_byte(int r, int c) { const int st = (r >> 4) * 2 + (c >> 5), rr = r & 15, cc = c & 31, ob = rr * 64 + cc * 2; return st * 1024 + (ob ^ (((ob >> 9) & 1) << 5)); }
__host__ __device__ __forceinline__ void stage_rc(int b, int& R, int& C) { const int st = b / 1024, sb = b % 1024, swz = sb ^ (((sb >> 9) & 1) << 5); R = (st >> 1) * 16 + swz / 64; C = (st & 1) * 32 + (swz % 64) / 2; }
__host__ __device__ __forceinline__ int perm32(int rho) { const int n = rho >> 4, i = rho & 15; return 8 * (i >> 2) + 4 * n + (i & 3); }

struct Unit { int pm, pn; };
struct Gemm { const bf16_t* A; const bf16_t* Bt; int M, N, K; };

struct StaticOrder {
    int nM, nN, nwg, G, c;
    __host__ __device__ void init(int M, int N, int G_, int c_) { nM = M / BM; nN = N / BM; nwg = nM * nN; G = G_; c = c_; }
    __host__ __device__ bool next(int i, Unit& u) const {
        const long L = (long)i * G + c; if (L >= nwg) return false;
        int wgid = (int)L; { const int q = nwg / NXCD, r = nwg % NXCD, xcd = wgid % NXCD, off = wgid / NXCD; wgid = (xcd < r ? xcd * (q + 1) : r * (q + 1) + (xcd - r) * q) + off; }
        const int nig = WGM * nN, gid = wgid / nig, fm = gid * WGM, gsz = (nM - fm) < WGM ? (nM - fm) : WGM;
        u.pm = fm + ((wgid % nig) % gsz); u.pn = (wgid % nig) / gsz; return true;
    }
    __device__ __forceinline__ void a_ready(const Unit&) const {}
    __device__ __forceinline__ void done(const Unit&) const {}
};

}
namespace pg8 {
template <class Epi, class Sched, bool ALIGN_EPI = false, bool SP2 = false>
__device__ __forceinline__ void gemm_phase(PG8_LAS unsigned char* lds, const Gemm g, const Sched& S, const Epi& E) {
    const int tid = threadIdx.x, wid = __builtin_amdgcn_readfirstlane(tid >> 6), lane = tid & 63, wr = wid >> 2, wc = wid & 3, fr = lane & 15, fq = lane >> 4;
    const int K = g.K, nt = K / BK;
    unsigned voffA[2], voffB[2];
#pragma unroll
    for (int i = 0; i < 2; ++i) { int R, C; stage_rc(tid * 16 + i * 8192, R, C); const int Rb = Epi::PERM ? ((R & ~31) + perm32(R & 31)) : R;
        voffA[i] = (unsigned)(R * K + C) * 2u; voffB[i] = (unsigned)(Rb * K + C) * 2u; }
    const size_t kstep = (size_t)(BK * 2);
    const size_t hstep = (size_t)HALF * K * 2;
    const size_t tstep = 2 * hstep;
    const unsigned ldsw = (unsigned)wid * 1024u;
    const int aoff = lds_byte(wr * 64 + fr, fq * 8), boff = lds_byte(wc * 32 + fr, fq * 8);
#define PG8_SA(b, h) (((b) * 2 + (h)) * HTB)
#define PG8_SB(b, h) ((4 + (b) * 2 + (h)) * HTB)
#define PG8_STAGE(bufoff, gbase, voff) do { _Pragma("unroll") for (int _i = 0; _i < 2; ++_i) \
        __builtin_amdgcn_global_load_lds((const unsigned*)((const char*)(gbase) + (voff)[_i]), (PG8_LAS unsigned*)(lds + (bufoff) + ldsw + _i * 8192), 16, 0, 0); } while (0)
#define PG8_LDA(dst, b, h) do { _Pragma("unroll") for (int m = 0; m < 4; ++m) _Pragma("unroll") for (int k = 0; k < 2; ++k) dst[m][k] = *(const PG8_LAS bf16x8*)(lds + PG8_SA(b, h) + aoff + m * 2048 + k * 1024); } while (0)
#define PG8_LDB(dst, b, h) do { _Pragma("unroll") for (int n = 0; n < 2; ++n) _Pragma("unroll") for (int k = 0; k < 2; ++k) dst[n][k] = *(const PG8_LAS bf16x8*)(lds + PG8_SB(b, h) + boff + n * 2048 + k * 1024); } while (0)
#define PG8_MMA(ai, bj, At, Bt) do { __builtin_amdgcn_s_setprio(1); _Pragma("unroll") for (int m = 0; m < 4; ++m) _Pragma("unroll") for (int n = 0; n < 2; ++n) _Pragma("unroll") for (int k = 0; k < 2; ++k) \
        acc[ai][bj][m][n] = __builtin_amdgcn_mfma_f32_16x16x32_bf16(Bt[n][k], At[m][k], acc[ai][bj][m][n], 0, 0, 0); __builtin_amdgcn_s_setprio(0); } while (0)
#define PG8_WAIT_V(n) asm volatile("s_waitcnt vmcnt(" #n ")" ::: "memory")
#define PG8_WAIT_L(n) asm volatile("s_waitcnt lgkmcnt(" #n ")" ::: "memory")
#define PG8_BAR __builtin_amdgcn_s_barrier()
#define PG8_SCHED __builtin_amdgcn_sched_barrier(0)
    Unit cur, nxt; int ui = 0;
    if (!S.next(0, cur)) return;
    f32x4 acc[2][2][4][2];
#pragma unroll
    for (int a = 0; a < 2; ++a)
#pragma unroll
        for (int b = 0; b < 2; ++b)
#pragma unroll
            for (int m = 0; m < 4; ++m)
#pragma unroll
                for (int n = 0; n < 2; ++n) acc[a][b][m][n] = (f32x4){0.f, 0.f, 0.f, 0.f};
    bf16x8 At[4][2], B0[2][2], B1[2][2];
    const char* cA = (const char*)g.A + (size_t)cur.pm * tstep; const char* cB = (const char*)g.Bt + (size_t)cur.pn * tstep;
    S.a_ready(cur);
    if constexpr (SP2) {
        PG8_STAGE(PG8_SB(0, 0), cB, voffB); PG8_STAGE(PG8_SB(0, 1), cB + hstep, voffB); PG8_STAGE(PG8_SA(0, 0), cA, voffA); PG8_STAGE(PG8_SA(0, 1), cA + hstep, voffA);
        if (wr == 1) PG8_BAR;
        PG8_WAIT_V(2); PG8_BAR;
        PG8_STAGE(PG8_SB(1, 0), cB + kstep, voffB); PG8_STAGE(PG8_SA(1, 0), cA + kstep, voffA); PG8_STAGE(PG8_SB(1, 1), cB + hstep + kstep, voffB);
        PG8_WAIT_V(6); PG8_BAR;
    } else {
        PG8_STAGE(PG8_SB(0, 0), cB, voffB); PG8_STAGE(PG8_SA(0, 0), cA, voffA); PG8_STAGE(PG8_SB(0, 1), cB + hstep, voffB); PG8_STAGE(PG8_SA(0, 1), cA + hstep, voffA);
        if (wr == 1) PG8_BAR;
        PG8_WAIT_V(4); PG8_BAR;
        PG8_STAGE(PG8_SB(1, 0), cB + kstep, voffB); PG8_STAGE(PG8_SA(1, 0), cA + kstep, voffA); PG8_STAGE(PG8_SB(1, 1), cB + hstep + kstep, voffB);
        PG8_WAIT_V(6); PG8_BAR;
    }
    for (;;) {
        const bool has_next = S.next(ui + 1, nxt);
        const char* nA = has_next ? (const char*)g.A + (size_t)nxt.pm * tstep : cA; const char* nB = has_next ? (const char*)g.Bt + (size_t)nxt.pn * tstep : cB;
        for (int t = 0; t < nt; t += 2) {
            const bool last = (t == nt - 2);
            const char* a1 = cA + (size_t)(t + 1) * kstep;
            const char* a2 = last ? nA : cA + (size_t)(t + 2) * kstep; const char* b2 = last ? nB : cB + (size_t)(t + 2) * kstep;
            const char* a3 = a2 + kstep; const char* b3 = b2 + kstep;
            if (last && has_next) S.a_ready(nxt);
            if constexpr (SP2) {
            PG8_LDB(B0, 0, 0); PG8_LDB(B1, 0, 1); PG8_SCHED; PG8_LDA(At, 0, 0); PG8_STAGE(PG8_SA(1, 1), a1 + hstep, voffA);
            PG8_WAIT_V(8); PG8_WAIT_L(0); PG8_BAR; PG8_MMA(0, 0, At, B0); PG8_MMA(0, 1, At, B1); PG8_BAR; PG8_SCHED;
            PG8_LDA(At, 0, 1); PG8_STAGE(PG8_SB(0, 0), b2, voffB); PG8_STAGE(PG8_SB(0, 1), b2 + hstep, voffB); PG8_STAGE(PG8_SA(0, 0), a2, voffA);
            PG8_WAIT_V(8); PG8_WAIT_L(0); PG8_BAR; PG8_MMA(1, 0, At, B0); PG8_MMA(1, 1, At, B1); PG8_BAR; PG8_SCHED;
            PG8_LDB(B0, 1, 0); PG8_LDB(B1, 1, 1); PG8_SCHED; PG8_LDA(At, 1, 0); PG8_STAGE(PG8_SA(0, 1), a2 + hstep, voffA);
            PG8_WAIT_V(8); PG8_WAIT_L(0); PG8_BAR; PG8_MMA(0, 0, At, B0); PG8_MMA(0, 1, At, B1); PG8_BAR; PG8_SCHED;
            PG8_LDA(At, 1, 1); PG8_STAGE(PG8_SB(1, 0), b3, voffB); PG8_STAGE(PG8_SB(1, 1), b3 + hstep, voffB); PG8_STAGE(PG8_SA(1, 0), a3, voffA);
            PG8_WAIT_V(8); PG8_WAIT_L(0); PG8_BAR; PG8_MMA(1, 0, At, B0); PG8_MMA(1, 1, At, B1); PG8_BAR; PG8_SCHED;
            } else {
            PG8_LDB(B0, 0, 0); PG8_SCHED; PG8_LDA(At, 0, 0); PG8_STAGE(PG8_SA(1, 1), a1 + hstep, voffA);
            PG8_WAIT_L(8); PG8_BAR; PG8_WAIT_L(0); PG8_MMA(0, 0, At, B0); PG8_BAR; PG8_SCHED;
            PG8_LDB(B1, 0, 1); PG8_STAGE(PG8_SB(0, 0), b2, voffB);
            PG8_BAR; PG8_WAIT_L(0); PG8_MMA(0, 1, At, B1); PG8_BAR;
            PG8_LDA(At, 0, 1); PG8_STAGE(PG8_SA(0, 0), a2, voffA);
            PG8_BAR; PG8_WAIT_L(0); PG8_MMA(1, 0, At, B0); PG8_BAR; PG8_SCHED;
            PG8_STAGE(PG8_SB(0, 1), b2 + hstep, voffB);
            PG8_WAIT_V(6); PG8_BAR; PG8_MMA(1, 1, At, B1); PG8_BAR;
            PG8_LDB(B0, 1, 0); PG8_SCHED; PG8_LDA(At, 1, 0); PG8_STAGE(PG8_SA(0, 1), a2 + hstep, voffA);
            PG8_WAIT_L(8); PG8_BAR; PG8_WAIT_L(0); PG8_MMA(0, 0, At, B0); PG8_BAR; PG8_SCHED;
            PG8_LDB(B1, 1, 1); PG8_STAGE(PG8_SB(1, 0), b3, voffB);
            PG8_BAR; PG8_WAIT_L(0); PG8_MMA(0, 1, At, B1); PG8_BAR;
            PG8_LDA(At, 1, 1); PG8_STAGE(PG8_SA(1, 0), a3, voffA);
            PG8_BAR; PG8_WAIT_L(0); PG8_MMA(1, 0, At, B0); PG8_BAR; PG8_SCHED;
            PG8_STAGE(PG8_SB(1, 1), b3 + hstep, voffB);
            PG8_WAIT_V(6); PG8_BAR; PG8_MMA(1, 1, At, B1); PG8_BAR;
            }
        }
        if constexpr (ALIGN_EPI) { if (wr == 0) PG8_BAR; }
        if constexpr (!Epi::AFTER_DRAIN) { E(acc, cur, wr, wc, fr, fq); S.done(cur); }
        if (!has_next) break;
#pragma unroll
        for (int a = 0; a < 2; ++a)
#pragma unroll
            for (int b = 0; b < 2; ++b)
#pragma unroll
                for (int m = 0; m < 4; ++m)
#pragma unroll
                    for (int n = 0; n < 2; ++n) acc[a][b][m][n] = (f32x4){0.f, 0.f, 0.f, 0.f};
        cur = nxt; cA = nA; cB = nB; ++ui;
        if constexpr (ALIGN_EPI) { if (wr == 1) PG8_BAR; }
    }
    PG8_WAIT_V(0);
    if constexpr (!ALIGN_EPI) { if (wr == 0) PG8_BAR; }
    PG8_BAR;
    if constexpr (Epi::AFTER_DRAIN) { E.fused(acc, cur, wr, wc, fr, fq, lds, wid, lane); S.done(cur); }
#undef PG8_SA
#undef PG8_SB
#undef PG8_STAGE
#undef PG8_LDA
#undef PG8_LDB
#undef PG8_MMA
#undef PG8_WAIT_V
#undef PG8_WAIT_L
#undef PG8_BAR
#undef PG8_SCHED
}
}

using pg8::bf16_t; using pg8::bf16x8; using pg8::f32x4;
#define LAS __attribute__((address_space(3)))
typedef short bf16x4 __attribute__((ext_vector_type(4)));
typedef unsigned u32x4 __attribute__((ext_vector_type(4)));
typedef unsigned u32x2 __attribute__((ext_vector_type(2)));

constexpr int NTHREADS = 512;
constexpr int T_ALL = 17408, NCTX = 1024, NLAT = 16384, DM = 1024, INC = 1792, FFD = 4096;
constexpr int LDS_BYTES = 147456;
constexpr float EPS = 1e-6f;

constexpr size_t MiB = 1u << 20;
constexpr size_t WS_MOD = 0;
constexpr size_t WS_CTAB = 256 * 1024;
constexpr size_t WS_STAB = 256 * 1024 + 8192;
constexpr size_t WS_PACK = 1 * MiB;
constexpr size_t WS_SLOC = 3 * MiB;
constexpr size_t WS_CARRY = 7 * MiB + 256 * 1024;
constexpr size_t WS_W = 12 * MiB;
constexpr size_t W_IN = 0, W_PW = W_IN + (size_t)INC * DM * 2, W_F = W_PW + 256 * 256 * 2, W_GLU = W_F + 256 * 256 * 2,
                 W_OUT = W_GLU + 512 * 256 * 2, W_1 = W_OUT + (size_t)DM * DM * 2, W_2 = W_1 + (size_t)FFD * DM * 2, W_LAYER = W_2 + (size_t)FFD * DM * 2;
static_assert(W_LAYER == 22 * MiB, "weights per layer");
constexpr size_t WS_XC = 56 * MiB;
constexpr size_t WS_XN = 60 * MiB;
constexpr size_t WS_BIG = 94 * MiB;
constexpr size_t WS_H = WS_BIG;
constexpr size_t WS_PX = WS_BIG;
constexpr size_t WS_VT = 154 * MiB;
constexpr size_t WS_VTC = 162 * MiB;
constexpr size_t WS_CV = 163 * MiB;
constexpr size_t WS_YB = 172 * MiB;
constexpr size_t WS_FN = 188 * MiB;
constexpr size_t WS_YS = 197 * MiB;
constexpr size_t WS_ZS = 206 * MiB;
constexpr size_t WS_MIX = 223 * MiB;
constexpr size_t WS_END = 256 * MiB;
static_assert(WS_H + (size_t)T_ALL * FFD * 2 <= WS_END && WS_MIX + (size_t)T_ALL * 768 * 2 <= WS_END && WS_PX + (size_t)T_ALL * INC * 2 <= WS_VT, "ws map");

__device__ __forceinline__ unsigned f2bf(float f) { unsigned u = __builtin_bit_cast(unsigned, f); return (u + 0x7fffu + ((u >> 16) & 1u)) >> 16; }
__device__ __forceinline__ unsigned pk2(float lo, float hi) { return f2bf(lo) | (f2bf(hi) << 16); }
__device__ __forceinline__ float bf2f(unsigned h) { return __builtin_bit_cast(float, (h & 0xffffu) << 16); }
__device__ __forceinline__ float bflo(unsigned w) { return __builtin_bit_cast(float, w << 16); }
__device__ __forceinline__ float bfhi(unsigned w) { return __builtin_bit_cast(float, w & 0xffff0000u); }
__device__ __forceinline__ bf16x8 pack8(f32x4 a, f32x4 b) {
    u32x4 w; w.x = pk2(a[0], a[1]); w.y = pk2(a[2], a[3]); w.z = pk2(b[0], b[1]); w.w = pk2(b[2], b[3]);
    return __builtin_bit_cast(bf16x8, w);
}
__device__ __forceinline__ bf16x8 neg8(bf16x8 v) { u32x4 w = __builtin_bit_cast(u32x4, v); w.x ^= 0x80008000u; w.y ^= 0x80008000u; w.z ^= 0x80008000u; w.w ^= 0x80008000u; return __builtin_bit_cast(bf16x8, w); }
__device__ __forceinline__ bf16x8 zero8() { u32x4 w = {0u, 0u, 0u, 0u}; return __builtin_bit_cast(bf16x8, w); }
__device__ __forceinline__ bf16x8 cat4(u32x2 a, u32x2 b) { u32x4 w; w.x = a.x; w.y = a.y; w.z = b.x; w.w = b.y; return __builtin_bit_cast(bf16x8, w); }
__device__ __forceinline__ f32x4 mfma16(bf16x8 a, bf16x8 b, f32x4 c) { return __builtin_amdgcn_mfma_f32_16x16x32_bf16(a, b, c, 0, 0, 0); }
__device__ __forceinline__ void settle4(f32x4& a, f32x4& b, f32x4& c, f32x4& d) { asm volatile("s_nop 15\n\ts_nop 15" : "+v"(a), "+v"(b), "+v"(c), "+v"(d)); }
__device__ __forceinline__ void settle4m(f32x4& a, f32x4& b, f32x4& c, f32x4& d) { asm volatile("s_nop 7\n\ts_nop 7" : "+v"(a), "+v"(b), "+v"(c), "+v"(d) :: "memory"); }
__device__ __forceinline__ f32x4 mfma16s(bf16x8 a, bf16x8 b, f32x4 c) { asm volatile("s_nop 7" : "+v"(a), "+v"(b)); return __builtin_amdgcn_mfma_f32_16x16x32_bf16(a, b, c, 0, 0, 0); }
__device__ __forceinline__ void settle2(f32x4& a, f32x4& b) { asm volatile("s_nop 15\n\ts_nop 15" : "+v"(a), "+v"(b)); }
__device__ __forceinline__ void settle_in(bf16x8& a, bf16x8& b) { asm volatile("s_nop 3" : "+v"(a), "+v"(b)); }
__device__ __forceinline__ float wave_sum(float v) {
    v += __shfl_xor(v, 1); v += __shfl_xor(v, 2); v += __shfl_xor(v, 4); v += __shfl_xor(v, 8); v += __shfl_xor(v, 16); v += __shfl_xor(v, 32); return v;
}
__device__ __forceinline__ float sigmoidf_(float x) { return 1.0f / (1.0f + __expf(-x)); }
struct cplx { float re, im; };
__device__ __forceinline__ cplx cmul(cplx a, cplx b) { return cplx{a.re * b.re - a.im * b.im, a.re * b.im + a.im * b.re}; }
__device__ __forceinline__ cplx cmad(cplx acc, cplx a, cplx b) { return cplx{acc.re + a.re * b.re - a.im * b.im, acc.im + a.re * b.im + a.im * b.re}; }

struct Args { const float* in[36]; float* out; unsigned char* ws; int ph_lo, ph_hi, part, pad; };
struct Frame {
    const Args& A;
    float* out; unsigned char* ws;
    int tid, lane, wave;
};
#define FP(off, type) ((type*)(F.ws + (off)))

constexpr int PK_N = 23;
constexpr int PK_IDX[PK_N] = {6,8,9,10,11,13,15,16,17,18,19,20,21,22,23,24,26,27,29,30,32,34,35};
constexpr int PK_CNT[PK_N] = {2048,15872,512,512,512,512,512,3720,4096,4096,64,65536,65536,65536,65536,512,1024,2048,2048,2048,8192,2048,1024};
constexpr int pk_off(int k) { int o = 0; for (int i = 0; i < PK_N; ++i) { if (PK_IDX[i] == k) return o; o += PK_CNT[i]; } return -1; }
#define PK(k) (FP(WS_PACK, float) + pk_off(k))
static_assert(pk_off(35) + 1024 <= (int)(2 * MiB / 4), "pack size");

struct EpiU {
    static constexpr bool PERM = false, AFTER_DRAIN = false;
    const Frame& F; int l; int kind; int row_lo;
    __device__ __forceinline__ void operator()(const f32x4 (&acc)[2][2][4][2], const pg8::Unit& u, int wr, int wc, int fr, int fq) const {
        const int c0 = u.pn * 256 + wc * 32 + fq * 4;
        const int r0 = u.pm * 256 + wr * 64 + fr;
        if (kind < 6) {
            bf16_t* base; size_t ldc; const float* bias = nullptr;
            if (kind == 0) { base = FP(WS_PX, bf16_t) + (size_t)r0 * INC + c0; ldc = INC; }
            else if (kind == 1) {
                if (u.pn < 4) { base = FP(WS_VTC, bf16_t) + (size_t)u.pn * 65536 + (size_t)r0 * 256 + (c0 - u.pn * 256); ldc = 256; }
                else { const int tt = u.pn - 4; base = FP(WS_VT, bf16_t) + (size_t)(tt >> 4) * 256 * 4096 + (tt & 15) * 256 + (size_t)r0 * 4096 + (c0 - u.pn * 256); ldc = 4096; }
            }
            else if (kind == 2) { base = FP(WS_MIX, bf16_t) + (size_t)(row_lo + r0) * 768 + c0; ldc = 768; bias = PK(13) + l * 256; }
            else if (kind == 3) { base = FP(WS_MIX, bf16_t) + (size_t)(row_lo + r0) * 768 + 256 + c0; ldc = 768; bias = PK(15) + l * 256; }
            else if (kind == 4) { base = FP(WS_ZS, bf16_t) + (size_t)(row_lo + r0) * 512 + c0; ldc = 512; bias = PK(26) + l * 512; }
            else { base = FP(WS_H, bf16_t) + (size_t)(row_lo + r0) * FFD + c0; ldc = FFD; bias = PK(32) + l * FFD; }
#pragma unroll
            for (int bj = 0; bj < 2; ++bj)
#pragma unroll
                for (int n = 0; n < 2; ++n) {
                    f32x4 bv = f32x4{0.f, 0.f, 0.f, 0.f};
                    if (bias) bv = *(const f32x4*)(bias + c0 + bj * 128 + n * 16);
#pragma unroll
                    for (int ai = 0; ai < 2; ++ai)
#pragma unroll
                        for (int m = 0; m < 4; ++m) {
                            f32x4 v = acc[ai][bj][m][n] + bv;
                            if (kind == 5) {
#pragma unroll
                                for (int j = 0; j < 4; ++j) { const float r = fmaxf(v[j], 0.f); v[j] = r * r; }
                            }
                            u32x2 w; w.x = pk2(v[0], v[1]); w.y = pk2(v[2], v[3]);
                            *(u32x2*)(base + (size_t)(ai * 128 + m * 16) * ldc + bj * 128 + n * 16) = w;
                        }
                }
        } else {
            const int gp = u.pm + (row_lo >> 8); const bool isc = gp < 4; const int lrow0 = isc ? gp * 256 : (gp - 4) * 256; const int br = isc ? 4 : ((gp - 4) >> 4);
            const float* sC; const float* sL; const float* bias; int gate_off;
            if (kind == 6) { sC = l == 0 ? F.A.in[2] : FP(WS_XC, float); sL = l == 0 ? F.A.in[0] : F.out; bias = PK(29) + l * DM; gate_off = 2048; }
            else { sC = FP(WS_XC, float); sL = F.out; bias = PK(34) + l * DM; gate_off = 5120; }
            const size_t roff = (size_t)(lrow0 + wr * 64 + fr) * DM + c0;
            const float* s = (isc ? sC : sL) + roff; float* d = (isc ? FP(WS_XC, float) : F.out) + roff;
            const float* gate = FP(WS_MOD, float) + (l * 5 + br) * 6144 + gate_off;
#pragma unroll
            for (int bj = 0; bj < 2; ++bj)
#pragma unroll
                for (int n = 0; n < 2; ++n) {
                    const int cc = c0 + bj * 128 + n * 16;
                    const f32x4 bv = *(const f32x4*)(bias + cc); const f32x4 gv = *(const f32x4*)(gate + cc);
#pragma unroll
                    for (int ai = 0; ai < 2; ++ai)
#pragma unroll
                        for (int m = 0; m < 4; ++m) {
                            const size_t o = (size_t)(ai * 128 + m * 16) * DM + bj * 128 + n * 16;
                            const f32x4 xv = *(const f32x4*)(s + o);
                            *(f32x4*)(d + o) = xv + gv * (acc[ai][bj][m][n] + bv);
                        }
                }
        }
    }
};

__device__ __forceinline__ void transpose_tile(const float* W, int K, int N, bf16_t* Wt, int tile, float* scr, int tid) {
    const int ntn = N >> 6; const int tk = tile / ntn, tn = tile - tk * ntn; const int k0 = tk * 64, n0 = tn * 64;
    { const int n = tid & 63, kk = tid >> 6;
#pragma unroll
      for (int i = 0; i < 8; ++i) { const int k = kk + 8 * i; scr[k * 65 + n] = W[(size_t)(k0 + k) * N + n0 + n]; } }
    __syncthreads();
    { const int kp = tid & 31, nn = tid >> 5;
#pragma unroll
      for (int i = 0; i < 4; ++i) { const int n = nn + 16 * i; const unsigned v = pk2(scr[(2 * kp) * 65 + n], scr[(2 * kp + 1) * 65 + n]); *(unsigned*)(Wt + (size_t)(n0 + n) * K + k0 + 2 * kp) = v; } }
    __syncthreads();
}
__device__ __forceinline__ void mod_unit(const Frame& F, int unit, float* scr) {
    const int l = unit / 96, cc = unit - l * 96; const int tid = F.tid;
    float* sl = scr; float* red = scr + 5 * 1024;
    for (int i = tid; i < 5 * 1024; i += NTHREADS) { const int r = i >> 10, k = i & 1023; const float c = r < 4 ? F.A.in[1][r * 1024 + k] : F.A.in[3][k]; sl[i] = c * sigmoidf_(c); }
    __syncthreads();
    const int col = tid & 63, kg = tid >> 6;
    const float* w = F.A.in[4] + (size_t)l * DM * 6144 + cc * 64 + col;
    float a0 = 0.f, a1 = 0.f, a2 = 0.f, a3 = 0.f, a4 = 0.f;
    for (int k = kg * 128; k < kg * 128 + 128; ++k) { const float wv = w[(size_t)k * 6144]; a0 += sl[k] * wv; a1 += sl[1024 + k] * wv; a2 += sl[2048 + k] * wv; a3 += sl[3072 + k] * wv; a4 += sl[4096 + k] * wv; }
    red[(kg * 5 + 0) * 64 + col] = a0; red[(kg * 5 + 1) * 64 + col] = a1; red[(kg * 5 + 2) * 64 + col] = a2; red[(kg * 5 + 3) * 64 + col] = a3; red[(kg * 5 + 4) * 64 + col] = a4;
    __syncthreads();
    if (tid < 320) { const int r = tid >> 6, c2 = tid & 63; float s = 0.f;
#pragma unroll
        for (int g = 0; g < 8; ++g) s += red[(g * 5 + r) * 64 + c2];
        FP(WS_MOD, float)[(l * 5 + r) * 6144 + cc * 64 + c2] = s + F.A.in[5][l * 6144 + cc * 64 + c2]; }
    __syncthreads();
}
__device__ __forceinline__ void p0_prologue(const Frame& F, float* scr) {
    const int NT_L = 448 + 16 + 16 + 32 + 256 + 1024 + 1024;
    const int njobs = 193 + 2 * NT_L + PK_N;
    for (int job = blockIdx.x; job < njobs; job += gridDim.x) {
        if (job >= 193 + 2 * NT_L) {
            const int e = job - (193 + 2 * NT_L); const float* src = nullptr; int cnt = 0, off = 0;
#define PKC(i) if (e == i) { src = F.A.in[PK_IDX[i]]; cnt = PK_CNT[i]; off = pk_off(PK_IDX[i]); }
            PKC(0) PKC(1) PKC(2) PKC(3) PKC(4) PKC(5) PKC(6) PKC(7) PKC(8) PKC(9) PKC(10) PKC(11) PKC(12) PKC(13) PKC(14) PKC(15) PKC(16) PKC(17) PKC(18) PKC(19) PKC(20) PKC(21) PKC(22)
#undef PKC
            float* dst = FP(WS_PACK, float) + off;
            for (int i = F.tid; i < cnt; i += NTHREADS) dst[i] = src[i];
        }
        else if (job < 192) { mod_unit(F, job, scr); }
        else if (job == 192) {
            for (int i = F.tid; i < 4096; i += NTHREADS) { const int m = i >> 6, j = i & 63; const float x = (float)((m * j) & 63) * (1.0f / 32.0f);
                FP(WS_CTAB, bf16_t)[i] = (bf16_t)f2bf(cospif(x)); FP(WS_STAB, bf16_t)[i] = (bf16_t)f2bf(sinpif(x)); }
        } else {
            int t = job - 193; const int l = t / NT_L; t -= l * NT_L;
            unsigned char* wl = F.ws + WS_W + (size_t)l * W_LAYER;
            if (t < 448) transpose_tile(F.A.in[7] + (size_t)l * DM * INC, DM, INC, (bf16_t*)(wl + W_IN), t, scr, F.tid);
            else if ((t -= 448) < 16) transpose_tile(F.A.in[12] + (size_t)l * 65536, 256, 256, (bf16_t*)(wl + W_PW), t, scr, F.tid);
            else if ((t -= 16) < 16) transpose_tile(F.A.in[14] + (size_t)l * 65536, 256, 256, (bf16_t*)(wl + W_F), t, scr, F.tid);
            else if ((t -= 16) < 32) transpose_tile(F.A.in[25] + (size_t)l * 131072, 256, 512, (bf16_t*)(wl + W_GLU), t, scr, F.tid);
            else if ((t -= 32) < 256) transpose_tile(F.A.in[28] + (size_t)l * DM * DM, DM, DM, (bf16_t*)(wl + W_OUT), t, scr, F.tid);
            else if ((t -= 256) < 1024) transpose_tile(F.A.in[31] + (size_t)l * DM * FFD, DM, FFD, (bf16_t*)(wl + W_1), t, scr, F.tid);
            else { t -= 1024; transpose_tile(F.A.in[33] + (size_t)l * DM * FFD, FFD, DM, (bf16_t*)(wl + W_2), t, scr, F.tid); }
        }
    }
}

__device__ __forceinline__ void prep_norm_mod(const Frame& F, const float* srcC, const float* srcL, const float* g, const float* modl, int sh_off, int sc_off, bf16_t* XN, int row_lo) {
    const int gw = blockIdx.x * 8 + F.wave, nw = gridDim.x * 8, lane = F.lane;
    for (int row = row_lo + gw; row < T_ALL; row += nw) {
        const bool isc = row < NCTX; const float* x = isc ? srcC + (size_t)row * DM : srcL + (size_t)(row - NCTX) * DM; const int br = isc ? 4 : ((row - NCTX) >> 12);
        const float* sh = modl + br * 6144 + sh_off; const float* sc = modl + br * 6144 + sc_off;
        f32x4 v[4]; float ss = 0.f;
#pragma unroll
        for (int i = 0; i < 4; ++i) { v[i] = *(const f32x4*)(x + i * 256 + lane * 4); ss += v[i][0] * v[i][0] + v[i][1] * v[i][1] + v[i][2] * v[i][2] + v[i][3] * v[i][3]; }
        ss = wave_sum(ss); const float r = rsqrtf(ss * (1.0f / 1024.0f) + EPS);
#pragma unroll
        for (int i = 0; i < 4; ++i) { const int c = i * 256 + lane * 4; const f32x4 gv = *(const f32x4*)(g + c), shv = *(const f32x4*)(sh + c), scv = *(const f32x4*)(sc + c);
            f32x4 y = v[i] * r * gv; y = y * (scv + 1.0f) + shv; u32x2 w; w.x = pk2(y[0], y[1]); w.y = pk2(y[2], y[3]); *(u32x2*)(XN + (size_t)row * DM + c) = w; }
    }
}
__device__ __forceinline__ f32x4 ld_bf4(const bf16_t* p) { const u32x2 w = *(const u32x2*)p; return f32x4{bflo(w.x), bfhi(w.x), bflo(w.y), bfhi(w.y)}; }
__device__ __forceinline__ void prep_group(const Frame& F, int l, int row_lo) {
    const int gw = blockIdx.x * 8 + F.wave, nw = gridDim.x * 8, lane = F.lane;
    const bf16_t* MIX = FP(WS_MIX, bf16_t); const bf16_t* ZS = FP(WS_ZS, bf16_t); bf16_t* O = FP(WS_XN, bf16_t); const float* gg = PK(27) + l * DM;
    for (int row = row_lo + gw; row < T_ALL; row += nw) {
#pragma unroll
        for (int grp = 0; grp < 4; ++grp) {
            f32x4 v;
            if (grp < 3) v = ld_bf4(MIX + (size_t)row * 768 + grp * 256 + lane * 4);
            else { const f32x4 a = ld_bf4(ZS + (size_t)row * 512 + lane * 4), gt = ld_bf4(ZS + (size_t)row * 512 + 256 + lane * 4);
#pragma unroll
                for (int j = 0; j < 4; ++j) v[j] = a[j] * sigmoidf_(gt[j]); }
            float ss = v[0] * v[0] + v[1] * v[1] + v[2] * v[2] + v[3] * v[3]; ss = wave_sum(ss);
            const float r = rsqrtf(ss * (1.0f / 256.0f) + EPS); const f32x4 gv = *(const f32x4*)(gg + grp * 256 + lane * 4); const f32x4 y = v * r * gv;
            u32x2 w; w.x = pk2(y[0], y[1]); w.y = pk2(y[2], y[3]); *(u32x2*)(O + (size_t)row * DM + grp * 256 + lane * 4) = w;
        }
    }
}
__device__ __forceinline__ void final_norm(const Frame& F) {
    const int gw = blockIdx.x * 8 + F.wave, nw = gridDim.x * 8, lane = F.lane; const float* g = PK(35);
    for (int row = gw; row < NLAT; row += nw) {
        float* x = F.out + (size_t)row * DM; f32x4 v[4]; float ss = 0.f;
#pragma unroll
        for (int i = 0; i < 4; ++i) { v[i] = *(const f32x4*)(x + i * 256 + lane * 4); ss += v[i][0] * v[i][0] + v[i][1] * v[i][1] + v[i][2] * v[i][2] + v[i][3] * v[i][3]; }
        ss = wave_sum(ss); const float r = rsqrtf(ss * (1.0f / 1024.0f) + EPS);
#pragma unroll
        for (int i = 0; i < 4; ++i) { const int c = i * 256 + lane * 4; *(f32x4*)(x + c) = v[i] * r * *(const f32x4*)(g + c); }
    }
}

__device__ __forceinline__ void conv_unit(const Frame& F, int l, int unit, float* scr) {
    const bf16_t* PX = FP(WS_PX, bf16_t); bf16_t* CV = FP(WS_CV, bf16_t);
    int prow0, Lseq, t0;
    if (unit < 512) { const int b = unit >> 7; t0 = (unit & 127) * 32; prow0 = NCTX + b * 4096; Lseq = 4096; }
    else { const int uu = unit - 512; const int b = uu >> 3; t0 = (uu & 7) * 32; prow0 = b * 256; Lseq = 256; }
    float* vt = scr; float* ot = scr + 62 * 256; int tid = F.tid; asm volatile("" : "+v"(tid));
    for (int idx = tid; idx < 62 * 256; idx += NTHREADS) { const int rr = idx >> 8, c = idx & 255; const int t = t0 - 15 + rr; float v = 0.f;
        if (t >= 0 && t < Lseq) { const bf16_t* p = PX + (size_t)(prow0 + t) * INC; const float a = bf2f(p[c]), gt = bf2f(p[256 + c]); v = a * sigmoidf_(gt); }
        vt[idx] = v; }
    __syncthreads();
    { const int c = tid & 255, half = tid >> 8; float w[31];
#pragma unroll
      for (int j = 0; j < 31; ++j) w[j] = PK(8)[(l * 31 + j) * 256 + c];
      const float bd = PK(9)[l * 256 + c];
      for (int tt = 0; tt < 16; ++tt) { const int t = half * 16 + tt; float s = bd;
#pragma unroll
          for (int j = 0; j < 31; ++j) s += w[j] * vt[(t + j) * 256 + c];
          ot[t * 256 + c] = s; } }
    __syncthreads();
    { const int lane = tid & 63; const f32x4 lg = *(const f32x4*)(PK(10) + l * 256 + lane * 4), lb = *(const f32x4*)(PK(11) + l * 256 + lane * 4);
      for (int i = 0; i < 4; ++i) { const int t = F.wave * 4 + i; const f32x4 x = *(const f32x4*)(ot + t * 256 + lane * 4);
          const float mu = wave_sum(x[0] + x[1] + x[2] + x[3]) * (1.0f / 256.0f); const f32x4 d = x - mu;
          const float var = wave_sum(d[0] * d[0] + d[1] * d[1] + d[2] * d[2] + d[3] * d[3]) * (1.0f / 256.0f); const float r = rsqrtf(var + EPS);
          f32x4 y = d * r * lg + lb;
#pragma unroll
          for (int j = 0; j < 4; ++j) y[j] = y[j] * sigmoidf_(y[j]);
          u32x2 w; w.x = pk2(y[0], y[1]); w.y = pk2(y[2], y[3]); *(u32x2*)(CV + (size_t)(prow0 + t0 + t) * 256 + lane * 4) = w; } }
    __syncthreads();
}

__device__ __forceinline__ void fnetctx_unit(const Frame& F, int unit, float* scr) {
    const bf16_t* PX = FP(WS_PX, bf16_t); bf16_t* FN = FP(WS_FN, bf16_t);
    const int mh = unit & 1, kh = (unit >> 1) & 3, h = (unit >> 3) & 3, b = unit >> 5; int tid = F.tid; asm volatile("" : "+v"(tid));
    float* zc = scr; float* zs = scr + 8192; float* c64 = scr + 16384; float* s64 = c64 + 64; float* c256 = s64 + 64; float* s256 = c256 + 256;
    if (tid < 64) { const float x = (float)tid * (1.0f / 32.0f); c64[tid] = cospif(x); s64[tid] = sinpif(x); }
    if (tid < 256) { const float x = (float)tid * (1.0f / 128.0f); c256[tid] = cospif(x); s256[tid] = sinpif(x); }
    __syncthreads();
    for (int idx = tid; idx < 8192; idx += NTHREADS) { const int n = idx >> 5, mm = idx & 31, m = mh * 32 + mm; const bf16_t* up = PX + (size_t)(b * 256 + n) * INC + 512 + h * 64;
        float ac = 0.f, as = 0.f;
        for (int j = 0; j < 64; ++j) { const float uv = bf2f(up[j]); const int a = (j * m) & 63; ac += uv * c64[a]; as += uv * s64[a]; }
        zc[idx] = ac; zs[idx] = as; }
    __syncthreads();
    for (int idx = tid; idx < 2048; idx += NTHREADS) { const int k = kh * 64 + (idx >> 5), mm = idx & 31; float acc = 0.f;
        for (int n = 0; n < 256; ++n) { const int a = (k * n) & 255; acc += c256[a] * zc[n * 32 + mm] - s256[a] * zs[n * 32 + mm]; }
        FN[(size_t)(b * 256 + k) * 256 + h * 64 + mh * 32 + mm] = (bf16_t)f2bf(acc * (1.0f / 128.0f)); }
    __syncthreads();
}
__device__ __forceinline__ void fnetA_unit(const Frame& F, int unit, unsigned char* lds) {
    const bf16_t* PX = FP(WS_PX, bf16_t); const bf16_t* Ct = FP(WS_CTAB, bf16_t); const bf16_t* St = FP(WS_STAB, bf16_t); bf16_t* YB = FP(WS_YB, bf16_t);
    const int oct = unit & 7, h = (unit >> 3) & 3, b = unit >> 5; int tid = F.tid; asm volatile("" : "+v"(tid)); const int lane = tid & 63, fr = lane & 15, fq = lane >> 4; const int n2 = oct * 8 + F.wave;
    bf16x8 ua[4][2];
#pragma unroll
    for (int mi = 0; mi < 4; ++mi)
#pragma unroll
        for (int kk = 0; kk < 2; ++kk) ua[mi][kk] = *(const bf16x8*)(PX + (size_t)(NCTX + b * 4096 + 64 * (16 * mi + fr) + n2) * INC + 512 + h * 64 + kk * 32 + fq * 8);
    bf16x8 zre[2][4], zs[2][4];
#pragma unroll
    for (int ni = 0; ni < 4; ++ni) {
        bf16x8 bc[2], bs[2];
#pragma unroll
        for (int kk = 0; kk < 2; ++kk) { bc[kk] = *(const bf16x8*)(Ct + (16 * ni + fr) * 64 + kk * 32 + fq * 8); bs[kk] = *(const bf16x8*)(St + (16 * ni + fr) * 64 + kk * 32 + fq * 8); }
#pragma unroll
        for (int pr = 0; pr < 2; ++pr) {
            f32x4 c0 = {0.f, 0.f, 0.f, 0.f}, c1 = c0, s0 = c0, s1 = c0;
#pragma unroll
            for (int kk = 0; kk < 2; ++kk) { c0 = mfma16(ua[2 * pr][kk], bc[kk], c0); c1 = mfma16(ua[2 * pr + 1][kk], bc[kk], c1); s0 = mfma16(ua[2 * pr][kk], bs[kk], s0); s1 = mfma16(ua[2 * pr + 1][kk], bs[kk], s1); }
            zre[pr][ni] = pack8(c0, c1); zs[pr][ni] = pack8(s0, s1);
        }
    }
    bf16_t* T = (bf16_t*)lds;
    for (int mi2 = 0; mi2 < 4; ++mi2) {
        bf16x8 cf[2], sf[2], sfn[2];
#pragma unroll
        for (int pr = 0; pr < 2; ++pr) {
            const bf16_t* cp = Ct + (16 * mi2 + fr) * 64 + 32 * pr + 4 * fq; const bf16_t* sp = St + (16 * mi2 + fr) * 64 + 32 * pr + 4 * fq;
            cf[pr] = cat4(*(const u32x2*)cp, *(const u32x2*)(cp + 16)); sf[pr] = cat4(*(const u32x2*)sp, *(const u32x2*)(sp + 16)); sfn[pr] = neg8(sf[pr]);
        }
        float cs[4], sn[4];
#pragma unroll
        for (int j = 0; j < 4; ++j) { const int k1 = 16 * mi2 + 4 * fq + j; const float x = (float)(n2 * k1) * (1.0f / 2048.0f); cs[j] = cospif(x); sn[j] = sinpif(x); }
#pragma unroll
        for (int ni = 0; ni < 4; ++ni) {
            f32x4 yre = {0.f, 0.f, 0.f, 0.f}, yin = yre;
#pragma unroll
            for (int pr = 0; pr < 2; ++pr) { yre = mfma16s(cf[pr], zre[pr][ni], yre); yre = mfma16s(sfn[pr], zs[pr][ni], yre); yin = mfma16s(cf[pr], zs[pr][ni], yin); yin = mfma16s(sf[pr], zre[pr][ni], yin); }
#pragma unroll
            for (int j = 0; j < 4; ++j) { const int k1 = 16 * mi2 + 4 * fq + j; const int m = 16 * ni + fr;
                const float y1 = yre[j] * cs[j] - yin[j] * sn[j], y2 = yin[j] * cs[j] + yre[j] * sn[j];
                T[((0 * 64 + k1) * 64 + m) * 8 + F.wave] = (bf16_t)f2bf(y1); T[((1 * 64 + k1) * 64 + m) * 8 + F.wave] = (bf16_t)f2bf(y2); }
        }
    }
    __syncthreads();
    for (int it = 0; it < 16; ++it) { const int cidx = it * NTHREADS + tid; const int m = cidx & 63, k1 = (cidx >> 6) & 63, plane = cidx >> 12;
        const u32x4 v = *(const u32x4*)(lds + (size_t)cidx * 16);
        *(u32x4*)(YB + ((((size_t)(b * 4 + h) * 64 + k1) * 2 + plane) * 64 + m) * 64 + oct * 8) = v; }
    __syncthreads();
}
__device__ __forceinline__ void fnetB_item(const Frame& F, int item) {
    const bf16_t* Ct = FP(WS_CTAB, bf16_t); const bf16_t* St = FP(WS_STAB, bf16_t); const bf16_t* YB = FP(WS_YB, bf16_t); bf16_t* FN = FP(WS_FN, bf16_t);
    const int k1 = item & 63, h = (item >> 6) & 3, b = item >> 8; int lane = F.lane; asm volatile("" : "+v"(lane)); const int fr = lane & 15, fq = lane >> 4;
    const bf16_t* base = YB + (((size_t)(b * 4 + h) * 64 + k1) * 2) * 4096;
    f32x4 acc[4][4];
#pragma unroll
    for (int mi = 0; mi < 4; ++mi)
#pragma unroll
        for (int ni = 0; ni < 4; ++ni) acc[mi][ni] = f32x4{0.f, 0.f, 0.f, 0.f};
#pragma unroll
    for (int kk = 0; kk < 2; ++kk) {
        bf16x8 bc[4], bsn[4];
#pragma unroll
        for (int ni = 0; ni < 4; ++ni) { bc[ni] = *(const bf16x8*)(Ct + (16 * ni + fr) * 64 + kk * 32 + fq * 8); bsn[ni] = neg8(*(const bf16x8*)(St + (16 * ni + fr) * 64 + kk * 32 + fq * 8)); }
#pragma unroll
        for (int mi = 0; mi < 4; ++mi) {
            const bf16x8 are = *(const bf16x8*)(base + (16 * mi + fr) * 64 + kk * 32 + fq * 8), aim = *(const bf16x8*)(base + 4096 + (16 * mi + fr) * 64 + kk * 32 + fq * 8);
#pragma unroll
            for (int ni = 0; ni < 4; ++ni) { acc[mi][ni] = mfma16(are, bc[ni], acc[mi][ni]); acc[mi][ni] = mfma16s(aim, bsn[ni], acc[mi][ni]); }
        }
    }
#pragma unroll
    for (int mi = 0; mi < 4; ++mi)
#pragma unroll
        for (int ni = 0; ni < 4; ++ni) { const int k = k1 + 64 * (16 * ni + fr); const f32x4 v = acc[mi][ni] * (1.0f / 512.0f);
            u32x2 w; w.x = pk2(v[0], v[1]); w.y = pk2(v[2], v[3]); *(u32x2*)(FN + (size_t)(NCTX + b * 4096 + k) * 256 + h * 64 + 16 * mi + 4 * fq) = w; }
}

template <bool LOCAL>
__device__ __forceinline__ void attn_item(const Frame& F, int l, int item) {
    const bf16_t* PX = FP(WS_PX, bf16_t); const bf16_t* VT = FP(WS_VT, bf16_t); const bf16_t* VTc = FP(WS_VTC, bf16_t); bf16_t* MIX = FP(WS_MIX, bf16_t);
    const float* rpb = PK(16) + l * (4 * 15 * 31);
    int lane = F.lane; asm volatile("" : "+v"(lane)); const int fr = lane & 15, fq = lane >> 4;
    int b, h, r = 0, jb = 0, qrow0;
    if (LOCAL) { h = item & 3; jb = (item >> 2) & 3; r = (item >> 4) & 63; b = item >> 10; qrow0 = NCTX + b * 4096 + r * 64 + jb * 16; }
    else { h = item & 3; const int qb = (item >> 2) & 15; b = item >> 6; qrow0 = b * 256 + qb * 16; }
    constexpr int NT = LOCAL ? 32 : 16;
    const int rs = LOCAL ? min(max(r - 4, 0), 56) : 0; const int kcs = LOCAL ? min(max(16 * jb - 8, 0), 32) : 0;
    bf16x8 qf[2];
#pragma unroll
    for (int kk = 0; kk < 2; ++kk) qf[kk] = *(const bf16x8*)(PX + (size_t)(qrow0 + fr) * INC + 768 + h * 64 + kk * 32 + fq * 8);
    f32x4 s[NT];
#pragma unroll
    for (int t = 0; t < NT; ++t) {
        int krow;
        if (LOCAL && t < 16) krow = NCTX + b * 4096 + (rs + (t >> 1)) * 64 + kcs + (t & 1) * 16 + fr;
        else krow = b * 256 + (t - (LOCAL ? 16 : 0)) * 16 + fr;
        const bf16_t* kp = PX + (size_t)krow * INC + 1024 + h * 64 + fq * 8;
        const bf16x8 k0 = *(const bf16x8*)kp, k1 = *(const bf16x8*)(kp + 32);
        f32x4 a = {0.f, 0.f, 0.f, 0.f}; a = mfma16(k0, qf[0], a); a = mfma16(k1, qf[1], a); s[t] = a;
    }
    float mx = -3.0e38f;
    const int qcol = 16 * jb + fr; const int cstart = min(max(qcol - 8, 0), 48);
#pragma unroll
    for (int t = 0; t < NT; ++t)
#pragma unroll
        for (int j = 0; j < 4; ++j) {
            float v = s[t][j] * 0.125f;
            if (LOCAL && t < 16) { const int kcol = kcs + (t & 1) * 16 + 4 * fq + j; const bool valid = (kcol >= cstart) && (kcol < cstart + 16);
                const int dr = rs + (t >> 1) - r + 7; const int dc = min(max(kcol - qcol + 15, 0), 30);
                v = valid ? v + rpb[(h * 15 + dr) * 31 + dc] : -1.0e30f; }
            s[t][j] = v; mx = fmaxf(mx, v);
        }
    mx = fmaxf(mx, __shfl_xor(mx, 16)); mx = fmaxf(mx, __shfl_xor(mx, 32));
    float sum = 0.f;
#pragma unroll
    for (int t = 0; t < NT; ++t)
#pragma unroll
        for (int j = 0; j < 4; ++j) { const float p = __expf(s[t][j] - mx); s[t][j] = p; sum += p; }
    sum += __shfl_xor(sum, 16); sum += __shfl_xor(sum, 32);
    f32x4 o[4];
#pragma unroll
    for (int di = 0; di < 4; ++di) o[di] = f32x4{0.f, 0.f, 0.f, 0.f};
#pragma unroll
    for (int u = 0; u < NT / 2; ++u) {
        const bf16x8 pb = pack8(s[2 * u], s[2 * u + 1]);
        const bf16_t* vbase; size_t stride;
        if (LOCAL && u < 8) { vbase = VT + (size_t)(b * 256 + h * 64) * 4096 + (rs + u) * 64 + kcs + 4 * fq; stride = 4096; }
        else { const int uu = u - (LOCAL ? 8 : 0); vbase = VTc + (size_t)(b * 256 + h * 64) * 256 + uu * 32 + 4 * fq; stride = 256; }
#pragma unroll
        for (int di = 0; di < 4; ++di) { const bf16_t* vp = vbase + (size_t)(16 * di + fr) * stride; const bf16x8 va = cat4(*(const u32x2*)vp, *(const u32x2*)(vp + 16)); o[di] = mfma16s(va, pb, o[di]); }
    }
    const float inv = 1.0f / sum;
#pragma unroll
    for (int di = 0; di < 4; ++di) { const f32x4 v = o[di] * inv; u32x2 w; w.x = pk2(v[0], v[1]); w.y = pk2(v[2], v[3]);
        *(u32x2*)(MIX + (size_t)(qrow0 + fr) * 768 + 512 + h * 64 + 16 * di + 4 * fq) = w; }
}

__device__ __forceinline__ cplx csel(bool c, cplx a, cplx b) { return cplx{c ? a.re : b.re, c ? a.im : b.im}; }
#define WAITALL() asm volatile("s_waitcnt vmcnt(0) lgkmcnt(0)" ::: "memory")
__device__ __forceinline__ cplx pow_sel(int k, cplx a, cplx a2, cplx a4, cplx a8, cplx a16) {
    cplx r = cplx{1.f, 0.f};
    r = csel((k & 1) != 0, cmul(r, a), r); r = csel((k & 2) != 0, cmul(r, a2), r); r = csel((k & 4) != 0, cmul(r, a4), r); r = csel((k & 8) != 0, cmul(r, a8), r); r = csel((k & 16) != 0, cmul(r, a16), r);
    return r;
}
__device__ __forceinline__ void ssm_consts(float lre, float lim, float dt, cplx& a, cplx& f) {
    const float e = __expf(lre * dt);
    float revs = lim * dt * 0.15915494309189535f; revs -= rintf(revs);
    a = cplx{e * __builtin_amdgcn_cosf(revs), e * __builtin_amdgcn_sinf(revs)};
    const float xr = a.re - 1.0f, xi = a.im, den = __builtin_amdgcn_rcpf(lre * lre + lim * lim);
    f = cplx{(xr * lre + xi * lim) * den, (xi * lre - xr * lim) * den};
}
template <int PASS, int DIR>
__device__ __forceinline__ void ssm_dir(const Frame& F, int lane, int l, int b, int g, int tb, const bf16x8 (&ub)[4], f32x4 (&accy)[4]) {
    const int fr = lane & 15, fq = lane >> 4;
    const int c = DIR == 0 ? tb : (tb < 4 ? 3 - tb : 71 - tb);
    const int pg = (l * 2 + DIR) * 16 + g;
    const float dt = __expf(PK(19)[pg]);
    cplx* Sloc = FP(WS_SLOC, cplx); const cplx* Carry = FP(WS_CARRY, cplx);
    const size_t sbase = ((size_t)((b * 2 + DIR) * 16 + g) * 68 + c) * 64;
    for (int q = 0; q < 4; ++q) {
        bf16x8 are, aim;
        { const int kq = (fq & 1) * 8; const float* pr = PK(20) + ((size_t)pg * 64 + 16 * q + fr) * 16 + kq; const float* pi = PK(21) + ((size_t)pg * 64 + 16 * q + fr) * 16 + kq;
          const f32x4 zz = f32x4{0.f, 0.f, 0.f, 0.f}; const bool on = fq < 2;
          const f32x4 r0 = *(const f32x4*)pr, r1 = *(const f32x4*)(pr + 4), i0 = *(const f32x4*)pi, i1 = *(const f32x4*)(pi + 4);

          are = pack8(on ? r0 : zz, on ? r1 : zz); aim = pack8(on ? i0 : zz, on ? i1 : zz); }
        f32x4 bre[4], bim[4];
        asm volatile("s_nop 7" : "+v"(are), "+v"(aim));
#pragma unroll
        for (int ni = 0; ni < 4; ++ni) { bre[ni] = mfma16(are, ub[ni], f32x4{0.f, 0.f, 0.f, 0.f}); bim[ni] = mfma16(aim, ub[ni], f32x4{0.f, 0.f, 0.f, 0.f}); }
        settle4m(bre[0], bre[1], bre[2], bre[3]); settle4m(bim[0], bim[1], bim[2], bim[3]);
#pragma unroll
        for (int j = 0; j < 4; ++j) {
            const int p = 16 * q + 4 * fq + j;
            const float lre = PK(17)[pg * 64 + p], lim = PK(18)[pg * 64 + p];

            cplx a, f; ssm_consts(lre, lim, dt, a, f);
            const cplx a2 = cmul(a, a), a4 = cmul(a2, a2), a8 = cmul(a4, a4), a16 = cmul(a8, a8);
            if (PASS == 1) {
                cplx Tt;
                if (DIR == 0) { Tt = cplx{bre[0][j], bim[0][j]}; Tt = cmad(cplx{bre[1][j], bim[1][j]}, Tt, a16); Tt = cmad(cplx{bre[2][j], bim[2][j]}, Tt, a16); Tt = cmad(cplx{bre[3][j], bim[3][j]}, Tt, a16); }
                else { Tt = cplx{bre[3][j], bim[3][j]}; Tt = cmad(cplx{bre[2][j], bim[2][j]}, Tt, a16); Tt = cmad(cplx{bre[1][j], bim[1][j]}, Tt, a16); Tt = cmad(cplx{bre[0][j], bim[0][j]}, Tt, a16); }
                const cplx w = pow_sel(DIR == 0 ? 15 - fr : fr, a, a2, a4, a8, a16);
                Tt = cmul(Tt, w);
                Tt.re += __shfl_xor(Tt.re, 1); Tt.im += __shfl_xor(Tt.im, 1); Tt.re += __shfl_xor(Tt.re, 2); Tt.im += __shfl_xor(Tt.im, 2);
                Tt.re += __shfl_xor(Tt.re, 4); Tt.im += __shfl_xor(Tt.im, 4); Tt.re += __shfl_xor(Tt.re, 8); Tt.im += __shfl_xor(Tt.im, 8);
                Tt = cmul(Tt, f);
                if (fr == 0) Sloc[sbase + p] = Tt;
            } else {
                const cplx w = pow_sel(DIR == 0 ? fr + 1 : 16 - fr, a, a2, a4, a8, a16);
                cplx x[4];
#pragma unroll
                for (int ni = 0; ni < 4; ++ni) {
                    cplx v = cmul(f, cplx{bre[ni][j], bim[ni][j]});
#define RLF(x, ln) __builtin_bit_cast(float, __builtin_amdgcn_readlane(__builtin_bit_cast(int, (x)), (ln)))
#define DPPF(x, ctrl) __builtin_bit_cast(float, __builtin_amdgcn_update_dpp(0, __builtin_bit_cast(int, (x)), (ctrl), 0xf, 0xf, true))
#define KS_STEP(d, ad) { cplx y; if (DIR == 0) { y.re = DPPF(v.re, 0x110 + d); y.im = DPPF(v.im, 0x110 + d); v = csel(fr >= d, cmad(v, ad, y), v); } \
                                   else { y.re = DPPF(v.re, 0x100 + d); y.im = DPPF(v.im, 0x100 + d); v = csel(fr + d <= 15, cmad(v, ad, y), v); } }
                    KS_STEP(1, a) KS_STEP(2, a2) KS_STEP(4, a4) KS_STEP(8, a8)
#undef KS_STEP
                    x[ni] = v;
                }
                cplx E = Carry[sbase + p];
#pragma unroll
                for (int bi = 0; bi < 4; ++bi) {
                    const int ni = DIR == 0 ? bi : 3 - bi;
                    const cplx hh = cmad(x[ni], w, E);
                    cplx tot;
                    { constexpr int L0 = DIR == 0 ? 15 : 0;
                      const float r0 = RLF(x[ni].re, L0), r1 = RLF(x[ni].re, L0 + 16), r2 = RLF(x[ni].re, L0 + 32), r3 = RLF(x[ni].re, L0 + 48);
                      const float i0 = RLF(x[ni].im, L0), i1 = RLF(x[ni].im, L0 + 16), i2 = RLF(x[ni].im, L0 + 32), i3 = RLF(x[ni].im, L0 + 48);
                      tot.re = fq == 0 ? r0 : fq == 1 ? r1 : fq == 2 ? r2 : r3; tot.im = fq == 0 ? i0 : fq == 1 ? i1 : fq == 2 ? i2 : i3; }
                    E = cmad(tot, a16, E);
                    bre[ni][j] = hh.re; bim[ni][j] = hh.im;
                }
            }
        }
        if (PASS == 3) {
            const float* cr = PK(22) + ((size_t)pg * 16 + fr) * 64 + 16 * q + 4 * fq; const float* ci = PK(23) + ((size_t)pg * 16 + fr) * 64 + 16 * q + 4 * fq;
            const f32x4 cre = *(const f32x4*)cr; const f32x4 cim = *(const f32x4*)ci;
            const bf16x8 ca = pack8(cre, f32x4{-cim[0], -cim[1], -cim[2], -cim[3]});
#pragma unroll
            for (int ni = 0; ni < 4; ++ni) { bf16x8 hb = pack8(bre[ni], bim[ni]); bf16x8 ca2 = ca; asm volatile("s_nop 7" : "+v"(ca2), "+v"(hb)); accy[ni] = mfma16(ca2, hb, accy[ni]); }
            settle4m(accy[0], accy[1], accy[2], accy[3]);
        }
    }
}
template <int PASS>
__device__ __forceinline__ void ssm_item(const Frame& F, int l_u, int item_u) {
    int l = l_u, item = item_u; asm volatile("" : "+v"(l), "+v"(item));
    const bf16_t* PX = FP(WS_PX, bf16_t);
    int lane = F.lane; asm volatile("" : "+v"(lane)); const int fr = lane & 15, fq = lane >> 4;
    const int tb = item % 68; const int g = (item / 68) & 15; const int b = item / (68 * 16);
    const int prow0 = tb < 4 ? b * 256 + tb * 64 : NCTX + b * 4096 + (tb - 4) * 64;
    bf16x8 ub[4];
#pragma unroll
    for (int ni = 0; ni < 4; ++ni) { const bf16x8 ld = *(const bf16x8*)(PX + (size_t)(prow0 + 16 * ni + fr) * INC + 1536 + g * 16 + (fq & 1) * 8); ub[ni] = fq < 2 ? ld : zero8(); }
    f32x4 accy[4];
#pragma unroll
    for (int ni = 0; ni < 4; ++ni) accy[ni] = f32x4{0.f, 0.f, 0.f, 0.f};

    ssm_dir<PASS, 0>(F, lane, l, b, g, tb, ub, accy);
    ssm_dir<PASS, 1>(F, lane, l, b, g, tb, ub, accy);
    if (PASS == 3) {
        bf16_t* YS = FP(WS_YS, bf16_t); const f32x4 dv = *(const f32x4*)(PK(24) + l * 256 + g * 16 + 4 * fq);
#pragma unroll
        for (int ni = 0; ni < 4; ++ni) { const int row = prow0 + 16 * ni + fr; const f32x4 uv = ld_bf4(PX + (size_t)row * INC + 1536 + g * 16 + 4 * fq);
            const f32x4 y = accy[ni] + dv * uv; u32x2 w; w.x = pk2(y[0], y[1]); w.y = pk2(y[2], y[3]); *(u32x2*)(YS + (size_t)row * 256 + g * 16 + 4 * fq) = w; }
    }
}
__device__ __forceinline__ void ssm_pass2(const Frame& F, int l) {
    const int idx = blockIdx.x * NTHREADS + F.tid; if (idx >= 8192) return;
    const int p = idx & 63, g = (idx >> 6) & 15, dir = (idx >> 10) & 1, b = idx >> 11;
    const int pg = (l * 2 + dir) * 16 + g; const float dt = __expf(PK(19)[pg]);
    const float lre = PK(17)[pg * 64 + p], lim = PK(18)[pg * 64 + p];
    cplx a, f_unused; ssm_consts(lre, lim, dt, a, f_unused);
#pragma unroll
    for (int i = 0; i < 6; ++i) a = cmul(a, a);
    const cplx* Sloc = FP(WS_SLOC, cplx); cplx* Carry = FP(WS_CARRY, cplx);
    const size_t base = ((size_t)((b * 2 + dir) * 16 + g) * 68) * 64 + p;
    cplx E = cplx{0.f, 0.f};
    for (int c0 = 0; c0 < 68; c0 += 4) {
        const cplx s0 = Sloc[base + (size_t)(c0 + 0) * 64], s1 = Sloc[base + (size_t)(c0 + 1) * 64], s2 = Sloc[base + (size_t)(c0 + 2) * 64], s3 = Sloc[base + (size_t)(c0 + 3) * 64];
        Carry[base + (size_t)(c0 + 0) * 64] = E; E = cmad(s0, a, E);
        Carry[base + (size_t)(c0 + 1) * 64] = E; E = cmad(s1, a, E);
        Carry[base + (size_t)(c0 + 2) * 64] = E; E = cmad(s2, a, E);
        Carry[base + (size_t)(c0 + 3) * 64] = E; E = cmad(s3, a, E);
    }
}


constexpr size_t WS_BAR = 512 * 1024;
#define XB_TMO      128
#define XB_XCNT(j)  (256  + 64 * (j))
#define XB_XSUB(j)  (1280 + 64 * (j))
#define XB_XGEN(j)  (2304 + 64 * (j))
#define XB_TOP      3328
#define XB_TOPGEN   3392
#define XCD_BAR_WORDS 3456
#define XB_SPIN_CAP (1u << 18)

__device__ __forceinline__ unsigned xb_ld(unsigned* p)              { return __hip_atomic_load(p, __ATOMIC_RELAXED, __HIP_MEMORY_SCOPE_AGENT); }
__device__ __forceinline__ unsigned xb_add(unsigned* p, unsigned v) { return __hip_atomic_fetch_add(p, v, __ATOMIC_RELAXED, __HIP_MEMORY_SCOPE_AGENT); }
__device__ __forceinline__ unsigned xb_xcc_id() { return (unsigned)__builtin_amdgcn_s_getreg((3 << 11) | 20) & 0xFu; }
#define XB_SPIN(cond, bar) do { unsigned _sp = 0; while (cond) { __builtin_amdgcn_s_sleep(1); \
    if ((++_sp & 255u) == 0u) { if (xb_ld(&(bar)[XB_TMO])) break; if (_sp > XB_SPIN_CAP) { atomicAdd(&(bar)[XB_TMO], 1u); break; } } } } while (0)

struct XcdBarrier {
    unsigned* bar; unsigned x;
    volatile LAS unsigned* st;
};

__device__ __forceinline__ XcdBarrier xcd_barrier_post(unsigned* bar, volatile LAS unsigned* st) {
    XcdBarrier b; b.bar = bar; b.x = xb_xcc_id(); b.st = st;
    if (threadIdx.x == 0) (void)xb_add(&bar[XB_XCNT(b.x)], 1u);
    return b;
}
__device__ __forceinline__ void xcd_barrier_complete(unsigned* bar, unsigned x, unsigned& nloc, unsigned& nx) {
    const unsigned G = gridDim.x * gridDim.y * gridDim.z;
    unsigned sum, cnt, mine, sp = 0u;
    for (;;) {
        sum = 0u; cnt = 0u; mine = 0u;
#pragma unroll
        for (unsigned j = 0; j < 16; ++j) { const unsigned c = xb_ld(&bar[XB_XCNT(j)]); sum += c; cnt += (c > 0u) ? 1u : 0u; mine = (j == x) ? c : mine; }
        if (sum == G) break;
        __builtin_amdgcn_s_sleep(1);
        if ((++sp & 255u) == 0u) { if (xb_ld(&bar[XB_TMO])) break; if (sp > XB_SPIN_CAP) { atomicAdd(&bar[XB_TMO], 1u); break; } }
    }
    nloc = mine > 0u ? mine : 1u; nx = cnt > 0u ? cnt : 1u;
}

__device__ __forceinline__ void xcd_barrier(const XcdBarrier& b) {
    asm volatile("s_waitcnt vmcnt(0)" ::: "memory");
    __syncthreads();
    if (threadIdx.x == 0) {
        unsigned* bar = b.bar;
        __builtin_amdgcn_s_waitcnt(0);
        unsigned nloc = b.st[0], nx = b.st[1];
        if (nloc == 0u) { xcd_barrier_complete(bar, b.x, nloc, nx); b.st[0] = nloc; b.st[1] = nx; }
        const unsigned old = xb_add(&bar[XB_XSUB(b.x)], 1u);
        const unsigned gen = old / nloc;
        if (old + 1u == (gen + 1u) * nloc) {
            __builtin_amdgcn_fence(__ATOMIC_RELEASE, "agent");
            asm volatile("s_waitcnt vmcnt(0)" ::: "memory");
            const unsigned og = xb_add(&bar[XB_TOP], 1u);
            const unsigned tg = og / nx;
            if (og + 1u == (tg + 1u) * nx) xb_add(&bar[XB_TOPGEN], 1u);
            else XB_SPIN(xb_ld(&bar[XB_TOPGEN]) == tg, bar);
            __builtin_amdgcn_fence(__ATOMIC_ACQUIRE, "agent");
            xb_add(&bar[XB_XGEN(b.x)], 1u);
            asm volatile("s_waitcnt vmcnt(0)" ::: "memory");
        } else {
            XB_SPIN(xb_ld(&bar[XB_XGEN(b.x)]) == gen, bar);
            __builtin_amdgcn_fence(__ATOMIC_ACQUIRE, "agent");
            asm volatile("s_waitcnt vmcnt(0)" ::: "memory");
        }
    }
    __syncthreads();
}
enum : unsigned { W_PREP1 = 1u << 0, W_GIN = 1u << 1, W_GVT = 1u << 2, W_FC = 1u << 3, W_FA = 1u << 4, W_CV = 1u << 5, W_ATT = 1u << 6, W_SSM1 = 1u << 7, W_GPW = 1u << 8,
                  W_P2 = 1u << 9, W_FB = 1u << 10, W_GFW = 1u << 11, W_SSM3 = 1u << 12, W_GGLU = 1u << 13, W_GN = 1u << 14, W_GOUT = 1u << 15, W_PREP3 = 1u << 16, W_GFF1 = 1u << 17, W_GFF2 = 1u << 18 };
#ifndef PH_FINE
#define PH_FINE 0
#endif
#if PH_FINE
constexpr int NSP = 18;
__host__ __device__ __forceinline__ unsigned phase_mask(int sp) {
    switch (sp) { case 0: return W_PREP1; case 1: return W_GIN; case 2: return W_GVT; case 3: return W_FC; case 4: return W_FA; case 5: return W_CV; case 6: return W_ATT; case 7: return W_SSM1;
                  case 8: return W_GPW; case 9: return W_P2 | W_FB; case 10: return W_GFW; case 11: return W_SSM3; case 12: return W_GGLU; case 13: return W_GN; case 14: return W_GOUT;
                  case 15: return W_PREP3; case 16: return W_GFF1; default: return W_GFF2; }
}
#else
constexpr int NSP = 11;
__host__ __device__ __forceinline__ unsigned phase_mask(int sp) {
    switch (sp) { case 0: return W_PREP1; case 1: return W_GIN | W_GVT; case 2: return W_FA | W_CV | W_ATT | W_SSM1; case 3: return W_GPW | W_P2 | W_FB | W_FC;
                  case 4: return W_GFW | W_SSM3; case 5: return W_GGLU; case 6: return W_GN; case 7: return W_GOUT; case 8: return W_PREP3; case 9: return W_GFF1; default: return W_GFF2; }
}
#endif
constexpr int NPH = 2 + 2 * NSP;
#ifndef ZP1
#define ZP1 12
#define ZP2 30
#endif
#define OPQ_S(x) asm volatile("" : "+s"(x))
#define GSYNC() xcd_barrier(xb)
__global__ void __launch_bounds__(NTHREADS, 2) fwd(Args args) {
    extern __shared__ __attribute__((aligned(16))) unsigned char lds[];

    cg::grid_group grid = cg::this_grid();
    const int tid_ = threadIdx.x;
    const int wave_ = __builtin_amdgcn_readfirstlane(tid_ >> 6);
    float* scr = (float*)lds;
    const int G = gridDim.x, bx = blockIdx.x;
    const int gw = bx * 8 + wave_, nw = G * 8;
    const int lo = args.ph_lo, hi = args.ph_hi;
    if (lo < 0) grid.sync();
    volatile LAS unsigned* xb_st = (volatile LAS unsigned*)((LAS unsigned char*)lds + (LDS_BYTES - 64));
    if (tid_ == 0) { xb_st[0] = 0u; xb_st[1] = 0u; }
    __syncthreads();
    const XcdBarrier xb = xcd_barrier_post((unsigned*)(args.ws + WS_BAR), xb_st);
    if (lo == 0) { const Frame F{args, args.out, args.ws, tid_, tid_ & 63, wave_}; p0_prologue(F, scr); if (hi > 1) GSYNC(); }
#pragma nounroll
    for (int ph0 = (lo == 0 ? 1 : lo); ph0 < hi; ++ph0) {
        int ph = ph0; OPQ_S(ph);
        int tidv = tid_; asm volatile("" : "+v"(tidv));
        __attribute__((address_space(1))) unsigned char* wsg = (__attribute__((address_space(1))) unsigned char*)args.ws; __attribute__((address_space(1))) float* outg = (__attribute__((address_space(1))) float*)args.out;
        OPQ_S(wsg); OPQ_S(outg);
        unsigned char* wsv = (unsigned char*)wsg; float* outv = (float*)outg;
        const Frame F{args, outv, wsv, tidv, tidv & 63, wave_};
        if (ph == NPH - 1) { final_norm(F); continue; }
        const int l = (ph - 1) / NSP; const int sp = (ph - 1) - l * NSP;
        const unsigned wm = phase_mask(sp);
        const int row_lo = l == 0 ? 0 : NCTX;
        const int M_post = T_ALL - row_lo;
        unsigned char* wl = F.ws + WS_W + (size_t)l * W_LAYER;
#pragma nounroll
        for (int kind = 0; kind < 8; ++kind) {
            const unsigned bit = kind == 0 ? W_GIN : kind == 1 ? W_GVT : kind == 2 ? W_GPW : kind == 3 ? W_GFW : kind == 4 ? W_GGLU : kind == 5 ? W_GFF1 : kind == 6 ? W_GOUT : W_GFF2;
            if (!(wm & bit)) continue;
            const bf16_t* A; const bf16_t* Bt; int M, N, K;
            if (kind == 0) { A = FP(WS_XN, bf16_t); Bt = (const bf16_t*)(wl + W_IN); M = T_ALL; N = INC; K = DM; }
            else if (kind == 1) { A = (const bf16_t*)(wl + W_IN) + (size_t)1280 * DM; Bt = FP(WS_XN, bf16_t); M = 256; N = T_ALL; K = DM; }
            else if (kind == 2) { A = FP(WS_CV, bf16_t) + (size_t)row_lo * 256; Bt = (const bf16_t*)(wl + W_PW); M = M_post; N = 256; K = 256; }
            else if (kind == 3) { A = FP(WS_FN, bf16_t) + (size_t)row_lo * 256; Bt = (const bf16_t*)(wl + W_F); M = M_post; N = 256; K = 256; }
            else if (kind == 4) { A = FP(WS_YS, bf16_t) + (size_t)row_lo * 256; Bt = (const bf16_t*)(wl + W_GLU); M = M_post; N = 512; K = 256; }
            else if (kind == 5) { A = FP(WS_XN, bf16_t) + (size_t)row_lo * DM; Bt = (const bf16_t*)(wl + W_1); M = M_post; N = FFD; K = DM; }
            else if (kind == 6) { A = FP(WS_XN, bf16_t) + (size_t)row_lo * DM; Bt = (const bf16_t*)(wl + W_OUT); M = M_post; N = DM; K = DM; }
            else { A = FP(WS_H, bf16_t) + (size_t)row_lo * FFD; Bt = (const bf16_t*)(wl + W_2); M = M_post; N = DM; K = FFD; }
            pg8::Gemm g{A, Bt, M, N, K}; pg8::StaticOrder S; S.init(M, N, G, bx);
            EpiU E{F, l, kind, row_lo};
            pg8::gemm_phase<EpiU, pg8::StaticOrder, true, true>((PG8_LAS unsigned char*)lds, g, S, E);
        }
        if (wm & (W_FC | W_FA | W_CV)) {
            const int n_fc = (l == 0 && (wm & W_FC)) ? 128 : 0, n_fa = (wm & W_FA) ? 128 : 0, n_cv = (wm & W_CV) ? (l == 0 ? 544 : 512) : 0; const int nbu = n_fc + n_fa + n_cv;
            const int ustart = (n_fa + n_cv == 0) ? (G - 1 - bx) : bx;
#pragma nounroll
            for (int u = ustart; u < nbu; u += G) {
                if (u < n_fc) fnetctx_unit(F, u, scr);
                else if (u < n_fc + n_fa) fnetA_unit(F, u - n_fc, lds);
                else conv_unit(F, l, u - n_fc - n_fa, scr);
            }
        }
        if (wm & W_P2) ssm_pass2(F, l);
        if (wm & W_SSM3) {
#pragma nounroll
            for (int it = gw; it < 4096; it += nw) ssm_item<3>(F, l, it);
#pragma nounroll
            for (int it = 4096 + gw; it < 4352; it += nw) ssm_item<3>(F, l, it);
        }
        if (wm & (W_ATT | W_SSM1 | W_FB)) {
            const int n_ac = (l == 0 && (wm & W_ATT)) ? 256 : 0, n_al = (wm & W_ATT) ? 4096 : 0, n_s1 = (wm & W_SSM1) ? 4352 : 0, n_fb = (wm & W_FB) ? 1024 : 0, n_s3 = 0;
            const int e0 = n_ac, e1 = e0 + n_al, e2 = e1 + n_s1, e3 = e2 + n_fb, e4 = e3 + n_s3;
            const int gw_i = (wm & W_ATT) ? ((G - 1 - bx) * 8 + wave_) : gw;
#pragma nounroll
            for (int it = gw_i; it < e4; it += nw) {
                if (it < e0) attn_item<false>(F, l, it);
                else if (it < e1) attn_item<true>(F, l, it - e0);
                else if (it < e2) ssm_item<1>(F, l, it - e1);
                else if (it < e3) fnetB_item(F, it - e2);
                else { ssm_item<3>(F, l, it - e3); }
            }
        }
        if (wm & W_PREP1) prep_norm_mod(F, l == 0 ? F.A.in[2] : FP(WS_XC, float), l == 0 ? F.A.in[0] : F.out, PK(6) + l * DM, FP(WS_MOD, float) + l * 5 * 6144, 0, 1024, FP(WS_XN, bf16_t), 0);
        if (wm & W_GN) prep_group(F, l, row_lo);
        if (wm & W_PREP3) prep_norm_mod(F, FP(WS_XC, float), F.out, PK(30) + l * DM, FP(WS_MOD, float) + l * 5 * 6144, 3072, 4096, FP(WS_XN, bf16_t), row_lo);
        if (ph0 + 1 < hi) GSYNC();
    }
}

extern "C" void kernel_launch(void* const* d_in, const int* in_sizes, int n_in, void* d_out, int out_size, void* d_ws, size_t ws_size, hipStream_t stream) {
    static int grid = 0;
    if (grid == 0) {
        if (n_in != 36 || ws_size < WS_END) { fprintf(stderr, "kernel_launch: unexpected n_in %d / ws %zu\n", n_in, ws_size); grid = -1; return; }
        int dev = 0, cus = 0, per_cu = 0;
        (void)hipGetDevice(&dev); (void)hipDeviceGetAttribute(&cus, hipDeviceAttributeMultiprocessorCount, dev);
        (void)hipFuncSetAttribute((const void*)fwd, hipFuncAttributeMaxDynamicSharedMemorySize, LDS_BYTES);
        (void)hipOccupancyMaxActiveBlocksPerMultiprocessor(&per_cu, (const void*)fwd, NTHREADS, LDS_BYTES);
        (void)hipGetLastError();
        grid = cus > 0 ? cus : 256;
    }
    if (grid < 0) return;
    Args a{};
    for (int i = 0; i < 36; ++i) a.in[i] = (const float*)d_in[i];
    a.out = (float*)d_out; a.ws = (unsigned char*)d_ws;
#if MODE_COOP
    (void)hipMemsetAsync((unsigned char*)d_ws + WS_BAR, 0, 16384, stream);
    a.ph_lo = 0; a.ph_hi = NPH; a.part = 15;
    void* kargs[] = {&a};
    hipError_t e = hipLaunchCooperativeKernel((const void*)fwd, dim3(grid), dim3(NTHREADS), kargs, LDS_BYTES, stream);
    if (e != hipSuccess) fprintf(stderr, "cooperative launch failed: %s (grid %d)\n", hipGetErrorString(e), grid);
#else
    for (int ph = 0; ph < NPH; ++ph) { a.ph_lo = ph; a.ph_hi = ph + 1; a.part = 15; hipLaunchKernelGGL(fwd, dim3(grid), dim3(NTHREADS), LDS_BYTES, stream, a); }
#endif
}
```

```cpp
#include <hip/hip_runtime.h>
#include <hip/hip_cooperative_groups.h>
#include <cstdio>
#include <cstdint>
namespace cg = cooperative_groups;
#ifndef MODE_COOP
#define MODE_COOP 1
#endif
namespace pg8 {
#define PG8_LAS __attribute__((address_space(3)))
typedef unsigned short bf16_t;
typedef short bf16x8 __attribute__((ext_vector_type(8)));
typedef float f32x4 __attribute__((ext_vector_type(4)));
typedef unsigned u32x4 __attribute__((ext_vector_type(4)));
constexpr int BM = 256, BK = 64, HALF = 128, HTB = HALF * BK * 2  , STAGE_BYTES = 8 * HTB, NXCD = 8, WGM = 8;

__host__ __device__ __forceinline__ int lds_byte(int r, int c) { const int st = (r >> 4) * 2 + (c >> 5), rr = r & 15, cc = c & 31, ob = rr * 64 + cc * 2; return st * 1024 + (ob ^ (((ob >> 9) & 1) << 5)); }
__host__ __device__ __forceinline__ void stage_rc(int b, int& R, int& C) { const int st = b / 1024, sb = b % 1024, swz = sb ^ (((sb >> 9) & 1) << 5); R = (st >> 1) * 16 + swz / 64; C = (st & 1) * 32 + (swz % 64) / 2; }
__host__ __device__ __forceinline__ int perm32(int rho) { const int n = rho >> 4, i = rho & 15; return 8 * (i >> 2) + 4 * n + (i & 3); }

struct Unit { int pm, pn; };
struct Gemm { const bf16_t* A; const bf16_t* Bt; int M, N, K; };

struct StaticOrder {
    int nM, nN, nwg, G, c;
    __host__ __device__ void init(int M, int N, int G_, int c_) { nM = M / BM; nN = N / BM; nwg = nM * nN; G = G_; c = c_; }
    __host__ __device__ bool next(int i, Unit& u) const {
        const long L = (long)i * G + c; if (L >= nwg) return false;
        int wgid = (int)L; { const int q = nwg / NXCD, r = nwg % NXCD, xcd = wgid % NXCD, off = wgid / NXCD; wgid = (xcd < r ? xcd * (q + 1) : r * (q + 1) + (xcd - r) * q) + off; }
        const int nig = WGM * nN, gid = wgid / nig, fm = gid * WGM, gsz = (nM - fm) < WGM ? (nM - fm) : WGM;
        u.pm = fm + ((wgid % nig) % gsz); u.pn = (wgid % nig) / gsz; return true;
    }
    __device__ __forceinline__ void a_ready(const Unit&) const {}
    __device__ __forceinline__ void done(const Unit&) const {}
};

}
namespace pg8 {
template <class Epi, class Sched, bool ALIGN_EPI = false, bool SP2 = false>
__device__ __forceinline__ void gemm_phase(PG8_LAS unsigned char* lds, const Gemm g, const Sched& S, const Epi& E) {
    const int tid = threadIdx.x, wid = __builtin_amdgcn_readfirstlane(tid >> 6), lane = tid & 63, wr = wid >> 2, wc = wid & 3, fr = lane & 15, fq = lane >> 4;
    const int K = g.K, nt = K / BK;
    unsigned voffA[2], voffB[2];
#pragma unroll
    for (int i = 0; i < 2; ++i) { int R, C; stage_rc(tid * 16 + i * 8192, R, C); const int Rb = Epi::PERM ? ((R & ~31) + perm32(R & 31)) : R;
        voffA[i] = (unsigned)(R * K + C) * 2u; voffB[i] = (unsigned)(Rb * K + C) * 2u; }
    const size_t kstep = (size_t)(BK * 2);
    const size_t hstep = (size_t)HALF * K * 2;
    const size_t tstep = 2 * hstep;
    const unsigned ldsw = (unsigned)wid * 1024u;
    const int aoff = lds_byte(wr * 64 + fr, fq * 8), boff = lds_byte(wc * 32 + fr, fq * 8);
#define PG8_SA(b, h) (((b) * 2 + (h)) * HTB)
#define PG8_SB(b, h) ((4 + (b) * 2 + (h)) * HTB)
#define PG8_STAGE(bufoff, gbase, voff) do { _Pragma("unroll") for (int _i = 0; _i < 2; ++_i) \
        __builtin_amdgcn_global_load_lds((const unsigned*)((const char*)(gbase) + (voff)[_i]), (PG8_LAS unsigned*)(lds + (bufoff) + ldsw + _i * 8192), 16, 0, 0); } while (0)
#define PG8_LDA(dst, b, h) do { _Pragma("unroll") for (int m = 0; m < 4; ++m) _Pragma("unroll") for (int k = 0; k < 2; ++k) dst[m][k] = *(const PG8_LAS bf16x8*)(lds + PG8_SA(b, h) + aoff + m * 2048 + k * 1024); } while (0)
#define PG8_LDB(dst, b, h) do { _Pragma("unroll") for (int n = 0; n < 2; ++n) _Pragma("unroll") for (int k = 0; k < 2; ++k) dst[n][k] = *(const PG8_LAS bf16x8*)(lds + PG8_SB(b, h) + boff + n * 2048 + k * 1024); } while (0)
#define PG8_MMA(ai, bj, At, Bt) do { __builtin_amdgcn_s_setprio(1); _Pragma("unroll") for (int m = 0; m < 4; ++m) _Pragma("unroll") for (int n = 0; n < 2; ++n) _Pragma("unroll") for (int k = 0; k < 2; ++k) \
        acc[ai][bj][m][n] = __builtin_amdgcn_mfma_f32_16x16x32_bf16(Bt[n][k], At[m][k], acc[ai][bj][m][n], 0, 0, 0); __builtin_amdgcn_s_setprio(0); } while (0)
#define PG8_WAIT_V(n) asm volatile("s_waitcnt vmcnt(" #n ")" ::: "memory")
#define PG8_WAIT_L(n) asm volatile("s_waitcnt lgkmcnt(" #n ")" ::: "memory")
#define PG8_BAR __builtin_amdgcn_s_barrier()
#define PG8_SCHED __builtin_amdgcn_sched_barrier(0)
    Unit cur, nxt; int ui = 0;
    if (!S.next(0, cur)) return;
    f32x4 acc[2][2][4][2];
#pragma unroll
    for (int a = 0; a < 2; ++a)
#pragma unroll
        for (int b = 0; b < 2; ++b)
#pragma unroll
            for (int m = 0; m < 4; ++m)
#pragma unroll
                for (int n = 0; n < 2; ++n) acc[a][b][m][n] = (f32x4){0.f, 0.f, 0.f, 0.f};
    bf16x8 At[4][2], B0[2][2], B1[2][2];
    const char* cA = (const char*)g.A + (size_t)cur.pm * tstep; const char* cB = (const char*)g.Bt + (size_t)cur.pn * tstep;
    S.a_ready(cur);
    if constexpr (SP2) {
        PG8_STAGE(PG8_SB(0, 0), cB, voffB); PG8_STAGE(PG8_SB(0, 1), cB + hstep, voffB); PG8_STAGE(PG8_SA(0, 0), cA, voffA); PG8_STAGE(PG8_SA(0, 1), cA + hstep, voffA);
        if (wr == 1) PG8_BAR;
        PG8_WAIT_V(2); PG8_BAR;
        PG8_STAGE(PG8_SB(1, 0), cB + kstep, voffB); PG8_STAGE(PG8_SA(1, 0), cA + kstep, voffA); PG8_STAGE(PG8_SB(1, 1), cB + hstep + kstep, voffB);
        PG8_WAIT_V(6); PG8_BAR;
    } else {
        PG8_STAGE(PG8_SB(0, 0), cB, voffB); PG8_STAGE(PG8_SA(0, 0), cA, voffA); PG8_STAGE(PG8_SB(0, 1), cB + hstep, voffB); PG8_STAGE(PG8_SA(0, 1), cA + hstep, voffA);
        if (wr == 1) PG8_BAR;
        PG8_WAIT_V(4); PG8_BAR;
        PG8_STAGE(PG8_SB(1, 0), cB + kstep, voffB); PG8_STAGE(PG8_SA(1, 0), cA + kstep, voffA); PG8_STAGE(PG8_SB(1, 1), cB + hstep + kstep, voffB);
        PG8_WAIT_V(6); PG8_BAR;
    }
    for (;;) {
        const bool has_next = S.next(ui + 1, nxt);
        const char* nA = has_next ? (const char*)g.A + (size_t)nxt.pm * tstep : cA; const char* nB = has_next ? (const char*)g.Bt + (size_t)nxt.pn * tstep : cB;
        for (int t = 0; t < nt; t += 2) {
            const bool last = (t == nt - 2);
            const char* a1 = cA + (size_t)(t + 1) * kstep;
            const char* a2 = last ? nA : cA + (size_t)(t + 2) * kstep; const char* b2 = last ? nB : cB + (size_t)(t + 2) * kstep;
            const char* a3 = a2 + kstep; const char* b3 = b2 + kstep;
            if (last && has_next) S.a_ready(nxt);
            if constexpr (SP2) {
            PG8_LDB(B0, 0, 0); PG8_LDB(B1, 0, 1); PG8_SCHED; PG8_LDA(At, 0, 0); PG8_STAGE(PG8_SA(1, 1), a1 + hstep, voffA);
            PG8_WAIT_V(8); PG8_WAIT_L(0); PG8_BAR; PG8_MMA(0, 0, At, B0); PG8_MMA(0, 1, At, B1); PG8_BAR; PG8_SCHED;
            PG8_LDA(At, 0, 1); PG8_STAGE(PG8_SB(0, 0), b2, voffB); PG8_STAGE(PG8_SB(0, 1), b2 + hstep, voffB); PG8_STAGE(PG8_SA(0, 0), a2, voffA);
            PG8_WAIT_V(8); PG8_WAIT_L(0); PG8_BAR; PG8_MMA(1, 0, At, B0); PG8_MMA(1, 1, At, B1); PG8_BAR; PG8_SCHED;
            PG8_LDB(B0, 1, 0); PG8_LDB(B1, 1, 1); PG8_SCHED; PG8_LDA(At, 1, 0); PG8_STAGE(PG8_SA(0, 1), a2 + hstep, voffA);
            PG8_WAIT_V(8); PG8_WAIT_L(0); PG8_BAR; PG8_MMA(0, 0, At, B0); PG8_MMA(0, 1, At, B1); PG8_BAR; PG8_SCHED;
            PG8_LDA(At, 1, 1); PG8_STAGE(PG8_SB(1, 0), b3, voffB); PG8_STAGE(PG8_SB(1, 1), b3 + hstep, voffB); PG8_STAGE(PG8_SA(1, 0), a3, voffA);
            PG8_WAIT_V(8); PG8_WAIT_L(0); PG8_BAR; PG8_MMA(1, 0, At, B0); PG8_MMA(1, 1, At, B1); PG8_BAR; PG8_SCHED;
            } else {
            PG8_LDB(B0, 0, 0); PG8_SCHED; PG8_LDA(At, 0, 0); PG8_STAGE(PG8_SA(1, 1), a1 + hstep, voffA);
            PG8_WAIT_L(8); PG8_BAR; PG8_WAIT_L(0); PG8_MMA(0, 0, At, B0); PG8_BAR; PG8_SCHED;
            PG8_LDB(B1, 0, 1); PG8_STAGE(PG8_SB(0, 0), b2, voffB);
            PG8_BAR; PG8_WAIT_L(0); PG8_MMA(0, 1, At, B1); PG8_BAR;
            PG8_LDA(At, 0, 1); PG8_STAGE(PG8_SA(0, 0), a2, voffA);
            PG8_BAR; PG8_WAIT_L(0); PG8_MMA(1, 0, At, B0); PG8_BAR; PG8_SCHED;
            PG8_STAGE(PG8_SB(0, 1), b2 + hstep, voffB);
            PG8_WAIT_V(6); PG8_BAR; PG8_MMA(1, 1, At, B1); PG8_BAR;
            PG8_LDB(B0, 1, 0); PG8_SCHED; PG8_LDA(At, 1, 0); PG8_STAGE(PG8_SA(0, 1), a2 + hstep, voffA);
            PG8_WAIT_L(8); PG8_BAR; PG8_WAIT_L(0); PG8_MMA(0, 0, At, B0); PG8_BAR; PG8_SCHED;
            PG8_LDB(B1, 1, 1); PG8_STAGE(PG8_SB(1, 0), b3, voffB);
            PG8_BAR; PG8_WAIT_L(0); PG8_MMA(0, 1, At, B1); PG8_BAR;
            PG8_LDA(At, 1, 1); PG8_STAGE(PG8_SA(1, 0), a3, voffA);
            PG8_BAR; PG8_WAIT_L(0); PG8_MMA(1, 0, At, B0); PG8_BAR; PG8_SCHED;
            PG8_STAGE(PG8_SB(1, 1), b3 + hstep, voffB);
            PG8_WAIT_V(6); PG8_BAR; PG8_MMA(1, 1, At, B1); PG8_BAR;
            }
        }
        if constexpr (ALIGN_EPI) { if (wr == 0) PG8_BAR; }
        if constexpr (!Epi::AFTER_DRAIN) { E(acc, cur, wr, wc, fr, fq); S.done(cur); }
        if (!has_next) break;
#pragma unroll
        for (int a = 0; a < 2; ++a)
#pragma unroll
            for (int b = 0; b < 2; ++b)
#pragma unroll
                for (int m = 0; m < 4; ++m)
#pragma unroll
                    for (int n = 0; n < 2; ++n) acc[a][b][m][n] = (f32x4){0.f, 0.f, 0.f, 0.f};
        cur = nxt; cA = nA; cB = nB; ++ui;
        if constexpr (ALIGN_EPI) { if (wr == 1) PG8_BAR; }
    }
    PG8_WAIT_V(0);
    if constexpr (!ALIGN_EPI) { if (wr == 0) PG8_BAR; }
    PG8_BAR;
    if constexpr (Epi::AFTER_DRAIN) { E.fused(acc, cur, wr, wc, fr, fq, lds, wid, lane); S.done(cur); }
#undef PG8_SA
#undef PG8_SB
#undef PG8_STAGE
#undef PG8_LDA
#undef PG8_LDB
#undef PG8_MMA
#undef PG8_WAIT_V
#undef PG8_WAIT_L
#undef PG8_BAR
#undef PG8_SCHED
}
}

using pg8::bf16_t; using pg8::bf16x8; using pg8::f32x4;
#define LAS __attribute__((address_space(3)))
typedef short bf16x4 __attribute__((ext_vector_type(4)));
typedef unsigned u32x4 __attribute__((ext_vector_type(4)));
typedef unsigned u32x2 __attribute__((ext_vector_type(2)));

constexpr int NTHREADS = 512;
constexpr int T_ALL = 17408, NCTX = 1024, NLAT = 16384, DM = 1024, INC = 1792, FFD = 4096;
constexpr int LDS_BYTES = 147456;
constexpr float EPS = 1e-6f;

constexpr size_t MiB = 1u << 20;
constexpr size_t WS_MOD = 0;
constexpr size_t WS_CTAB = 256 * 1024;
constexpr size_t WS_STAB = 256 * 1024 + 8192;
constexpr size_t WS_PACK = 1 * MiB;
constexpr size_t WS_SLOC = 3 * MiB;
constexpr size_t WS_CARRY = 7 * MiB + 256 * 1024;
constexpr size_t WS_W = 12 * MiB;
constexpr size_t W_IN = 0, W_PW = W_IN + (size_t)INC * DM * 2, W_F = W_PW + 256 * 256 * 2, W_GLU = W_F + 256 * 256 * 2,
                 W_OUT = W_GLU + 512 * 256 * 2, W_1 = W_OUT + (size_t)DM * DM * 2, W_2 = W_1 + (size_t)FFD * DM * 2, W_LAYER = W_2 + (size_t)FFD * DM * 2;
static_assert(W_LAYER == 22 * MiB, "weights per layer");
constexpr size_t WS_XC = 56 * MiB;
constexpr size_t WS_XN = 60 * MiB;
constexpr size_t WS_BIG = 94 * MiB;
constexpr size_t WS_H = WS_BIG;
constexpr size_t WS_PX = WS_BIG;
constexpr size_t WS_VT = 154 * MiB;
constexpr size_t WS_VTC = 162 * MiB;
constexpr size_t WS_CV = 163 * MiB;
constexpr size_t WS_YB = 172 * MiB;
constexpr size_t WS_FN = 188 * MiB;
constexpr size_t WS_YS = 197 * MiB;
constexpr size_t WS_ZS = 206 * MiB;
constexpr size_t WS_MIX = 223 * MiB;
constexpr size_t WS_END = 256 * MiB;
static_assert(WS_H + (size_t)T_ALL * FFD * 2 <= WS_END && WS_MIX + (size_t)T_ALL * 768 * 2 <= WS_END && WS_PX + (size_t)T_ALL * INC * 2 <= WS_VT, "ws map");

__device__ __forceinline__ unsigned f2bf(float f) { unsigned u = __builtin_bit_cast(unsigned, f); return (u + 0x7fffu + ((u >> 16) & 1u)) >> 16; }
__device__ __forceinline__ unsigned pk2(float lo, float hi) { return f2bf(lo) | (f2bf(hi) << 16); }
__device__ __forceinline__ float bf2f(unsigned h) { return __builtin_bit_cast(float, (h & 0xffffu) << 16); }
__device__ __forceinline__ float bflo(unsigned w) { return __builtin_bit_cast(float, w << 16); }
__device__ __forceinline__ float bfhi(unsigned w) { return __builtin_bit_cast(float, w & 0xffff0000u); }
__device__ __forceinline__ bf16x8 pack8(f32x4 a, f32x4 b) {
    u32x4 w; w.x = pk2(a[0], a[1]); w.y = pk2(a[2], a[3]); w.z = pk2(b[0], b[1]); w.w = pk2(b[2], b[3]);
    return __builtin_bit_cast(bf16x8, w);
}
__device__ __forceinline__ bf16x8 neg8(bf16x8 v) { u32x4 w = __builtin_bit_cast(u32x4, v); w.x ^= 0x80008000u; w.y ^= 0x80008000u; w.z ^= 0x80008000u; w.w ^= 0x80008000u; return __builtin_bit_cast(bf16x8, w); }
__device__ __forceinline__ bf16x8 zero8() { u32x4 w = {0u, 0u, 0u, 0u}; return __builtin_bit_cast(bf16x8, w); }
__device__ __forceinline__ bf16x8 cat4(u32x2 a, u32x2 b) { u32x4 w; w.x = a.x; w.y = a.y; w.z = b.x; w.w = b.y; return __builtin_bit_cast(bf16x8, w); }
__device__ __forceinline__ f32x4 mfma16(bf16x8 a, bf16x8 b, f32x4 c) { return __builtin_amdgcn_mfma_f32_16x16x32_bf16(a, b, c, 0, 0, 0); }
__device__ __forceinline__ void settle4(f32x4& a, f32x4& b, f32x4& c, f32x4& d) { asm volatile("s_nop 15\n\ts_nop 15" : "+v"(a), "+v"(b), "+v"(c), "+v"(d)); }
__device__ __forceinline__ void settle4m(f32x4& a, f32x4& b, f32x4& c, f32x4& d) { asm volatile("s_nop 7\n\ts_nop 7" : "+v"(a), "+v"(b), "+v"(c), "+v"(d) :: "memory"); }
__device__ __forceinline__ f32x4 mfma16s(bf16x8 a, bf16x8 b, f32x4 c) { asm volatile("s_nop 7" : "+v"(a), "+v"(b)); return __builtin_amdgcn_mfma_f32_16x16x32_bf16(a, b, c, 0, 0, 0); }
__device__ __forceinline__ void settle2(f32x4& a, f32x4& b) { asm volatile("s_nop 15\n\ts_nop 15" : "+v"(a), "+v"(b)); }
__device__ __forceinline__ void settle_in(bf16x8& a, bf16x8& b) { asm volatile("s_nop 3" : "+v"(a), "+v"(b)); }
__device__ __forceinline__ float wave_sum(float v) {
    v += __shfl_xor(v, 1); v += __shfl_xor(v, 2); v += __shfl_xor(v, 4); v += __shfl_xor(v, 8); v += __shfl_xor(v, 16); v += __shfl_xor(v, 32); return v;
}
__device__ __forceinline__ float sigmoidf_(float x) { return 1.0f / (1.0f + __expf(-x)); }
struct cplx { float re, im; };
__device__ __forceinline__ cplx cmul(cplx a, cplx b) { return cplx{a.re * b.re - a.im * b.im, a.re * b.im + a.im * b.re}; }
__device__ __forceinline__ cplx cmad(cplx acc, cplx a, cplx b) { return cplx{acc.re + a.re * b.re - a.im * b.im, acc.im + a.re * b.im + a.im * b.re}; }

struct Args { const float* in[36]; float* out; unsigned char* ws; int ph_lo, ph_hi, part, pad; };
struct Frame {
    const Args& A;
    float* out; unsigned char* ws;
    int tid, lane, wave;
};
#define FP(off, type) ((type*)(F.ws + (off)))

constexpr int PK_N = 23;
constexpr int PK_IDX[PK_N] = {6,8,9,10,11,13,15,16,17,18,19,20,21,22,23,24,26,27,29,30,32,34,35};
constexpr int PK_CNT[PK_N] = {2048,15872,512,512,512,512,512,3720,4096,4096,64,65536,65536,65536,65536,512,1024,2048,2048,2048,8192,2048,1024};
constexpr int pk_off(int k) { int o = 0; for (int i = 0; i < PK_N; ++i) { if (PK_IDX[i] == k) return o; o += PK_CNT[i]; } return -1; }
#define PK(k) (FP(WS_PACK, float) + pk_off(k))
static_assert(pk_off(35) + 1024 <= (int)(2 * MiB / 4), "pack size");

struct EpiU {
    static constexpr bool PERM = false, AFTER_DRAIN = false;
    const Frame& F; int l; int kind; int row_lo;
    __device__ __forceinline__ void operator()(const f32x4 (&acc)[2][2][4][2], const pg8::Unit& u, int wr, int wc, int fr, int fq) const {
        const int c0 = u.pn * 256 + wc * 32 + fq * 4;
        const int r0 = u.pm * 256 + wr * 64 + fr;
        if (kind < 6) {
            bf16_t* base; size_t ldc; const float* bias = nullptr;
            if (kind == 0) { base = FP(WS_PX, bf16_t) + (size_t)r0 * INC + c0; ldc = INC; }
            else if (kind == 1) {
                if (u.pn < 4) { base = FP(WS_VTC, bf16_t) + (size_t)u.pn * 65536 + (size_t)r0 * 256 + (c0 - u.pn * 256); ldc = 256; }
                else { const int tt = u.pn - 4; base = FP(WS_VT, bf16_t) + (size_t)(tt >> 4) * 256 * 4096 + (tt & 15) * 256 + (size_t)r0 * 4096 + (c0 - u.pn * 256); ldc = 4096; }
            }
            else if (kind == 2) { base = FP(WS_MIX, bf16_t) + (size_t)(row_lo + r0) * 768 + c0; ldc = 768; bias = PK(13) + l * 256; }
            else if (kind == 3) { base = FP(WS_MIX, bf16_t) + (size_t)(row_lo + r0) * 768 + 256 + c0; ldc = 768; bias = PK(15) + l * 256; }
            else if (kind == 4) { base = FP(WS_ZS, bf16_t) + (size_t)(row_lo + r0) * 512 + c0; ldc = 512; bias = PK(26) + l * 512; }
            else { base = FP(WS_H, bf16_t) + (size_t)(row_lo + r0) * FFD + c0; ldc = FFD; bias = PK(32) + l * FFD; }
#pragma unroll
            for (int bj = 0; bj < 2; ++bj)
#pragma unroll
                for (int n = 0; n < 2; ++n) {
                    f32x4 bv = f32x4{0.f, 0.f, 0.f, 0.f};
                    if (bias) bv = *(const f32x4*)(bias + c0 + bj * 128 + n * 16);
#pragma unroll
                    for (int ai = 0; ai < 2; ++ai)
#pragma unroll
                        for (int m = 0; m < 4; ++m) {
                            f32x4 v = acc[ai][bj][m][n] + bv;
                            if (kind == 5) {
#pragma unroll
                                for (int j = 0; j < 4; ++j) { const float r = fmaxf(v[j], 0.f); v[j] = r * r; }
                            }
                            u32x2 w; w.x = pk2(v[0], v[1]); w.y = pk2(v[2], v[3]);
                            *(u32x2*)(base + (size_t)(ai * 128 + m * 16) * ldc + bj * 128 + n * 16) = w;
                        }
                }
        } else {
            const int gp = u.pm + (row_lo >> 8); const bool isc = gp < 4; const int lrow0 = isc ? gp * 256 : (gp - 4) * 256; const int br = isc ? 4 : ((gp - 4) >> 4);
            const float* sC; const float* sL; const float* bias; int gate_off;
            if (kind == 6) { sC = l == 0 ? F.A.in[2] : FP(WS_XC, float); sL = l == 0 ? F.A.in[0] : F.out; bias = PK(29) + l * DM; gate_off = 2048; }
            else { sC = FP(WS_XC, float); sL = F.out; bias = PK(34) + l * DM; gate_off = 5120; }
            const size_t roff = (size_t)(lrow0 + wr * 64 + fr) * DM + c0;
            const float* s = (isc ? sC : sL) + roff; float* d = (isc ? FP(WS_XC, float) : F.out) + roff;
            const float* gate = FP(WS_MOD, float) + (l * 5 + br) * 6144 + gate_off;
#pragma unroll
            for (int bj = 0; bj < 2; ++bj)
#pragma unroll
                for (int n = 0; n < 2; ++n) {
                    const int cc = c0 + bj * 128 + n * 16;
                    const f32x4 bv = *(const f32x4*)(bias + cc); const f32x4 gv = *(const f32x4*)(gate + cc);
#pragma unroll
                    for (int ai = 0; ai < 2; ++ai)
#pragma unroll
                        for (int m = 0; m < 4; ++m) {
                            const size_t o = (size_t)(ai * 128 + m * 16) * DM + bj * 128 + n * 16;
                            const f32x4 xv = *(const f32x4*)(s + o);
                            *(f32x4*)(d + o) = xv + gv * (acc[ai][bj][m][n] + bv);
                        }
                }
        }
    }
};

__device__ __forceinline__ void transpose_tile(const float* W, int K, int N, bf16_t* Wt, int tile, float* scr, int tid) {
    const int ntn = N >> 6; const int tk = tile / ntn, tn = tile - tk * ntn; const int k0 = tk * 64, n0 = tn * 64;
    { const int n = tid & 63, kk = tid >> 6;
#pragma unroll
      for (int i = 0; i < 8; ++i) { const int k = kk + 8 * i; scr[k * 65 + n] = W[(size_t)(k0 + k) * N + n0 + n]; } }
    __syncthreads();
    { const int kp = tid & 31, nn = tid >> 5;
#pragma unroll
      for (int i = 0; i < 4; ++i) { const int n = nn + 16 * i; const unsigned v = pk2(scr[(2 * kp) * 65 + n], scr[(2 * kp + 1) * 65 + n]); *(unsigned*)(Wt + (size_t)(n0 + n) * K + k0 + 2 * kp) = v; } }
    __syncthreads();
}
__device__ __forceinline__ void mod_unit(const Frame& F, int unit, float* scr) {
    const int l = unit / 96, cc = unit - l * 96; const int tid = F.tid;
    float* sl = scr; float* red = scr + 5 * 1024;
    for (int i = tid; i < 5 * 1024; i += NTHREADS) { const int r = i >> 10, k = i & 1023; const float c = r < 4 ? F.A.in[1][r * 1024 + k] : F.A.in[3][k]; sl[i] = c * sigmoidf_(c); }
    __syncthreads();
    const int col = tid & 63, kg = tid >> 6;
    const float* w = F.A.in[4] + (size_t)l * DM * 6144 + cc * 64 + col;
    float a0 = 0.f, a1 = 0.f, a2 = 0.f, a3 = 0.f, a4 = 0.f;
    for (int k = kg * 128; k < kg * 128 + 128; ++k) { const float wv = w[(size_t)k * 6144]; a0 += sl[k] * wv; a1 += sl[1024 + k] * wv; a2 += sl[2048 + k] * wv; a3 += sl[3072 + k] * wv; a4 += sl[4096 + k] * wv; }
    red[(kg * 5 + 0) * 64 + col] = a0; red[(kg * 5 + 1) * 64 + col] = a1; red[(kg * 5 + 2) * 64 + col] = a2; red[(kg * 5 + 3) * 64 + col] = a3; red[(kg * 5 + 4) * 64 + col] = a4;
    __syncthreads();
    if (tid < 320) { const int r = tid >> 6, c2 = tid & 63; float s = 0.f;
#pragma unroll
        for (int g = 0; g < 8; ++g) s += red[(g * 5 + r) * 64 + c2];
        FP(WS_MOD, float)[(l * 5 + r) * 6144 + cc * 64 + c2] = s + F.A.in[5][l * 6144 + cc * 64 + c2]; }
    __syncthreads();
}
__device__ __forceinline__ void p0_prologue(const Frame& F, float* scr) {
    const int NT_L = 448 + 16 + 16 + 32 + 256 + 1024 + 1024;
    const int njobs = 193 + 2 * NT_L + PK_N;
    for (int job = blockIdx.x; job < njobs; job += gridDim.x) {
        if (job >= 193 + 2 * NT_L) {
            const int e = job - (193 + 2 * NT_L); const float* src = nullptr; int cnt = 0, off = 0;
#define PKC(i) if (e == i) { src = F.A.in[PK_IDX[i]]; cnt = PK_CNT[i]; off = pk_off(PK_IDX[i]); }
            PKC(0) PKC(1) PKC(2) PKC(3) PKC(4) PKC(5) PKC(6) PKC(7) PKC(8) PKC(9) PKC(10) PKC(11) PKC(12) PKC(13) PKC(14) PKC(15) PKC(16) PKC(17) PKC(18) PKC(19) PKC(20) PKC(21) PKC(22)
#undef PKC
            float* dst = FP(WS_PACK, float) + off;
            for (int i = F.tid; i < cnt; i += NTHREADS) dst[i] = src[i];
        }
        else if (job < 192) { mod_unit(F, job, scr); }
        else if (job == 192) {
            for (int i = F.tid; i < 4096; i += NTHREADS) { const int m = i >> 6, j = i & 63; const float x = (float)((m * j) & 63) * (1.0f / 32.0f);
                FP(WS_CTAB, bf16_t)[i] = (bf16_t)f2bf(cospif(x)); FP(WS_STAB, bf16_t)[i] = (bf16_t)f2bf(sinpif(x)); }
        } else {
            int t = job - 193; const int l = t / NT_L; t -= l * NT_L;
            unsigned char* wl = F.ws + WS_W + (size_t)l * W_LAYER;
            if (t < 448) transpose_tile(F.A.in[7] + (size_t)l * DM * INC, DM, INC, (bf16_t*)(wl + W_IN), t, scr, F.tid);
            else if ((t -= 448) < 16) transpose_tile(F.A.in[12] + (size_t)l * 65536, 256, 256, (bf16_t*)(wl + W_PW), t, scr, F.tid);
            else if ((t -= 16) < 16) transpose_tile(F.A.in[14] + (size_t)l * 65536, 256, 256, (bf16_t*)(wl + W_F), t, scr, F.tid);
            else if ((t -= 16) < 32) transpose_tile(F.A.in[25] + (size_t)l * 131072, 256, 512, (bf16_t*)(wl + W_GLU), t, scr, F.tid);
            else if ((t -= 32) < 256) transpose_tile(F.A.in[28] + (size_t)l * DM * DM, DM, DM, (bf16_t*)(wl + W_OUT), t, scr, F.tid);
            else if ((t -= 256) < 1024) transpose_tile(F.A.in[31] + (size_t)l * DM * FFD, DM, FFD, (bf16_t*)(wl + W_1), t, scr, F.tid);
            else { t -= 1024; transpose_tile(F.A.in[33] + (size_t)l * DM * FFD, FFD, DM, (bf16_t*)(wl + W_2), t, scr, F.tid); }
        }
    }
}

__device__ __forceinline__ void prep_norm_mod(const Frame& F, const float* srcC, const float* srcL, const float* g, const float* modl, int sh_off, int sc_off, bf16_t* XN, int row_lo) {
    const int gw = blockIdx.x * 8 + F.wave, nw = gridDim.x * 8, lane = F.lane;
    for (int row = row_lo + gw; row < T_ALL; row += nw) {
        const bool isc = row < NCTX; const float* x = isc ? srcC + (size_t)row * DM : srcL + (size_t)(row - NCTX) * DM; const int br = isc ? 4 : ((row - NCTX) >> 12);
        const float* sh = modl + br * 6144 + sh_off; const float* sc = modl + br * 6144 + sc_off;
        f32x4 v[4]; float ss = 0.f;
#pragma unroll
        for (int i = 0; i < 4; ++i) { v[i] = *(const f32x4*)(x + i * 256 + lane * 4); ss += v[i][0] * v[i][0] + v[i][1] * v[i][1] + v[i][2] * v[i][2] + v[i][3] * v[i][3]; }
        ss = wave_sum(ss); const float r = rsqrtf(ss * (1.0f / 1024.0f) + EPS);
#pragma unroll
        for (int i = 0; i < 4; ++i) { const int c = i * 256 + lane * 4; const f32x4 gv = *(const f32x4*)(g + c), shv = *(const f32x4*)(sh + c), scv = *(const f32x4*)(sc + c);
            f32x4 y = v[i] * r * gv; y = y * (scv + 1.0f) + shv; u32x2 w; w.x = pk2(y[0], y[1]); w.y = pk2(y[2], y[3]); *(u32x2*)(XN + (size_t)row * DM + c) = w; }
    }
}
__device__ __forceinline__ f32x4 ld_bf4(const bf16_t* p) { const u32x2 w = *(const u32x2*)p; return f32x4{bflo(w.x), bfhi(w.x), bflo(w.y), bfhi(w.y)}; }
__device__ __forceinline__ void prep_group(const Frame& F, int l, int row_lo) {
    const int gw = blockIdx.x * 8 + F.wave, nw = gridDim.x * 8, lane = F.lane;
    const bf16_t* MIX = FP(WS_MIX, bf16_t); const bf16_t* ZS = FP(WS_ZS, bf16_t); bf16_t* O = FP(WS_XN, bf16_t); const float* gg = PK(27) + l * DM;
    for (int row = row_lo + gw; row < T_ALL; row += nw) {
#pragma unroll
        for (int grp = 0; grp < 4; ++grp) {
            f32x4 v;
            if (grp < 3) v = ld_bf4(MIX + (size_t)row * 768 + grp * 256 + lane * 4);
            else { const f32x4 a = ld_bf4(ZS + (size_t)row * 512 + lane * 4), gt = ld_bf4(ZS + (size_t)row * 512 + 256 + lane * 4);
#pragma unroll
                for (int j = 0; j < 4; ++j) v[j] = a[j] * sigmoidf_(gt[j]); }
            float ss = v[0] * v[0] + v[1] * v[1] + v[2] * v[2] + v[3] * v[3]; ss = wave_sum(ss);
            const float r = rsqrtf(ss * (1.0f / 256.0f) + EPS); const f32x4 gv = *(const f32x4*)(gg + grp * 256 + lane * 4); const f32x4 y = v * r * gv;
            u32x2 w; w.x = pk2(y[0], y[1]); w.y = pk2(y[2], y[3]); *(u32x2*)(O + (size_t)row * DM + grp * 256 + lane * 4) = w;
        }
    }
}
__device__ __forceinline__ void final_norm(const Frame& F) {
    const int gw = blockIdx.x * 8 + F.wave, nw = gridDim.x * 8, lane = F.lane; const float* g = PK(35);
    for (int row = gw; row < NLAT; row += nw) {
        float* x = F.out + (size_t)row * DM; f32x4 v[4]; float ss = 0.f;
#pragma unroll
        for (int i = 0; i < 4; ++i) { v[i] = *(const f32x4*)(x + i * 256 + lane * 4); ss += v[i][0] * v[i][0] + v[i][1] * v[i][1] + v[i][2] * v[i][2] + v[i][3] * v[i][3]; }
        ss = wave_sum(ss); const float r = rsqrtf(ss * (1.0f / 1024.0f) + EPS);
#pragma unroll
        for (int i = 0; i < 4; ++i) { const int c = i * 256 + lane * 4; *(f32x4*)(x + c) = v[i] * r * *(const f32x4*)(g + c); }
    }
}

__device__ __forceinline__ void conv_unit(const Frame& F, int l, int unit, float* scr) {
    const bf16_t* PX = FP(WS_PX, bf16_t); bf16_t* CV = FP(WS_CV, bf16_t);
    int prow0, Lseq, t0;
    if (unit < 512) { const int b = unit >> 7; t0 = (unit & 127) * 32; prow0 = NCTX + b * 4096; Lseq = 4096; }
    else { const int uu = unit - 512; const int b = uu >> 3; t0 = (uu & 7) * 32; prow0 = b * 256; Lseq = 256; }
    float* vt = scr; float* ot = scr + 62 * 256; int tid = F.tid; asm volatile("" : "+v"(tid));
    for (int idx = tid; idx < 62 * 256; idx += NTHREADS) { const int rr = idx >> 8, c = idx & 255; const int t = t0 - 15 + rr; float v = 0.f;
        if (t >= 0 && t < Lseq) { const bf16_t* p = PX + (size_t)(prow0 + t) * INC; const float a = bf2f(p[c]), gt = bf2f(p[256 + c]); v = a * sigmoidf_(gt); }
        vt[idx] = v; }
    __syncthreads();
    { const int c = tid & 255, half = tid >> 8; float w[31];
#pragma unroll
      for (int j = 0; j < 31; ++j) w[j] = PK(8)[(l * 31 + j) * 256 + c];
      const float bd = PK(9)[l * 256 + c];
      for (int tt = 0; tt < 16; ++tt) { const int t = half * 16 + tt; float s = bd;
#pragma unroll
          for (int j = 0; j < 31; ++j) s += w[j] * vt[(t + j) * 256 + c];
          ot[t * 256 + c] = s; } }
    __syncthreads();
    { const int lane = tid & 63; const f32x4 lg = *(const f32x4*)(PK(10) + l * 256 + lane * 4), lb = *(const f32x4*)(PK(11) + l * 256 + lane * 4);
      for (int i = 0; i < 4; ++i) { const int t = F.wave * 4 + i; const f32x4 x = *(const f32x4*)(ot + t * 256 + lane * 4);
          const float mu = wave_sum(x[0] + x[1] + x[2] + x[3]) * (1.0f / 256.0f); const f32x4 d = x - mu;
          const float var = wave_sum(d[0] * d[0] + d[1] * d[1] + d[2] * d[2] + d[3] * d[3]) * (1.0f / 256.0f); const float r = rsqrtf(var + EPS);
          f32x4 y = d * r * lg + lb;
#pragma unroll
          for (int j = 0; j < 4; ++j) y[j] = y[j] * sigmoidf_(y[j]);
          u32x2 w; w.x = pk2(y[0], y[1]); w.y = pk2(y[2], y[3]); *(u32x2*)(CV + (size_t)(prow0 + t0 + t) * 256 + lane * 4) = w; } }
    __syncthreads();
}

__device__ __forceinline__ void fnetctx_unit(const Frame& F, int unit, float* scr) {
    const bf16_t* PX = FP(WS_PX, bf16_t); bf16_t* FN = FP(WS_FN, bf16_t);
    const int mh = unit & 1, kh = (unit >> 1) & 3, h = (unit >> 3) & 3, b = unit >> 5; int tid = F.tid; asm volatile("" : "+v"(tid));
    float* zc = scr; float* zs = scr + 8192; float* c64 = scr + 16384; float* s64 = c64 + 64; float* c256 = s64 + 64; float* s256 = c256 + 256;
    if (tid < 64) { const float x = (float)tid * (1.0f / 32.0f); c64[tid] = cospif(x); s64[tid] = sinpif(x); }
    if (tid < 256) { const float x = (float)tid * (1.0f / 128.0f); c256[tid] = cospif(x); s256[tid] = sinpif(x); }
    __syncthreads();
    for (int idx = tid; idx < 8192; idx += NTHREADS) { const int n = idx >> 5, mm = idx & 31, m = mh * 32 + mm; const bf16_t* up = PX + (size_t)(b * 256 + n) * INC + 512 + h * 64;
        float ac = 0.f, as = 0.f;
        for (int j = 0; j < 64; ++j) { const float uv = bf2f(up[j]); const int a = (j * m) & 63; ac += uv * c64[a]; as += uv * s64[a]; }
        zc[idx] = ac; zs[idx] = as; }
    __syncthreads();
    for (int idx = tid; idx < 2048; idx += NTHREADS) { const int k = kh * 64 + (idx >> 5), mm = idx & 31; float acc = 0.f;
        for (int n = 0; n < 256; ++n) { const int a = (k * n) & 255; acc += c256[a] * zc[n * 32 + mm] - s256[a] * zs[n * 32 + mm]; }
        FN[(size_t)(b * 256 + k) * 256 + h * 64 + mh * 32 + mm] = (bf16_t)f2bf(acc * (1.0f / 128.0f)); }
    __syncthreads();
}
__device__ __forceinline__ void fnetA_unit(const Frame& F, int unit, unsigned char* lds) {
    const bf16_t* PX = FP(WS_PX, bf16_t); const bf16_t* Ct = FP(WS_CTAB, bf16_t); const bf16_t* St = FP(WS_STAB, bf16_t); bf16_t* YB = FP(WS_YB, bf16_t);
    const int oct = unit & 7, h = (unit >> 3) & 3, b = unit >> 5; int tid = F.tid; asm volatile("" : "+v"(tid)); const int lane = tid & 63, fr = lane & 15, fq = lane >> 4; const int n2 = oct * 8 + F.wave;
    bf16x8 ua[4][2];
#pragma unroll
    for (int mi = 0; mi < 4; ++mi)
#pragma unroll
        for (int kk = 0; kk < 2; ++kk) ua[mi][kk] = *(const bf16x8*)(PX + (size_t)(NCTX + b * 4096 + 64 * (16 * mi + fr) + n2) * INC + 512 + h * 64 + kk * 32 + fq * 8);
    bf16x8 zre[2][4], zs[2][4];
#pragma unroll
    for (int ni = 0; ni < 4; ++ni) {
        bf16x8 bc[2], bs[2];
#pragma unroll
        for (int kk = 0; kk < 2; ++kk) { bc[kk] = *(const bf16x8*)(Ct + (16 * ni + fr) * 64 + kk * 32 + fq * 8); bs[kk] = *(const bf16x8*)(St + (16 * ni + fr) * 64 + kk * 32 + fq * 8); }
#pragma unroll
        for (int pr = 0; pr < 2; ++pr) {
            f32x4 c0 = {0.f, 0.f, 0.f, 0.f}, c1 = c0, s0 = c0, s1 = c0;
#pragma unroll
            for (int kk = 0; kk < 2; ++kk) { c0 = mfma16(ua[2 * pr][kk], bc[kk], c0); c1 = mfma16(ua[2 * pr + 1][kk], bc[kk], c1); s0 = mfma16(ua[2 * pr][kk], bs[kk], s0); s1 = mfma16(ua[2 * pr + 1][kk], bs[kk], s1); }
            zre[pr][ni] = pack8(c0, c1); zs[pr][ni] = pack8(s0, s1);
        }
    }
    bf16_t* T = (bf16_t*)lds;
    for (int mi2 = 0; mi2 < 4; ++mi2) {
        bf16x8 cf[2], sf[2], sfn[2];
#pragma unroll
        for (int pr = 0; pr < 2; ++pr) {
            const bf16_t* cp = Ct + (16 * mi2 + fr) * 64 + 32 * pr + 4 * fq; const bf16_t* sp = St + (16 * mi2 + fr) * 64 + 32 * pr + 4 * fq;
            cf[pr] = cat4(*(const u32x2*)cp, *(const u32x2*)(cp + 16)); sf[pr] = cat4(*(const u32x2*)sp, *(const u32x2*)(sp + 16)); sfn[pr] = neg8(sf[pr]);
        }
        float cs[4], sn[4];
#pragma unroll
        for (int j = 0; j < 4; ++j) { const int k1 = 16 * mi2 + 4 * fq + j; const float x = (float)(n2 * k1) * (1.0f / 2048.0f); cs[j] = cospif(x); sn[j] = sinpif(x); }
#pragma unroll
        for (int ni = 0; ni < 4; ++ni) {
            f32x4 yre = {0.f, 0.f, 0.f, 0.f}, yin = yre;
#pragma unroll
            for (int pr = 0; pr < 2; ++pr) { yre = mfma16s(cf[pr], zre[pr][ni], yre); yre = mfma16s(sfn[pr], zs[pr][ni], yre); yin = mfma16s(cf[pr], zs[pr][ni], yin); yin = mfma16s(sf[pr], zre[pr][ni], yin); }
#pragma unroll
            for (int j = 0; j < 4; ++j) { const int k1 = 16 * mi2 + 4 * fq + j; const int m = 16 * ni + fr;
                const float y1 = yre[j] * cs[j] - yin[j] * sn[j], y2 = yin[j] * cs[j] + yre[j] * sn[j];
                T[((0 * 64 + k1) * 64 + m) * 8 + F.wave] = (bf16_t)f2bf(y1); T[((1 * 64 + k1) * 64 + m) * 8 + F.wave] = (bf16_t)f2bf(y2); }
        }
    }
    __syncthreads();
    for (int it = 0; it < 16; ++it) { const int cidx = it * NTHREADS + tid; const int m = cidx & 63, k1 = (cidx >> 6) & 63, plane = cidx >> 12;
        const u32x4 v = *(const u32x4*)(lds + (size_t)cidx * 16);
        *(u32x4*)(YB + ((((size_t)(b * 4 + h) * 64 + k1) * 2 + plane) * 64 + m) * 64 + oct * 8) = v; }
    __syncthreads();
}
__device__ __forceinline__ void fnetB_item(const Frame& F, int item) {
    const bf16_t* Ct = FP(WS_CTAB, bf16_t); const bf16_t* St = FP(WS_STAB, bf16_t); const bf16_t* YB = FP(WS_YB, bf16_t); bf16_t* FN = FP(WS_FN, bf16_t);
    const int k1 = item & 63, h = (item >> 6) & 3, b = item >> 8; int lane = F.lane; asm volatile("" : "+v"(lane)); const int fr = lane & 15, fq = lane >> 4;
    const bf16_t* base = YB + (((size_t)(b * 4 + h) * 64 + k1) * 2) * 4096;
    f32x4 acc[4][4];
#pragma unroll
    for (int mi = 0; mi < 4; ++mi)
#pragma unroll
        for (int ni = 0; ni < 4; ++ni) acc[mi][ni] = f32x4{0.f, 0.f, 0.f, 0.f};
#pragma unroll
    for (int kk = 0; kk < 2; ++kk) {
        bf16x8 bc[4], bsn[4];
#pragma unroll
        for (int ni = 0; ni < 4; ++ni) { bc[ni] = *(const bf16x8*)(Ct + (16 * ni + fr) * 64 + kk * 32 + fq * 8); bsn[ni] = neg8(*(const bf16x8*)(St + (16 * ni + fr) * 64 + kk * 32 + fq * 8)); }
#pragma unroll
        for (int mi = 0; mi < 4; ++mi) {
            const bf16x8 are = *(const bf16x8*)(base + (16 * mi + fr) * 64 + kk * 32 + fq * 8), aim = *(const bf16x8*)(base + 4096 + (16 * mi + fr) * 64 + kk * 32 + fq * 8);
#pragma unroll
            for (int ni = 0; ni < 4; ++ni) { acc[mi][ni] = mfma16(are, bc[ni], acc[mi][ni]); acc[mi][ni] = mfma16s(aim, bsn[ni], acc[mi][ni]); }
        }
    }
#pragma unroll
    for (int mi = 0; mi < 4; ++mi)
#pragma unroll
        for (int ni = 0; ni < 4; ++ni) { const int k = k1 + 64 * (16 * ni + fr); const f32x4 v = acc[mi][ni] * (1.0f / 512.0f);
            u32x2 w; w.x = pk2(v[0], v[1]); w.y = pk2(v[2], v[3]); *(u32x2*)(FN + (size_t)(NCTX + b * 4096 + k) * 256 + h * 64 + 16 * mi + 4 * fq) = w; }
}

template <bool LOCAL>
__device__ __forceinline__ void attn_item(const Frame& F, int l, int item) {
    const bf16_t* PX = FP(WS_PX, bf16_t); const bf16_t* VT = FP(WS_VT, bf16_t); const bf16_t* VTc = FP(WS_VTC, bf16_t); bf16_t* MIX = FP(WS_MIX, bf16_t);
    const float* rpb = PK(16) + l * (4 * 15 * 31);
    int lane = F.lane; asm volatile("" : "+v"(lane)); const int fr = lane & 15, fq = lane >> 4;
    int b, h, r = 0, jb = 0, qrow0;
    if (LOCAL) { h = item & 3; jb = (item >> 2) & 3; r = (item >> 4) & 63; b = item >> 10; qrow0 = NCTX + b * 4096 + r * 64 + jb * 16; }
    else { h = item & 3; const int qb = (item >> 2) & 15; b = item >> 6; qrow0 = b * 256 + qb * 16; }
    constexpr int NT = LOCAL ? 32 : 16;
    const int rs = LOCAL ? min(max(r - 4, 0), 56) : 0; const int kcs = LOCAL ? min(max(16 * jb - 8, 0), 32) : 0;
    bf16x8 qf[2];
#pragma unroll
    for (int kk = 0; kk < 2; ++kk) qf[kk] = *(const bf16x8*)(PX + (size_t)(qrow0 + fr) * INC + 768 + h * 64 + kk * 32 + fq * 8);
    f32x4 s[NT];
#pragma unroll
    for (int t = 0; t < NT; ++t) {
        int krow;
        if (LOCAL && t < 16) krow = NCTX + b * 4096 + (rs + (t >> 1)) * 64 + kcs + (t & 1) * 16 + fr;
        else krow = b * 256 + (t - (LOCAL ? 16 : 0)) * 16 + fr;
        const bf16_t* kp = PX + (size_t)krow * INC + 1024 + h * 64 + fq * 8;
        const bf16x8 k0 = *(const bf16x8*)kp, k1 = *(const bf16x8*)(kp + 32);
        f32x4 a = {0.f, 0.f, 0.f, 0.f}; a = mfma16(k0, qf[0], a); a = mfma16(k1, qf[1], a); s[t] = a;
    }
    float mx = -3.0e38f;
    const int qcol = 16 * jb + fr; const int cstart = min(max(qcol - 8, 0), 48);
#pragma unroll
    for (int t = 0; t < NT; ++t)
#pragma unroll
        for (int j = 0; j < 4; ++j) {
            float v = s[t][j] * 0.125f;
            if (LOCAL && t < 16) { const int kcol = kcs + (t & 1) * 16 + 4 * fq + j; const bool valid = (kcol >= cstart) && (kcol < cstart + 16);
                const int dr = rs + (t >> 1) - r + 7; const int dc = min(max(kcol - qcol + 15, 0), 30);
                v = valid ? v + rpb[(h * 15 + dr) * 31 + dc] : -1.0e30f; }
            s[t][j] = v; mx = fmaxf(mx, v);
        }
    mx = fmaxf(mx, __shfl_xor(mx, 16)); mx = fmaxf(mx, __shfl_xor(mx, 32));
    float sum = 0.f;
#pragma unroll
    for (int t = 0; t < NT; ++t)
#pragma unroll
        for (int j = 0; j < 4; ++j) { const float p = __expf(s[t][j] - mx); s[t][j] = p; sum += p; }
    sum += __shfl_xor(sum, 16); sum += __shfl_xor(sum, 32);
    f32x4 o[4];
#pragma unroll
    for (int di = 0; di < 4; ++di) o[di] = f32x4{0.f, 0.f, 0.f, 0.f};
#pragma unroll
    for (int u = 0; u < NT / 2; ++u) {
        const bf16x8 pb = pack8(s[2 * u], s[2 * u + 1]);
        const bf16_t* vbase; size_t stride;
        if (LOCAL && u < 8) { vbase = VT + (size_t)(b * 256 + h * 64) * 4096 + (rs + u) * 64 + kcs + 4 * fq; stride = 4096; }
        else { const int uu = u - (LOCAL ? 8 : 0); vbase = VTc + (size_t)(b * 256 + h * 64) * 256 + uu * 32 + 4 * fq; stride = 256; }
#pragma unroll
        for (int di = 0; di < 4; ++di) { const bf16_t* vp = vbase + (size_t)(16 * di + fr) * stride; const bf16x8 va = cat4(*(const u32x2*)vp, *(const u32x2*)(vp + 16)); o[di] = mfma16s(va, pb, o[di]); }
    }
    const float inv = 1.0f / sum;
#pragma unroll
    for (int di = 0; di < 4; ++di) { const f32x4 v = o[di] * inv; u32x2 w; w.x = pk2(v[0], v[1]); w.y = pk2(v[2], v[3]);
        *(u32x2*)(MIX + (size_t)(qrow0 + fr) * 768 + 512 + h * 64 + 16 * di + 4 * fq) = w; }
}

__device__ __forceinline__ cplx csel(bool c, cplx a, cplx b) { return cplx{c ? a.re : b.re, c ? a.im : b.im}; }
#define WAITALL() asm volatile("s_waitcnt vmcnt(0) lgkmcnt(0)" ::: "memory")
__device__ __forceinline__ cplx pow_sel(int k, cplx a, cplx a2, cplx a4, cplx a8, cplx a16) {
    cplx r = cplx{1.f, 0.f};
    r = csel((k & 1) != 0, cmul(r, a), r); r = csel((k & 2) != 0, cmul(r, a2), r); r = csel((k & 4) != 0, cmul(r, a4), r); r = csel((k & 8) != 0, cmul(r, a8), r); r = csel((k & 16) != 0, cmul(r, a16), r);
    return r;
}
__device__ __forceinline__ void ssm_consts(float lre, float lim, float dt, cplx& a, cplx& f) {
    const float e = __expf(lre * dt);
    float revs = lim * dt * 0.15915494309189535f; revs -= rintf(revs);
    a = cplx{e * __builtin_amdgcn_cosf(revs), e * __builtin_amdgcn_sinf(revs)};
    const float xr = a.re - 1.0f, xi = a.im, den = __builtin_amdgcn_rcpf(lre * lre + lim * lim);
    f = cplx{(xr * lre + xi * lim) * den, (xi * lre - xr * lim) * den};
}
template <int PASS, int DIR>
__device__ __forceinline__ void ssm_dir(const Frame& F, int lane, int l, int b, int g, int tb, const bf16x8 (&ub)[4], f32x4 (&accy)[4]) {
    const int fr = lane & 15, fq = lane >> 4;
    const int c = DIR == 0 ? tb : (tb < 4 ? 3 - tb : 71 - tb);
    const int pg = (l * 2 + DIR) * 16 + g;
    const float dt = __expf(PK(19)[pg]);
    cplx* Sloc = FP(WS_SLOC, cplx); const cplx* Carry = FP(WS_CARRY, cplx);
    const size_t sbase = ((size_t)((b * 2 + DIR) * 16 + g) * 68 + c) * 64;
    for (int q = 0; q < 4; ++q) {
        bf16x8 are, aim;
        { const int kq = (fq & 1) * 8; const float* pr = PK(20) + ((size_t)pg * 64 + 16 * q + fr) * 16 + kq; const float* pi = PK(21) + ((size_t)pg * 64 + 16 * q + fr) * 16 + kq;
          const f32x4 zz = f32x4{0.f, 0.f, 0.f, 0.f}; const bool on = fq < 2;
          const f32x4 r0 = *(const f32x4*)pr, r1 = *(const f32x4*)(pr + 4), i0 = *(const f32x4*)pi, i1 = *(const f32x4*)(pi + 4);

          are = pack8(on ? r0 : zz, on ? r1 : zz); aim = pack8(on ? i0 : zz, on ? i1 : zz); }
        f32x4 bre[4], bim[4];
        asm volatile("s_nop 7" : "+v"(are), "+v"(aim));
#pragma unroll
        for (int ni = 0; ni < 4; ++ni) { bre[ni] = mfma16(are, ub[ni], f32x4{0.f, 0.f, 0.f, 0.f}); bim[ni] = mfma16(aim, ub[ni], f32x4{0.f, 0.f, 0.f, 0.f}); }
        settle4m(bre[0], bre[1], bre[2], bre[3]); settle4m(bim[0], bim[1], bim[2], bim[3]);
#pragma unroll
        for (int j = 0; j < 4; ++j) {
            const int p = 16 * q + 4 * fq + j;
            const float lre = PK(17)[pg * 64 + p], lim = PK(18)[pg * 64 + p];

            cplx a, f; ssm_consts(lre, lim, dt, a, f);
            const cplx a2 = cmul(a, a), a4 = cmul(a2, a2), a8 = cmul(a4, a4), a16 = cmul(a8, a8);
            if (PASS == 1) {
                cplx Tt;
                if (DIR == 0) { Tt = cplx{bre[0][j], bim[0][j]}; Tt = cmad(cplx{bre[1][j], bim[1][j]}, Tt, a16); Tt = cmad(cplx{bre[2][j], bim[2][j]}, Tt, a16); Tt = cmad(cplx{bre[3][j], bim[3][j]}, Tt, a16); }
                else { Tt = cplx{bre[3][j], bim[3][j]}; Tt = cmad(cplx{bre[2][j], bim[2][j]}, Tt, a16); Tt = cmad(cplx{bre[1][j], bim[1][j]}, Tt, a16); Tt = cmad(cplx{bre[0][j], bim[0][j]}, Tt, a16); }
                const cplx w = pow_sel(DIR == 0 ? 15 - fr : fr, a, a2, a4, a8, a16);
                Tt = cmul(Tt, w);
                Tt.re += __shfl_xor(Tt.re, 1); Tt.im += __shfl_xor(Tt.im, 1); Tt.re += __shfl_xor(Tt.re, 2); Tt.im += __shfl_xor(Tt.im, 2);
                Tt.re += __shfl_xor(Tt.re, 4); Tt.im += __shfl_xor(Tt.im, 4); Tt.re += __shfl_xor(Tt.re, 8); Tt.im += __shfl_xor(Tt.im, 8);
                Tt = cmul(Tt, f);
                if (fr == 0) Sloc[sbase + p] = Tt;
            } else {
                const cplx w = pow_sel(DIR == 0 ? fr + 1 : 16 - fr, a, a2, a4, a8, a16);
                cplx x[4];
#pragma unroll
                for (int ni = 0; ni < 4; ++ni) {
                    cplx v = cmul(f, cplx{bre[ni][j], bim[ni][j]});
#define RLF(x, ln) __builtin_bit_cast(float, __builtin_amdgcn_readlane(__builtin_bit_cast(int, (x)), (ln)))
#define DPPF(x, ctrl) __builtin_bit_cast(float, __builtin_amdgcn_update_dpp(0, __builtin_bit_cast(int, (x)), (ctrl), 0xf, 0xf, true))
#define KS_STEP(d, ad) { cplx y; if (DIR == 0) { y.re = DPPF(v.re, 0x110 + d); y.im = DPPF(v.im, 0x110 + d); v = csel(fr >= d, cmad(v, ad, y), v); } \
                                   else { y.re = DPPF(v.re, 0x100 + d); y.im = DPPF(v.im, 0x100 + d); v = csel(fr + d <= 15, cmad(v, ad, y), v); } }
                    KS_STEP(1, a) KS_STEP(2, a2) KS_STEP(4, a4) KS_STEP(8, a8)
#undef KS_STEP
                    x[ni] = v;
                }
                cplx E = Carry[sbase + p];
#pragma unroll
                for (int bi = 0; bi < 4; ++bi) {
                    const int ni = DIR == 0 ? bi : 3 - bi;
                    const cplx hh = cmad(x[ni], w, E);
                    cplx tot;
                    { constexpr int L0 = DIR == 0 ? 15 : 0;
                      const float r0 = RLF(x[ni].re, L0), r1 = RLF(x[ni].re, L0 + 16), r2 = RLF(x[ni].re, L0 + 32), r3 = RLF(x[ni].re, L0 + 48);
                      const float i0 = RLF(x[ni].im, L0), i1 = RLF(x[ni].im, L0 + 16), i2 = RLF(x[ni].im, L0 + 32), i3 = RLF(x[ni].im, L0 + 48);
                      tot.re = fq == 0 ? r0 : fq == 1 ? r1 : fq == 2 ? r2 : r3; tot.im = fq == 0 ? i0 : fq == 1 ? i1 : fq == 2 ? i2 : i3; }
                    E = cmad(tot, a16, E);
                    bre[ni][j] = hh.re; bim[ni][j] = hh.im;
                }
            }
        }
        if (PASS == 3) {
            const float* cr = PK(22) + ((size_t)pg * 16 + fr) * 64 + 16 * q + 4 * fq; const float* ci = PK(23) + ((size_t)pg * 16 + fr) * 64 + 16 * q + 4 * fq;
            const f32x4 cre = *(const f32x4*)cr; const f32x4 cim = *(const f32x4*)ci;
            const bf16x8 ca = pack8(cre, f32x4{-cim[0], -cim[1], -cim[2], -cim[3]});
#pragma unroll
            for (int ni = 0; ni < 4; ++ni) { bf16x8 hb = pack8(bre[ni], bim[ni]); bf16x8 ca2 = ca; asm volatile("s_nop 7" : "+v"(ca2), "+v"(hb)); accy[ni] = mfma16(ca2, hb, accy[ni]); }
            settle4m(accy[0], accy[1], accy[2], accy[3]);
        }
    }
}
template <int PASS>
__device__ __forceinline__ void ssm_item(const Frame& F, int l_u, int item_u) {
    int l = l_u, item = item_u; asm volatile("" : "+v"(l), "+v"(item));
    const bf16_t* PX = FP(WS_PX, bf16_t);
    int lane = F.lane; asm volatile("" : "+v"(lane)); const int fr = lane & 15, fq = lane >> 4;
    const int tb = item % 68; const int g = (item / 68) & 15; const int b = item / (68 * 16);
    const int prow0 = tb < 4 ? b * 256 + tb * 64 : NCTX + b * 4096 + (tb - 4) * 64;
    bf16x8 ub[4];
#pragma unroll
    for (int ni = 0; ni < 4; ++ni) { const bf16x8 ld = *(const bf16x8*)(PX + (size_t)(prow0 + 16 * ni + fr) * INC + 1536 + g * 16 + (fq & 1) * 8); ub[ni] = fq < 2 ? ld : zero8(); }
    f32x4 accy[4];
#pragma unroll
    for (int ni = 0; ni < 4; ++ni) accy[ni] = f32x4{0.f, 0.f, 0.f, 0.f};

    ssm_dir<PASS, 0>(F, lane, l, b, g, tb, ub, accy);
    ssm_dir<PASS, 1>(F, lane, l, b, g, tb, ub, accy);
    if (PASS == 3) {
        bf16_t* YS = FP(WS_YS, bf16_t); const f32x4 dv = *(const f32x4*)(PK(24) + l * 256 + g * 16 + 4 * fq);
#pragma unroll
        for (int ni = 0; ni < 4; ++ni) { const int row = prow0 + 16 * ni + fr; const f32x4 uv = ld_bf4(PX + (size_t)row * INC + 1536 + g * 16 + 4 * fq);
            const f32x4 y = accy[ni] + dv * uv; u32x2 w; w.x = pk2(y[0], y[1]); w.y = pk2(y[2], y[3]); *(u32x2*)(YS + (size_t)row * 256 + g * 16 + 4 * fq) = w; }
    }
}
__device__ __forceinline__ void ssm_pass2(const Frame& F, int l) {
    const int pb = (int)blockIdx.x - 112; if (pb < 0 || pb >= 16) return;
    const int idx = pb * NTHREADS + F.tid;
    const int p = idx & 63, g = (idx >> 6) & 15, dir = (idx >> 10) & 1, b = idx >> 11;
    const int pg = (l * 2 + dir) * 16 + g; const float dt = __expf(PK(19)[pg]);
    const float lre = PK(17)[pg * 64 + p], lim = PK(18)[pg * 64 + p];
    cplx a, f_unused; ssm_consts(lre, lim, dt, a, f_unused);
#pragma unroll
    for (int i = 0; i < 6; ++i) a = cmul(a, a);
    const cplx* Sloc = FP(WS_SLOC, cplx); cplx* Carry = FP(WS_CARRY, cplx);
    const size_t base = ((size_t)((b * 2 + dir) * 16 + g) * 68) * 64 + p;
    cplx E = cplx{0.f, 0.f};
    for (int c0 = 0; c0 < 68; c0 += 4) {
        const cplx s0 = Sloc[base + (size_t)(c0 + 0) * 64], s1 = Sloc[base + (size_t)(c0 + 1) * 64], s2 = Sloc[base + (size_t)(c0 + 2) * 64], s3 = Sloc[base + (size_t)(c0 + 3) * 64];
        Carry[base + (size_t)(c0 + 0) * 64] = E; E = cmad(s0, a, E);
        Carry[base + (size_t)(c0 + 1) * 64] = E; E = cmad(s1, a, E);
        Carry[base + (size_t)(c0 + 2) * 64] = E; E = cmad(s2, a, E);
        Carry[base + (size_t)(c0 + 3) * 64] = E; E = cmad(s3, a, E);
    }
}


constexpr size_t WS_BAR = 512 * 1024;
#define XB_TMO      128
#define XB_XCNT(j)  (256  + 64 * (j))
#define XB_XSUB(j)  (1280 + 64 * (j))
#define XB_XGEN(j)  (2304 + 64 * (j))
#define XB_TOP      3328
#define XB_TOPGEN   3392
#define XCD_BAR_WORDS 3456
#define XB_SPIN_CAP (1u << 18)

__device__ __forceinline__ unsigned xb_ld(unsigned* p)              { return __hip_atomic_load(p, __ATOMIC_RELAXED, __HIP_MEMORY_SCOPE_AGENT); }
__device__ __forceinline__ unsigned xb_add(unsigned* p, unsigned v) { return __hip_atomic_fetch_add(p, v, __ATOMIC_RELAXED, __HIP_MEMORY_SCOPE_AGENT); }
__device__ __forceinline__ unsigned xb_xcc_id() { return (unsigned)__builtin_amdgcn_s_getreg((3 << 11) | 20) & 0xFu; }
#define XB_SPIN(cond, bar) do { unsigned _sp = 0; while (cond) { __builtin_amdgcn_s_sleep(1); \
    if ((++_sp & 255u) == 0u) { if (xb_ld(&(bar)[XB_TMO])) break; if (_sp > XB_SPIN_CAP) { atomicAdd(&(bar)[XB_TMO], 1u); break; } } } } while (0)

struct XcdBarrier {
    unsigned* bar; unsigned x;
    volatile LAS unsigned* st;
};

__device__ __forceinline__ XcdBarrier xcd_barrier_post(unsigned* bar, volatile LAS unsigned* st) {
    XcdBarrier b; b.bar = bar; b.x = xb_xcc_id(); b.st = st;
    if (threadIdx.x == 0) (void)xb_add(&bar[XB_XCNT(b.x)], 1u);
    return b;
}
__device__ __forceinline__ void xcd_barrier_complete(unsigned* bar, unsigned x, unsigned& nloc, unsigned& nx) {
    const unsigned G = gridDim.x * gridDim.y * gridDim.z;
    unsigned sum, cnt, mine, sp = 0u;
    for (;;) {
        sum = 0u; cnt = 0u; mine = 0u;
#pragma unroll
        for (unsigned j = 0; j < 16; ++j) { const unsigned c = xb_ld(&bar[XB_XCNT(j)]); sum += c; cnt += (c > 0u) ? 1u : 0u; mine = (j == x) ? c : mine; }
        if (sum == G) break;
        __builtin_amdgcn_s_sleep(1);
        if ((++sp & 255u) == 0u) { if (xb_ld(&bar[XB_TMO])) break; if (sp > XB_SPIN_CAP) { atomicAdd(&bar[XB_TMO], 1u); break; } }
    }
    nloc = mine > 0u ? mine : 1u; nx = cnt > 0u ? cnt : 1u;
}

__device__ __forceinline__ void xcd_barrier(const XcdBarrier& b) {
    asm volatile("s_waitcnt vmcnt(0)" ::: "memory");
    __syncthreads();
    if (threadIdx.x == 0) {
        unsigned* bar = b.bar;
        __builtin_amdgcn_s_waitcnt(0);
        unsigned nloc = b.st[0], nx = b.st[1];
        if (nloc == 0u) { xcd_barrier_complete(bar, b.x, nloc, nx); b.st[0] = nloc; b.st[1] = nx; }
        const unsigned old = xb_add(&bar[XB_XSUB(b.x)], 1u);
        const unsigned gen = old / nloc;
        if (old + 1u == (gen + 1u) * nloc) {
            __builtin_amdgcn_fence(__ATOMIC_RELEASE, "agent");
            asm volatile("s_waitcnt vmcnt(0)" ::: "memory");
            const unsigned og = xb_add(&bar[XB_TOP], 1u);
            const unsigned tg = og / nx;
            if (og + 1u == (tg + 1u) * nx) xb_add(&bar[XB_TOPGEN], 1u);
            else XB_SPIN(xb_ld(&bar[XB_TOPGEN]) == tg, bar);
            __builtin_amdgcn_fence(__ATOMIC_ACQUIRE, "agent");
            xb_add(&bar[XB_XGEN(b.x)], 1u);
            asm volatile("s_waitcnt vmcnt(0)" ::: "memory");
        } else {
            XB_SPIN(xb_ld(&bar[XB_XGEN(b.x)]) == gen, bar);
            __builtin_amdgcn_fence(__ATOMIC_ACQUIRE, "agent");
            asm volatile("s_waitcnt vmcnt(0)" ::: "memory");
        }
    }
    __syncthreads();
}
enum : unsigned { W_PREP1 = 1u << 0, W_GIN = 1u << 1, W_GVT = 1u << 2, W_FC = 1u << 3, W_FA = 1u << 4, W_CV = 1u << 5, W_ATT = 1u << 6, W_SSM1 = 1u << 7, W_GPW = 1u << 8,
                  W_P2 = 1u << 9, W_FB = 1u << 10, W_GFW = 1u << 11, W_SSM3 = 1u << 12, W_GGLU = 1u << 13, W_GN = 1u << 14, W_GOUT = 1u << 15, W_PREP3 = 1u << 16, W_GFF1 = 1u << 17, W_GFF2 = 1u << 18 };
#ifndef PH_FINE
#define PH_FINE 0
#endif
#if PH_FINE
constexpr int NSP = 18;
__host__ __device__ __forceinline__ unsigned phase_mask(int sp) {
    switch (sp) { case 0: return W_PREP1; case 1: return W_GIN; case 2: return W_GVT; case 3: return W_FC; case 4: return W_FA; case 5: return W_CV; case 6: return W_ATT; case 7: return W_SSM1;
                  case 8: return W_GPW; case 9: return W_P2 | W_FB; case 10: return W_GFW; case 11: return W_SSM3; case 12: return W_GGLU; case 13: return W_GN; case 14: return W_GOUT;
                  case 15: return W_PREP3; case 16: return W_GFF1; default: return W_GFF2; }
}
#else
constexpr int NSP = 11;
__host__ __device__ __forceinline__ unsigned phase_mask(int sp) {
    switch (sp) { case 0: return W_PREP1; case 1: return W_GIN | W_GVT; case 2: return W_FA | W_CV | W_ATT | W_SSM1; case 3: return W_GPW | W_P2 | W_FB | W_FC;
                  case 4: return W_GFW | W_SSM3; case 5: return W_GGLU; case 6: return W_GN; case 7: return W_GOUT; case 8: return W_PREP3; case 9: return W_GFF1; default: return W_GFF2; }
}
#endif
constexpr int NPH = 2 + 2 * NSP;
#ifndef ZP1
#define ZP1 12
#define ZP2 30
#endif
#define OPQ_S(x) asm volatile("" : "+s"(x))
#define GSYNC() xcd_barrier(xb)
__global__ void __launch_bounds__(NTHREADS, 2) fwd(Args args) {
    extern __shared__ __attribute__((aligned(16))) unsigned char lds[];

    cg::grid_group grid = cg::this_grid();
    const int tid_ = threadIdx.x;
    const int wave_ = __builtin_amdgcn_readfirstlane(tid_ >> 6);
    float* scr = (float*)lds;
    const int G = gridDim.x, bx = blockIdx.x;
    const int gw = bx * 8 + wave_, nw = G * 8;
    const int lo = args.ph_lo, hi = args.ph_hi;
    if (lo < 0) grid.sync();
    volatile LAS unsigned* xb_st = (volatile LAS unsigned*)((LAS unsigned char*)lds + (LDS_BYTES - 64));
    if (tid_ == 0) { xb_st[0] = 0u; xb_st[1] = 0u; }
    __syncthreads();
    const XcdBarrier xb = xcd_barrier_post((unsigned*)(args.ws + WS_BAR), xb_st);
    if (lo == 0) { const Frame F{args, args.out, args.ws, tid_, tid_ & 63, wave_}; p0_prologue(F, scr); if (hi > 1) GSYNC(); }
#pragma nounroll
    for (int ph0 = (lo == 0 ? 1 : lo); ph0 < hi; ++ph0) {
        int ph = ph0; OPQ_S(ph);
        int tidv = tid_; asm volatile("" : "+v"(tidv));
        __attribute__((address_space(1))) unsigned char* wsg = (__attribute__((address_space(1))) unsigned char*)args.ws; __attribute__((address_space(1))) float* outg = (__attribute__((address_space(1))) float*)args.out;
        OPQ_S(wsg); OPQ_S(outg);
        unsigned char* wsv = (unsigned char*)wsg; float* outv = (float*)outg;
        const Frame F{args, outv, wsv, tidv, tidv & 63, wave_};
        if (ph == NPH - 1) { final_norm(F); continue; }
        const int l = (ph - 1) / NSP; const int sp = (ph - 1) - l * NSP;
        const unsigned wm = phase_mask(sp);
        const int row_lo = l == 0 ? 0 : NCTX;
        const int M_post = T_ALL - row_lo;
        unsigned char* wl = F.ws + WS_W + (size_t)l * W_LAYER;
#pragma nounroll
        for (int kind = 0; kind < 8; ++kind) {
            const unsigned bit = kind == 0 ? W_GIN : kind == 1 ? W_GVT : kind == 2 ? W_GPW : kind == 3 ? W_GFW : kind == 4 ? W_GGLU : kind == 5 ? W_GFF1 : kind == 6 ? W_GOUT : W_GFF2;
            if (!(wm & bit)) continue;
            const bf16_t* A; const bf16_t* Bt; int M, N, K;
            if (kind == 0) { A = FP(WS_XN, bf16_t); Bt = (const bf16_t*)(wl + W_IN); M = T_ALL; N = INC; K = DM; }
            else if (kind == 1) { A = (const bf16_t*)(wl + W_IN) + (size_t)1280 * DM; Bt = FP(WS_XN, bf16_t); M = 256; N = T_ALL; K = DM; }
            else if (kind == 2) { A = FP(WS_CV, bf16_t) + (size_t)row_lo * 256; Bt = (const bf16_t*)(wl + W_PW); M = M_post; N = 256; K = 256; }
            else if (kind == 3) { A = FP(WS_FN, bf16_t) + (size_t)row_lo * 256; Bt = (const bf16_t*)(wl + W_F); M = M_post; N = 256; K = 256; }
            else if (kind == 4) { A = FP(WS_YS, bf16_t) + (size_t)row_lo * 256; Bt = (const bf16_t*)(wl + W_GLU); M = M_post; N = 512; K = 256; }
            else if (kind == 5) { A = FP(WS_XN, bf16_t) + (size_t)row_lo * DM; Bt = (const bf16_t*)(wl + W_1); M = M_post; N = FFD; K = DM; }
            else if (kind == 6) { A = FP(WS_XN, bf16_t) + (size_t)row_lo * DM; Bt = (const bf16_t*)(wl + W_OUT); M = M_post; N = DM; K = DM; }
            else { A = FP(WS_H, bf16_t) + (size_t)row_lo * FFD; Bt = (const bf16_t*)(wl + W_2); M = M_post; N = DM; K = FFD; }
            pg8::Gemm g{A, Bt, M, N, K}; pg8::StaticOrder S; S.init(M, N, G, bx);
            EpiU E{F, l, kind, row_lo};
            pg8::gemm_phase<EpiU, pg8::StaticOrder, true, true>((PG8_LAS unsigned char*)lds, g, S, E);
        }
        if (wm & (W_FC | W_FA | W_CV)) {
            const int n_fc = (l == 0 && (wm & W_FC)) ? 128 : 0, n_fa = (wm & W_FA) ? 128 : 0, n_cv = (wm & W_CV) ? (l == 0 ? 544 : 512) : 0; const int nbu = n_fc + n_fa + n_cv;
            const int ustart = (n_fa + n_cv == 0) ? (G - 1 - bx) : bx;
#pragma nounroll
            for (int u = ustart; u < nbu; u += G) {
                if (u < n_fc) fnetctx_unit(F, u, scr);
                else if (u < n_fc + n_fa) fnetA_unit(F, u - n_fc, lds);
                else conv_unit(F, l, u - n_fc - n_fa, scr);
            }
        }
        if (wm & W_P2) ssm_pass2(F, l);
        if (wm & W_SSM3) {
#pragma nounroll
            for (int it = gw; it < 4096; it += nw) ssm_item<3>(F, l, it);
#pragma nounroll
            for (int it = 4096 + (G - 1 - bx) * 8 + wave_; it < 4352; it += nw) ssm_item<3>(F, l, it);
        }
        if (wm & (W_ATT | W_SSM1 | W_FB)) {
            const int n_ac = (l == 0 && (wm & W_ATT)) ? 256 : 0, n_al = (wm & W_ATT) ? 4096 : 0, n_s1 = (wm & W_SSM1) ? 4352 : 0, n_fb = (wm & W_FB) ? 1024 : 0, n_s3 = 0;
            const int e0 = n_ac, e1 = e0 + n_al, e2 = e1 + n_s1, e3 = e2 + n_fb, e4 = e3 + n_s3;
            const int gw_i = (wm & W_ATT) ? ((G - 1 - bx) * 8 + wave_) : gw;
#pragma nounroll
            for (int it = gw_i; it < e4; it += nw) {
                if (it < e0) attn_item<false>(F, l, it);
                else if (it < e1) attn_item<true>(F, l, it - e0);
                else if (it < e2) ssm_item<1>(F, l, it - e1);
                else if (it < e3) fnetB_item(F, it - e2);
                else { ssm_item<3>(F, l, it - e3); }
            }
        }
        if (wm & W_PREP1) prep_norm_mod(F, l == 0 ? F.A.in[2] : FP(WS_XC, float), l == 0 ? F.A.in[0] : F.out, PK(6) + l * DM, FP(WS_MOD, float) + l * 5 * 6144, 0, 1024, FP(WS_XN, bf16_t), 0);
        if (wm & W_GN) prep_group(F, l, row_lo);
        if (wm & W_PREP3) prep_norm_mod(F, FP(WS_XC, float), F.out, PK(30) + l * DM, FP(WS_MOD, float) + l * 5 * 6144, 3072, 4096, FP(WS_XN, bf16_t), row_lo);
        if (ph0 + 1 < hi) GSYNC();
    }
}

extern "C" void kernel_launch(void* const* d_in, const int* in_sizes, int n_in, void* d_out, int out_size, void* d_ws, size_t ws_size, hipStream_t stream) {
    static int grid = 0;
    if (grid == 0) {
        if (n_in != 36 || ws_size < WS_END) { fprintf(stderr, "kernel_launch: unexpected n_in %d / ws %zu\n", n_in, ws_size); grid = -1; return; }
        int dev = 0, cus = 0, per_cu = 0;
        (void)hipGetDevice(&dev); (void)hipDeviceGetAttribute(&cus, hipDeviceAttributeMultiprocessorCount, dev);
        (void)hipFuncSetAttribute((const void*)fwd, hipFuncAttributeMaxDynamicSharedMemorySize, LDS_BYTES);
        (void)hipOccupancyMaxActiveBlocksPerMultiprocessor(&per_cu, (const void*)fwd, NTHREADS, LDS_BYTES);
        (void)hipGetLastError();
        grid = cus > 0 ? cus : 256;
    }
    if (grid < 0) return;
    Args a{};
    for (int i = 0; i < 36; ++i) a.in[i] = (const float*)d_in[i];
    a.out = (float*)d_out; a.ws = (unsigned char*)d_ws;
#if MODE_COOP
    (void)hipMemsetAsync((unsigned char*)d_ws + WS_BAR, 0, 16384, stream);
    a.ph_lo = 0; a.ph_hi = NPH; a.part = 15;
    void* kargs[] = {&a};
    hipError_t e = hipLaunchCooperativeKernel((const void*)fwd, dim3(grid), dim3(NTHREADS), kargs, LDS_BYTES, stream);
    if (e != hipSuccess) fprintf(stderr, "cooperative launch failed: %s (grid %d)\n", hipGetErrorString(e), grid);
#else
    for (int ph = 0; ph < NPH; ++ph) { a.ph_lo = ph; a.ph_hi = ph + 1; a.part = 15; hipLaunchKernelGGL(fwd, dim3(grid), dim3(NTHREADS), LDS_BYTES, stream, a); }
#endif
}
```

```cpp
#include <hip/hip_runtime.h>
#include <hip/hip_cooperative_groups.h>
#include <cstdio>
#include <cstdint>
namespace cg = cooperative_groups;
#ifndef MODE_COOP
#define MODE_COOP 1
#endif
namespace pg8 {
#define PG8_LAS __attribute__((address_space(3)))
typedef unsigned short bf16_t;
typedef short bf16x8 __attribute__((ext_vector_type(8)));
typedef float f32x4 __attribute__((ext_vector_type(4)));
typedef unsigned u32x4 __attribute__((ext_vector_type(4)));
constexpr int BM = 256, BK = 64, HALF = 128, HTB = HALF * BK * 2  , STAGE_BYTES = 8 * HTB, NXCD = 8, WGM = 8;

__host__ __device__ __forceinline__ int lds_byte(int r, int c) { const int st = (r >> 4) * 2 + (c >> 5), rr = r & 15, cc = c & 31, ob = rr * 64 + cc * 2; return st * 1024 + (ob ^ (((ob >> 9) & 1) << 5)); }
__host__ __device__ __forceinline__ void stage_rc(int b, int& R, int& C) { const int st = b / 1024, sb = b % 1024, swz = sb ^ (((sb >> 9) & 1) << 5); R = (st >> 1) * 16 + swz / 64; C = (st & 1) * 32 + (swz % 64) / 2; }
__host__ __device__ __forceinline__ int perm32(int rho) { const int n = rho >> 4, i = rho & 15; return 8 * (i >> 2) + 4 * n + (i & 3); }

struct Unit { int pm, pn; };
struct Gemm { const bf16_t* A; const bf16_t* Bt; int M, N, K; };

struct StaticOrder {
    int nM, nN, nwg, G, c;
    __host__ __device__ void init(int M, int N, int G_, int c_) { nM = M / BM; nN = N / BM; nwg = nM * nN; G = G_; c = c_; }
    __host__ __device__ bool next(int i, Unit& u) const {
        const long L = (long)i * G + c; if (L >= nwg) return false;
        int wgid = (int)L; { const int q = nwg / NXCD, r = nwg % NXCD, xcd = wgid % NXCD, off = wgid / NXCD; wgid = (xcd < r ? xcd * (q + 1) : r * (q + 1) + (xcd - r) * q) + off; }
        const int nig = WGM * nN, gid = wgid / nig, fm = gid * WGM, gsz = (nM - fm) < WGM ? (nM - fm) : WGM;
        u.pm = fm + ((wgid % nig) % gsz); u.pn = (wgid % nig) / gsz; return true;
    }
    __device__ __forceinline__ void a_ready(const Unit&) const {}
    __device__ __forceinline__ void done(const Unit&) const {}
};

}
namespace pg8 {
template <class Epi, class Sched, bool ALIGN_EPI = false, bool SP2 = false>
__device__ __forceinline__ void gemm_phase(PG8_LAS unsigned char* lds, const Gemm g, const Sched& S, const Epi& E) {
    const int tid = threadIdx.x, wid = __builtin_amdgcn_readfirstlane(tid >> 6), lane = tid & 63, wr = wid >> 2, wc = wid & 3, fr = lane & 15, fq = lane >> 4;
    const int K = g.K, nt = K / BK;
    unsigned voffA[2], voffB[2];
#pragma unroll
    for (int i = 0; i < 2; ++i) { int R, C; stage_rc(tid * 16 + i * 8192, R, C); const int Rb = Epi::PERM ? ((R & ~31) + perm32(R & 31)) : R;
        voffA[i] = (unsigned)(R * K + C) * 2u; voffB[i] = (unsigned)(Rb * K + C) * 2u; }
    const size_t kstep = (size_t)(BK * 2);
    const size_t hstep = (size_t)HALF * K * 2;
    const size_t tstep = 2 * hstep;
    const unsigned ldsw = (unsigned)wid * 1024u;
    const int aoff = lds_byte(wr * 64 + fr, fq * 8), boff = lds_byte(wc * 32 + fr, fq * 8);
#define PG8_SA(b, h) (((b) * 2 + (h)) * HTB)
#define PG8_SB(b, h) ((4 + (b) * 2 + (h)) * HTB)
#define PG8_STAGE(bufoff, gbase, voff) do { _Pragma("unroll") for (int _i = 0; _i < 2; ++_i) \
        __builtin_amdgcn_global_load_lds((const unsigned*)((const char*)(gbase) + (voff)[_i]), (PG8_LAS unsigned*)(lds + (bufoff) + ldsw + _i * 8192), 16, 0, 0); } while (0)
#define PG8_LDA(dst, b, h) do { _Pragma("unroll") for (int m = 0; m < 4; ++m) _Pragma("unroll") for (int k = 0; k < 2; ++k) dst[m][k] = *(const PG8_LAS bf16x8*)(lds + PG8_SA(b, h) + aoff + m * 2048 + k * 1024); } while (0)
#define PG8_LDB(dst, b, h) do { _Pragma("unroll") for (int n = 0; n < 2; ++n) _Pragma("unroll") for (int k = 0; k < 2; ++k) dst[n][k] = *(const PG8_LAS bf16x8*)(lds + PG8_SB(b, h) + boff + n * 2048 + k * 1024); } while (0)
#define PG8_MMA(ai, bj, At, Bt) do { __builtin_amdgcn_s_setprio(1); _Pragma("unroll") for (int m = 0; m < 4; ++m) _Pragma("unroll") for (int n = 0; n < 2; ++n) _Pragma("unroll") for (int k = 0; k < 2; ++k) \
        acc[ai][bj][m][n] = __builtin_amdgcn_mfma_f32_16x16x32_bf16(Bt[n][k], At[m][k], acc[ai][bj][m][n], 0, 0, 0); __builtin_amdgcn_s_setprio(0); } while (0)
#define PG8_WAIT_V(n) asm volatile("s_waitcnt vmcnt(" #n ")" ::: "memory")
#define PG8_WAIT_L(n) asm volatile("s_waitcnt lgkmcnt(" #n ")" ::: "memory")
#define PG8_BAR __builtin_amdgcn_s_barrier()
#define PG8_SCHED __builtin_amdgcn_sched_barrier(0)
    Unit cur, nxt; int ui = 0;
    if (!S.next(0, cur)) return;
    f32x4 acc[2][2][4][2];
#pragma unroll
    for (int a = 0; a < 2; ++a)
#pragma unroll
        for (int b = 0; b < 2; ++b)
#pragma unroll
            for (int m = 0; m < 4; ++m)
#pragma unroll
                for (int n = 0; n < 2; ++n) acc[a][b][m][n] = (f32x4){0.f, 0.f, 0.f, 0.f};
    bf16x8 At[4][2], B0[2][2], B1[2][2];
    const char* cA = (const char*)g.A + (size_t)cur.pm * tstep; const char* cB = (const char*)g.Bt + (size_t)cur.pn * tstep;
    S.a_ready(cur);
    if constexpr (SP2) {
        PG8_STAGE(PG8_SB(0, 0), cB, voffB); PG8_STAGE(PG8_SB(0, 1), cB + hstep, voffB); PG8_STAGE(PG8_SA(0, 0), cA, voffA); PG8_STAGE(PG8_SA(0, 1), cA + hstep, voffA);
        if (wr == 1) PG8_BAR;
        PG8_WAIT_V(2); PG8_BAR;
        PG8_STAGE(PG8_SB(1, 0), cB + kstep, voffB); PG8_STAGE(PG8_SA(1, 0), cA + kstep, voffA); PG8_STAGE(PG8_SB(1, 1), cB + hstep + kstep, voffB);
        PG8_WAIT_V(6); PG8_BAR;
    } else {
        PG8_STAGE(PG8_SB(0, 0), cB, voffB); PG8_STAGE(PG8_SA(0, 0), cA, voffA); PG8_STAGE(PG8_SB(0, 1), cB + hstep, voffB); PG8_STAGE(PG8_SA(0, 1), cA + hstep, voffA);
        if (wr == 1) PG8_BAR;
        PG8_WAIT_V(4); PG8_BAR;
        PG8_STAGE(PG8_SB(1, 0), cB + kstep, voffB); PG8_STAGE(PG8_SA(1, 0), cA + kstep, voffA); PG8_STAGE(PG8_SB(1, 1), cB + hstep + kstep, voffB);
        PG8_WAIT_V(6); PG8_BAR;
    }
    for (;;) {
        const bool has_next = S.next(ui + 1, nxt);
        const char* nA = has_next ? (const char*)g.A + (size_t)nxt.pm * tstep : cA; const char* nB = has_next ? (const char*)g.Bt + (size_t)nxt.pn * tstep : cB;
        for (int t = 0; t < nt; t += 2) {
            const bool last = (t == nt - 2);
            const char* a1 = cA + (size_t)(t + 1) * kstep;
            const char* a2 = last ? nA : cA + (size_t)(t + 2) * kstep; const char* b2 = last ? nB : cB + (size_t)(t + 2) * kstep;
            const char* a3 = a2 + kstep; const char* b3 = b2 + kstep;
            if (last && has_next) S.a_ready(nxt);
            if constexpr (SP2) {
            PG8_LDB(B0, 0, 0); PG8_LDB(B1, 0, 1); PG8_SCHED; PG8_LDA(At, 0, 0); PG8_STAGE(PG8_SA(1, 1), a1 + hstep, voffA);
            PG8_WAIT_V(8); PG8_WAIT_L(0); PG8_BAR; PG8_MMA(0, 0, At, B0); PG8_MMA(0, 1, At, B1); PG8_BAR; PG8_SCHED;
            PG8_LDA(At, 0, 1); PG8_STAGE(PG8_SB(0, 0), b2, voffB); PG8_STAGE(PG8_SB(0, 1), b2 + hstep, voffB); PG8_STAGE(PG8_SA(0, 0), a2, voffA);
            PG8_WAIT_V(8); PG8_WAIT_L(0); PG8_BAR; PG8_MMA(1, 0, At, B0); PG8_MMA(1, 1, At, B1); PG8_BAR; PG8_SCHED;
            PG8_LDB(B0, 1, 0); PG8_LDB(B1, 1, 1); PG8_SCHED; PG8_LDA(At, 1, 0); PG8_STAGE(PG8_SA(0, 1), a2 + hstep, voffA);
            PG8_WAIT_V(8); PG8_WAIT_L(0); PG8_BAR; PG8_MMA(0, 0, At, B0); PG8_MMA(0, 1, At, B1); PG8_BAR; PG8_SCHED;
            PG8_LDA(At, 1, 1); PG8_STAGE(PG8_SB(1, 0), b3, voffB); PG8_STAGE(PG8_SB(1, 1), b3 + hstep, voffB); PG8_STAGE(PG8_SA(1, 0), a3, voffA);
            PG8_WAIT_V(8); PG8_WAIT_L(0); PG8_BAR; PG8_MMA(1, 0, At, B0); PG8_MMA(1, 1, At, B1); PG8_BAR; PG8_SCHED;
            } else {
            PG8_LDB(B0, 0, 0); PG8_SCHED; PG8_LDA(At, 0, 0); PG8_STAGE(PG8_SA(1, 1), a1 + hstep, voffA);
            PG8_WAIT_L(8); PG8_BAR; PG8_WAIT_L(0); PG8_MMA(0, 0, At, B0); PG8_BAR; PG8_SCHED;
            PG8_LDB(B1, 0, 1); PG8_STAGE(PG8_SB(0, 0), b2, voffB);
            PG8_BAR; PG8_WAIT_L(0); PG8_MMA(0, 1, At, B1); PG8_BAR;
            PG8_LDA(At, 0, 1); PG8_STAGE(PG8_SA(0, 0), a2, voffA);
            PG8_BAR; PG8_WAIT_L(0); PG8_MMA(1, 0, At, B0); PG8_BAR; PG8_SCHED;
            PG8_STAGE(PG8_SB(0, 1), b2 + hstep, voffB);
            PG8_WAIT_V(6); PG8_BAR; PG8_MMA(1, 1, At, B1); PG8_BAR;
            PG8_LDB(B0, 1, 0); PG8_SCHED; PG8_LDA(At, 1, 0); PG8_STAGE(PG8_SA(0, 1), a2 + hstep, voffA);
            PG8_WAIT_L(8); PG8_BAR; PG8_WAIT_L(0); PG8_MMA(0, 0, At, B0); PG8_BAR; PG8_SCHED;
            PG8_LDB(B1, 1, 1); PG8_STAGE(PG8_SB(1, 0), b3, voffB);
            PG8_BAR; PG8_WAIT_L(0); PG8_MMA(0, 1, At, B1); PG8_BAR;
            PG8_LDA(At, 1, 1); PG8_STAGE(PG8_SA(1, 0), a3, voffA);
            PG8_BAR; PG8_WAIT_L(0); PG8_MMA(1, 0, At, B0); PG8_BAR; PG8_SCHED;
            PG8_STAGE(PG8_SB(1, 1), b3 + hstep, voffB);
            PG8_WAIT_V(6); PG8_BAR; PG8_MMA(1, 1, At, B1); PG8_BAR;
            }
        }
        if constexpr (ALIGN_EPI) { if (wr == 0) PG8_BAR; }
        if constexpr (!Epi::AFTER_DRAIN) { E(acc, cur, wr, wc, fr, fq); S.done(cur); }
        if (!has_next) break;
#pragma unroll
        for (int a = 0; a < 2; ++a)
#pragma unroll
            for (int b = 0; b < 2; ++b)
#pragma unroll
                for (int m = 0; m < 4; ++m)
#pragma unroll
                    for (int n = 0; n < 2; ++n) acc[a][b][m][n] = (f32x4){0.f, 0.f, 0.f, 0.f};
        cur = nxt; cA = nA; cB = nB; ++ui;
        if constexpr (ALIGN_EPI) { if (wr == 1) PG8_BAR; }
    }
    PG8_WAIT_V(0);
    if constexpr (!ALIGN_EPI) { if (wr == 0) PG8_BAR; }
    PG8_BAR;
    if constexpr (Epi::AFTER_DRAIN) { E.fused(acc, cur, wr, wc, fr, fq, lds, wid, lane); S.done(cur); }
#undef PG8_SA
#undef PG8_SB
#undef PG8_STAGE
#undef PG8_LDA
#undef PG8_LDB
#undef PG8_MMA
#undef PG8_WAIT_V
#undef PG8_WAIT_L
#undef PG8_BAR
#undef PG8_SCHED
}
}

using pg8::bf16_t; using pg8::bf16x8; using pg8::f32x4;
#define LAS __attribute__((address_space(3)))
typedef short bf16x4 __attribute__((ext_vector_type(4)));
typedef unsigned u32x4 __attribute__((ext_vector_type(4)));
typedef unsigned u32x2 __attribute__((ext_vector_type(2)));

constexpr int NTHREADS = 512;
constexpr int T_ALL = 17408, NCTX = 1024, NLAT = 16384, DM = 1024, INC = 1792, FFD = 4096;
constexpr int LDS_BYTES = 147456;
constexpr float EPS = 1e-6f;

constexpr size_t MiB = 1u << 20;
constexpr size_t WS_MOD = 0;
constexpr size_t WS_CTAB = 256 * 1024;
constexpr size_t WS_STAB = 256 * 1024 + 8192;
constexpr size_t WS_PACK = 1 * MiB;
constexpr size_t WS_SLOC = 3 * MiB;
constexpr size_t WS_CARRY = 7 * MiB + 256 * 1024;
constexpr size_t WS_W = 12 * MiB;
constexpr size_t W_IN = 0, W_PW = W_IN + (size_t)INC * DM * 2, W_F = W_PW + 256 * 256 * 2, W_GLU = W_F + 256 * 256 * 2,
                 W_OUT = W_GLU + 512 * 256 * 2, W_1 = W_OUT + (size_t)DM * DM * 2, W_2 = W_1 + (size_t)FFD * DM * 2, W_LAYER = W_2 + (size_t)FFD * DM * 2;
static_assert(W_LAYER == 22 * MiB, "weights per layer");
constexpr size_t WS_XC = 56 * MiB;
constexpr size_t WS_XN = 60 * MiB;
constexpr size_t WS_BIG = 94 * MiB;
constexpr size_t WS_H = WS_BIG;
constexpr size_t WS_PX = WS_BIG;
constexpr size_t WS_VT = 154 * MiB;
constexpr size_t WS_VTC = 162 * MiB;
constexpr size_t WS_CV = 163 * MiB;
constexpr size_t WS_YB = 172 * MiB;
constexpr size_t WS_FN = 188 * MiB;
constexpr size_t WS_YS = 197 * MiB;
constexpr size_t WS_ZS = 206 * MiB;
constexpr size_t WS_MIX = 223 * MiB;
constexpr size_t WS_END = 256 * MiB;
static_assert(WS_H + (size_t)T_ALL * FFD * 2 <= WS_END && WS_MIX + (size_t)T_ALL * 768 * 2 <= WS_END && WS_PX + (size_t)T_ALL * INC * 2 <= WS_VT, "ws map");

__device__ __forceinline__ unsigned f2bf(float f) { unsigned u = __builtin_bit_cast(unsigned, f); return (u + 0x7fffu + ((u >> 16) & 1u)) >> 16; }
__device__ __forceinline__ unsigned pk2(float lo, float hi) { return f2bf(lo) | (f2bf(hi) << 16); }
__device__ __forceinline__ float bf2f(unsigned h) { return __builtin_bit_cast(float, (h & 0xffffu) << 16); }
__device__ __forceinline__ float bflo(unsigned w) { return __builtin_bit_cast(float, w << 16); }
__device__ __forceinline__ float bfhi(unsigned w) { return __builtin_bit_cast(float, w & 0xffff0000u); }
__device__ __forceinline__ bf16x8 pack8(f32x4 a, f32x4 b) {
    u32x4 w; w.x = pk2(a[0], a[1]); w.y = pk2(a[2], a[3]); w.z = pk2(b[0], b[1]); w.w = pk2(b[2], b[3]);
    return __builtin_bit_cast(bf16x8, w);
}
__device__ __forceinline__ bf16x8 neg8(bf16x8 v) { u32x4 w = __builtin_bit_cast(u32x4, v); w.x ^= 0x80008000u; w.y ^= 0x80008000u; w.z ^= 0x80008000u; w.w ^= 0x80008000u; return __builtin_bit_cast(bf16x8, w); }
__device__ __forceinline__ bf16x8 zero8() { u32x4 w = {0u, 0u, 0u, 0u}; return __builtin_bit_cast(bf16x8, w); }
__device__ __forceinline__ bf16x8 cat4(u32x2 a, u32x2 b) { u32x4 w; w.x = a.x; w.y = a.y; w.z = b.x; w.w = b.y; return __builtin_bit_cast(bf16x8, w); }
__device__ __forceinline__ f32x4 mfma16(bf16x8 a, bf16x8 b, f32x4 c) { return __builtin_amdgcn_mfma_f32_16x16x32_bf16(a, b, c, 0, 0, 0); }
__device__ __forceinline__ void settle4(f32x4& a, f32x4& b, f32x4& c, f32x4& d) { asm volatile("s_nop 15\n\ts_nop 15" : "+v"(a), "+v"(b), "+v"(c), "+v"(d)); }
__device__ __forceinline__ void settle4m(f32x4& a, f32x4& b, f32x4& c, f32x4& d) { asm volatile("s_nop 7\n\ts_nop 7" : "+v"(a), "+v"(b), "+v"(c), "+v"(d) :: "memory"); }
__device__ __forceinline__ f32x4 mfma16s(bf16x8 a, bf16x8 b, f32x4 c) { asm volatile("s_nop 7" : "+v"(a), "+v"(b)); return __builtin_amdgcn_mfma_f32_16x16x32_bf16(a, b, c, 0, 0, 0); }
__device__ __forceinline__ void settle2(f32x4& a, f32x4& b) { asm volatile("s_nop 15\n\ts_nop 15" : "+v"(a), "+v"(b)); }
__device__ __forceinline__ void settle_in(bf16x8& a, bf16x8& b) { asm volatile("s_nop 3" : "+v"(a), "+v"(b)); }
__device__ __forceinline__ float wave_sum(float v) {
    v += __shfl_xor(v, 1); v += __shfl_xor(v, 2); v += __shfl_xor(v, 4); v += __shfl_xor(v, 8); v += __shfl_xor(v, 16); v += __shfl_xor(v, 32); return v;
}
__device__ __forceinline__ float sigmoidf_(float x) { return 1.0f / (1.0f + __expf(-x)); }
struct cplx { float re, im; };
__device__ __forceinline__ cplx cmul(cplx a, cplx b) { return cplx{a.re * b.re - a.im * b.im, a.re * b.im + a.im * b.re}; }
__device__ __forceinline__ cplx cmad(cplx acc, cplx a, cplx b) { return cplx{acc.re + a.re * b.re - a.im * b.im, acc.im + a.re * b.im + a.im * b.re}; }

struct Args { const float* in[36]; float* out; unsigned char* ws; int ph_lo, ph_hi, part, pad; };
struct Frame {
    const Args& A;
    float* out; unsigned char* ws;
    int tid, lane, wave;
};
#define FP(off, type) ((type*)(F.ws + (off)))

constexpr int PK_N = 23;
constexpr int PK_IDX[PK_N] = {6,8,9,10,11,13,15,16,17,18,19,20,21,22,23,24,26,27,29,30,32,34,35};
constexpr int PK_CNT[PK_N] = {2048,15872,512,512,512,512,512,3720,4096,4096,64,65536,65536,65536,65536,512,1024,2048,2048,2048,8192,2048,1024};
constexpr int pk_off(int k) { int o = 0; for (int i = 0; i < PK_N; ++i) { if (PK_IDX[i] == k) return o; o += PK_CNT[i]; } return -1; }
#define PK(k) (FP(WS_PACK, float) + pk_off(k))
static_assert(pk_off(35) + 1024 <= (int)(2 * MiB / 4), "pack size");

struct EpiU {
    static constexpr bool PERM = false, AFTER_DRAIN = false;
    const Frame& F; int l; int kind; int row_lo;
    __device__ __forceinline__ void operator()(const f32x4 (&acc)[2][2][4][2], const pg8::Unit& u, int wr, int wc, int fr, int fq) const {
        const int c0 = u.pn * 256 + wc * 32 + fq * 4;
        const int r0 = u.pm * 256 + wr * 64 + fr;
        if (kind < 6) {
            bf16_t* base; size_t ldc; const float* bias = nullptr;
            if (kind == 0) { base = FP(WS_PX, bf16_t) + (size_t)r0 * INC + c0; ldc = INC; }
            else if (kind == 1) {
                if (u.pn < 4) { base = FP(WS_VTC, bf16_t) + (size_t)u.pn * 65536 + (size_t)r0 * 256 + (c0 - u.pn * 256); ldc = 256; }
                else { const int tt = u.pn - 4; base = FP(WS_VT, bf16_t) + (size_t)(tt >> 4) * 256 * 4096 + (tt & 15) * 256 + (size_t)r0 * 4096 + (c0 - u.pn * 256); ldc = 4096; }
            }
            else if (kind == 2) { base = FP(WS_MIX, bf16_t) + (size_t)(row_lo + r0) * 768 + c0; ldc = 768; bias = PK(13) + l * 256; }
            else if (kind == 3) { base = FP(WS_MIX, bf16_t) + (size_t)(row_lo + r0) * 768 + 256 + c0; ldc = 768; bias = PK(15) + l * 256; }
            else if (kind == 4) { base = FP(WS_ZS, bf16_t) + (size_t)(row_lo + r0) * 512 + c0; ldc = 512; bias = PK(26) + l * 512; }
            else { base = FP(WS_H, bf16_t) + (size_t)(row_lo + r0) * FFD + c0; ldc = FFD; bias = PK(32) + l * FFD; }
#pragma unroll
            for (int bj = 0; bj < 2; ++bj)
#pragma unroll
                for (int n = 0; n < 2; ++n) {
                    f32x4 bv = f32x4{0.f, 0.f, 0.f, 0.f};
                    if (bias) bv = *(const f32x4*)(bias + c0 + bj * 128 + n * 16);
#pragma unroll
                    for (int ai = 0; ai < 2; ++ai)
#pragma unroll
                        for (int m = 0; m < 4; ++m) {
                            f32x4 v = acc[ai][bj][m][n] + bv;
                            if (kind == 5) {
#pragma unroll
                                for (int j = 0; j < 4; ++j) { const float r = fmaxf(v[j], 0.f); v[j] = r * r; }
                            }
                            u32x2 w; w.x = pk2(v[0], v[1]); w.y = pk2(v[2], v[3]);
                            *(u32x2*)(base + (size_t)(ai * 128 + m * 16) * ldc + bj * 128 + n * 16) = w;
                        }
                }
        } else {
            const int gp = u.pm + (row_lo >> 8); const bool isc = gp < 4; const int lrow0 = isc ? gp * 256 : (gp - 4) * 256; const int br = isc ? 4 : ((gp - 4) >> 4);
            const float* sC; const float* sL; const float* bias; int gate_off;
            if (kind == 6) { sC = l == 0 ? F.A.in[2] : FP(WS_XC, float); sL = l == 0 ? F.A.in[0] : F.out; bias = PK(29) + l * DM; gate_off = 2048; }
            else { sC = FP(WS_XC, float); sL = F.out; bias = PK(34) + l * DM; gate_off = 5120; }
            const size_t roff = (size_t)(lrow0 + wr * 64 + fr) * DM + c0;
            const float* s = (isc ? sC : sL) + roff; float* d = (isc ? FP(WS_XC, float) : F.out) + roff;
            const float* gate = FP(WS_MOD, float) + (l * 5 + br) * 6144 + gate_off;
#pragma unroll
            for (int bj = 0; bj < 2; ++bj)
#pragma unroll
                for (int n = 0; n < 2; ++n) {
                    const int cc = c0 + bj * 128 + n * 16;
                    const f32x4 bv = *(const f32x4*)(bias + cc); const f32x4 gv = *(const f32x4*)(gate + cc);
#pragma unroll
                    for (int ai = 0; ai < 2; ++ai)
#pragma unroll
                        for (int m = 0; m < 4; ++m) {
                            const size_t o = (size_t)(ai * 128 + m * 16) * DM + bj * 128 + n * 16;
                            const f32x4 xv = *(const f32x4*)(s + o);
                            *(f32x4*)(d + o) = xv + gv * (acc[ai][bj][m][n] + bv);
                        }
                }
        }
    }
};

__device__ __forceinline__ void transpose_tile(const float* W, int K, int N, bf16_t* Wt, int tile, float* scr, int tid) {
    const int ntn = N >> 6; const int tk = tile / ntn, tn = tile - tk * ntn; const int k0 = tk * 64, n0 = tn * 64;
    { const int n = tid & 63, kk = tid >> 6;
#pragma unroll
      for (int i = 0; i < 8; ++i) { const int k = kk + 8 * i; scr[k * 65 + n] = W[(size_t)(k0 + k) * N + n0 + n]; } }
    __syncthreads();
    { const int kp = tid & 31, nn = tid >> 5;
#pragma unroll
      for (int i = 0; i < 4; ++i) { const int n = nn + 16 * i; const unsigned v = pk2(scr[(2 * kp) * 65 + n], scr[(2 * kp + 1) * 65 + n]); *(unsigned*)(Wt + (size_t)(n0 + n) * K + k0 + 2 * kp) = v; } }
    __syncthreads();
}
__device__ __forceinline__ void mod_unit(const Frame& F, int unit, float* scr) {
    const int l = unit / 96, cc = unit - l * 96; const int tid = F.tid;
    float* sl = scr; float* red = scr + 5 * 1024;
    for (int i = tid; i < 5 * 1024; i += NTHREADS) { const int r = i >> 10, k = i & 1023; const float c = r < 4 ? F.A.in[1][r * 1024 + k] : F.A.in[3][k]; sl[i] = c * sigmoidf_(c); }
    __syncthreads();
    const int col = tid & 63, kg = tid >> 6;
    const float* w = F.A.in[4] + (size_t)l * DM * 6144 + cc * 64 + col;
    float a0 = 0.f, a1 = 0.f, a2 = 0.f, a3 = 0.f, a4 = 0.f;
    for (int k = kg * 128; k < kg * 128 + 128; ++k) { const float wv = w[(size_t)k * 6144]; a0 += sl[k] * wv; a1 += sl[1024 + k] * wv; a2 += sl[2048 + k] * wv; a3 += sl[3072 + k] * wv; a4 += sl[4096 + k] * wv; }
    red[(kg * 5 + 0) * 64 + col] = a0; red[(kg * 5 + 1) * 64 + col] = a1; red[(kg * 5 + 2) * 64 + col] = a2; red[(kg * 5 + 3) * 64 + col] = a3; red[(kg * 5 + 4) * 64 + col] = a4;
    __syncthreads();
    if (tid < 320) { const int r = tid >> 6, c2 = tid & 63; float s = 0.f;
#pragma unroll
        for (int g = 0; g < 8; ++g) s += red[(g * 5 + r) * 64 + c2];
        FP(WS_MOD, float)[(l * 5 + r) * 6144 + cc * 64 + c2] = s + F.A.in[5][l * 6144 + cc * 64 + c2]; }
    __syncthreads();
}
__device__ __forceinline__ void p0_prologue(const Frame& F, float* scr) {
    const int NT_L = 448 + 16 + 16 + 32 + 256 + 1024 + 1024;
    const int njobs = 193 + 2 * NT_L + PK_N;
    for (int job = blockIdx.x; job < njobs; job += gridDim.x) {
        if (job >= 193 + 2 * NT_L) {
            const int e = job - (193 + 2 * NT_L); const float* src = nullptr; int cnt = 0, off = 0;
#define PKC(i) if (e == i) { src = F.A.in[PK_IDX[i]]; cnt = PK_CNT[i]; off = pk_off(PK_IDX[i]); }
            PKC(0) PKC(1) PKC(2) PKC(3) PKC(4) PKC(5) PKC(6) PKC(7) PKC(8) PKC(9) PKC(10) PKC(11) PKC(12) PKC(13) PKC(14) PKC(15) PKC(16) PKC(17) PKC(18) PKC(19) PKC(20) PKC(21) PKC(22)
#undef PKC
            float* dst = FP(WS_PACK, float) + off;
            for (int i = F.tid; i < cnt; i += NTHREADS) dst[i] = src[i];
        }
        else if (job < 192) { mod_unit(F, job, scr); }
        else if (job == 192) {
            for (int i = F.tid; i < 4096; i += NTHREADS) { const int m = i >> 6, j = i & 63; const float x = (float)((m * j) & 63) * (1.0f / 32.0f);
                FP(WS_CTAB, bf16_t)[i] = (bf16_t)f2bf(cospif(x)); FP(WS_STAB, bf16_t)[i] = (bf16_t)f2bf(sinpif(x)); }
        } else {
            int t = job - 193; const int l = t / NT_L; t -= l * NT_L;
            unsigned char* wl = F.ws + WS_W + (size_t)l * W_LAYER;
            if (t < 448) transpose_tile(F.A.in[7] + (size_t)l * DM * INC, DM, INC, (bf16_t*)(wl + W_IN), t, scr, F.tid);
            else if ((t -= 448) < 16) transpose_tile(F.A.in[12] + (size_t)l * 65536, 256, 256, (bf16_t*)(wl + W_PW), t, scr, F.tid);
            else if ((t -= 16) < 16) transpose_tile(F.A.in[14] + (size_t)l * 65536, 256, 256, (bf16_t*)(wl + W_F), t, scr, F.tid);
            else if ((t -= 16) < 32) transpose_tile(F.A.in[25] + (size_t)l * 131072, 256, 512, (bf16_t*)(wl + W_GLU), t, scr, F.tid);
            else if ((t -= 32) < 256) transpose_tile(F.A.in[28] + (size_t)l * DM * DM, DM, DM, (bf16_t*)(wl + W_OUT), t, scr, F.tid);
            else if ((t -= 256) < 1024) transpose_tile(F.A.in[31] + (size_t)l * DM * FFD, DM, FFD, (bf16_t*)(wl + W_1), t, scr, F.tid);
            else { t -= 1024; transpose_tile(F.A.in[33] + (size_t)l * DM * FFD, FFD, DM, (bf16_t*)(wl + W_2), t, scr, F.tid); }
        }
    }
}

__device__ __forceinline__ void prep_norm_mod(const Frame& F, const float* srcC, const float* srcL, const float* g, const float* modl, int sh_off, int sc_off, bf16_t* XN, int row_lo) {
    const int gw = blockIdx.x * 8 + F.wave, nw = gridDim.x * 8, lane = F.lane;
    for (int row = row_lo + gw; row < T_ALL; row += nw) {
        const bool isc = row < NCTX; const float* x = isc ? srcC + (size_t)row * DM : srcL + (size_t)(row - NCTX) * DM; const int br = isc ? 4 : ((row - NCTX) >> 12);
        const float* sh = modl + br * 6144 + sh_off; const float* sc = modl + br * 6144 + sc_off;
        f32x4 v[4]; float ss = 0.f;
#pragma unroll
        for (int i = 0; i < 4; ++i) { v[i] = *(const f32x4*)(x + i * 256 + lane * 4); ss += v[i][0] * v[i][0] + v[i][1] * v[i][1] + v[i][2] * v[i][2] + v[i][3] * v[i][3]; }
        ss = wave_sum(ss); const float r = rsqrtf(ss * (1.0f / 1024.0f) + EPS);
#pragma unroll
        for (int i = 0; i < 4; ++i) { const int c = i * 256 + lane * 4; const f32x4 gv = *(const f32x4*)(g + c), shv = *(const f32x4*)(sh + c), scv = *(const f32x4*)(sc + c);
            f32x4 y = v[i] * r * gv; y = y * (scv + 1.0f) + shv; u32x2 w; w.x = pk2(y[0], y[1]); w.y = pk2(y[2], y[3]); *(u32x2*)(XN + (size_t)row * DM + c) = w; }
    }
}
__device__ __forceinline__ f32x4 ld_bf4(const bf16_t* p) { const u32x2 w = *(const u32x2*)p; return f32x4{bflo(w.x), bfhi(w.x), bflo(w.y), bfhi(w.y)}; }
__device__ __forceinline__ void prep_group(const Frame& F, int l, int row_lo) {
    const int gw = blockIdx.x * 8 + F.wave, nw = gridDim.x * 8, lane = F.lane;
    const bf16_t* MIX = FP(WS_MIX, bf16_t); const bf16_t* ZS = FP(WS_ZS, bf16_t); bf16_t* O = FP(WS_XN, bf16_t); const float* gg = PK(27) + l * DM;
    for (int row = row_lo + gw; row < T_ALL; row += nw) {
#pragma unroll
        for (int grp = 0; grp < 4; ++grp) {
            f32x4 v;
            if (grp < 3) v = ld_bf4(MIX + (size_t)row * 768 + grp * 256 + lane * 4);
            else { const f32x4 a = ld_bf4(ZS + (size_t)row * 512 + lane * 4), gt = ld_bf4(ZS + (size_t)row * 512 + 256 + lane * 4);
#pragma unroll
                for (int j = 0; j < 4; ++j) v[j] = a[j] * sigmoidf_(gt[j]); }
            float ss = v[0] * v[0] + v[1] * v[1] + v[2] * v[2] + v[3] * v[3]; ss = wave_sum(ss);
            const float r = rsqrtf(ss * (1.0f / 256.0f) + EPS); const f32x4 gv = *(const f32x4*)(gg + grp * 256 + lane * 4); const f32x4 y = v * r * gv;
            u32x2 w; w.x = pk2(y[0], y[1]); w.y = pk2(y[2], y[3]); *(u32x2*)(O + (size_t)row * DM + grp * 256 + lane * 4) = w;
        }
    }
}
__device__ __forceinline__ void final_norm(const Frame& F) {
    const int gw = blockIdx.x * 8 + F.wave, nw = gridDim.x * 8, lane = F.lane; const float* g = PK(35);
    for (int row = gw; row < NLAT; row += nw) {
        float* x = F.out + (size_t)row * DM; f32x4 v[4]; float ss = 0.f;
#pragma unroll
        for (int i = 0; i < 4; ++i) { v[i] = *(const f32x4*)(x + i * 256 + lane * 4); ss += v[i][0] * v[i][0] + v[i][1] * v[i][1] + v[i][2] * v[i][2] + v[i][3] * v[i][3]; }
        ss = wave_sum(ss); const float r = rsqrtf(ss * (1.0f / 1024.0f) + EPS);
#pragma unroll
        for (int i = 0; i < 4; ++i) { const int c = i * 256 + lane * 4; *(f32x4*)(x + c) = v[i] * r * *(const f32x4*)(g + c); }
    }
}

__device__ __forceinline__ void conv_unit(const Frame& F, int l, int unit, float* scr) {
    const bf16_t* PX = FP(WS_PX, bf16_t); bf16_t* CV = FP(WS_CV, bf16_t);
    int prow0, Lseq, t0;
    if (unit < 512) { const int b = unit >> 7; t0 = (unit & 127) * 32; prow0 = NCTX + b * 4096; Lseq = 4096; }
    else { const int uu = unit - 512; const int b = uu >> 3; t0 = (uu & 7) * 32; prow0 = b * 256; Lseq = 256; }
    float* vt = scr; float* ot = scr + 62 * 256; int tid = F.tid; asm volatile("" : "+v"(tid));
    for (int idx = tid; idx < 62 * 256; idx += NTHREADS) { const int rr = idx >> 8, c = idx & 255; const int t = t0 - 15 + rr; float v = 0.f;
        if (t >= 0 && t < Lseq) { const bf16_t* p = PX + (size_t)(prow0 + t) * INC; const float a = bf2f(p[c]), gt = bf2f(p[256 + c]); v = a * sigmoidf_(gt); }
        vt[idx] = v; }
    __syncthreads();
    { const int c = tid & 255, half = tid >> 8; float w[31];
#pragma unroll
      for (int j = 0; j < 31; ++j) w[j] = PK(8)[(l * 31 + j) * 256 + c];
      const float bd = PK(9)[l * 256 + c];
      for (int tt = 0; tt < 16; ++tt) { const int t = half * 16 + tt; float s = bd;
#pragma unroll
          for (int j = 0; j < 31; ++j) s += w[j] * vt[(t + j) * 256 + c];
          ot[t * 256 + c] = s; } }
    __syncthreads();
    { const int lane = tid & 63; const f32x4 lg = *(const f32x4*)(PK(10) + l * 256 + lane * 4), lb = *(const f32x4*)(PK(11) + l * 256 + lane * 4);
      for (int i = 0; i < 4; ++i) { const int t = F.wave * 4 + i; const f32x4 x = *(const f32x4*)(ot + t * 256 + lane * 4);
          const float mu = wave_sum(x[0] + x[1] + x[2] + x[3]) * (1.0f / 256.0f); const f32x4 d = x - mu;
          const float var = wave_sum(d[0] * d[0] + d[1] * d[1] + d[2] * d[2] + d[3] * d[3]) * (1.0f / 256.0f); const float r = rsqrtf(var + EPS);
          f32x4 y = d * r * lg + lb;
#pragma unroll
          for (int j = 0; j < 4; ++j) y[j] = y[j] * sigmoidf_(y[j]);
          u32x2 w; w.x = pk2(y[0], y[1]); w.y = pk2(y[2], y[3]); *(u32x2*)(CV + (size_t)(prow0 + t0 + t) * 256 + lane * 4) = w; } }
    __syncthreads();
}

__device__ __forceinline__ void fnetctx_unit(const Frame& F, int unit, float* scr) {
    const bf16_t* PX = FP(WS_PX, bf16_t); bf16_t* FN = FP(WS_FN, bf16_t);
    const int mh = unit & 1, kh = (unit >> 1) & 3, h = (unit >> 3) & 3, b = unit >> 5; int tid = F.tid; asm volatile("" : "+v"(tid));
    float* zc = scr; float* zs = scr + 8192; float* c64 = scr + 16384; float* s64 = c64 + 64; float* c256 = s64 + 64; float* s256 = c256 + 256;
    if (tid < 64) { const float x = (float)tid * (1.0f / 32.0f); c64[tid] = cospif(x); s64[tid] = sinpif(x); }
    if (tid < 256) { const float x = (float)tid * (1.0f / 128.0f); c256[tid] = cospif(x); s256[tid] = sinpif(x); }
    __syncthreads();
    for (int idx = tid; idx < 8192; idx += NTHREADS) { const int n = idx >> 5, mm = idx & 31, m = mh * 32 + mm; const bf16_t* up = PX + (size_t)(b * 256 + n) * INC + 512 + h * 64;
        float ac = 0.f, as = 0.f;
        for (int j = 0; j < 64; ++j) { const float uv = bf2f(up[j]); const int a = (j * m) & 63; ac += uv * c64[a]; as += uv * s64[a]; }
        zc[idx] = ac; zs[idx] = as; }
    __syncthreads();
    for (int idx = tid; idx < 2048; idx += NTHREADS) { const int k = kh * 64 + (idx >> 5), mm = idx & 31; float acc = 0.f;
        for (int n = 0; n < 256; ++n) { const int a = (k * n) & 255; acc += c256[a] * zc[n * 32 + mm] - s256[a] * zs[n * 32 + mm]; }
        FN[(size_t)(b * 256 + k) * 256 + h * 64 + mh * 32 + mm] = (bf16_t)f2bf(acc * (1.0f / 128.0f)); }
    __syncthreads();
}
__device__ __forceinline__ void fnetA_unit(const Frame& F, int unit, unsigned char* lds) {
    const bf16_t* PX = FP(WS_PX, bf16_t); const bf16_t* Ct = FP(WS_CTAB, bf16_t); const bf16_t* St = FP(WS_STAB, bf16_t); bf16_t* YB = FP(WS_YB, bf16_t);
    const int oct = unit & 7, h = (unit >> 3) & 3, b = unit >> 5; int tid = F.tid; asm volatile("" : "+v"(tid)); const int lane = tid & 63, fr = lane & 15, fq = lane >> 4; const int n2 = oct * 8 + F.wave;
    bf16x8 ua[4][2];
#pragma unroll
    for (int mi = 0; mi < 4; ++mi)
#pragma unroll
        for (int kk = 0; kk < 2; ++kk) ua[mi][kk] = *(const bf16x8*)(PX + (size_t)(NCTX + b * 4096 + 64 * (16 * mi + fr) + n2) * INC + 512 + h * 64 + kk * 32 + fq * 8);
    bf16x8 zre[2][4], zs[2][4];
#pragma unroll
    for (int ni = 0; ni < 4; ++ni) {
        bf16x8 bc[2], bs[2];
#pragma unroll
        for (int kk = 0; kk < 2; ++kk) { bc[kk] = *(const bf16x8*)(Ct + (16 * ni + fr) * 64 + kk * 32 + fq * 8); bs[kk] = *(const bf16x8*)(St + (16 * ni + fr) * 64 + kk * 32 + fq * 8); }
#pragma unroll
        for (int pr = 0; pr < 2; ++pr) {
            f32x4 c0 = {0.f, 0.f, 0.f, 0.f}, c1 = c0, s0 = c0, s1 = c0;
#pragma unroll
            for (int kk = 0; kk < 2; ++kk) { c0 = mfma16(ua[2 * pr][kk], bc[kk], c0); c1 = mfma16(ua[2 * pr + 1][kk], bc[kk], c1); s0 = mfma16(ua[2 * pr][kk], bs[kk], s0); s1 = mfma16(ua[2 * pr + 1][kk], bs[kk], s1); }
            zre[pr][ni] = pack8(c0, c1); zs[pr][ni] = pack8(s0, s1);
        }
    }
    bf16_t* T = (bf16_t*)lds;
    for (int mi2 = 0; mi2 < 4; ++mi2) {
        bf16x8 cf[2], sf[2], sfn[2];
#pragma unroll
        for (int pr = 0; pr < 2; ++pr) {
            const bf16_t* cp = Ct + (16 * mi2 + fr) * 64 + 32 * pr + 4 * fq; const bf16_t* sp = St + (16 * mi2 + fr) * 64 + 32 * pr + 4 * fq;
            cf[pr] = cat4(*(const u32x2*)cp, *(const u32x2*)(cp + 16)); sf[pr] = cat4(*(const u32x2*)sp, *(const u32x2*)(sp + 16)); sfn[pr] = neg8(sf[pr]);
        }
        float cs[4], sn[4];
#pragma unroll
        for (int j = 0; j < 4; ++j) { const int k1 = 16 * mi2 + 4 * fq + j; const float x = (float)(n2 * k1) * (1.0f / 2048.0f); cs[j] = cospif(x); sn[j] = sinpif(x); }
#pragma unroll
        for (int ni = 0; ni < 4; ++ni) {
            f32x4 yre = {0.f, 0.f, 0.f, 0.f}, yin = yre;
#pragma unroll
            for (int pr = 0; pr < 2; ++pr) { yre = mfma16s(cf[pr], zre[pr][ni], yre); yre = mfma16s(sfn[pr], zs[pr][ni], yre); yin = mfma16s(cf[pr], zs[pr][ni], yin); yin = mfma16s(sf[pr], zre[pr][ni], yin); }
#pragma unroll
            for (int j = 0; j < 4; ++j) { const int k1 = 16 * mi2 + 4 * fq + j; const int m = 16 * ni + fr;
                const float y1 = yre[j] * cs[j] - yin[j] * sn[j], y2 = yin[j] * cs[j] + yre[j] * sn[j];
                T[((0 * 64 + k1) * 64 + m) * 8 + F.wave] = (bf16_t)f2bf(y1); T[((1 * 64 + k1) * 64 + m) * 8 + F.wave] = (bf16_t)f2bf(y2); }
        }
    }
    __syncthreads();
    for (int it = 0; it < 16; ++it) { const int cidx = it * NTHREADS + tid; const int m = cidx & 63, k1 = (cidx >> 6) & 63, plane = cidx >> 12;
        const u32x4 v = *(const u32x4*)(lds + (size_t)cidx * 16);
        *(u32x4*)(YB + ((((size_t)(b * 4 + h) * 64 + k1) * 2 + plane) * 64 + m) * 64 + oct * 8) = v; }
    __syncthreads();
}
__device__ __forceinline__ void fnetB_item(const Frame& F, int item) {
    const bf16_t* Ct = FP(WS_CTAB, bf16_t); const bf16_t* St = FP(WS_STAB, bf16_t); const bf16_t* YB = FP(WS_YB, bf16_t); bf16_t* FN = FP(WS_FN, bf16_t);
    const int k1 = item & 63, h = (item >> 6) & 3, b = item >> 8; int lane = F.lane; asm volatile("" : "+v"(lane)); const int fr = lane & 15, fq = lane >> 4;
    const bf16_t* base = YB + (((size_t)(b * 4 + h) * 64 + k1) * 2) * 4096;
    f32x4 acc[4][4];
#pragma unroll
    for (int mi = 0; mi < 4; ++mi)
#pragma unroll
        for (int ni = 0; ni < 4; ++ni) acc[mi][ni] = f32x4{0.f, 0.f, 0.f, 0.f};
#pragma unroll
    for (int kk = 0; kk < 2; ++kk) {
        bf16x8 bc[4], bsn[4];
#pragma unroll
        for (int ni = 0; ni < 4; ++ni) { bc[ni] = *(const bf16x8*)(Ct + (16 * ni + fr) * 64 + kk * 32 + fq * 8); bsn[ni] = neg8(*(const bf16x8*)(St + (16 * ni + fr) * 64 + kk * 32 + fq * 8)); }
#pragma unroll
        for (int mi = 0; mi < 4; ++mi) {
            const bf16x8 are = *(const bf16x8*)(base + (16 * mi + fr) * 64 + kk * 32 + fq * 8), aim = *(const bf16x8*)(base + 4096 + (16 * mi + fr) * 64 + kk * 32 + fq * 8);
#pragma unroll
            for (int ni = 0; ni < 4; ++ni) { acc[mi][ni] = mfma16(are, bc[ni], acc[mi][ni]); acc[mi][ni] = mfma16s(aim, bsn[ni], acc[mi][ni]); }
        }
    }
#pragma unroll
    for (int mi = 0; mi < 4; ++mi)
#pragma unroll
        for (int ni = 0; ni < 4; ++ni) { const int k = k1 + 64 * (16 * ni + fr); const f32x4 v = acc[mi][ni] * (1.0f / 512.0f);
            u32x2 w; w.x = pk2(v[0], v[1]); w.y = pk2(v[2], v[3]); *(u32x2*)(FN + (size_t)(NCTX + b * 4096 + k) * 256 + h * 64 + 16 * mi + 4 * fq) = w; }
}

template <bool LOCAL>
__device__ __forceinline__ void attn_item(const Frame& F, int l, int item) {
    const bf16_t* PX = FP(WS_PX, bf16_t); const bf16_t* VT = FP(WS_VT, bf16_t); const bf16_t* VTc = FP(WS_VTC, bf16_t); bf16_t* MIX = FP(WS_MIX, bf16_t);
    const float* rpb = PK(16) + l * (4 * 15 * 31);
    int lane = F.lane; asm volatile("" : "+v"(lane)); const int fr = lane & 15, fq = lane >> 4;
    int b, h, r = 0, jb = 0, qrow0;
    if (LOCAL) { h = item & 3; jb = (item >> 2) & 3; r = (item >> 4) & 63; b = item >> 10; qrow0 = NCTX + b * 4096 + r * 64 + jb * 16; }
    else { h = item & 3; const int qb = (item >> 2) & 15; b = item >> 6; qrow0 = b * 256 + qb * 16; }
    constexpr int NT = LOCAL ? 32 : 16;
    const int rs = LOCAL ? min(max(r - 4, 0), 56) : 0; const int kcs = LOCAL ? min(max(16 * jb - 8, 0), 32) : 0;
    bf16x8 qf[2];
#pragma unroll
    for (int kk = 0; kk < 2; ++kk) qf[kk] = *(const bf16x8*)(PX + (size_t)(qrow0 + fr) * INC + 768 + h * 64 + kk * 32 + fq * 8);
    f32x4 s[NT];
#pragma unroll
    for (int t = 0; t < NT; ++t) {
        int krow;
        if (LOCAL && t < 16) krow = NCTX + b * 4096 + (rs + (t >> 1)) * 64 + kcs + (t & 1) * 16 + fr;
        else krow = b * 256 + (t - (LOCAL ? 16 : 0)) * 16 + fr;
        const bf16_t* kp = PX + (size_t)krow * INC + 1024 + h * 64 + fq * 8;
        const bf16x8 k0 = *(const bf16x8*)kp, k1 = *(const bf16x8*)(kp + 32);
        f32x4 a = {0.f, 0.f, 0.f, 0.f}; a = mfma16(k0, qf[0], a); a = mfma16(k1, qf[1], a); s[t] = a;
    }
    float mx = -3.0e38f;
    const int qcol = 16 * jb + fr; const int cstart = min(max(qcol - 8, 0), 48);
#pragma unroll
    for (int t = 0; t < NT; ++t)
#pragma unroll
        for (int j = 0; j < 4; ++j) {
            float v = s[t][j] * 0.125f;
            if (LOCAL && t < 16) { const int kcol = kcs + (t & 1) * 16 + 4 * fq + j; const bool valid = (kcol >= cstart) && (kcol < cstart + 16);
                const int dr = rs + (t >> 1) - r + 7; const int dc = min(max(kcol - qcol + 15, 0), 30);
                v = valid ? v + rpb[(h * 15 + dr) * 31 + dc] : -1.0e30f; }
            s[t][j] = v; mx = fmaxf(mx, v);
        }
    mx = fmaxf(mx, __shfl_xor(mx, 16)); mx = fmaxf(mx, __shfl_xor(mx, 32));
    float sum = 0.f;
#pragma unroll
    for (int t = 0; t < NT; ++t)
#pragma unroll
        for (int j = 0; j < 4; ++j) { const float p = __expf(s[t][j] - mx); s[t][j] = p; sum += p; }
    sum += __shfl_xor(sum, 16); sum += __shfl_xor(sum, 32);
    f32x4 o[4];
#pragma unroll
    for (int di = 0; di < 4; ++di) o[di] = f32x4{0.f, 0.f, 0.f, 0.f};
#pragma unroll
    for (int u = 0; u < NT / 2; ++u) {
        const bf16x8 pb = pack8(s[2 * u], s[2 * u + 1]);
        const bf16_t* vbase; size_t stride;
        if (LOCAL && u < 8) { vbase = VT + (size_t)(b * 256 + h * 64) * 4096 + (rs + u) * 64 + kcs + 4 * fq; stride = 4096; }
        else { const int uu = u - (LOCAL ? 8 : 0); vbase = VTc + (size_t)(b * 256 + h * 64) * 256 + uu * 32 + 4 * fq; stride = 256; }
#pragma unroll
        for (int di = 0; di < 4; ++di) { const bf16_t* vp = vbase + (size_t)(16 * di + fr) * stride; const bf16x8 va = cat4(*(const u32x2*)vp, *(const u32x2*)(vp + 16)); o[di] = mfma16s(va, pb, o[di]); }
    }
    const float inv = 1.0f / sum;
#pragma unroll
    for (int di = 0; di < 4; ++di) { const f32x4 v = o[di] * inv; u32x2 w; w.x = pk2(v[0], v[1]); w.y = pk2(v[2], v[3]);
        *(u32x2*)(MIX + (size_t)(qrow0 + fr) * 768 + 512 + h * 64 + 16 * di + 4 * fq) = w; }
}

__device__ __forceinline__ cplx csel(bool c, cplx a, cplx b) { return cplx{c ? a.re : b.re, c ? a.im : b.im}; }
#define WAITALL() asm volatile("s_waitcnt vmcnt(0) lgkmcnt(0)" ::: "memory")
__device__ __forceinline__ cplx pow_sel(int k, cplx a, cplx a2, cplx a4, cplx a8, cplx a16) {
    cplx r = cplx{1.f, 0.f};
    r = csel((k & 1) != 0, cmul(r, a), r); r = csel((k & 2) != 0, cmul(r, a2), r); r = csel((k & 4) != 0, cmul(r, a4), r); r = csel((k & 8) != 0, cmul(r, a8), r); r = csel((k & 16) != 0, cmul(r, a16), r);
    return r;
}
__device__ __forceinline__ void ssm_consts(float lre, float lim, float dt, cplx& a, cplx& f) {
    const float e = __expf(lre * dt);
    float revs = lim * dt * 0.15915494309189535f; revs -= rintf(revs);
    a = cplx{e * __builtin_amdgcn_cosf(revs), e * __builtin_amdgcn_sinf(revs)};
    const float xr = a.re - 1.0f, xi = a.im, den = __builtin_amdgcn_rcpf(lre * lre + lim * lim);
    f = cplx{(xr * lre + xi * lim) * den, (xi * lre - xr * lim) * den};
}
template <int PASS, int DIR>
__device__ __forceinline__ void ssm_dir(const Frame& F, int lane, int l, int b, int g, int tb, const bf16x8 (&ub)[4], f32x4 (&accy)[4]) {
    const int fr = lane & 15, fq = lane >> 4;
    const int c = DIR == 0 ? tb : (tb < 4 ? 3 - tb : 71 - tb);
    const int pg = (l * 2 + DIR) * 16 + g;
    const float dt = __expf(PK(19)[pg]);
    cplx* Sloc = FP(WS_SLOC, cplx); const cplx* Carry = FP(WS_CARRY, cplx);
    const size_t sbase = ((size_t)((b * 2 + DIR) * 16 + g) * 68 + c) * 64;
    for (int q = 0; q < 4; ++q) {
        bf16x8 are, aim;
        { const int kq = (fq & 1) * 8; const float* pr = PK(20) + ((size_t)pg * 64 + 16 * q + fr) * 16 + kq; const float* pi = PK(21) + ((size_t)pg * 64 + 16 * q + fr) * 16 + kq;
          const f32x4 zz = f32x4{0.f, 0.f, 0.f, 0.f}; const bool on = fq < 2;
          const f32x4 r0 = *(const f32x4*)pr, r1 = *(const f32x4*)(pr + 4), i0 = *(const f32x4*)pi, i1 = *(const f32x4*)(pi + 4);

          are = pack8(on ? r0 : zz, on ? r1 : zz); aim = pack8(on ? i0 : zz, on ? i1 : zz); }
        f32x4 bre[4], bim[4];
        asm volatile("s_nop 7" : "+v"(are), "+v"(aim));
#pragma unroll
        for (int ni = 0; ni < 4; ++ni) { bre[ni] = mfma16(are, ub[ni], f32x4{0.f, 0.f, 0.f, 0.f}); bim[ni] = mfma16(aim, ub[ni], f32x4{0.f, 0.f, 0.f, 0.f}); }
        settle4m(bre[0], bre[1], bre[2], bre[3]); settle4m(bim[0], bim[1], bim[2], bim[3]);
#pragma unroll
        for (int j = 0; j < 4; ++j) {
            const int p = 16 * q + 4 * fq + j;
            const float lre = PK(17)[pg * 64 + p], lim = PK(18)[pg * 64 + p];

            cplx a, f; ssm_consts(lre, lim, dt, a, f);
            const cplx a2 = cmul(a, a), a4 = cmul(a2, a2), a8 = cmul(a4, a4), a16 = cmul(a8, a8);
            if (PASS == 1) {
                cplx Tt;
                if (DIR == 0) { Tt = cplx{bre[0][j], bim[0][j]}; Tt = cmad(cplx{bre[1][j], bim[1][j]}, Tt, a16); Tt = cmad(cplx{bre[2][j], bim[2][j]}, Tt, a16); Tt = cmad(cplx{bre[3][j], bim[3][j]}, Tt, a16); }
                else { Tt = cplx{bre[3][j], bim[3][j]}; Tt = cmad(cplx{bre[2][j], bim[2][j]}, Tt, a16); Tt = cmad(cplx{bre[1][j], bim[1][j]}, Tt, a16); Tt = cmad(cplx{bre[0][j], bim[0][j]}, Tt, a16); }
                const cplx w = pow_sel(DIR == 0 ? 15 - fr : fr, a, a2, a4, a8, a16);
                Tt = cmul(Tt, w);
                Tt.re += __shfl_xor(Tt.re, 1); Tt.im += __shfl_xor(Tt.im, 1); Tt.re += __shfl_xor(Tt.re, 2); Tt.im += __shfl_xor(Tt.im, 2);
                Tt.re += __shfl_xor(Tt.re, 4); Tt.im += __shfl_xor(Tt.im, 4); Tt.re += __shfl_xor(Tt.re, 8); Tt.im += __shfl_xor(Tt.im, 8);
                Tt = cmul(Tt, f);
                if (fr == 0) Sloc[sbase + p] = Tt;
            } else {
                const cplx w = pow_sel(DIR == 0 ? fr + 1 : 16 - fr, a, a2, a4, a8, a16);
                cplx x[4];
#pragma unroll
                for (int ni = 0; ni < 4; ++ni) {
                    cplx v = cmul(f, cplx{bre[ni][j], bim[ni][j]});
#define RLF(x, ln) __builtin_bit_cast(float, __builtin_amdgcn_readlane(__builtin_bit_cast(int, (x)), (ln)))
#define DPPF(x, ctrl) __builtin_bit_cast(float, __builtin_amdgcn_update_dpp(0, __builtin_bit_cast(int, (x)), (ctrl), 0xf, 0xf, true))
#define KS_STEP(d, ad) { cplx y; if (DIR == 0) { y.re = DPPF(v.re, 0x110 + d); y.im = DPPF(v.im, 0x110 + d); v = csel(fr >= d, cmad(v, ad, y), v); } \
                                   else { y.re = DPPF(v.re, 0x100 + d); y.im = DPPF(v.im, 0x100 + d); v = csel(fr + d <= 15, cmad(v, ad, y), v); } }
                    KS_STEP(1, a) KS_STEP(2, a2) KS_STEP(4, a4) KS_STEP(8, a8)
#undef KS_STEP
                    x[ni] = v;
                }
                cplx E = Carry[sbase + p];
#pragma unroll
                for (int bi = 0; bi < 4; ++bi) {
                    const int ni = DIR == 0 ? bi : 3 - bi;
                    const cplx hh = cmad(x[ni], w, E);
                    cplx tot;
                    { constexpr int L0 = DIR == 0 ? 15 : 0;
                      const float r0 = RLF(x[ni].re, L0), r1 = RLF(x[ni].re, L0 + 16), r2 = RLF(x[ni].re, L0 + 32), r3 = RLF(x[ni].re, L0 + 48);
                      const float i0 = RLF(x[ni].im, L0), i1 = RLF(x[ni].im, L0 + 16), i2 = RLF(x[ni].im, L0 + 32), i3 = RLF(x[ni].im, L0 + 48);
                      tot.re = fq == 0 ? r0 : fq == 1 ? r1 : fq == 2 ? r2 : r3; tot.im = fq == 0 ? i0 : fq == 1 ? i1 : fq == 2 ? i2 : i3; }
                    E = cmad(tot, a16, E);
                    bre[ni][j] = hh.re; bim[ni][j] = hh.im;
                }
            }
        }
        if (PASS == 3) {
            const float* cr = PK(22) + ((size_t)pg * 16 + fr) * 64 + 16 * q + 4 * fq; const float* ci = PK(23) + ((size_t)pg * 16 + fr) * 64 + 16 * q + 4 * fq;
            const f32x4 cre = *(const f32x4*)cr; const f32x4 cim = *(const f32x4*)ci;
            const bf16x8 ca = pack8(cre, f32x4{-cim[0], -cim[1], -cim[2], -cim[3]});
#pragma unroll
            for (int ni = 0; ni < 4; ++ni) { bf16x8 hb = pack8(bre[ni], bim[ni]); bf16x8 ca2 = ca; asm volatile("s_nop 7" : "+v"(ca2), "+v"(hb)); accy[ni] = mfma16(ca2, hb, accy[ni]); }
            settle4m(accy[0], accy[1], accy[2], accy[3]);
        }
    }
}
template <int PASS>
__device__ __forceinline__ void ssm_item(const Frame& F, int l_u, int item_u) {
    int l = l_u, item = item_u; asm volatile("" : "+v"(l), "+v"(item));
    const bf16_t* PX = FP(WS_PX, bf16_t);
    int lane = F.lane; asm volatile("" : "+v"(lane)); const int fr = lane & 15, fq = lane >> 4;
    const int tb = item % 68; const int g = (item / 68) & 15; const int b = item / (68 * 16);
    const int prow0 = tb < 4 ? b * 256 + tb * 64 : NCTX + b * 4096 + (tb - 4) * 64;
    bf16x8 ub[4];
#pragma unroll
    for (int ni = 0; ni < 4; ++ni) { const bf16x8 ld = *(const bf16x8*)(PX + (size_t)(prow0 + 16 * ni + fr) * INC + 1536 + g * 16 + (fq & 1) * 8); ub[ni] = fq < 2 ? ld : zero8(); }
    f32x4 accy[4];
#pragma unroll
    for (int ni = 0; ni < 4; ++ni) accy[ni] = f32x4{0.f, 0.f, 0.f, 0.f};

    ssm_dir<PASS, 0>(F, lane, l, b, g, tb, ub, accy);
    ssm_dir<PASS, 1>(F, lane, l, b, g, tb, ub, accy);
    if (PASS == 3) {
        bf16_t* YS = FP(WS_YS, bf16_t); const f32x4 dv = *(const f32x4*)(PK(24) + l * 256 + g * 16 + 4 * fq);
#pragma unroll
        for (int ni = 0; ni < 4; ++ni) { const int row = prow0 + 16 * ni + fr; const f32x4 uv = ld_bf4(PX + (size_t)row * INC + 1536 + g * 16 + 4 * fq);
            const f32x4 y = accy[ni] + dv * uv; u32x2 w; w.x = pk2(y[0], y[1]); w.y = pk2(y[2], y[3]); *(u32x2*)(YS + (size_t)row * 256 + g * 16 + 4 * fq) = w; }
    }
}
__device__ __forceinline__ void ssm_pass2(const Frame& F, int l) {
    const int pb = (int)blockIdx.x - 112; if (pb < 0 || pb >= 16) return;
    const int idx = pb * NTHREADS + F.tid;
    const int p = idx & 63, g = (idx >> 6) & 15, dir = (idx >> 10) & 1, b = idx >> 11;
    const int pg = (l * 2 + dir) * 16 + g; const float dt = __expf(PK(19)[pg]);
    const float lre = PK(17)[pg * 64 + p], lim = PK(18)[pg * 64 + p];
    cplx a, f_unused; ssm_consts(lre, lim, dt, a, f_unused);
#pragma unroll
    for (int i = 0; i < 6; ++i) a = cmul(a, a);
    const cplx* Sloc = FP(WS_SLOC, cplx); cplx* Carry = FP(WS_CARRY, cplx);
    const size_t base = ((size_t)((b * 2 + dir) * 16 + g) * 68) * 64 + p;
    cplx E = cplx{0.f, 0.f};
    for (int c0 = 0; c0 < 68; c0 += 4) {
        const cplx s0 = Sloc[base + (size_t)(c0 + 0) * 64], s1 = Sloc[base + (size_t)(c0 + 1) * 64], s2 = Sloc[base + (size_t)(c0 + 2) * 64], s3 = Sloc[base + (size_t)(c0 + 3) * 64];
        Carry[base + (size_t)(c0 + 0) * 64] = E; E = cmad(s0, a, E);
        Carry[base + (size_t)(c0 + 1) * 64] = E; E = cmad(s1, a, E);
        Carry[base + (size_t)(c0 + 2) * 64] = E; E = cmad(s2, a, E);
        Carry[base + (size_t)(c0 + 3) * 64] = E; E = cmad(s3, a, E);
    }
}


constexpr size_t WS_BAR = 512 * 1024;
#define XB_TMO      128
#define XB_XCNT(j)  (256  + 64 * (j))
#define XB_XSUB(j)  (1280 + 64 * (j))
#define XB_XGEN(j)  (2304 + 64 * (j))
#define XB_TOP      3328
#define XB_TOPGEN   3392
#define XCD_BAR_WORDS 3456
#define XB_SPIN_CAP (1u << 18)

__device__ __forceinline__ unsigned xb_ld(unsigned* p)              { return __hip_atomic_load(p, __ATOMIC_RELAXED, __HIP_MEMORY_SCOPE_AGENT); }
__device__ __forceinline__ unsigned xb_add(unsigned* p, unsigned v) { return __hip_atomic_fetch_add(p, v, __ATOMIC_RELAXED, __HIP_MEMORY_SCOPE_AGENT); }
__device__ __forceinline__ unsigned xb_xcc_id() { return (unsigned)__builtin_amdgcn_s_getreg((3 << 11) | 20) & 0xFu; }
#define XB_SPIN(cond, bar) do { unsigned _sp = 0; while (cond) { __builtin_amdgcn_s_sleep(1); \
    if ((++_sp & 255u) == 0u) { if (xb_ld(&(bar)[XB_TMO])) break; if (_sp > XB_SPIN_CAP) { atomicAdd(&(bar)[XB_TMO], 1u); break; } } } } while (0)

struct XcdBarrier {
    unsigned* bar; unsigned x;
    volatile LAS unsigned* st;
};

__device__ __forceinline__ XcdBarrier xcd_barrier_post(unsigned* bar, volatile LAS unsigned* st) {
    XcdBarrier b; b.bar = bar; b.x = xb_xcc_id(); b.st = st;
    if (threadIdx.x == 0) (void)xb_add(&bar[XB_XCNT(b.x)], 1u);
    return b;
}
__device__ __forceinline__ void xcd_barrier_complete(unsigned* bar, unsigned x, unsigned& nloc, unsigned& nx) {
    const unsigned G = gridDim.x * gridDim.y * gridDim.z;
    unsigned sum, cnt, mine, sp = 0u;
    for (;;) {
        sum = 0u; cnt = 0u; mine = 0u;
#pragma unroll
        for (unsigned j = 0; j < 16; ++j) { const unsigned c = xb_ld(&bar[XB_XCNT(j)]); sum += c; cnt += (c > 0u) ? 1u : 0u; mine = (j == x) ? c : mine; }
        if (sum == G) break;
        __builtin_amdgcn_s_sleep(1);
        if ((++sp & 255u) == 0u) { if (xb_ld(&bar[XB_TMO])) break; if (sp > XB_SPIN_CAP) { atomicAdd(&bar[XB_TMO], 1u); break; } }
    }
    nloc = mine > 0u ? mine : 1u; nx = cnt > 0u ? cnt : 1u;
}

__device__ __forceinline__ void xcd_barrier(const XcdBarrier& b) {
    asm volatile("s_waitcnt vmcnt(0)" ::: "memory");
    __syncthreads();
    if (threadIdx.x == 0) {
        unsigned* bar = b.bar;
        __builtin_amdgcn_s_waitcnt(0);
        unsigned nloc = b.st[0], nx = b.st[1];
        if (nloc == 0u) { xcd_barrier_complete(bar, b.x, nloc, nx); b.st[0] = nloc; b.st[1] = nx; }
        const unsigned old = xb_add(&bar[XB_XSUB(b.x)], 1u);
        const unsigned gen = old / nloc;
        if (old + 1u == (gen + 1u) * nloc) {
            __builtin_amdgcn_fence(__ATOMIC_RELEASE, "agent");
            asm volatile("s_waitcnt vmcnt(0)" ::: "memory");
            const unsigned og = xb_add(&bar[XB_TOP], 1u);
            const unsigned tg = og / nx;
            if (og + 1u == (tg + 1u) * nx) xb_add(&bar[XB_TOPGEN], 1u);
            else XB_SPIN(xb_ld(&bar[XB_TOPGEN]) == tg, bar);
            __builtin_amdgcn_fence(__ATOMIC_ACQUIRE, "agent");
            xb_add(&bar[XB_XGEN(b.x)], 1u);
            asm volatile("s_waitcnt vmcnt(0)" ::: "memory");
        } else {
            XB_SPIN(xb_ld(&bar[XB_XGEN(b.x)]) == gen, bar);
            __builtin_amdgcn_fence(__ATOMIC_ACQUIRE, "agent");
            asm volatile("s_waitcnt vmcnt(0)" ::: "memory");
        }
    }
    __syncthreads();
}
enum : unsigned { W_PREP1 = 1u << 0, W_GIN = 1u << 1, W_GVT = 1u << 2, W_FC = 1u << 3, W_FA = 1u << 4, W_CV = 1u << 5, W_ATT = 1u << 6, W_SSM1 = 1u << 7, W_GPW = 1u << 8,
                  W_P2 = 1u << 9, W_FB = 1u << 10, W_GFW = 1u << 11, W_SSM3 = 1u << 12, W_GGLU = 1u << 13, W_GN = 1u << 14, W_GOUT = 1u << 15, W_PREP3 = 1u << 16, W_GFF1 = 1u << 17, W_GFF2 = 1u << 18 };
#ifndef PH_FINE
#define PH_FINE 0
#endif
#if PH_FINE
constexpr int NSP = 18;
__host__ __device__ __forceinline__ unsigned phase_mask(int sp) {
    switch (sp) { case 0: return W_PREP1; case 1: return W_GIN; case 2: return W_GVT; case 3: return W_FC; case 4: return W_FA; case 5: return W_CV; case 6: return W_ATT; case 7: return W_SSM1;
                  case 8: return W_GPW; case 9: return W_P2 | W_FB; case 10: return W_GFW; case 11: return W_SSM3; case 12: return W_GGLU; case 13: return W_GN; case 14: return W_GOUT;
                  case 15: return W_PREP3; case 16: return W_GFF1; default: return W_GFF2; }
}
#else
constexpr int NSP = 11;
__host__ __device__ __forceinline__ unsigned phase_mask(int sp) {
    switch (sp) { case 0: return W_PREP1; case 1: return W_GIN | W_GVT; case 2: return W_FA | W_CV | W_ATT | W_SSM1; case 3: return W_GPW | W_P2 | W_FB | W_FC;
                  case 4: return W_GFW | W_SSM3; case 5: return W_GGLU; case 6: return W_GN; case 7: return W_GOUT; case 8: return W_PREP3; case 9: return W_GFF1; default: return W_GFF2; }
}
#endif
constexpr int NPH = 2 + 2 * NSP;
#ifndef ZP1
#define ZP1 12
#define ZP2 30
#endif
#define OPQ_S(x) asm volatile("" : "+s"(x))
#define GSYNC() xcd_barrier(xb)
__global__ void __launch_bounds__(NTHREADS, 2) fwd(Args args) {
    extern __shared__ __attribute__((aligned(16))) unsigned char lds[];

    cg::grid_group grid = cg::this_grid();
    const int tid_ = threadIdx.x;
    const int wave_ = __builtin_amdgcn_readfirstlane(tid_ >> 6);
    float* scr = (float*)lds;
    const int G = gridDim.x, bx = blockIdx.x;
    const int gw = bx * 8 + wave_, nw = G * 8;
    const int lo = args.ph_lo, hi = args.ph_hi;
    if (lo < 0) grid.sync();
    volatile LAS unsigned* xb_st = (volatile LAS unsigned*)((LAS unsigned char*)lds + (LDS_BYTES - 64));
    if (tid_ == 0) { xb_st[0] = 0u; xb_st[1] = 0u; }
    __syncthreads();
    const XcdBarrier xb = xcd_barrier_post((unsigned*)(args.ws + WS_BAR), xb_st);
    if (lo == 0) { const Frame F{args, args.out, args.ws, tid_, tid_ & 63, wave_}; p0_prologue(F, scr); if (hi > 1) GSYNC(); }
#pragma nounroll
    for (int ph0 = (lo == 0 ? 1 : lo); ph0 < hi; ++ph0) {
        int ph = ph0; OPQ_S(ph);
        int tidv = tid_; asm volatile("" : "+v"(tidv));
        __attribute__((address_space(1))) unsigned char* wsg = (__attribute__((address_space(1))) unsigned char*)args.ws; __attribute__((address_space(1))) float* outg = (__attribute__((address_space(1))) float*)args.out;
        OPQ_S(wsg); OPQ_S(outg);
        unsigned char* wsv = (unsigned char*)wsg; float* outv = (float*)outg;
        const Frame F{args, outv, wsv, tidv, tidv & 63, wave_};
        if (ph == NPH - 1) { final_norm(F); continue; }
        const int l = (ph - 1) / NSP; const int sp = (ph - 1) - l * NSP;
        const unsigned wm = phase_mask(sp);
        const int row_lo = l == 0 ? 0 : NCTX;
        const int M_post = T_ALL - row_lo;
        unsigned char* wl = F.ws + WS_W + (size_t)l * W_LAYER;
#pragma nounroll
        for (int kind = 0; kind < 8; ++kind) {
            const unsigned bit = kind == 0 ? W_GIN : kind == 1 ? W_GVT : kind == 2 ? W_GPW : kind == 3 ? W_GFW : kind == 4 ? W_GGLU : kind == 5 ? W_GFF1 : kind == 6 ? W_GOUT : W_GFF2;
            if (!(wm & bit)) continue;
            const bf16_t* A; const bf16_t* Bt; int M, N, K;
            if (kind == 0) { A = FP(WS_XN, bf16_t); Bt = (const bf16_t*)(wl + W_IN); M = T_ALL; N = INC; K = DM; }
            else if (kind == 1) { A = (const bf16_t*)(wl + W_IN) + (size_t)1280 * DM; Bt = FP(WS_XN, bf16_t); M = 256; N = T_ALL; K = DM; }
            else if (kind == 2) { A = FP(WS_CV, bf16_t) + (size_t)row_lo * 256; Bt = (const bf16_t*)(wl + W_PW); M = M_post; N = 256; K = 256; }
            else if (kind == 3) { A = FP(WS_FN, bf16_t) + (size_t)row_lo * 256; Bt = (const bf16_t*)(wl + W_F); M = M_post; N = 256; K = 256; }
            else if (kind == 4) { A = FP(WS_YS, bf16_t) + (size_t)row_lo * 256; Bt = (const bf16_t*)(wl + W_GLU); M = M_post; N = 512; K = 256; }
            else if (kind == 5) { A = FP(WS_XN, bf16_t) + (size_t)row_lo * DM; Bt = (const bf16_t*)(wl + W_1); M = M_post; N = FFD; K = DM; }
            else if (kind == 6) { A = FP(WS_XN, bf16_t) + (size_t)row_lo * DM; Bt = (const bf16_t*)(wl + W_OUT); M = M_post; N = DM; K = DM; }
            else { A = FP(WS_H, bf16_t) + (size_t)row_lo * FFD; Bt = (const bf16_t*)(wl + W_2); M = M_post; N = DM; K = FFD; }
            pg8::Gemm g{A, Bt, M, N, K}; pg8::StaticOrder S; S.init(M, N, G, bx);
            EpiU E{F, l, kind, row_lo};
            pg8::gemm_phase<EpiU, pg8::StaticOrder, true, true>((PG8_LAS unsigned char*)lds, g, S, E);
        }
        if (wm & (W_FC | W_FA | W_CV)) {
            const int n_fc = (l == 0 && (wm & W_FC)) ? 128 : 0, n_fa = (wm & W_FA) ? 128 : 0, n_cv = (wm & W_CV) ? (l == 0 ? 544 : 512) : 0; const int nbu = n_fc + n_fa + n_cv;
            const int ustart = (n_fa + n_cv == 0) ? (G - 1 - bx) : bx;
#pragma nounroll
            for (int u = ustart; u < nbu; u += G) {
                if (u < n_fc) fnetctx_unit(F, u, scr);
                else if (u < n_fc + n_fa) fnetA_unit(F, u - n_fc, lds);
                else conv_unit(F, l, u - n_fc - n_fa, scr);
            }
        }
        if (wm & W_P2) ssm_pass2(F, l);
        if (wm & W_SSM3) {
#pragma nounroll
            for (int it = gw; it < 4096; it += nw) ssm_item<3>(F, l, it);
            if (G >= 128) { if (wave_ < 2) { const int k = (G - 1 - bx) * 2 + wave_; if (k < 256) ssm_item<3>(F, l, 4096 + k); } }
            else { for (int it = 4096 + gw; it < 4352; it += nw) ssm_item<3>(F, l, it); }
        }
        if (wm & (W_ATT | W_SSM1 | W_FB)) {
            const int n_ac = (l == 0 && (wm & W_ATT)) ? 256 : 0, n_al = (wm & W_ATT) ? 4096 : 0, n_s1 = (wm & W_SSM1) ? 4352 : 0, n_fb = (wm & W_FB) ? 1024 : 0, n_s3 = 0;
            const int e0 = n_ac, e1 = e0 + n_al, e2 = e1 + n_s1, e3 = e2 + n_fb, e4 = e3 + n_s3;
            const int gw_i = (wm & W_ATT) ? ((G - 1 - bx) * 8 + wave_) : gw;
#pragma nounroll
            for (int it = gw_i; it < e4; it += nw) {
                if (it < e0) attn_item<false>(F, l, it);
                else if (it < e1) attn_item<true>(F, l, it - e0);
                else if (it < e2) ssm_item<1>(F, l, it - e1);
                else if (it < e3) fnetB_item(F, it - e2);
                else { ssm_item<3>(F, l, it - e3); }
            }
        }
        if (wm & W_PREP1) prep_norm_mod(F, l == 0 ? F.A.in[2] : FP(WS_XC, float), l == 0 ? F.A.in[0] : F.out, PK(6) + l * DM, FP(WS_MOD, float) + l * 5 * 6144, 0, 1024, FP(WS_XN, bf16_t), 0);
        if (wm & W_GN) prep_group(F, l, row_lo);
        if (wm & W_PREP3) prep_norm_mod(F, FP(WS_XC, float), F.out, PK(30) + l * DM, FP(WS_MOD, float) + l * 5 * 6144, 3072, 4096, FP(WS_XN, bf16_t), row_lo);
        if (ph0 + 1 < hi) GSYNC();
    }
}

extern "C" void kernel_launch(void* const* d_in, const int* in_sizes, int n_in, void* d_out, int out_size, void* d_ws, size_t ws_size, hipStream_t stream) {
    static int grid = 0;
    if (grid == 0) {
        if (n_in != 36 || ws_size < WS_END) { fprintf(stderr, "kernel_launch: unexpected n_in %d / ws %zu\n", n_in, ws_size); grid = -1; return; }
        int dev = 0, cus = 0, per_cu = 0;
        (void)hipGetDevice(&dev); (void)hipDeviceGetAttribute(&cus, hipDeviceAttributeMultiprocessorCount, dev);
        (void)hipFuncSetAttribute((const void*)fwd, hipFuncAttributeMaxDynamicSharedMemorySize, LDS_BYTES);
        (void)hipOccupancyMaxActiveBlocksPerMultiprocessor(&per_cu, (const void*)fwd, NTHREADS, LDS_BYTES);
        (void)hipGetLastError();
        grid = cus > 0 ? cus : 256;
    }
    if (grid < 0) return;
    Args a{};
    for (int i = 0; i < 36; ++i) a.in[i] = (const float*)d_in[i];
    a.out = (float*)d_out; a.ws = (unsigned char*)d_ws;
#if MODE_COOP
    (void)hipMemsetAsync((unsigned char*)d_ws + WS_BAR, 0, 16384, stream);
    a.ph_lo = 0; a.ph_hi = NPH; a.part = 15;
    void* kargs[] = {&a};
    hipError_t e = hipLaunchCooperativeKernel((const void*)fwd, dim3(grid), dim3(NTHREADS), kargs, LDS_BYTES, stream);
    if (e != hipSuccess) fprintf(stderr, "cooperative launch failed: %s (grid %d)\n", hipGetErrorString(e), grid);
#else
    for (int ph = 0; ph < NPH; ++ph) { a.ph_lo = ph; a.ph_hi = ph + 1; a.part = 15; hipLaunchKernelGGL(fwd, dim3(grid), dim3(NTHREADS), LDS_BYTES, stream, a); }
#endif
}
```

```cpp
#include <hip/hip_runtime.h>
#include <hip/hip_cooperative_groups.h>
#include <cstdio>
#include <cstdint>
namespace cg = cooperative_groups;
#ifndef MODE_COOP
#define MODE_COOP 1
#endif
namespace pg8 {
#define PG8_LAS __attribute__((address_space(3)))
typedef unsigned short bf16_t;
typedef short bf16x8 __attribute__((ext_vector_type(8)));
typedef float f32x4 __attribute__((ext_vector_type(4)));
typedef unsigned u32x4 __attribute__((ext_vector_type(4)));
constexpr int BM = 256, BK = 64, HALF = 128, HTB = HALF * BK * 2  , STAGE_BYTES = 8 * HTB, NXCD = 8, WGM = 8;

__host__ __device__ __forceinline__ int lds_byte(int r, int c) { const int st = (r >> 4) * 2 + (c >> 5), rr = r & 15, cc = c & 31, ob = rr * 64 + cc * 2; return st * 1024 + (ob ^ (((ob >> 9) & 1) << 5)); }
__host__ __device__ __forceinline__ void stage_rc(int b, int& R, int& C) { const int st = b / 1024, sb = b % 1024, swz = sb ^ (((sb >> 9) & 1) << 5); R = (st >> 1) * 16 + swz / 64; C = (st & 1) * 32 + (swz % 64) / 2; }
__host__ __device__ __forceinline__ int perm32(int rho) { const int n = rho >> 4, i = rho & 15; return 8 * (i >> 2) + 4 * n + (i & 3); }

struct Unit { int pm, pn; };
struct Gemm { const bf16_t* A; const bf16_t* Bt; int M, N, K; };

struct StaticOrder {
    int nM, nN, nwg, G, c;
    __host__ __device__ void init(int M, int N, int G_, int c_) { nM = M / BM; nN = N / BM; nwg = nM * nN; G = G_; c = c_; }
    __host__ __device__ bool next(int i, Unit& u) const {
        const long L = (long)i * G + c; if (L >= nwg) return false;
        int wgid = (int)L; { const int q = nwg / NXCD, r = nwg % NXCD, xcd = wgid % NXCD, off = wgid / NXCD; wgid = (xcd < r ? xcd * (q + 1) : r * (q + 1) + (xcd - r) * q) + off; }
        const int nig = WGM * nN, gid = wgid / nig, fm = gid * WGM, gsz = (nM - fm) < WGM ? (nM - fm) : WGM;
        u.pm = fm + ((wgid % nig) % gsz); u.pn = (wgid % nig) / gsz; return true;
    }
    __device__ __forceinline__ void a_ready(const Unit&) const {}
    __device__ __forceinline__ void done(const Unit&) const {}
};

}
namespace pg8 {
template <class Epi, class Sched, bool ALIGN_EPI = false, bool SP2 = false>
__device__ __forceinline__ void gemm_phase(PG8_LAS unsigned char* lds, const Gemm g, const Sched& S, const Epi& E) {
    const int tid = threadIdx.x, wid = __builtin_amdgcn_readfirstlane(tid >> 6), lane = tid & 63, wr = wid >> 2, wc = wid & 3, fr = lane & 15, fq = lane >> 4;
    const int K = g.K, nt = K / BK;
    unsigned voffA[2], voffB[2];
#pragma unroll
    for (int i = 0; i < 2; ++i) { int R, C; stage_rc(tid * 16 + i * 8192, R, C); const int Rb = Epi::PERM ? ((R & ~31) + perm32(R & 31)) : R;
        voffA[i] = (unsigned)(R * K + C) * 2u; voffB[i] = (unsigned)(Rb * K + C) * 2u; }
    const size_t kstep = (size_t)(BK * 2);
    const size_t hstep = (size_t)HALF * K * 2;
    const size_t tstep = 2 * hstep;
    const unsigned ldsw = (unsigned)wid * 1024u;
    const int aoff = lds_byte(wr * 64 + fr, fq * 8), boff = lds_byte(wc * 32 + fr, fq * 8);
#define PG8_SA(b, h) (((b) * 2 + (h)) * HTB)
#define PG8_SB(b, h) ((4 + (b) * 2 + (h)) * HTB)
#define PG8_STAGE(bufoff, gbase, voff) do { _Pragma("unroll") for (int _i = 0; _i < 2; ++_i) \
        __builtin_amdgcn_global_load_lds((const unsigned*)((const char*)(gbase) + (voff)[_i]), (PG8_LAS unsigned*)(lds + (bufoff) + ldsw + _i * 8192), 16, 0, 0); } while (0)
#define PG8_LDA(dst, b, h) do { _Pragma("unroll") for (int m = 0; m < 4; ++m) _Pragma("unroll") for (int k = 0; k < 2; ++k) dst[m][k] = *(const PG8_LAS bf16x8*)(lds + PG8_SA(b, h) + aoff + m * 2048 + k * 1024); } while (0)
#define PG8_LDB(dst, b, h) do { _Pragma("unroll") for (int n = 0; n < 2; ++n) _Pragma("unroll") for (int k = 0; k < 2; ++k) dst[n][k] = *(const PG8_LAS bf16x8*)(lds + PG8_SB(b, h) + boff + n * 2048 + k * 1024); } while (0)
#define PG8_MMA(ai, bj, At, Bt) do { __builtin_amdgcn_s_setprio(1); _Pragma("unroll") for (int m = 0; m < 4; ++m) _Pragma("unroll") for (int n = 0; n < 2; ++n) _Pragma("unroll") for (int k = 0; k < 2; ++k) \
        acc[ai][bj][m][n] = __builtin_amdgcn_mfma_f32_16x16x32_bf16(Bt[n][k], At[m][k], acc[ai][bj][m][n], 0, 0, 0); __builtin_amdgcn_s_setprio(0); } while (0)
#define PG8_WAIT_V(n) asm volatile("s_waitcnt vmcnt(" #n ")" ::: "memory")
#define PG8_WAIT_L(n) asm volatile("s_waitcnt lgkmcnt(" #n ")" ::: "memory")
#define PG8_BAR __builtin_amdgcn_s_barrier()
#define PG8_SCHED __builtin_amdgcn_sched_barrier(0)
    Unit cur, nxt; int ui = 0;
    if (!S.next(0, cur)) return;
    f32x4 acc[2][2][4][2];
#pragma unroll
    for (int a = 0; a < 2; ++a)
#pragma unroll
        for (int b = 0; b < 2; ++b)
#pragma unroll
            for (int m = 0; m < 4; ++m)
#pragma unroll
                for (int n = 0; n < 2; ++n) acc[a][b][m][n] = (f32x4){0.f, 0.f, 0.f, 0.f};
    bf16x8 At[4][2], B0[2][2], B1[2][2];
    const char* cA = (const char*)g.A + (size_t)cur.pm * tstep; const char* cB = (const char*)g.Bt + (size_t)cur.pn * tstep;
    S.a_ready(cur);
    if constexpr (SP2) {
        PG8_STAGE(PG8_SB(0, 0), cB, voffB); PG8_STAGE(PG8_SB(0, 1), cB + hstep, voffB); PG8_STAGE(PG8_SA(0, 0), cA, voffA); PG8_STAGE(PG8_SA(0, 1), cA + hstep, voffA);
        if (wr == 1) PG8_BAR;
        PG8_WAIT_V(2); PG8_BAR;
        PG8_STAGE(PG8_SB(1, 0), cB + kstep, voffB); PG8_STAGE(PG8_SA(1, 0), cA + kstep, voffA); PG8_STAGE(PG8_SB(1, 1), cB + hstep + kstep, voffB);
        PG8_WAIT_V(6); PG8_BAR;
    } else {
        PG8_STAGE(PG8_SB(0, 0), cB, voffB); PG8_STAGE(PG8_SA(0, 0), cA, voffA); PG8_STAGE(PG8_SB(0, 1), cB + hstep, voffB); PG8_STAGE(PG8_SA(0, 1), cA + hstep, voffA);
        if (wr == 1) PG8_BAR;
        PG8_WAIT_V(4); PG8_BAR;
        PG8_STAGE(PG8_SB(1, 0), cB + kstep, voffB); PG8_STAGE(PG8_SA(1, 0), cA + kstep, voffA); PG8_STAGE(PG8_SB(1, 1), cB + hstep + kstep, voffB);
        PG8_WAIT_V(6); PG8_BAR;
    }
    for (;;) {
        const bool has_next = S.next(ui + 1, nxt);
        const char* nA = has_next ? (const char*)g.A + (size_t)nxt.pm * tstep : cA; const char* nB = has_next ? (const char*)g.Bt + (size_t)nxt.pn * tstep : cB;
        for (int t = 0; t < nt; t += 2) {
            const bool last = (t == nt - 2);
            const char* a1 = cA + (size_t)(t + 1) * kstep;
            const char* a2 = last ? nA : cA + (size_t)(t + 2) * kstep; const char* b2 = last ? nB : cB + (size_t)(t + 2) * kstep;
            const char* a3 = a2 + kstep; const char* b3 = b2 + kstep;
            if (last && has_next) S.a_ready(nxt);
            if constexpr (SP2) {
            PG8_LDB(B0, 0, 0); PG8_LDB(B1, 0, 1); PG8_SCHED; PG8_LDA(At, 0, 0); PG8_STAGE(PG8_SA(1, 1), a1 + hstep, voffA);
            PG8_WAIT_V(8); PG8_WAIT_L(0); PG8_BAR; PG8_MMA(0, 0, At, B0); PG8_MMA(0, 1, At, B1); PG8_BAR; PG8_SCHED;
            PG8_LDA(At, 0, 1); PG8_STAGE(PG8_SB(0, 0), b2, voffB); PG8_STAGE(PG8_SB(0, 1), b2 + hstep, voffB); PG8_STAGE(PG8_SA(0, 0), a2, voffA);
            PG8_WAIT_V(8); PG8_WAIT_L(0); PG8_BAR; PG8_MMA(1, 0, At, B0); PG8_MMA(1, 1, At, B1); PG8_BAR; PG8_SCHED;
            PG8_LDB(B0, 1, 0); PG8_LDB(B1, 1, 1); PG8_SCHED; PG8_LDA(At, 1, 0); PG8_STAGE(PG8_SA(0, 1), a2 + hstep, voffA);
            PG8_WAIT_V(8); PG8_WAIT_L(0); PG8_BAR; PG8_MMA(0, 0, At, B0); PG8_MMA(0, 1, At, B1); PG8_BAR; PG8_SCHED;
            PG8_LDA(At, 1, 1); PG8_STAGE(PG8_SB(1, 0), b3, voffB); PG8_STAGE(PG8_SB(1, 1), b3 + hstep, voffB); PG8_STAGE(PG8_SA(1, 0), a3, voffA);
            PG8_WAIT_V(8); PG8_WAIT_L(0); PG8_BAR; PG8_MMA(1, 0, At, B0); PG8_MMA(1, 1, At, B1); PG8_BAR; PG8_SCHED;
            } else {
            PG8_LDB(B0, 0, 0); PG8_SCHED; PG8_LDA(At, 0, 0); PG8_STAGE(PG8_SA(1, 1), a1 + hstep, voffA);
            PG8_WAIT_L(8); PG8_BAR; PG8_WAIT_L(0); PG8_MMA(0, 0, At, B0); PG8_BAR; PG8_SCHED;
            PG8_LDB(B1, 0, 1); PG8_STAGE(PG8_SB(0, 0), b2, voffB);
            PG8_BAR; PG8_WAIT_L(0); PG8_MMA(0, 1, At, B1); PG8_BAR;
            PG8_LDA(At, 0, 1); PG8_STAGE(PG8_SA(0, 0), a2, voffA);
            PG8_BAR; PG8_WAIT_L(0); PG8_MMA(1, 0, At, B0); PG8_BAR; PG8_SCHED;
            PG8_STAGE(PG8_SB(0, 1), b2 + hstep, voffB);
            PG8_WAIT_V(6); PG8_BAR; PG8_MMA(1, 1, At, B1); PG8_BAR;
            PG8_LDB(B0, 1, 0); PG8_SCHED; PG8_LDA(At, 1, 0); PG8_STAGE(PG8_SA(0, 1), a2 + hstep, voffA);
            PG8_WAIT_L(8); PG8_BAR; PG8_WAIT_L(0); PG8_MMA(0, 0, At, B0); PG8_BAR; PG8_SCHED;
            PG8_LDB(B1, 1, 1); PG8_STAGE(PG8_SB(1, 0), b3, voffB);
            PG8_BAR; PG8_WAIT_L(0); PG8_MMA(0, 1, At, B1); PG8_BAR;
            PG8_LDA(At, 1, 1); PG8_STAGE(PG8_SA(1, 0), a3, voffA);
            PG8_BAR; PG8_WAIT_L(0); PG8_MMA(1, 0, At, B0); PG8_BAR; PG8_SCHED;
            PG8_STAGE(PG8_SB(1, 1), b3 + hstep, voffB);
            PG8_WAIT_V(6); PG8_BAR; PG8_MMA(1, 1, At, B1); PG8_BAR;
            }
        }
        if constexpr (ALIGN_EPI) { if (wr == 0) PG8_BAR; }
        if constexpr (!Epi::AFTER_DRAIN) { E(acc, cur, wr, wc, fr, fq); S.done(cur); }
        if (!has_next) break;
#pragma unroll
        for (int a = 0; a < 2; ++a)
#pragma unroll
            for (int b = 0; b < 2; ++b)
#pragma unroll
                for (int m = 0; m < 4; ++m)
#pragma unroll
                    for (int n = 0; n < 2; ++n) acc[a][b][m][n] = (f32x4){0.f, 0.f, 0.f, 0.f};
        cur = nxt; cA = nA; cB = nB; ++ui;
        if constexpr (ALIGN_EPI) { if (wr == 1) PG8_BAR; }
    }
    PG8_WAIT_V(0);
    if constexpr (!ALIGN_EPI) { if (wr == 0) PG8_BAR; }
    PG8_BAR;
    if constexpr (Epi::AFTER_DRAIN) { E.fused(acc, cur, wr, wc, fr, fq, lds, wid, lane); S.done(cur); }
#undef PG8_SA
#undef PG8_SB
#undef PG8_STAGE
#undef PG8_LDA
#undef PG8_LDB
#undef PG8_MMA
#undef PG8_WAIT_V
#undef PG8_WAIT_L
#undef PG8_BAR
#undef PG8_SCHED
}
}

using pg8::bf16_t; using pg8::bf16x8; using pg8::f32x4;
#define LAS __attribute__((address_space(3)))
typedef short bf16x4 __attribute__((ext_vector_type(4)));
typedef unsigned u32x4 __attribute__((ext_vector_type(4)));
typedef unsigned u32x2 __attribute__((ext_vector_type(2)));

constexpr int NTHREADS = 512;
constexpr int T_ALL = 17408, NCTX = 1024, NLAT = 16384, DM = 1024, INC = 1792, FFD = 4096;
constexpr int LDS_BYTES = 147456;
constexpr float EPS = 1e-6f;

constexpr size_t MiB = 1u << 20;
constexpr size_t WS_MOD = 0;
constexpr size_t WS_CTAB = 256 * 1024;
constexpr size_t WS_STAB = 256 * 1024 + 8192;
constexpr size_t WS_PACK = 1 * MiB;
constexpr size_t WS_SLOC = 3 * MiB;
constexpr size_t WS_CARRY = 7 * MiB + 256 * 1024;
constexpr size_t WS_W = 12 * MiB;
constexpr size_t W_IN = 0, W_PW = W_IN + (size_t)INC * DM * 2, W_F = W_PW + 256 * 256 * 2, W_GLU = W_F + 256 * 256 * 2,
                 W_OUT = W_GLU + 512 * 256 * 2, W_1 = W_OUT + (size_t)DM * DM * 2, W_2 = W_1 + (size_t)FFD * DM * 2, W_LAYER = W_2 + (size_t)FFD * DM * 2;
static_assert(W_LAYER == 22 * MiB, "weights per layer");
constexpr size_t WS_XC = 56 * MiB;
constexpr size_t WS_XN = 60 * MiB;
constexpr size_t WS_BIG = 94 * MiB;
constexpr size_t WS_H = WS_BIG;
constexpr size_t WS_PX = WS_BIG;
constexpr size_t WS_VT = 154 * MiB;
constexpr size_t WS_VTC = 162 * MiB;
constexpr size_t WS_CV = 163 * MiB;
constexpr size_t WS_YB = 172 * MiB;
constexpr size_t WS_FN = 188 * MiB;
constexpr size_t WS_YS = 197 * MiB;
constexpr size_t WS_ZS = 206 * MiB;
constexpr size_t WS_MIX = 223 * MiB;
constexpr size_t WS_END = 256 * MiB;
static_assert(WS_H + (size_t)T_ALL * FFD * 2 <= WS_END && WS_MIX + (size_t)T_ALL * 768 * 2 <= WS_END && WS_PX + (size_t)T_ALL * INC * 2 <= WS_VT, "ws map");

__device__ __forceinline__ unsigned f2bf(float f) { unsigned u = __builtin_bit_cast(unsigned, f); return (u + 0x7fffu + ((u >> 16) & 1u)) >> 16; }
__device__ __forceinline__ unsigned pk2(float lo, float hi) { return f2bf(lo) | (f2bf(hi) << 16); }
__device__ __forceinline__ float bf2f(unsigned h) { return __builtin_bit_cast(float, (h & 0xffffu) << 16); }
__device__ __forceinline__ float bflo(unsigned w) { return __builtin_bit_cast(float, w << 16); }
__device__ __forceinline__ float bfhi(unsigned w) { return __builtin_bit_cast(float, w & 0xffff0000u); }
__device__ __forceinline__ bf16x8 pack8(f32x4 a, f32x4 b) {
    u32x4 w; w.x = pk2(a[0], a[1]); w.y = pk2(a[2], a[3]); w.z = pk2(b[0], b[1]); w.w = pk2(b[2], b[3]);
    return __builtin_bit_cast(bf16x8, w);
}
__device__ __forceinline__ bf16x8 neg8(bf16x8 v) { u32x4 w = __builtin_bit_cast(u32x4, v); w.x ^= 0x80008000u; w.y ^= 0x80008000u; w.z ^= 0x80008000u; w.w ^= 0x80008000u; return __builtin_bit_cast(bf16x8, w); }
__device__ __forceinline__ bf16x8 zero8() { u32x4 w = {0u, 0u, 0u, 0u}; return __builtin_bit_cast(bf16x8, w); }
__device__ __forceinline__ bf16x8 cat4(u32x2 a, u32x2 b) { u32x4 w; w.x = a.x; w.y = a.y; w.z = b.x; w.w = b.y; return __builtin_bit_cast(bf16x8, w); }
__device__ __forceinline__ f32x4 mfma16(bf16x8 a, bf16x8 b, f32x4 c) { return __builtin_amdgcn_mfma_f32_16x16x32_bf16(a, b, c, 0, 0, 0); }
__device__ __forceinline__ void settle4(f32x4& a, f32x4& b, f32x4& c, f32x4& d) { asm volatile("s_nop 15\n\ts_nop 15" : "+v"(a), "+v"(b), "+v"(c), "+v"(d)); }
__device__ __forceinline__ void settle4m(f32x4& a, f32x4& b, f32x4& c, f32x4& d) { asm volatile("s_nop 7\n\ts_nop 7" : "+v"(a), "+v"(b), "+v"(c), "+v"(d) :: "memory"); }
__device__ __forceinline__ f32x4 mfma16s(bf16x8 a, bf16x8 b, f32x4 c) { asm volatile("s_nop 7" : "+v"(a), "+v"(b)); return __builtin_amdgcn_mfma_f32_16x16x32_bf16(a, b, c, 0, 0, 0); }
__device__ __forceinline__ void settle2(f32x4& a, f32x4& b) { asm volatile("s_nop 15\n\ts_nop 15" : "+v"(a), "+v"(b)); }
__device__ __forceinline__ void settle_in(bf16x8& a, bf16x8& b) { asm volatile("s_nop 3" : "+v"(a), "+v"(b)); }
__device__ __forceinline__ float wave_sum(float v) {
    v += __shfl_xor(v, 1); v += __shfl_xor(v, 2); v += __shfl_xor(v, 4); v += __shfl_xor(v, 8); v += __shfl_xor(v, 16); v += __shfl_xor(v, 32); return v;
}
__device__ __forceinline__ float sigmoidf_(float x) { return 1.0f / (1.0f + __expf(-x)); }
struct cplx { float re, im; };
__device__ __forceinline__ cplx cmul(cplx a, cplx b) { return cplx{a.re * b.re - a.im * b.im, a.re * b.im + a.im * b.re}; }
__device__ __forceinline__ cplx cmad(cplx acc, cplx a, cplx b) { return cplx{acc.re + a.re * b.re - a.im * b.im, acc.im + a.re * b.im + a.im * b.re}; }

struct Args { const float* in[36]; float* out; unsigned char* ws; int ph_lo, ph_hi, part, pad; };
struct Frame {
    const Args& A;
    float* out; unsigned char* ws;
    int tid, lane, wave;
};
#define FP(off, type) ((type*)(F.ws + (off)))

constexpr int PK_N = 23;
constexpr int PK_IDX[PK_N] = {6,8,9,10,11,13,15,16,17,18,19,20,21,22,23,24,26,27,29,30,32,34,35};
constexpr int PK_CNT[PK_N] = {2048,15872,512,512,512,512,512,3720,4096,4096,64,65536,65536,65536,65536,512,1024,2048,2048,2048,8192,2048,1024};
constexpr int pk_off(int k) { int o = 0; for (int i = 0; i < PK_N; ++i) { if (PK_IDX[i] == k) return o; o += PK_CNT[i]; } return -1; }
#define PK(k) (FP(WS_PACK, float) + pk_off(k))
static_assert(pk_off(35) + 1024 <= (int)(2 * MiB / 4), "pack size");

struct EpiU {
    static constexpr bool PERM = false, AFTER_DRAIN = false;
    const Frame& F; int l; int kind; int row_lo;
    __device__ __forceinline__ void operator()(const f32x4 (&acc)[2][2][4][2], const pg8::Unit& u, int wr, int wc, int fr, int fq) const {
        const int c0 = u.pn * 256 + wc * 32 + fq * 4;
        const int r0 = u.pm * 256 + wr * 64 + fr;
        if (kind < 6) {
            bf16_t* base; size_t ldc; const float* bias = nullptr;
            if (kind == 0) { base = FP(WS_PX, bf16_t) + (size_t)r0 * INC + c0; ldc = INC; }
            else if (kind == 1) {
                if (u.pn < 4) { base = FP(WS_VTC, bf16_t) + (size_t)u.pn * 65536 + (size_t)r0 * 256 + (c0 - u.pn * 256); ldc = 256; }
                else { const int tt = u.pn - 4; base = FP(WS_VT, bf16_t) + (size_t)(tt >> 4) * 256 * 4096 + (tt & 15) * 256 + (size_t)r0 * 4096 + (c0 - u.pn * 256); ldc = 4096; }
            }
            else if (kind == 2) { base = FP(WS_MIX, bf16_t) + (size_t)(row_lo + r0) * 768 + c0; ldc = 768; bias = PK(13) + l * 256; }
            else if (kind == 3) { base = FP(WS_MIX, bf16_t) + (size_t)(row_lo + r0) * 768 + 256 + c0; ldc = 768; bias = PK(15) + l * 256; }
            else if (kind == 4) { base = FP(WS_ZS, bf16_t) + (size_t)(row_lo + r0) * 512 + c0; ldc = 512; bias = PK(26) + l * 512; }
            else { base = FP(WS_H, bf16_t) + (size_t)(row_lo + r0) * FFD + c0; ldc = FFD; bias = PK(32) + l * FFD; }
#pragma unroll
            for (int bj = 0; bj < 2; ++bj)
#pragma unroll
                for (int n = 0; n < 2; ++n) {
                    f32x4 bv = f32x4{0.f, 0.f, 0.f, 0.f};
                    if (bias) bv = *(const f32x4*)(bias + c0 + bj * 128 + n * 16);
#pragma unroll
                    for (int ai = 0; ai < 2; ++ai)
#pragma unroll
                        for (int m = 0; m < 4; ++m) {
                            f32x4 v = acc[ai][bj][m][n] + bv;
                            if (kind == 5) {
#pragma unroll
                                for (int j = 0; j < 4; ++j) { const float r = fmaxf(v[j], 0.f); v[j] = r * r; }
                            }
                            u32x2 w; w.x = pk2(v[0], v[1]); w.y = pk2(v[2], v[3]);
                            *(u32x2*)(base + (size_t)(ai * 128 + m * 16) * ldc + bj * 128 + n * 16) = w;
                        }
                }
        } else {
            const int gp = u.pm + (row_lo >> 8); const bool isc = gp < 4; const int lrow0 = isc ? gp * 256 : (gp - 4) * 256; const int br = isc ? 4 : ((gp - 4) >> 4);
            const float* sC; const float* sL; const float* bias; int gate_off;
            if (kind == 6) { sC = l == 0 ? F.A.in[2] : FP(WS_XC, float); sL = l == 0 ? F.A.in[0] : F.out; bias = PK(29) + l * DM; gate_off = 2048; }
            else { sC = FP(WS_XC, float); sL = F.out; bias = PK(34) + l * DM; gate_off = 5120; }
            const size_t roff = (size_t)(lrow0 + wr * 64 + fr) * DM + c0;
            const float* s = (isc ? sC : sL) + roff; float* d = (isc ? FP(WS_XC, float) : F.out) + roff;
            const float* gate = FP(WS_MOD, float) + (l * 5 + br) * 6144 + gate_off;
#pragma unroll
            for (int bj = 0; bj < 2; ++bj)
#pragma unroll
                for (int n = 0; n < 2; ++n) {
                    const int cc = c0 + bj * 128 + n * 16;
                    const f32x4 bv = *(const f32x4*)(bias + cc); const f32x4 gv = *(const f32x4*)(gate + cc);
#pragma unroll
                    for (int ai = 0; ai < 2; ++ai)
#pragma unroll
                        for (int m = 0; m < 4; ++m) {
                            const size_t o = (size_t)(ai * 128 + m * 16) * DM + bj * 128 + n * 16;
                            const f32x4 xv = *(const f32x4*)(s + o);
                            *(f32x4*)(d + o) = xv + gv * (acc[ai][bj][m][n] + bv);
                        }
                }
        }
    }
};

__device__ __forceinline__ void transpose_tile(const float* W, int K, int N, bf16_t* Wt, int tile, float* scr, int tid) {
    const int ntn = N >> 6; const int tk = tile / ntn, tn = tile - tk * ntn; const int k0 = tk * 64, n0 = tn * 64;
    { const int n = tid & 63, kk = tid >> 6;
#pragma unroll
      for (int i = 0; i < 8; ++i) { const int k = kk + 8 * i; scr[k * 65 + n] = W[(size_t)(k0 + k) * N + n0 + n]; } }
    __syncthreads();
    { const int kp = tid & 31, nn = tid >> 5;
#pragma unroll
      for (int i = 0; i < 4; ++i) { const int n = nn + 16 * i; const unsigned v = pk2(scr[(2 * kp) * 65 + n], scr[(2 * kp + 1) * 65 + n]); *(unsigned*)(Wt + (size_t)(n0 + n) * K + k0 + 2 * kp) = v; } }
    __syncthreads();
}
__device__ __forceinline__ void mod_unit(const Frame& F, int unit, float* scr) {
    const int l = unit / 96, cc = unit - l * 96; const int tid = F.tid;
    float* sl = scr; float* red = scr + 5 * 1024;
    for (int i = tid; i < 5 * 1024; i += NTHREADS) { const int r = i >> 10, k = i & 1023; const float c = r < 4 ? F.A.in[1][r * 1024 + k] : F.A.in[3][k]; sl[i] = c * sigmoidf_(c); }
    __syncthreads();
    const int col = tid & 63, kg = tid >> 6;
    const float* w = F.A.in[4] + (size_t)l * DM * 6144 + cc * 64 + col;
    float a0 = 0.f, a1 = 0.f, a2 = 0.f, a3 = 0.f, a4 = 0.f;
    for (int k = kg * 128; k < kg * 128 + 128; ++k) { const float wv = w[(size_t)k * 6144]; a0 += sl[k] * wv; a1 += sl[1024 + k] * wv; a2 += sl[2048 + k] * wv; a3 += sl[3072 + k] * wv; a4 += sl[4096 + k] * wv; }
    red[(kg * 5 + 0) * 64 + col] = a0; red[(kg * 5 + 1) * 64 + col] = a1; red[(kg * 5 + 2) * 64 + col] = a2; red[(kg * 5 + 3) * 64 + col] = a3; red[(kg * 5 + 4) * 64 + col] = a4;
    __syncthreads();
    if (tid < 320) { const int r = tid >> 6, c2 = tid & 63; float s = 0.f;
#pragma unroll
        for (int g = 0; g < 8; ++g) s += red[(g * 5 + r) * 64 + c2];
        FP(WS_MOD, float)[(l * 5 + r) * 6144 + cc * 64 + c2] = s + F.A.in[5][l * 6144 + cc * 64 + c2]; }
    __syncthreads();
}
__device__ __forceinline__ void p0_prologue(const Frame& F, float* scr) {
    const int NT_L = 448 + 16 + 16 + 32 + 256 + 1024 + 1024;
    const int njobs = 193 + 2 * NT_L + PK_N;
    for (int job = blockIdx.x; job < njobs; job += gridDim.x) {
        if (job >= 193 + 2 * NT_L) {
            const int e = job - (193 + 2 * NT_L); const float* src = nullptr; int cnt = 0, off = 0;
#define PKC(i) if (e == i) { src = F.A.in[PK_IDX[i]]; cnt = PK_CNT[i]; off = pk_off(PK_IDX[i]); }
            PKC(0) PKC(1) PKC(2) PKC(3) PKC(4) PKC(5) PKC(6) PKC(7) PKC(8) PKC(9) PKC(10) PKC(11) PKC(12) PKC(13) PKC(14) PKC(15) PKC(16) PKC(17) PKC(18) PKC(19) PKC(20) PKC(21) PKC(22)
#undef PKC
            float* dst = FP(WS_PACK, float) + off;
            for (int i = F.tid; i < cnt; i += NTHREADS) dst[i] = src[i];
        }
        else if (job < 192) { mod_unit(F, job, scr); }
        else if (job == 192) {
            for (int i = F.tid; i < 4096; i += NTHREADS) { const int m = i >> 6, j = i & 63; const float x = (float)((m * j) & 63) * (1.0f / 32.0f);
                FP(WS_CTAB, bf16_t)[i] = (bf16_t)f2bf(cospif(x)); FP(WS_STAB, bf16_t)[i] = (bf16_t)f2bf(sinpif(x)); }
        } else {
            int t = job - 193; const int l = t / NT_L; t -= l * NT_L;
            unsigned char* wl = F.ws + WS_W + (size_t)l * W_LAYER;
            if (t < 448) transpose_tile(F.A.in[7] + (size_t)l * DM * INC, DM, INC, (bf16_t*)(wl + W_IN), t, scr, F.tid);
            else if ((t -= 448) < 16) transpose_tile(F.A.in[12] + (size_t)l * 65536, 256, 256, (bf16_t*)(wl + W_PW), t, scr, F.tid);
            else if ((t -= 16) < 16) transpose_tile(F.A.in[14] + (size_t)l * 65536, 256, 256, (bf16_t*)(wl + W_F), t, scr, F.tid);
            else if ((t -= 16) < 32) transpose_tile(F.A.in[25] + (size_t)l * 131072, 256, 512, (bf16_t*)(wl + W_GLU), t, scr, F.tid);
            else if ((t -= 32) < 256) transpose_tile(F.A.in[28] + (size_t)l * DM * DM, DM, DM, (bf16_t*)(wl + W_OUT), t, scr, F.tid);
            else if ((t -= 256) < 1024) transpose_tile(F.A.in[31] + (size_t)l * DM * FFD, DM, FFD, (bf16_t*)(wl + W_1), t, scr, F.tid);
            else { t -= 1024; transpose_tile(F.A.in[33] + (size_t)l * DM * FFD, FFD, DM, (bf16_t*)(wl + W_2), t, scr, F.tid); }
        }
    }
}

__device__ __forceinline__ void prep_norm_mod(const Frame& F, const float* srcC, const float* srcL, const float* g, const float* modl, int sh_off, int sc_off, bf16_t* XN, int row_lo) {
    const int gw = blockIdx.x * 8 + F.wave, nw = gridDim.x * 8, lane = F.lane;
    for (int row = row_lo + gw; row < T_ALL; row += nw) {
        const bool isc = row < NCTX; const float* x = isc ? srcC + (size_t)row * DM : srcL + (size_t)(row - NCTX) * DM; const int br = isc ? 4 : ((row - NCTX) >> 12);
        const float* sh = modl + br * 6144 + sh_off; const float* sc = modl + br * 6144 + sc_off;
        f32x4 v[4]; float ss = 0.f;
#pragma unroll
        for (int i = 0; i < 4; ++i) { v[i] = *(const f32x4*)(x + i * 256 + lane * 4); ss += v[i][0] * v[i][0] + v[i][1] * v[i][1] + v[i][2] * v[i][2] + v[i][3] * v[i][3]; }
        ss = wave_sum(ss); const float r = rsqrtf(ss * (1.0f / 1024.0f) + EPS);
#pragma unroll
        for (int i = 0; i < 4; ++i) { const int c = i * 256 + lane * 4; const f32x4 gv = *(const f32x4*)(g + c), shv = *(const f32x4*)(sh + c), scv = *(const f32x4*)(sc + c);
            f32x4 y = v[i] * r * gv; y = y * (scv + 1.0f) + shv; u32x2 w; w.x = pk2(y[0], y[1]); w.y = pk2(y[2], y[3]); *(u32x2*)(XN + (size_t)row * DM + c) = w; }
    }
}
__device__ __forceinline__ f32x4 ld_bf4(const bf16_t* p) { const u32x2 w = *(const u32x2*)p; return f32x4{bflo(w.x), bfhi(w.x), bflo(w.y), bfhi(w.y)}; }
__device__ __forceinline__ void prep_group(const Frame& F, int l, int row_lo) {
    const int gw = blockIdx.x * 8 + F.wave, nw = gridDim.x * 8, lane = F.lane;
    const bf16_t* MIX = FP(WS_MIX, bf16_t); const bf16_t* ZS = FP(WS_ZS, bf16_t); bf16_t* O = FP(WS_XN, bf16_t); const float* gg = PK(27) + l * DM;
    for (int row = row_lo + gw; row < T_ALL; row += nw) {
#pragma unroll
        for (int grp = 0; grp < 4; ++grp) {
            f32x4 v;
            if (grp < 3) v = ld_bf4(MIX + (size_t)row * 768 + grp * 256 + lane * 4);
            else { const f32x4 a = ld_bf4(ZS + (size_t)row * 512 + lane * 4), gt = ld_bf4(ZS + (size_t)row * 512 + 256 + lane * 4);
#pragma unroll
                for (int j = 0; j < 4; ++j) v[j] = a[j] * sigmoidf_(gt[j]); }
            float ss = v[0] * v[0] + v[1] * v[1] + v[2] * v[2] + v[3] * v[3]; ss = wave_sum(ss);
            const float r = rsqrtf(ss * (1.0f / 256.0f) + EPS); const f32x4 gv = *(const f32x4*)(gg + grp * 256 + lane * 4); const f32x4 y = v * r * gv;
            u32x2 w; w.x = pk2(y[0], y[1]); w.y = pk2(y[2], y[3]); *(u32x2*)(O + (size_t)row * DM + grp * 256 + lane * 4) = w;
        }
    }
}
__device__ __forceinline__ void final_norm(const Frame& F) {
    const int gw = blockIdx.x * 8 + F.wave, nw = gridDim.x * 8, lane = F.lane; const float* g = PK(35);
    for (int row = gw; row < NLAT; row += nw) {
        float* x = F.out + (size_t)row * DM; f32x4 v[4]; float ss = 0.f;
#pragma unroll
        for (int i = 0; i < 4; ++i) { v[i] = *(const f32x4*)(x + i * 256 + lane * 4); ss += v[i][0] * v[i][0] + v[i][1] * v[i][1] + v[i][2] * v[i][2] + v[i][3] * v[i][3]; }
        ss = wave_sum(ss); const float r = rsqrtf(ss * (1.0f / 1024.0f) + EPS);
#pragma unroll
        for (int i = 0; i < 4; ++i) { const int c = i * 256 + lane * 4; *(f32x4*)(x + c) = v[i] * r * *(const f32x4*)(g + c); }
    }
}

__device__ __forceinline__ void conv_unit(const Frame& F, int l, int unit, float* scr) {
    const bf16_t* PX = FP(WS_PX, bf16_t); bf16_t* CV = FP(WS_CV, bf16_t);
    int prow0, Lseq, t0;
    if (unit < 512) { const int b = unit >> 7; t0 = (unit & 127) * 32; prow0 = NCTX + b * 4096; Lseq = 4096; }
    else { const int uu = unit - 512; const int b = uu >> 3; t0 = (uu & 7) * 32; prow0 = b * 256; Lseq = 256; }
    float* vt = scr; float* ot = scr + 62 * 256; int tid = F.tid; asm volatile("" : "+v"(tid));
    for (int idx = tid; idx < 62 * 256; idx += NTHREADS) { const int rr = idx >> 8, c = idx & 255; const int t = t0 - 15 + rr; float v = 0.f;
        if (t >= 0 && t < Lseq) { const bf16_t* p = PX + (size_t)(prow0 + t) * INC; const float a = bf2f(p[c]), gt = bf2f(p[256 + c]); v = a * sigmoidf_(gt); }
        vt[idx] = v; }
    __syncthreads();
    { const int c = tid & 255, half = tid >> 8; float w[31];
#pragma unroll
      for (int j = 0; j < 31; ++j) w[j] = PK(8)[(l * 31 + j) * 256 + c];
      const float bd = PK(9)[l * 256 + c];
      for (int tt = 0; tt < 16; ++tt) { const int t = half * 16 + tt; float s = bd;
#pragma unroll
          for (int j = 0; j < 31; ++j) s += w[j] * vt[(t + j) * 256 + c];
          ot[t * 256 + c] = s; } }
    __syncthreads();
    { const int lane = tid & 63; const f32x4 lg = *(const f32x4*)(PK(10) + l * 256 + lane * 4), lb = *(const f32x4*)(PK(11) + l * 256 + lane * 4);
      for (int i = 0; i < 4; ++i) { const int t = F.wave * 4 + i; const f32x4 x = *(const f32x4*)(ot + t * 256 + lane * 4);
          const float mu = wave_sum(x[0] + x[1] + x[2] + x[3]) * (1.0f / 256.0f); const f32x4 d = x - mu;
          const float var = wave_sum(d[0] * d[0] + d[1] * d[1] + d[2] * d[2] + d[3] * d[3]) * (1.0f / 256.0f); const float r = rsqrtf(var + EPS);
          f32x4 y = d * r * lg + lb;
#pragma unroll
          for (int j = 0; j < 4; ++j) y[j] = y[j] * sigmoidf_(y[j]);
          u32x2 w; w.x = pk2(y[0], y[1]); w.y = pk2(y[2], y[3]); *(u32x2*)(CV + (size_t)(prow0 + t0 + t) * 256 + lane * 4) = w; } }
    __syncthreads();
}

__device__ __forceinline__ void fnetctx_unit(const Frame& F, int unit, float* scr) {
    const bf16_t* PX = FP(WS_PX, bf16_t); bf16_t* FN = FP(WS_FN, bf16_t);
    const int mh = unit & 1, kh = (unit >> 1) & 3, h = (unit >> 3) & 3, b = unit >> 5; int tid = F.tid; asm volatile("" : "+v"(tid));
    float* zc = scr; float* zs = scr + 8192; float* c64 = scr + 16384; float* s64 = c64 + 64; float* c256 = s64 + 64; float* s256 = c256 + 256;
    if (tid < 64) { const float x = (float)tid * (1.0f / 32.0f); c64[tid] = cospif(x); s64[tid] = sinpif(x); }
    if (tid < 256) { const float x = (float)tid * (1.0f / 128.0f); c256[tid] = cospif(x); s256[tid] = sinpif(x); }
    __syncthreads();
    for (int idx = tid; idx < 8192; idx += NTHREADS) { const int n = idx >> 5, mm = idx & 31, m = mh * 32 + mm; const bf16_t* up = PX + (size_t)(b * 256 + n) * INC + 512 + h * 64;
        float ac = 0.f, as = 0.f;
        for (int j = 0; j < 64; ++j) { const float uv = bf2f(up[j]); const int a = (j * m) & 63; ac += uv * c64[a]; as += uv * s64[a]; }
        zc[idx] = ac; zs[idx] = as; }
    __syncthreads();
    for (int idx = tid; idx < 2048; idx += NTHREADS) { const int k = kh * 64 + (idx >> 5), mm = idx & 31; float acc = 0.f;
        for (int n = 0; n < 256; ++n) { const int a = (k * n) & 255; acc += c256[a] * zc[n * 32 + mm] - s256[a] * zs[n * 32 + mm]; }
        FN[(size_t)(b * 256 + k) * 256 + h * 64 + mh * 32 + mm] = (bf16_t)f2bf(acc * (1.0f / 128.0f)); }
    __syncthreads();
}
__device__ __forceinline__ void fnetA_unit(const Frame& F, int unit, unsigned char* lds) {
    const bf16_t* PX = FP(WS_PX, bf16_t); const bf16_t* Ct = FP(WS_CTAB, bf16_t); const bf16_t* St = FP(WS_STAB, bf16_t); bf16_t* YB = FP(WS_YB, bf16_t);
    const int oct = unit & 7, h = (unit >> 3) & 3, b = unit >> 5; int tid = F.tid; asm volatile("" : "+v"(tid)); const int lane = tid & 63, fr = lane & 15, fq = lane >> 4; const int n2 = oct * 8 + F.wave;
    bf16x8 ua[4][2];
#pragma unroll
    for (int mi = 0; mi < 4; ++mi)
#pragma unroll
        for (int kk = 0; kk < 2; ++kk) ua[mi][kk] = *(const bf16x8*)(PX + (size_t)(NCTX + b * 4096 + 64 * (16 * mi + fr) + n2) * INC + 512 + h * 64 + kk * 32 + fq * 8);
    bf16x8 zre[2][4], zs[2][4];
#pragma unroll
    for (int ni = 0; ni < 4; ++ni) {
        bf16x8 bc[2], bs[2];
#pragma unroll
        for (int kk = 0; kk < 2; ++kk) { bc[kk] = *(const bf16x8*)(Ct + (16 * ni + fr) * 64 + kk * 32 + fq * 8); bs[kk] = *(const bf16x8*)(St + (16 * ni + fr) * 64 + kk * 32 + fq * 8); }
#pragma unroll
        for (int pr = 0; pr < 2; ++pr) {
            f32x4 c0 = {0.f, 0.f, 0.f, 0.f}, c1 = c0, s0 = c0, s1 = c0;
#pragma unroll
            for (int kk = 0; kk < 2; ++kk) { c0 = mfma16(ua[2 * pr][kk], bc[kk], c0); c1 = mfma16(ua[2 * pr + 1][kk], bc[kk], c1); s0 = mfma16(ua[2 * pr][kk], bs[kk], s0); s1 = mfma16(ua[2 * pr + 1][kk], bs[kk], s1); }
            zre[pr][ni] = pack8(c0, c1); zs[pr][ni] = pack8(s0, s1);
        }
    }
    bf16_t* T = (bf16_t*)lds;
    for (int mi2 = 0; mi2 < 4; ++mi2) {
        bf16x8 cf[2], sf[2], sfn[2];
#pragma unroll
        for (int pr = 0; pr < 2; ++pr) {
            const bf16_t* cp = Ct + (16 * mi2 + fr) * 64 + 32 * pr + 4 * fq; const bf16_t* sp = St + (16 * mi2 + fr) * 64 + 32 * pr + 4 * fq;
            cf[pr] = cat4(*(const u32x2*)cp, *(const u32x2*)(cp + 16)); sf[pr] = cat4(*(const u32x2*)sp, *(const u32x2*)(sp + 16)); sfn[pr] = neg8(sf[pr]);
        }
        float cs[4], sn[4];
#pragma unroll
        for (int j = 0; j < 4; ++j) { const int k1 = 16 * mi2 + 4 * fq + j; const float x = (float)(n2 * k1) * (1.0f / 2048.0f); cs[j] = cospif(x); sn[j] = sinpif(x); }
#pragma unroll
        for (int ni = 0; ni < 4; ++ni) {
            f32x4 yre = {0.f, 0.f, 0.f, 0.f}, yin = yre;
#pragma unroll
            for (int pr = 0; pr < 2; ++pr) { yre = mfma16s(cf[pr], zre[pr][ni], yre); yre = mfma16s(sfn[pr], zs[pr][ni], yre); yin = mfma16s(cf[pr], zs[pr][ni], yin); yin = mfma16s(sf[pr], zre[pr][ni], yin); }
#pragma unroll
            for (int j = 0; j < 4; ++j) { const int k1 = 16 * mi2 + 4 * fq + j; const int m = 16 * ni + fr;
                const float y1 = yre[j] * cs[j] - yin[j] * sn[j], y2 = yin[j] * cs[j] + yre[j] * sn[j];
                T[((0 * 64 + k1) * 64 + m) * 8 + F.wave] = (bf16_t)f2bf(y1); T[((1 * 64 + k1) * 64 + m) * 8 + F.wave] = (bf16_t)f2bf(y2); }
        }
    }
    __syncthreads();
    for (int it = 0; it < 16; ++it) { const int cidx = it * NTHREADS + tid; const int m = cidx & 63, k1 = (cidx >> 6) & 63, plane = cidx >> 12;
        const u32x4 v = *(const u32x4*)(lds + (size_t)cidx * 16);
        *(u32x4*)(YB + ((((size_t)(b * 4 + h) * 64 + k1) * 2 + plane) * 64 + m) * 64 + oct * 8) = v; }
    __syncthreads();
}
__device__ __forceinline__ void fnetB_item(const Frame& F, int item) {
    const bf16_t* Ct = FP(WS_CTAB, bf16_t); const bf16_t* St = FP(WS_STAB, bf16_t); const bf16_t* YB = FP(WS_YB, bf16_t); bf16_t* FN = FP(WS_FN, bf16_t);
    const int k1 = item & 63, h = (item >> 6) & 3, b = item >> 8; int lane = F.lane; asm volatile("" : "+v"(lane)); const int fr = lane & 15, fq = lane >> 4;
    const bf16_t* base = YB + (((size_t)(b * 4 + h) * 64 + k1) * 2) * 4096;
    f32x4 acc[4][4];
#pragma unroll
    for (int mi = 0; mi < 4; ++mi)
#pragma unroll
        for (int ni = 0; ni < 4; ++ni) acc[mi][ni] = f32x4{0.f, 0.f, 0.f, 0.f};
#pragma unroll
    for (int kk = 0; kk < 2; ++kk) {
        bf16x8 bc[4], bsn[4];
#pragma unroll
        for (int ni = 0; ni < 4; ++ni) { bc[ni] = *(const bf16x8*)(Ct + (16 * ni + fr) * 64 + kk * 32 + fq * 8); bsn[ni] = neg8(*(const bf16x8*)(St + (16 * ni + fr) * 64 + kk * 32 + fq * 8)); }
#pragma unroll
        for (int mi = 0; mi < 4; ++mi) {
            const bf16x8 are = *(const bf16x8*)(base + (16 * mi + fr) * 64 + kk * 32 + fq * 8), aim = *(const bf16x8*)(base + 4096 + (16 * mi + fr) * 64 + kk * 32 + fq * 8);
#pragma unroll
            for (int ni = 0; ni < 4; ++ni) { acc[mi][ni] = mfma16(are, bc[ni], acc[mi][ni]); acc[mi][ni] = mfma16s(aim, bsn[ni], acc[mi][ni]); }
        }
    }
#pragma unroll
    for (int mi = 0; mi < 4; ++mi)
#pragma unroll
        for (int ni = 0; ni < 4; ++ni) { const int k = k1 + 64 * (16 * ni + fr); const f32x4 v = acc[mi][ni] * (1.0f / 512.0f);
            u32x2 w; w.x = pk2(v[0], v[1]); w.y = pk2(v[2], v[3]); *(u32x2*)(FN + (size_t)(NCTX + b * 4096 + k) * 256 + h * 64 + 16 * mi + 4 * fq) = w; }
}

template <bool LOCAL>
__device__ __forceinline__ void attn_item(const Frame& F, int l, int item) {
    const bf16_t* PX = FP(WS_PX, bf16_t); const bf16_t* VT = FP(WS_VT, bf16_t); const bf16_t* VTc = FP(WS_VTC, bf16_t); bf16_t* MIX = FP(WS_MIX, bf16_t);
    const float* rpb = PK(16) + l * (4 * 15 * 31);
    int lane = F.lane; asm volatile("" : "+v"(lane)); const int fr = lane & 15, fq = lane >> 4;
    int b, h, r = 0, jb = 0, qrow0;
    if (LOCAL) { h = item & 3; jb = (item >> 2) & 3; r = (item >> 4) & 63; b = item >> 10; qrow0 = NCTX + b * 4096 + r * 64 + jb * 16; }
    else { h = item & 3; const int qb = (item >> 2) & 15; b = item >> 6; qrow0 = b * 256 + qb * 16; }
    constexpr int NT = LOCAL ? 32 : 16;
    const int rs = LOCAL ? min(max(r - 4, 0), 56) : 0; const int kcs = LOCAL ? min(max(16 * jb - 8, 0), 32) : 0;
    bf16x8 qf[2];
#pragma unroll
    for (int kk = 0; kk < 2; ++kk) qf[kk] = *(const bf16x8*)(PX + (size_t)(qrow0 + fr) * INC + 768 + h * 64 + kk * 32 + fq * 8);
    f32x4 s[NT];
#pragma unroll
    for (int t = 0; t < NT; ++t) {
        int krow;
        if (LOCAL && t < 16) krow = NCTX + b * 4096 + (rs + (t >> 1)) * 64 + kcs + (t & 1) * 16 + fr;
        else krow = b * 256 + (t - (LOCAL ? 16 : 0)) * 16 + fr;
        const bf16_t* kp = PX + (size_t)krow * INC + 1024 + h * 64 + fq * 8;
        const bf16x8 k0 = *(const bf16x8*)kp, k1 = *(const bf16x8*)(kp + 32);
        f32x4 a = {0.f, 0.f, 0.f, 0.f}; a = mfma16(k0, qf[0], a); a = mfma16(k1, qf[1], a); s[t] = a;
    }
    float mx = -3.0e38f;
    const int qcol = 16 * jb + fr; const int cstart = min(max(qcol - 8, 0), 48);
#pragma unroll
    for (int t = 0; t < NT; ++t)
#pragma unroll
        for (int j = 0; j < 4; ++j) {
            float v = s[t][j] * 0.125f;
            if (LOCAL && t < 16) { const int kcol = kcs + (t & 1) * 16 + 4 * fq + j; const bool valid = (kcol >= cstart) && (kcol < cstart + 16);
                const int dr = rs + (t >> 1) - r + 7; const int dc = min(max(kcol - qcol + 15, 0), 30);
                v = valid ? v + rpb[(h * 15 + dr) * 31 + dc] : -1.0e30f; }
            s[t][j] = v; mx = fmaxf(mx, v);
        }
    mx = fmaxf(mx, __shfl_xor(mx, 16)); mx = fmaxf(mx, __shfl_xor(mx, 32));
    float sum = 0.f;
#pragma unroll
    for (int t = 0; t < NT; ++t)
#pragma unroll
        for (int j = 0; j < 4; ++j) { const float p = __expf(s[t][j] - mx); s[t][j] = p; sum += p; }
    sum += __shfl_xor(sum, 16); sum += __shfl_xor(sum, 32);
    f32x4 o[4];
#pragma unroll
    for (int di = 0; di < 4; ++di) o[di] = f32x4{0.f, 0.f, 0.f, 0.f};
#pragma unroll
    for (int u = 0; u < NT / 2; ++u) {
        const bf16x8 pb = pack8(s[2 * u], s[2 * u + 1]);
        const bf16_t* vbase; size_t stride;
        if (LOCAL && u < 8) { vbase = VT + (size_t)(b * 256 + h * 64) * 4096 + (rs + u) * 64 + kcs + 4 * fq; stride = 4096; }
        else { const int uu = u - (LOCAL ? 8 : 0); vbase = VTc + (size_t)(b * 256 + h * 64) * 256 + uu * 32 + 4 * fq; stride = 256; }
#pragma unroll
        for (int di = 0; di < 4; ++di) { const bf16_t* vp = vbase + (size_t)(16 * di + fr) * stride; const bf16x8 va = cat4(*(const u32x2*)vp, *(const u32x2*)(vp + 16)); o[di] = mfma16s(va, pb, o[di]); }
    }
    const float inv = 1.0f / sum;
#pragma unroll
    for (int di = 0; di < 4; ++di) { const f32x4 v = o[di] * inv; u32x2 w; w.x = pk2(v[0], v[1]); w.y = pk2(v[2], v[3]);
        *(u32x2*)(MIX + (size_t)(qrow0 + fr) * 768 + 512 + h * 64 + 16 * di + 4 * fq) = w; }
}

__device__ __forceinline__ cplx csel(bool c, cplx a, cplx b) { return cplx{c ? a.re : b.re, c ? a.im : b.im}; }
#define WAITALL() asm volatile("s_waitcnt vmcnt(0) lgkmcnt(0)" ::: "memory")
__device__ __forceinline__ cplx pow_sel(int k, cplx a, cplx a2, cplx a4, cplx a8, cplx a16) {
    cplx r = cplx{1.f, 0.f};
    r = csel((k & 1) != 0, cmul(r, a), r); r = csel((k & 2) != 0, cmul(r, a2), r); r = csel((k & 4) != 0, cmul(r, a4), r); r = csel((k & 8) != 0, cmul(r, a8), r); r = csel((k & 16) != 0, cmul(r, a16), r);
    return r;
}
__device__ __forceinline__ void ssm_consts(float lre, float lim, float dt, cplx& a, cplx& f) {
    const float e = __expf(lre * dt);
    float revs = lim * dt * 0.15915494309189535f; revs -= rintf(revs);
    a = cplx{e * __builtin_amdgcn_cosf(revs), e * __builtin_amdgcn_sinf(revs)};
    const float xr = a.re - 1.0f, xi = a.im, den = __builtin_amdgcn_rcpf(lre * lre + lim * lim);
    f = cplx{(xr * lre + xi * lim) * den, (xi * lre - xr * lim) * den};
}
template <int PASS, int DIR>
__device__ __forceinline__ void ssm_dir(const Frame& F, int lane, int l, int b, int g, int tb, const bf16x8 (&ub)[4], f32x4 (&accy)[4]) {
    const int fr = lane & 15, fq = lane >> 4;
    const int c = DIR == 0 ? tb : (tb < 4 ? 3 - tb : 71 - tb);
    const int pg = (l * 2 + DIR) * 16 + g;
    const float dt = __expf(PK(19)[pg]);
    cplx* Sloc = FP(WS_SLOC, cplx); const cplx* Carry = FP(WS_CARRY, cplx);
    const size_t sbase = ((size_t)((b * 2 + DIR) * 16 + g) * 68 + c) * 64;
    for (int q = 0; q < 4; ++q) {
        bf16x8 are, aim;
        { const int kq = (fq & 1) * 8; const float* pr = PK(20) + ((size_t)pg * 64 + 16 * q + fr) * 16 + kq; const float* pi = PK(21) + ((size_t)pg * 64 + 16 * q + fr) * 16 + kq;
          const f32x4 zz = f32x4{0.f, 0.f, 0.f, 0.f}; const bool on = fq < 2;
          const f32x4 r0 = *(const f32x4*)pr, r1 = *(const f32x4*)(pr + 4), i0 = *(const f32x4*)pi, i1 = *(const f32x4*)(pi + 4);

          are = pack8(on ? r0 : zz, on ? r1 : zz); aim = pack8(on ? i0 : zz, on ? i1 : zz); }
        f32x4 bre[4], bim[4];
        asm volatile("s_nop 7" : "+v"(are), "+v"(aim));
#pragma unroll
        for (int ni = 0; ni < 4; ++ni) { bre[ni] = mfma16(are, ub[ni], f32x4{0.f, 0.f, 0.f, 0.f}); bim[ni] = mfma16(aim, ub[ni], f32x4{0.f, 0.f, 0.f, 0.f}); }
        settle4m(bre[0], bre[1], bre[2], bre[3]); settle4m(bim[0], bim[1], bim[2], bim[3]);
#pragma unroll
        for (int j = 0; j < 4; ++j) {
            const int p = 16 * q + 4 * fq + j;
            const float lre = PK(17)[pg * 64 + p], lim = PK(18)[pg * 64 + p];

            cplx a, f; ssm_consts(lre, lim, dt, a, f);
            const cplx a2 = cmul(a, a), a4 = cmul(a2, a2), a8 = cmul(a4, a4), a16 = cmul(a8, a8);
            if (PASS == 1) {
                cplx Tt;
                if (DIR == 0) { Tt = cplx{bre[0][j], bim[0][j]}; Tt = cmad(cplx{bre[1][j], bim[1][j]}, Tt, a16); Tt = cmad(cplx{bre[2][j], bim[2][j]}, Tt, a16); Tt = cmad(cplx{bre[3][j], bim[3][j]}, Tt, a16); }
                else { Tt = cplx{bre[3][j], bim[3][j]}; Tt = cmad(cplx{bre[2][j], bim[2][j]}, Tt, a16); Tt = cmad(cplx{bre[1][j], bim[1][j]}, Tt, a16); Tt = cmad(cplx{bre[0][j], bim[0][j]}, Tt, a16); }
                const cplx w = pow_sel(DIR == 0 ? 15 - fr : fr, a, a2, a4, a8, a16);
                Tt = cmul(Tt, w);
                Tt.re += __shfl_xor(Tt.re, 1); Tt.im += __shfl_xor(Tt.im, 1); Tt.re += __shfl_xor(Tt.re, 2); Tt.im += __shfl_xor(Tt.im, 2);
                Tt.re += __shfl_xor(Tt.re, 4); Tt.im += __shfl_xor(Tt.im, 4); Tt.re += __shfl_xor(Tt.re, 8); Tt.im += __shfl_xor(Tt.im, 8);
                Tt = cmul(Tt, f);
                if (fr == 0) Sloc[sbase + p] = Tt;
            } else {
                const cplx w = pow_sel(DIR == 0 ? fr + 1 : 16 - fr, a, a2, a4, a8, a16);
                cplx x[4];
#pragma unroll
                for (int ni = 0; ni < 4; ++ni) {
                    cplx v = cmul(f, cplx{bre[ni][j], bim[ni][j]});
#define RLF(x, ln) __builtin_bit_cast(float, __builtin_amdgcn_readlane(__builtin_bit_cast(int, (x)), (ln)))
#define DPPF(x, ctrl) __builtin_bit_cast(float, __builtin_amdgcn_update_dpp(0, __builtin_bit_cast(int, (x)), (ctrl), 0xf, 0xf, true))
#define KS_STEP(d, ad) { cplx y; if (DIR == 0) { y.re = DPPF(v.re, 0x110 + d); y.im = DPPF(v.im, 0x110 + d); v = csel(fr >= d, cmad(v, ad, y), v); } \
                                   else { y.re = DPPF(v.re, 0x100 + d); y.im = DPPF(v.im, 0x100 + d); v = csel(fr + d <= 15, cmad(v, ad, y), v); } }
                    KS_STEP(1, a) KS_STEP(2, a2) KS_STEP(4, a4) KS_STEP(8, a8)
#undef KS_STEP
                    x[ni] = v;
                }
                cplx E = Carry[sbase + p];
#pragma unroll
                for (int bi = 0; bi < 4; ++bi) {
                    const int ni = DIR == 0 ? bi : 3 - bi;
                    const cplx hh = cmad(x[ni], w, E);
                    cplx tot;
                    { constexpr int L0 = DIR == 0 ? 15 : 0;
                      const float r0 = RLF(x[ni].re, L0), r1 = RLF(x[ni].re, L0 + 16), r2 = RLF(x[ni].re, L0 + 32), r3 = RLF(x[ni].re, L0 + 48);
                      const float i0 = RLF(x[ni].im, L0), i1 = RLF(x[ni].im, L0 + 16), i2 = RLF(x[ni].im, L0 + 32), i3 = RLF(x[ni].im, L0 + 48);
                      tot.re = fq == 0 ? r0 : fq == 1 ? r1 : fq == 2 ? r2 : r3; tot.im = fq == 0 ? i0 : fq == 1 ? i1 : fq == 2 ? i2 : i3; }
                    E = cmad(tot, a16, E);
                    bre[ni][j] = hh.re; bim[ni][j] = hh.im;
                }
            }
        }
        if (PASS == 3) {
            const float* cr = PK(22) + ((size_t)pg * 16 + fr) * 64 + 16 * q + 4 * fq; const float* ci = PK(23) + ((size_t)pg * 16 + fr) * 64 + 16 * q + 4 * fq;
            const f32x4 cre = *(const f32x4*)cr; const f32x4 cim = *(const f32x4*)ci;
            const bf16x8 ca = pack8(cre, f32x4{-cim[0], -cim[1], -cim[2], -cim[3]});
#pragma unroll
            for (int ni = 0; ni < 4; ++ni) { bf16x8 hb = pack8(bre[ni], bim[ni]); bf16x8 ca2 = ca; asm volatile("s_nop 7" : "+v"(ca2), "+v"(hb)); accy[ni] = mfma16(ca2, hb, accy[ni]); }
            settle4m(accy[0], accy[1], accy[2], accy[3]);
        }
    }
}
template <int PASS>
__device__ __forceinline__ void ssm_item(const Frame& F, int l_u, int item_u) {
    int l = l_u, item = item_u; asm volatile("" : "+v"(l), "+v"(item));
    const bf16_t* PX = FP(WS_PX, bf16_t);
    int lane = F.lane; asm volatile("" : "+v"(lane)); const int fr = lane & 15, fq = lane >> 4;
    const int tb = item % 68; const int g = (item / 68) & 15; const int b = item / (68 * 16);
    const int prow0 = tb < 4 ? b * 256 + tb * 64 : NCTX + b * 4096 + (tb - 4) * 64;
    bf16x8 ub[4];
#pragma unroll
    for (int ni = 0; ni < 4; ++ni) { const bf16x8 ld = *(const bf16x8*)(PX + (size_t)(prow0 + 16 * ni + fr) * INC + 1536 + g * 16 + (fq & 1) * 8); ub[ni] = fq < 2 ? ld : zero8(); }
    f32x4 accy[4];
#pragma unroll
    for (int ni = 0; ni < 4; ++ni) accy[ni] = f32x4{0.f, 0.f, 0.f, 0.f};

    ssm_dir<PASS, 0>(F, lane, l, b, g, tb, ub, accy);
    ssm_dir<PASS, 1>(F, lane, l, b, g, tb, ub, accy);
    if (PASS == 3) {
        bf16_t* YS = FP(WS_YS, bf16_t); const f32x4 dv = *(const f32x4*)(PK(24) + l * 256 + g * 16 + 4 * fq);
#pragma unroll
        for (int ni = 0; ni < 4; ++ni) { const int row = prow0 + 16 * ni + fr; const f32x4 uv = ld_bf4(PX + (size_t)row * INC + 1536 + g * 16 + 4 * fq);
            const f32x4 y = accy[ni] + dv * uv; u32x2 w; w.x = pk2(y[0], y[1]); w.y = pk2(y[2], y[3]); *(u32x2*)(YS + (size_t)row * 256 + g * 16 + 4 * fq) = w; }
    }
}
__device__ __forceinline__ void ssm_pass2(const Frame& F, int l) {
    const int pb = (int)blockIdx.x - 112; if (pb < 0 || pb >= 16) return;
    const int idx = pb * NTHREADS + F.tid;
    const int p = idx & 63, g = (idx >> 6) & 15, dir = (idx >> 10) & 1, b = idx >> 11;
    const int pg = (l * 2 + dir) * 16 + g; const float dt = __expf(PK(19)[pg]);
    const float lre = PK(17)[pg * 64 + p], lim = PK(18)[pg * 64 + p];
    cplx a, f_unused; ssm_consts(lre, lim, dt, a, f_unused);
#pragma unroll
    for (int i = 0; i < 6; ++i) a = cmul(a, a);
    const cplx* Sloc = FP(WS_SLOC, cplx); cplx* Carry = FP(WS_CARRY, cplx);
    const size_t base = ((size_t)((b * 2 + dir) * 16 + g) * 68) * 64 + p;
    cplx E = cplx{0.f, 0.f};
    for (int c0 = 0; c0 < 68; c0 += 4) {
        const cplx s0 = Sloc[base + (size_t)(c0 + 0) * 64], s1 = Sloc[base + (size_t)(c0 + 1) * 64], s2 = Sloc[base + (size_t)(c0 + 2) * 64], s3 = Sloc[base + (size_t)(c0 + 3) * 64];
        Carry[base + (size_t)(c0 + 0) * 64] = E; E = cmad(s0, a, E);
        Carry[base + (size_t)(c0 + 1) * 64] = E; E = cmad(s1, a, E);
        Carry[base + (size_t)(c0 + 2) * 64] = E; E = cmad(s2, a, E);
        Carry[base + (size_t)(c0 + 3) * 64] = E; E = cmad(s3, a, E);
    }
}


constexpr size_t WS_BAR = 512 * 1024;
#define XB_TMO      128
#define XB_XCNT(j)  (256  + 64 * (j))
#define XB_XSUB(j)  (1280 + 64 * (j))
#define XB_XGEN(j)  (2304 + 64 * (j))
#define XB_TOP      3328
#define XB_TOPGEN   3392
#define XCD_BAR_WORDS 3456
#define XB_SPIN_CAP (1u << 18)

__device__ __forceinline__ unsigned xb_ld(unsigned* p)              { return __hip_atomic_load(p, __ATOMIC_RELAXED, __HIP_MEMORY_SCOPE_AGENT); }
__device__ __forceinline__ unsigned xb_add(unsigned* p, unsigned v) { return __hip_atomic_fetch_add(p, v, __ATOMIC_RELAXED, __HIP_MEMORY_SCOPE_AGENT); }
__device__ __forceinline__ unsigned xb_xcc_id() { return (unsigned)__builtin_amdgcn_s_getreg((3 << 11) | 20) & 0xFu; }
#define XB_SPIN(cond, bar) do { unsigned _sp = 0; while (cond) { __builtin_amdgcn_s_sleep(1); \
    if ((++_sp & 255u) == 0u) { if (xb_ld(&(bar)[XB_TMO])) break; if (_sp > XB_SPIN_CAP) { atomicAdd(&(bar)[XB_TMO], 1u); break; } } } } while (0)

struct XcdBarrier {
    unsigned* bar; unsigned x;
    volatile LAS unsigned* st;
};

__device__ __forceinline__ XcdBarrier xcd_barrier_post(unsigned* bar, volatile LAS unsigned* st) {
    XcdBarrier b; b.bar = bar; b.x = xb_xcc_id(); b.st = st;
    if (threadIdx.x == 0) (void)xb_add(&bar[XB_XCNT(b.x)], 1u);
    return b;
}
__device__ __forceinline__ void xcd_barrier_complete(unsigned* bar, unsigned x, unsigned& nloc, unsigned& nx) {
    const unsigned G = gridDim.x * gridDim.y * gridDim.z;
    unsigned sum, cnt, mine, sp = 0u;
    for (;;) {
        sum = 0u; cnt = 0u; mine = 0u;
#pragma unroll
        for (unsigned j = 0; j < 16; ++j) { const unsigned c = xb_ld(&bar[XB_XCNT(j)]); sum += c; cnt += (c > 0u) ? 1u : 0u; mine = (j == x) ? c : mine; }
        if (sum == G) break;
        __builtin_amdgcn_s_sleep(1);
        if ((++sp & 255u) == 0u) { if (xb_ld(&bar[XB_TMO])) break; if (sp > XB_SPIN_CAP) { atomicAdd(&bar[XB_TMO], 1u); break; } }
    }
    nloc = mine > 0u ? mine : 1u; nx = cnt > 0u ? cnt : 1u;
}

__device__ __forceinline__ void xcd_barrier(const XcdBarrier& b) {
    asm volatile("s_waitcnt vmcnt(0)" ::: "memory");
    __syncthreads();
    if (threadIdx.x == 0) {
        unsigned* bar = b.bar;
        __builtin_amdgcn_s_waitcnt(0);
        unsigned nloc = b.st[0], nx = b.st[1];
        if (nloc == 0u) { xcd_barrier_complete(bar, b.x, nloc, nx); b.st[0] = nloc; b.st[1] = nx; }
        const unsigned old = xb_add(&bar[XB_XSUB(b.x)], 1u);
        const unsigned gen = old / nloc;
        if (old + 1u == (gen + 1u) * nloc) {
            __builtin_amdgcn_fence(__ATOMIC_RELEASE, "agent");
            asm volatile("s_waitcnt vmcnt(0)" ::: "memory");
            const unsigned og = xb_add(&bar[XB_TOP], 1u);
            const unsigned tg = og / nx;
            if (og + 1u == (tg + 1u) * nx) xb_add(&bar[XB_TOPGEN], 1u);
            else XB_SPIN(xb_ld(&bar[XB_TOPGEN]) == tg, bar);
            __builtin_amdgcn_fence(__ATOMIC_ACQUIRE, "agent");
            xb_add(&bar[XB_XGEN(b.x)], 1u);
            asm volatile("s_waitcnt vmcnt(0)" ::: "memory");
        } else {
            XB_SPIN(xb_ld(&bar[XB_XGEN(b.x)]) == gen, bar);
            __builtin_amdgcn_fence(__ATOMIC_ACQUIRE, "agent");
            asm volatile("s_waitcnt vmcnt(0)" ::: "memory");
        }
    }
    __syncthreads();
}
enum : unsigned { W_PREP1 = 1u << 0, W_GIN = 1u << 1, W_GVT = 1u << 2, W_FC = 1u << 3, W_FA = 1u << 4, W_CV = 1u << 5, W_ATT = 1u << 6, W_SSM1 = 1u << 7, W_GPW = 1u << 8,
                  W_P2 = 1u << 9, W_FB = 1u << 10, W_GFW = 1u << 11, W_SSM3 = 1u << 12, W_GGLU = 1u << 13, W_GN = 1u << 14, W_GOUT = 1u << 15, W_PREP3 = 1u << 16, W_GFF1 = 1u << 17, W_GFF2 = 1u << 18 };
#ifndef PH_FINE
#define PH_FINE 0
#endif
#if PH_FINE
constexpr int NSP = 18;
__host__ __device__ __forceinline__ unsigned phase_mask(int sp) {
    switch (sp) { case 0: return W_PREP1; case 1: return W_GIN; case 2: return W_GVT; case 3: return W_FC; case 4: return W_FA; case 5: return W_CV; case 6: return W_ATT; case 7: return W_SSM1;
                  case 8: return W_GPW; case 9: return W_P2 | W_FB; case 10: return W_GFW; case 11: return W_SSM3; case 12: return W_GGLU; case 13: return W_GN; case 14: return W_GOUT;
                  case 15: return W_PREP3; case 16: return W_GFF1; default: return W_GFF2; }
}
#else
constexpr int NSP = 11;
__host__ __device__ __forceinline__ unsigned phase_mask(int sp) {
    switch (sp) { case 0: return W_PREP1; case 1: return W_GIN | W_GVT; case 2: return W_FA | W_CV | W_ATT | W_SSM1; case 3: return W_GPW | W_P2 | W_FB | W_FC;
                  case 4: return W_GFW | W_SSM3; case 5: return W_GGLU; case 6: return W_GN; case 7: return W_GOUT; case 8: return W_PREP3; case 9: return W_GFF1; default: return W_GFF2; }
}
#endif
constexpr int NPH = 2 + 2 * NSP;
#ifndef ZP1
#define ZP1 12
#define ZP2 30
#endif
#define OPQ_S(x) asm volatile("" : "+s"(x))
#define GSYNC() xcd_barrier(xb)
__global__ void __launch_bounds__(NTHREADS, 2) fwd(Args args) {
    extern __shared__ __attribute__((aligned(16))) unsigned char lds[];

    cg::grid_group grid = cg::this_grid();
    const int tid_ = threadIdx.x;
    const int wave_ = __builtin_amdgcn_readfirstlane(tid_ >> 6);
    float* scr = (float*)lds;
    const int G = gridDim.x, bx = blockIdx.x;
    const int gw = bx * 8 + wave_, nw = G * 8;
    const int lo = args.ph_lo, hi = args.ph_hi;
    if (lo < 0) grid.sync();
    volatile LAS unsigned* xb_st = (volatile LAS unsigned*)((LAS unsigned char*)lds + (LDS_BYTES - 64));
    if (tid_ == 0) { xb_st[0] = 0u; xb_st[1] = 0u; }
    __syncthreads();
    const XcdBarrier xb = xcd_barrier_post((unsigned*)(args.ws + WS_BAR), xb_st);
    if (lo == 0) { const Frame F{args, args.out, args.ws, tid_, tid_ & 63, wave_}; p0_prologue(F, scr); if (hi > 1) GSYNC(); }
#pragma nounroll
    for (int ph0 = (lo == 0 ? 1 : lo); ph0 < hi; ++ph0) {
        int ph = ph0; OPQ_S(ph);
        int tidv = tid_; asm volatile("" : "+v"(tidv));
        __attribute__((address_space(1))) unsigned char* wsg = (__attribute__((address_space(1))) unsigned char*)args.ws; __attribute__((address_space(1))) float* outg = (__attribute__((address_space(1))) float*)args.out;
        OPQ_S(wsg); OPQ_S(outg);
        unsigned char* wsv = (unsigned char*)wsg; float* outv = (float*)outg;
        const Frame F{args, outv, wsv, tidv, tidv & 63, wave_};
        if (ph == NPH - 1) { final_norm(F); continue; }
        const int l = (ph - 1) / NSP; const int sp = (ph - 1) - l * NSP;
        const unsigned wm = phase_mask(sp);
        const int row_lo = l == 0 ? 0 : NCTX;
        const int M_post = T_ALL - row_lo;
        unsigned char* wl = F.ws + WS_W + (size_t)l * W_LAYER;
#pragma nounroll
        for (int kind = 0; kind < 8; ++kind) {
            const unsigned bit = kind == 0 ? W_GIN : kind == 1 ? W_GVT : kind == 2 ? W_GPW : kind == 3 ? W_GFW : kind == 4 ? W_GGLU : kind == 5 ? W_GFF1 : kind == 6 ? W_GOUT : W_GFF2;
            if (!(wm & bit)) continue;
            const bf16_t* A; const bf16_t* Bt; int M, N, K;
            if (kind == 0) { A = FP(WS_XN, bf16_t); Bt = (const bf16_t*)(wl + W_IN); M = T_ALL; N = INC; K = DM; }
            else if (kind == 1) { A = (const bf16_t*)(wl + W_IN) + (size_t)1280 * DM; Bt = FP(WS_XN, bf16_t); M = 256; N = T_ALL; K = DM; }
            else if (kind == 2) { A = FP(WS_CV, bf16_t) + (size_t)row_lo * 256; Bt = (const bf16_t*)(wl + W_PW); M = M_post; N = 256; K = 256; }
            else if (kind == 3) { A = FP(WS_FN, bf16_t) + (size_t)row_lo * 256; Bt = (const bf16_t*)(wl + W_F); M = M_post; N = 256; K = 256; }
            else if (kind == 4) { A = FP(WS_YS, bf16_t) + (size_t)row_lo * 256; Bt = (const bf16_t*)(wl + W_GLU); M = M_post; N = 512; K = 256; }
            else if (kind == 5) { A = FP(WS_XN, bf16_t) + (size_t)row_lo * DM; Bt = (const bf16_t*)(wl + W_1); M = M_post; N = FFD; K = DM; }
            else if (kind == 6) { A = FP(WS_XN, bf16_t) + (size_t)row_lo * DM; Bt = (const bf16_t*)(wl + W_OUT); M = M_post; N = DM; K = DM; }
            else { A = FP(WS_H, bf16_t) + (size_t)row_lo * FFD; Bt = (const bf16_t*)(wl + W_2); M = M_post; N = DM; K = FFD; }
            pg8::Gemm g{A, Bt, M, N, K}; pg8::StaticOrder S; S.init(M, N, G, bx);
            EpiU E{F, l, kind, row_lo};
            pg8::gemm_phase<EpiU, pg8::StaticOrder, true, true>((PG8_LAS unsigned char*)lds, g, S, E);
        }
        if (wm & (W_FC | W_FA | W_CV)) {
            const int n_fc = (l == 0 && (wm & W_FC)) ? 128 : 0, n_fa = (wm & W_FA) ? 128 : 0, n_cv = (wm & W_CV) ? (l == 0 ? 544 : 512) : 0; const int nbu = n_fc + n_fa + n_cv;
            const int ustart = (n_fa + n_cv == 0) ? (G - 1 - bx) : bx;
#pragma nounroll
            for (int u = ustart; u < nbu; u += G) {
                if (u < n_fc) fnetctx_unit(F, u, scr);
                else if (u < n_fc + n_fa) fnetA_unit(F, u - n_fc, lds);
                else conv_unit(F, l, u - n_fc - n_fa, scr);
            }
        }
        if (wm & W_P2) ssm_pass2(F, l);
        if (wm & W_SSM3) {
#pragma nounroll
            for (int it = gw; it < 4096; it += nw) ssm_item<3>(F, l, it);
            if (G >= 128) { if (wave_ < 2) { const int k = (G - 1 - bx) * 2 + wave_; if (k < 256) ssm_item<3>(F, l, 4096 + k); } }
            else { for (int it = 4096 + gw; it < 4352; it += nw) ssm_item<3>(F, l, it); }
        }
        if (wm & (W_ATT | W_SSM1 | W_FB)) {
            const int n_ac = (l == 0 && (wm & W_ATT)) ? 256 : 0, n_al = (wm & W_ATT) ? 4096 : 0, n_s1 = (wm & W_SSM1) ? 4352 : 0, n_fb = (wm & W_FB) ? 1024 : 0, n_s3 = 0;
            const int e0 = n_ac, e1 = e0 + n_al, e2 = e1 + n_s1, e3 = e2 + n_fb, e4 = e3 + n_s3;
            const int gw_i = ((wm & W_ATT) || ((wm & W_FB) && l == 1)) ? ((G - 1 - bx) * 8 + wave_) : gw;
#pragma nounroll
            for (int it = gw_i; it < e4; it += nw) {
                if (it < e0) attn_item<false>(F, l, it);
                else if (it < e1) attn_item<true>(F, l, it - e0);
                else if (it < e2) ssm_item<1>(F, l, it - e1);
                else if (it < e3) fnetB_item(F, it - e2);
                else { ssm_item<3>(F, l, it - e3); }
            }
        }
        if (wm & W_PREP1) prep_norm_mod(F, l == 0 ? F.A.in[2] : FP(WS_XC, float), l == 0 ? F.A.in[0] : F.out, PK(6) + l * DM, FP(WS_MOD, float) + l * 5 * 6144, 0, 1024, FP(WS_XN, bf16_t), 0);
        if (wm & W_GN) prep_group(F, l, row_lo);
        if (wm & W_PREP3) prep_norm_mod(F, FP(WS_XC, float), F.out, PK(30) + l * DM, FP(WS_MOD, float) + l * 5 * 6144, 3072, 4096, FP(WS_XN, bf16_t), row_lo);
        if (ph0 + 1 < hi) GSYNC();
    }
}

extern "C" void kernel_launch(void* const* d_in, const int* in_sizes, int n_in, void* d_out, int out_size, void* d_ws, size_t ws_size, hipStream_t stream) {
    static int grid = 0;
    if (grid == 0) {
        if (n_in != 36 || ws_size < WS_END) { fprintf(stderr, "kernel_launch: unexpected n_in %d / ws %zu\n", n_in, ws_size); grid = -1; return; }
        int dev = 0, cus = 0, per_cu = 0;
        (void)hipGetDevice(&dev); (void)hipDeviceGetAttribute(&cus, hipDeviceAttributeMultiprocessorCount, dev);
        (void)hipFuncSetAttribute((const void*)fwd, hipFuncAttributeMaxDynamicSharedMemorySize, LDS_BYTES);
        (void)hipOccupancyMaxActiveBlocksPerMultiprocessor(&per_cu, (const void*)fwd, NTHREADS, LDS_BYTES);
        (void)hipGetLastError();
        grid = cus > 0 ? cus : 256;
    }
    if (grid < 0) return;
    Args a{};
    for (int i = 0; i < 36; ++i) a.in[i] = (const float*)d_in[i];
    a.out = (float*)d_out; a.ws = (unsigned char*)d_ws;
#if MODE_COOP
    (void)hipMemsetAsync((unsigned char*)d_ws + WS_BAR, 0, 16384, stream);
    a.ph_lo = 0; a.ph_hi = NPH; a.part = 15;
    void* kargs[] = {&a};
    hipError_t e = hipLaunchCooperativeKernel((const void*)fwd, dim3(grid), dim3(NTHREADS), kargs, LDS_BYTES, stream);
    if (e != hipSuccess) fprintf(stderr, "cooperative launch failed: %s (grid %d)\n", hipGetErrorString(e), grid);
#else
    for (int ph = 0; ph < NPH; ++ph) { a.ph_lo = ph; a.ph_hi = ph + 1; a.part = 15; hipLaunchKernelGGL(fwd, dim3(grid), dim3(NTHREADS), LDS_BYTES, stream, a); }
#endif
}
```
